# Optimizing an MI355X kernel written in HIP

```python
import math
import jax, jax.numpy as jnp
from jax import lax
import numpy as np

D_MODEL = 2048
BATCH = 16
SEQ = 256
DEPTH = 4
DEC_BATCH = 8
DEC_SEQ = 4096
PAST_LEN = 256

GRID_W = 64
N_MIXERS = 4
N_A = (DEPTH + 3) // 4
N_B = (DEPTH + 2) // 4
N_C = (DEPTH + 1) // 4
N_D = DEPTH // 4

NA_HEADS = 16
NA_HEAD_DIM = 128
NA_WIN_ROWS = 8
NA_WIN_COLS = 16
NA_KEY_COLS = 32

LRU_WIDTH = 2688
LRU_BLOCKS = 16
LRU_BLOCK = LRU_WIDTH // LRU_BLOCKS
LRU_CONV = 4
LRU_C = 8.0

MLA_HEADS = 16
MLA_Q_RANK = 768
MLA_KV_RANK = 512
MLA_NOPE = 128
MLA_ROPE = 64
MLA_QK = MLA_NOPE + MLA_ROPE
MLA_V = 128

SWA_HEADS = 32
SWA_KV_HEADS = 4
SWA_HEAD_DIM = 64
SWA_WINDOW = 128
SWA_BLOCK = 128

D_FF = 5632
FFN_CONV = 3

Q_BLOCK = 128
ROPE_BASE = 10000.0
EPS = 1e-6
NEG = -1e30

kernel_name = 'hybrid_diffusion_trunk_step'


def rms_norm(x, g):
    xf = x.astype(jnp.float32)
    y = xf * lax.rsqrt(jnp.mean(xf * xf, axis=-1, keepdims=True) + EPS)
    return (y * g.astype(jnp.float32)).astype(x.dtype)


def modulation(cond, w_mod, b_mod):
    m = jax.nn.silu(cond) @ w_mod + b_mod
    return jnp.split(m[:, None, :], 6, axis=-1)


def modulate(x, shift, scale):
    return x * (1 + scale) + shift


def dwconv_centred(x, w, b):
    K = w.shape[0]
    S = x.shape[1]
    left = K // 2
    xp = jnp.pad(x, ((0, 0), (left, K - 1 - left), (0, 0)))
    out = b
    for k in range(K):
        out = out + xp[:, k:k + S] * w[k]
    return out


def axial_rope_tables(n_tokens, rot_dim):
    t = jnp.arange(n_tokens)
    row = (t // GRID_W).astype(jnp.float32)
    col = (t % GRID_W).astype(jnp.float32)
    half = rot_dim // 2
    inv = ROPE_BASE ** (-jnp.arange(0, half, 2, dtype=jnp.float32) / half)
    ar = row[:, None] * inv
    ac = col[:, None] * inv
    ang = jnp.concatenate([ar, ar, ac, ac], axis=-1)
    return jnp.cos(ang), jnp.sin(ang)


def rotate_half(z):
    z1, z2 = jnp.split(z, 2, axis=-1)
    return jnp.concatenate([-z2, z1], axis=-1)


def apply_axial_rope(x, cos, sin):
    xf = x.astype(jnp.float32)
    xr, xc = jnp.split(xf, 2, axis=-1)
    rot = jnp.concatenate([rotate_half(xr), rotate_half(xc)], axis=-1)
    return (xf * cos + rot * sin).astype(x.dtype)


def rope_tail(x, cos, sin):
    n = cos.shape[-1]
    return jnp.concatenate([x[..., :-n], apply_axial_rope(x[..., -n:], cos, sin)], axis=-1)


def attn_probs(s, sink=None):
    s = s.astype(jnp.float32)
    m = jnp.max(s, axis=-1, keepdims=True)
    if sink is not None:
        m = jnp.maximum(m, sink)
    e = jnp.exp(s - m)
    den = jnp.sum(e, axis=-1, keepdims=True)
    if sink is not None:
        den = den + jnp.exp(sink - m)
    return e / den


def joint_probs(s_a, s_b, sink=None):
    p = attn_probs(jnp.concatenate([s_a.astype(jnp.float32), s_b.astype(jnp.float32)], axis=-1), sink)
    n = s_a.shape[-1]
    return p[..., :n], p[..., n:]


def dense_attention(q, k, v):
    s = jnp.einsum('bhqd,bhkd->bhqk', q, k).astype(jnp.float32) * (q.shape[-1] ** -0.5)
    p = attn_probs(s)
    return jnp.einsum('bhqk,bhkd->bhqd', p.astype(v.dtype), v)


def merge_heads(o, w_o):
    B, H, S, Dh = o.shape
    return o.transpose(0, 2, 1, 3).reshape(B, S, H * Dh) @ w_o


def natten_qkv(h, w_qkv, g_q, g_k):
    B, S, _ = h.shape
    qkv = (h @ w_qkv).reshape(B, S, 3, NA_HEADS, NA_HEAD_DIM)
    q = rms_norm(qkv[:, :, 0], g_q).transpose(0, 2, 1, 3)
    k = rms_norm(qkv[:, :, 1], g_k).transpose(0, 2, 1, 3)
    v = qkv[:, :, 2].transpose(0, 2, 1, 3)
    return q, k, v


def natten_context(h, w_qkv, g_q, g_k, w_o):
    q, k, v = natten_qkv(h, w_qkv, g_q, g_k)
    return merge_heads(dense_attention(q, k, v), w_o), k, v


def natten_latent(h, k_ctx, v_ctx, w_qkv, g_q, g_k, rpb, w_o):
    B, N, _ = h.shape
    H, Dh = NA_HEADS, NA_HEAD_DIM
    rows = N // GRID_W
    wr = min(NA_WIN_ROWS, rows)
    ncb = GRID_W // NA_WIN_COLS
    scale = Dh ** -0.5
    q, k, v = natten_qkv(h, w_qkv, g_q, g_k)
    qg = q.reshape(B, H, rows, GRID_W, Dh)
    kg = k.reshape(B, H, rows, GRID_W, Dh)
    vg = v.reshape(B, H, rows, GRID_W, Dh)
    qcol = np.arange(GRID_W).reshape(ncb, NA_WIN_COLS)
    kcol = np.clip(qcol[:, :1] - NA_WIN_COLS // 2, 0, GRID_W - NA_KEY_COLS) + np.arange(NA_KEY_COLS)
    cstart = np.clip(qcol - NA_WIN_COLS // 2, 0, GRID_W - NA_WIN_COLS)
    kc = kcol[:, None, :]
    col_mask = (kc >= cstart[:, :, None]) & (kc < cstart[:, :, None] + NA_WIN_COLS)
    dc_idx = np.clip(kc - qcol[:, :, None], 1 - NA_WIN_COLS, NA_WIN_COLS - 1) + NA_WIN_COLS - 1
    mask = jnp.asarray(np.broadcast_to(col_mask[:, :, None, :], (ncb, NA_WIN_COLS, wr, NA_KEY_COLS)).reshape(ncb, NA_WIN_COLS, wr * NA_KEY_COLS))

    def row_block(r):
        rs = jnp.clip(r - wr // 2, 0, rows - wr)

        def gather(z):
            zr = lax.dynamic_slice_in_dim(z, rs, wr, axis=2)[:, :, :, kcol]
            return zr.transpose(0, 1, 3, 2, 4, 5).reshape(B, H, ncb, wr * NA_KEY_COLS, Dh)

        kb, vb = gather(kg), gather(vg)
        qr = lax.dynamic_index_in_dim(qg, r, axis=2, keepdims=False).reshape(B, H, ncb, NA_WIN_COLS, Dh)
        dr_idx = rs + jnp.arange(wr) - r + NA_WIN_ROWS - 1
        bias = rpb[:, dr_idx][:, :, dc_idx].transpose(0, 2, 3, 1, 4).reshape(H, ncb, NA_WIN_COLS, wr * NA_KEY_COLS)
        s_loc = jnp.einsum('bhnqd,bhnkd->bhnqk', qr, kb).astype(jnp.float32) * scale + bias.astype(jnp.float32)
        s_loc = jnp.where(mask, s_loc, NEG)
        s_ctx = jnp.einsum('bhnqd,bhkd->bhnqk', qr, k_ctx).astype(jnp.float32) * scale
        p_loc, p_ctx = joint_probs(s_loc, s_ctx)
        o = (jnp.einsum('bhnqk,bhnkd->bhnqd', p_loc.astype(v.dtype), vb)
             + jnp.einsum('bhnqk,bhkd->bhnqd', p_ctx.astype(v.dtype), v_ctx))
        return o.reshape(B, H, GRID_W, Dh)

    o = lax.map(row_block, jnp.arange(rows))
    o = o.transpose(1, 2, 0, 3, 4).reshape(B, H, N, Dh)
    return merge_heads(o, w_o)


def lru_gates(xc, w_a, b_a, w_i, b_i, lam):
    B, S, C = xc.shape
    xb = xc.reshape(B, S, LRU_BLOCKS, LRU_BLOCK)
    r = jax.nn.sigmoid((jnp.einsum('bsnk,nkj->bsnj', xb, w_a).reshape(B, S, C) + b_a).astype(jnp.float32))
    i = jax.nn.sigmoid((jnp.einsum('bsnk,nkj->bsnj', xb, w_i).reshape(B, S, C) + b_i).astype(jnp.float32))
    log_a = -LRU_C * r * jax.nn.softplus(-lam.astype(jnp.float32))
    a = jnp.exp(log_a)
    bx = jnp.sqrt(-jnp.expm1(2.0 * log_a)) * (i * xc.astype(jnp.float32))
    return a, bx


def lru_scan(a, bx, h0, reverse):
    def step(hc, ab):
        hc = ab[0] * hc + ab[1]
        return hc, hc
    h_last, hs = lax.scan(step, h0, (jnp.swapaxes(a, 0, 1), jnp.swapaxes(bx, 0, 1)), reverse=reverse)
    return jnp.swapaxes(hs, 0, 1), h_last


def rglru_mixer(h, h0, w_in, conv_w, conv_b, w_a, b_a, w_i, b_i, lam, w_out):
    xb, gate = jnp.split(h @ w_in, 2, axis=-1)
    xc = dwconv_centred(xb, conv_w, conv_b)
    h0 = h0.astype(jnp.float32)
    a_f, b_f = lru_gates(xc, w_a[0], b_a[0], w_i[0], b_i[0], lam[0])
    hs_f, hT_f = lru_scan(a_f, b_f, h0[:, 0], False)
    a_b, b_b = lru_gates(xc, w_a[1], b_a[1], w_i[1], b_i[1], lam[1])
    hs_b, hT_b = lru_scan(a_b, b_b, h0[:, 1], True)
    y = (jax.nn.gelu(gate) * (hs_f + hs_b).astype(h.dtype)) @ w_out
    return y, jnp.stack([hT_f, hT_b], axis=1).astype(h.dtype)


def mla_down(h, w_down, g_qa, g_kva):
    d = h @ w_down
    cq = rms_norm(d[..., :MLA_Q_RANK], g_qa)
    ckv = rms_norm(d[..., MLA_Q_RANK:MLA_Q_RANK + MLA_KV_RANK], g_kva)
    k_rope = d[..., MLA_Q_RANK + MLA_KV_RANK:]
    return cq, ckv, k_rope


def mla_queries(cq, w_uq, g_q):
    B, S, _ = cq.shape
    q = (cq @ w_uq).reshape(B, S, MLA_HEADS, MLA_QK)
    return rms_norm(q, g_q).transpose(0, 2, 1, 3)


def mla_keys_values(ckv, k_rope, w_ukv, g_k):
    B, S, _ = ckv.shape
    kv = (ckv @ w_ukv).reshape(B, S, MLA_HEADS, MLA_NOPE + MLA_V)
    kr = jnp.broadcast_to(k_rope[:, :, None, :], (B, S, MLA_HEADS, MLA_ROPE))
    k = rms_norm(jnp.concatenate([kv[..., :MLA_NOPE], kr], axis=-1), g_k).transpose(0, 2, 1, 3)
    v = kv[..., MLA_NOPE:].transpose(0, 2, 1, 3)
    return k, v


def mla_context(h, w_down, g_qa, g_kva, w_uq, w_ukv, g_q, g_k, w_o):
    cq, ckv, kr = mla_down(h, w_down, g_qa, g_kva)
    q = mla_queries(cq, w_uq, g_q)
    k, v = mla_keys_values(ckv, kr, w_ukv, g_k)
    return merge_heads(dense_attention(q, k, v), w_o), ckv, kr


def blocked_joint_attention(q, k, v, k_ctx, v_ctx):
    B, H, N, Dq = q.shape
    nb = N // Q_BLOCK
    scale = Dq ** -0.5
    qb = q.reshape(B, H, nb, Q_BLOCK, Dq).transpose(2, 0, 1, 3, 4)

    def block(qi):
        s_lat = jnp.einsum('bhqd,bhkd->bhqk', qi, k).astype(jnp.float32) * scale
        s_ctx = jnp.einsum('bhqd,bhkd->bhqk', qi, k_ctx).astype(jnp.float32) * scale
        p_lat, p_ctx = joint_probs(s_lat, s_ctx)
        return (jnp.einsum('bhqk,bhkd->bhqd', p_lat.astype(v.dtype), v)
                + jnp.einsum('bhqk,bhkd->bhqd', p_ctx.astype(v.dtype), v_ctx))

    o = lax.map(block, qb)
    return o.transpose(1, 2, 0, 3, 4).reshape(B, H, N, v.shape[-1])


def mla_latent(h, ckv_ctx, kr_ctx, w_down, g_qa, g_kva, w_uq, w_ukv, g_q, g_k, w_o):
    N = h.shape[1]
    cos, sin = axial_rope_tables(N, MLA_ROPE)
    cq, ckv, kr = mla_down(h, w_down, g_qa, g_kva)
    q = rope_tail(mla_queries(cq, w_uq, g_q), cos, sin)
    k, v = mla_keys_values(ckv, kr, w_ukv, g_k)
    k = rope_tail(k, cos, sin)
    kc, vc = mla_keys_values(ckv_ctx, kr_ctx, w_ukv, g_k)
    return merge_heads(blocked_joint_attention(q, k, v, kc, vc), w_o)


def swa_qkv(h, w_qkv, g_q, g_k, cos=None, sin=None):
    B, S, _ = h.shape
    G = SWA_HEADS // SWA_KV_HEADS
    qkv = (h @ w_qkv).reshape(B, S, SWA_HEADS + 2 * SWA_KV_HEADS, SWA_HEAD_DIM)
    q = rms_norm(qkv[:, :, :SWA_HEADS], g_q).reshape(B, S, SWA_KV_HEADS, G, SWA_HEAD_DIM).transpose(0, 2, 3, 1, 4)
    k = rms_norm(qkv[:, :, SWA_HEADS:SWA_HEADS + SWA_KV_HEADS], g_k).transpose(0, 2, 1, 3)
    v = qkv[:, :, SWA_HEADS + SWA_KV_HEADS:].transpose(0, 2, 1, 3)
    if cos is not None:
        q = apply_axial_rope(q, cos, sin)
        k = apply_axial_rope(k, cos, sin)
    return q, k, v


def swa_merge(o, w_o):
    B, KVH, G, S, Dh = o.shape
    return o.transpose(0, 3, 1, 2, 4).reshape(B, S, KVH * G * Dh) @ w_o


def swa_context(h, w_qkv, g_q, g_k, sinks, w_o):
    q, k, v = swa_qkv(h, w_qkv, g_q, g_k)
    sink = sinks.astype(jnp.float32).reshape(SWA_KV_HEADS, -1, 1, 1)
    s = jnp.einsum('bkgqd,bksd->bkgqs', q, k).astype(jnp.float32) * (SWA_HEAD_DIM ** -0.5)
    p = attn_probs(s, sink)
    o = jnp.einsum('bkgqs,bksd->bkgqd', p.astype(v.dtype), v)
    return swa_merge(o, w_o), k, v


def swa_latent(h, k_ctx, v_ctx, w_qkv, g_q, g_k, sinks, w_o):
    B, N, _ = h.shape
    G = SWA_HEADS // SWA_KV_HEADS
    nb = N // SWA_BLOCK
    scale = SWA_HEAD_DIM ** -0.5
    cos, sin = axial_rope_tables(N, SWA_HEAD_DIM)
    q, k, v = swa_qkv(h, w_qkv, g_q, g_k, cos, sin)
    sink = sinks.astype(jnp.float32).reshape(SWA_KV_HEADS, G, 1, 1)
    pad = ((0, 0), (0, 0), (SWA_BLOCK, SWA_BLOCK), (0, 0))
    kp, vp = jnp.pad(k, pad), jnp.pad(v, pad)
    qb = q.reshape(B, SWA_KV_HEADS, G, nb, SWA_BLOCK, SWA_HEAD_DIM).transpose(3, 0, 1, 2, 4, 5)

    def block(args):
        qi, b = args
        kb = lax.dynamic_slice_in_dim(kp, b * SWA_BLOCK, 3 * SWA_BLOCK, axis=2)
        vb = lax.dynamic_slice_in_dim(vp, b * SWA_BLOCK, 3 * SWA_BLOCK, axis=2)
        qpos = b * SWA_BLOCK + jnp.arange(SWA_BLOCK)
        kpos = (b - 1) * SWA_BLOCK + jnp.arange(3 * SWA_BLOCK)
        mask = (jnp.abs(qpos[:, None] - kpos[None, :]) <= SWA_WINDOW) & (kpos[None, :] >= 0) & (kpos[None, :] < N)
        s_loc = jnp.where(mask, jnp.einsum('bkgqd,bksd->bkgqs', qi, kb).astype(jnp.float32) * scale, NEG)
        s_ctx = jnp.einsum('bkgqd,bksd->bkgqs', qi, k_ctx).astype(jnp.float32) * scale
        p_loc, p_ctx = joint_probs(s_loc, s_ctx, sink)
        return (jnp.einsum('bkgqs,bksd->bkgqd', p_loc.astype(v.dtype), vb)
                + jnp.einsum('bkgqs,bksd->bkgqd', p_ctx.astype(v.dtype), v_ctx))

    o = lax.map(block, (qb, jnp.arange(nb)))
    o = o.transpose(1, 2, 3, 0, 4, 5).reshape(B, SWA_KV_HEADS, G, N, SWA_HEAD_DIM)
    return swa_merge(o, w_o)


def conv_ffn(h, w_in, conv_w, conv_b, w_out):
    a, b = jnp.split(h @ w_in, 2, axis=-1)
    a = dwconv_centred(a, conv_w, conv_b)
    return (jax.nn.silu(a) * b) @ w_out


def setup_inputs(seed: int = 0) -> dict:
    key = jax.random.key(seed)
    ks = iter(jax.random.split(key, 64))

    def nrm(shape, scale=1.0):
        return jax.random.normal(next(ks), shape, jnp.float32) * scale

    def gain(shape):
        return 1.0 + nrm(shape, 0.02)

    D = D_MODEL
    u = jax.random.uniform(next(ks), (N_B, 2, LRU_WIDTH), jnp.float32, minval=0.9, maxval=0.999)
    a0 = u ** (1.0 / LRU_C)
    lam = jnp.log(a0) - jnp.log1p(-a0)
    return {
        'x_prompt': nrm((BATCH, SEQ, D)),
        'x_sample': nrm((DEC_BATCH, DEC_SEQ, D)),
        'cache_nat_k': nrm((DEC_BATCH, N_A, NA_HEADS, PAST_LEN, NA_HEAD_DIM)),
        'cache_nat_v': nrm((DEC_BATCH, N_A, NA_HEADS, PAST_LEN, NA_HEAD_DIM)),
        'state_lru': nrm((DEC_BATCH, N_B, 2, LRU_WIDTH), 0.5),
        'cache_mla_ckv': nrm((DEC_BATCH, N_C, PAST_LEN, MLA_KV_RANK)),
        'cache_mla_krope': nrm((DEC_BATCH, N_C, PAST_LEN, MLA_ROPE)),
        'cache_swa_k': nrm((DEC_BATCH, N_D, SWA_KV_HEADS, PAST_LEN, SWA_HEAD_DIM)),
        'cache_swa_v': nrm((DEC_BATCH, N_D, SWA_KV_HEADS, PAST_LEN, SWA_HEAD_DIM)),
        'c': nrm((DEC_BATCH, D)),
        'c_ctx': nrm((D,)),
        'norm_mix': gain((DEPTH, D)),
        'norm_ffn': gain((DEPTH, D)),
        'w_mod': nrm((DEPTH, D, 6 * D), 0.5 * D ** -0.5),
        'b_mod': nrm((DEPTH, 6 * D), 0.02),
        'ffn_w_in': nrm((DEPTH, D, 2 * D_FF), D ** -0.5),
        'ffn_conv_w': nrm((DEPTH, FFN_CONV, D_FF), FFN_CONV ** -0.5),
        'ffn_conv_b': nrm((DEPTH, D_FF), 0.02),
        'ffn_w_out': nrm((DEPTH, D_FF, D), D_FF ** -0.5),
        'nat_w_qkv': nrm((N_A, D, 3 * NA_HEADS * NA_HEAD_DIM), D ** -0.5),
        'nat_q_norm': gain((N_A, NA_HEAD_DIM)),
        'nat_k_norm': gain((N_A, NA_HEAD_DIM)),
        'nat_rpb': nrm((N_A, NA_HEADS, 2 * NA_WIN_ROWS - 1, 2 * NA_WIN_COLS - 1), 0.1),
        'nat_w_o': nrm((N_A, NA_HEADS * NA_HEAD_DIM, D), (NA_HEADS * NA_HEAD_DIM) ** -0.5),
        'lru_w_in': nrm((N_B, D, 2 * LRU_WIDTH), D ** -0.5),
        'lru_conv_w': nrm((N_B, LRU_CONV, LRU_WIDTH), LRU_CONV ** -0.5),
        'lru_conv_b': nrm((N_B, LRU_WIDTH), 0.02),
        'lru_w_a': nrm((N_B, 2, LRU_BLOCKS, LRU_BLOCK, LRU_BLOCK), LRU_BLOCK ** -0.5),
        'lru_b_a': nrm((N_B, 2, LRU_WIDTH), 0.02),
        'lru_w_i': nrm((N_B, 2, LRU_BLOCKS, LRU_BLOCK, LRU_BLOCK), LRU_BLOCK ** -0.5),
        'lru_b_i': nrm((N_B, 2, LRU_WIDTH), 0.02),
        'lru_lambda': lam,
        'lru_w_out': nrm((N_B, LRU_WIDTH, D), LRU_WIDTH ** -0.5),
        'mla_w_down': nrm((N_C, D, MLA_Q_RANK + MLA_KV_RANK + MLA_ROPE), D ** -0.5),
        'mla_q_a_norm': gain((N_C, MLA_Q_RANK)),
        'mla_kv_a_norm': gain((N_C, MLA_KV_RANK)),
        'mla_w_uq': nrm((N_C, MLA_Q_RANK, MLA_HEADS * MLA_QK), MLA_Q_RANK ** -0.5),
        'mla_w_ukv': nrm((N_C, MLA_KV_RANK, MLA_HEADS * (MLA_NOPE + MLA_V)), MLA_KV_RANK ** -0.5),
        'mla_q_norm': gain((N_C, MLA_QK)),
        'mla_k_norm': gain((N_C, MLA_QK)),
        'mla_w_o': nrm((N_C, MLA_HEADS * MLA_V, D), (MLA_HEADS * MLA_V) ** -0.5),
        'swa_w_qkv': nrm((N_D, D, (SWA_HEADS + 2 * SWA_KV_HEADS) * SWA_HEAD_DIM), D ** -0.5),
        'swa_q_norm': gain((N_D, SWA_HEAD_DIM)),
        'swa_k_norm': gain((N_D, SWA_HEAD_DIM)),
        'swa_sinks': nrm((N_D, SWA_HEADS)),
        'swa_w_o': nrm((N_D, SWA_HEADS * SWA_HEAD_DIM, D), (SWA_HEADS * SWA_HEAD_DIM) ** -0.5),
    }


def reference(x_prompt, x_sample, cache_nat_k, cache_nat_v, state_lru, cache_mla_ckv, cache_mla_krope,
              cache_swa_k, cache_swa_v, c, c_ctx, norm_mix, norm_ffn, w_mod, b_mod, ffn_w_in, ffn_conv_w,
              ffn_conv_b, ffn_w_out, nat_w_qkv, nat_q_norm, nat_k_norm, nat_rpb, nat_w_o, lru_w_in, lru_conv_w,
              lru_conv_b, lru_w_a, lru_b_a, lru_w_i, lru_b_i, lru_lambda, lru_w_out, mla_w_down, mla_q_a_norm,
              mla_kv_a_norm, mla_w_uq, mla_w_ukv, mla_q_norm, mla_k_norm, mla_w_o, swa_w_qkv, swa_q_norm,
              swa_k_norm, swa_sinks, swa_w_o):
    xp, xs = x_prompt, x_sample
    nat_k_l, nat_v_l, lru_l, ckv_l, krope_l, swa_k_l, swa_v_l = [], [], [], [], [], [], []
    for l in range(DEPTH):
        kind, j = l % N_MIXERS, l // N_MIXERS
        mp = modulation(c_ctx[None, :], w_mod[l], b_mod[l])
        ms = modulation(c, w_mod[l], b_mod[l])
        hp = modulate(rms_norm(xp, norm_mix[l]), mp[0], mp[1])
        hs = modulate(rms_norm(xs, norm_mix[l]), ms[0], ms[1])
        if kind == 0:
            yp, kc, vc = natten_context(hp, nat_w_qkv[j], nat_q_norm[j], nat_k_norm[j], nat_w_o[j])
            ys = natten_latent(hs, cache_nat_k[:, j], cache_nat_v[:, j], nat_w_qkv[j], nat_q_norm[j],
                               nat_k_norm[j], nat_rpb[j], nat_w_o[j])
            nat_k_l.append(kc)
            nat_v_l.append(vc)
        elif kind == 1:
            lru_args = (lru_w_in[j], lru_conv_w[j], lru_conv_b[j], lru_w_a[j], lru_b_a[j], lru_w_i[j],
                        lru_b_i[j], lru_lambda[j], lru_w_out[j])
            h0 = jnp.zeros((hp.shape[0], 2, LRU_WIDTH), jnp.float32)
            yp, st = rglru_mixer(hp, h0, *lru_args)
            ys, _ = rglru_mixer(hs, state_lru[:, j], *lru_args)
            lru_l.append(st)
        elif kind == 2:
            yp, ckv, kr = mla_context(hp, mla_w_down[j], mla_q_a_norm[j], mla_kv_a_norm[j], mla_w_uq[j],
                                      mla_w_ukv[j], mla_q_norm[j], mla_k_norm[j], mla_w_o[j])
            ys = mla_latent(hs, cache_mla_ckv[:, j], cache_mla_krope[:, j], mla_w_down[j], mla_q_a_norm[j],
                            mla_kv_a_norm[j], mla_w_uq[j], mla_w_ukv[j], mla_q_norm[j], mla_k_norm[j], mla_w_o[j])
            ckv_l.append(ckv)
            krope_l.append(kr)
        else:
            yp, kc, vc = swa_context(hp, swa_w_qkv[j], swa_q_norm[j], swa_k_norm[j], swa_sinks[j], swa_w_o[j])
            ys = swa_latent(hs, cache_swa_k[:, j], cache_swa_v[:, j], swa_w_qkv[j], swa_q_norm[j],
                            swa_k_norm[j], swa_sinks[j], swa_w_o[j])
            swa_k_l.append(kc)
            swa_v_l.append(vc)
        xp = xp + mp[2] * yp
        xs = xs + ms[2] * ys
        hp = modulate(rms_norm(xp, norm_ffn[l]), mp[3], mp[4])
        hs = modulate(rms_norm(xs, norm_ffn[l]), ms[3], ms[4])
        xp = xp + mp[5] * conv_ffn(hp, ffn_w_in[l], ffn_conv_w[l], ffn_conv_b[l], ffn_w_out[l])
        xs = xs + ms[5] * conv_ffn(hs, ffn_w_in[l], ffn_conv_w[l], ffn_conv_b[l], ffn_w_out[l])
    new_nat_k = jnp.stack(nat_k_l, axis=1)
    new_nat_v = jnp.stack(nat_v_l, axis=1)
    new_lru = jnp.stack(lru_l, axis=1)
    new_ckv = jnp.stack(ckv_l, axis=1)
    new_krope = jnp.stack(krope_l, axis=1)
    new_swa_k = jnp.stack(swa_k_l, axis=1)
    new_swa_v = jnp.stack(swa_v_l, axis=1)
    return (xp, xs, new_nat_k, new_nat_v, new_lru, new_ckv, new_krope, new_swa_k, new_swa_v)
```

```cpp
#include <hip/hip_runtime.h>
#include <cstdio>
#include <cstdint>
#include <math.h>
namespace pg8 {
#define PG8_LAS __attribute__((address_space(3)))
typedef unsigned short bf16_t;
typedef short bf16x8 __attribute__((ext_vector_type(8)));
typedef float f32x4 __attribute__((ext_vector_type(4)));
typedef unsigned u32x4 __attribute__((ext_vector_type(4)));
constexpr int BM = 256, BK = 64, HALF = 128, HTB = HALF * BK * 2  , STAGE_BYTES = 8 * HTB, NXCD = 8, WGM = 8;

__host__ __device__ __forceinline__ int lds_byte(int r, int c) { const int st = (r >> 4) * 2 + (c >> 5), rr = r & 15, cc = c & 31, ob = rr * 64 + cc * 2; return st * 1024 + (ob ^ (((ob >> 9) & 1) << 5)); }
__host__ __device__ __forceinline__ void stage_rc(int b, int& R, int& C) { const int st = b / 1024, sb = b % 1024, swz = sb ^ (((sb >> 9) & 1) << 5); R = (st >> 1) * 16 + swz / 64; C = (st & 1) * 32 + (swz % 64) / 2; }
__host__ __device__ __forceinline__ int perm32(int rho) { const int n = rho >> 4, i = rho & 15; return 8 * (i >> 2) + 4 * n + (i & 3); }

struct Unit { int pm, pn; };
struct Gemm { const bf16_t* A; const bf16_t* Bt; int M, N, K, lda, ldb, pad; };

struct StaticOrder {
    int nM, nN, nwg, G, c;
    __host__ __device__ void init(int M, int N, int G_, int c_) { nM = M / BM; nN = N / BM; nwg = nM * nN; G = G_; c = c_; }
    __host__ __device__ bool next(int i, Unit& u) const {
        const long L = (long)i * G + c; if (L >= nwg) return false;
        int wgid = (int)L; { const int q = nwg / NXCD, r = nwg % NXCD, xcd = wgid % NXCD, off = wgid / NXCD; wgid = (xcd < r ? xcd * (q + 1) : r * (q + 1) + (xcd - r) * q) + off; }
        const int nig = WGM * nN, gid = wgid / nig, fm = gid * WGM, gsz = (nM - fm) < WGM ? (nM - fm) : WGM;
        u.pm = fm + ((wgid % nig) % gsz); u.pn = (wgid % nig) / gsz; return true;
    }
    __device__ __forceinline__ void a_ready(const Unit&) const {}
    __device__ __forceinline__ void done(const Unit&) const {}
};

__device__ __forceinline__ unsigned cvt_pk_bf16(float lo, float hi) { unsigned r; asm volatile("v_cvt_pk_bf16_f32 %0, %1, %2" : "=v"(r) : "v"(lo), "v"(hi)); return r; }
typedef float f32x2 __attribute__((ext_vector_type(2)));
__device__ __forceinline__ f32x2 gelu_pk(f32x2 v) {
    const f32x2 av = __builtin_elementwise_abs(v), d = av * 0.2316418882f + 1.0f;
    f32x2 t; t.x = __builtin_amdgcn_rcpf(d.x); t.y = __builtin_amdgcn_rcpf(d.y);
    f32x2 q = t * 0.5307027145f + (-0.7265760135f); q = q * t + 0.7107068705f; q = q * t + (-0.142248368f); q = q * t + 0.127414796f; q = q * t;
    const f32x2 s = (v * v) * (-0.72134752044f);
    f32x2 e; e.x = __builtin_amdgcn_exp2f(s.x); e.y = __builtin_amdgcn_exp2f(s.y);
    const f32x2 m = v * (q * e), r = v - m;
    f32x2 o; o.x = v.x < 0.f ? m.x : r.x; o.y = v.y < 0.f ? m.y : r.y; return o;
}

template <int ACT  > struct EpiBf16 {
    static constexpr bool PERM = true, AFTER_DRAIN = false; static_assert(ACT == 0 || ACT == 1, "EpiBf16: ACT is 0 (none) or 1 (gelu_pk)");
    bf16_t* O; int ldc; const float* bias; int split_cols; size_t split_stride; float scale0;
    __device__ __forceinline__ void operator()(const f32x4 (&acc)[2][2][4][2], const Unit& u, int wr, int wc, int fr, int fq) const {
        const int row0 = u.pm * BM + wr * 64 + fr; int colt = u.pn * BM; bf16_t* base = O;
        float sc = 1.f; if (split_cols) { const int t = colt / split_cols; base += (size_t)t * split_stride; colt -= t * split_cols; if (t == 0) sc = scale0; }
        const int col0 = colt + wc * 32 + 8 * fq, bcol0 = u.pn * BM + wc * 32 + 8 * fq;
        f32x4 bv[2][2];
#pragma unroll
        for (int bj = 0; bj < 2; ++bj)
#pragma unroll
            for (int n = 0; n < 2; ++n) bv[bj][n] = bias ? *(const f32x4*)(bias + bcol0 + bj * HALF + 4 * n) : (f32x4){0.f, 0.f, 0.f, 0.f};
#pragma unroll
        for (int ai = 0; ai < 2; ++ai)
#pragma unroll
            for (int m = 0; m < 4; ++m) { bf16_t* rowp = base + (size_t)(row0 + ai * HALF + m * 16) * ldc + col0;
#pragma unroll
                for (int bj = 0; bj < 2; ++bj) { f32x4 v0 = acc[ai][bj][m][0] + bv[bj][0], v1 = acc[ai][bj][m][1] + bv[bj][1];
                    if (ACT == 1) { f32x2 a = gelu_pk((f32x2){v0[0], v0[1]}), b = gelu_pk((f32x2){v0[2], v0[3]}), c = gelu_pk((f32x2){v1[0], v1[1]}), d = gelu_pk((f32x2){v1[2], v1[3]});
                        v0 = (f32x4){a.x, a.y, b.x, b.y}; v1 = (f32x4){c.x, c.y, d.x, d.y}; }
                    v0 = v0 * sc; v1 = v1 * sc; u32x4 w; w.x = cvt_pk_bf16(v0[0], v0[1]); w.y = cvt_pk_bf16(v0[2], v0[3]); w.z = cvt_pk_bf16(v1[0], v1[1]); w.w = cvt_pk_bf16(v1[2], v1[3]);
                    *(u32x4*)(rowp + bj * HALF) = w; } }
    }
};


struct EpiF32 {
    static constexpr bool PERM = false, AFTER_DRAIN = false;
    float* C; int ldc;
    __device__ __forceinline__ void operator()(const f32x4 (&acc)[2][2][4][2], const Unit& u, int wr, int wc, int fr, int fq) const {
        const int row0 = u.pm * BM + wr * 64 + fr, col0 = u.pn * BM + wc * 32 + 4 * fq;
#pragma unroll
        for (int ai = 0; ai < 2; ++ai)
#pragma unroll
            for (int m = 0; m < 4; ++m) { float* rowp = C + (size_t)(row0 + ai * HALF + m * 16) * ldc + col0;
#pragma unroll
                for (int bj = 0; bj < 2; ++bj)
#pragma unroll
                    for (int n = 0; n < 2; ++n) *(f32x4*)(rowp + bj * HALF + n * 16) = acc[ai][bj][m][n]; }
    }
};
struct PanelStats {
    unsigned* xbuf;
    unsigned* cnt;
    unsigned* tmo;
    int ntn; float eps;
    unsigned code;
    __device__ __forceinline__ bool run(const f32x4 (&v)[2][2][4][2], const Unit& u, int wr, int wc, int fr, int fq, PG8_LAS unsigned char* lds, int wid, int lane) const {
        typedef float f32x2v __attribute__((ext_vector_type(2)));
        PG8_LAS f32x2v* P = (PG8_LAS f32x2v*)lds;
        PG8_LAS f32x2v* S = (PG8_LAS f32x2v*)(lds + 8192);
        PG8_LAS unsigned* flag = (PG8_LAS unsigned*)(lds + 8192 + 2048);
#pragma unroll
        for (int ai = 0; ai < 2; ++ai)
#pragma unroll
            for (int m = 0; m < 4; ++m) {
                float s = 0.f;
#pragma unroll
                for (int bj = 0; bj < 2; ++bj)
#pragma unroll
                    for (int n = 0; n < 2; ++n) { const f32x4 x = v[ai][bj][m][n]; s += (x[0] + x[1]) + (x[2] + x[3]); }
                s += __shfl_xor(s, 16); s += __shfl_xor(s, 32);
                const float mw = s * (1.0f / 64.0f); float q = 0.f;
#pragma unroll
                for (int bj = 0; bj < 2; ++bj)
#pragma unroll
                    for (int n = 0; n < 2; ++n) { const f32x4 d = v[ai][bj][m][n] - mw; q += (d[0] * d[0] + d[1] * d[1]) + (d[2] * d[2] + d[3] * d[3]); }
                q += __shfl_xor(q, 16); q += __shfl_xor(q, 32);
                if (fq == 0) P[(ai * HALF + wr * 64 + m * 16 + fr) * 4 + wc] = (f32x2v){mw, q};
            }
        asm volatile("s_waitcnt lgkmcnt(0)" ::: "memory"); __builtin_amdgcn_s_barrier(); asm volatile("" ::: "memory");
#if defined(BROKEN_EXCHANGE_NO_WAIT)
#warning BROKEN CONTROL BUILD: the row-statistics exchange does not wait; results are wrong by design
        if (blockIdx.x >= 64) { const long long t0_ = clock64(); while (clock64() - t0_ < 60000) __builtin_amdgcn_s_sleep(8); }
#endif
        const int row = wid * 32 + (lane & 31);
        if (lane < 32) {
            const f32x2v a = P[row * 4 + 0], b = P[row * 4 + 1], c = P[row * 4 + 2], d = P[row * 4 + 3];
            const float mt = (a.x + b.x + c.x + d.x) * 0.25f;
            const float da = a.x - mt, db = b.x - mt, dc = c.x - mt, dd = d.x - mt;
            const float m2 = (a.y + b.y) + (c.y + d.y) + 64.0f * ((da * da + db * db) + (dc * dc + dd * dd));
            unsigned long long* slot = (unsigned long long*)xbuf + ((size_t)(u.pm * BM + row) * 4 + u.pn);
            __hip_atomic_store(slot, ((unsigned long long)__float_as_uint(m2) << 32) | __float_as_uint(mt), __ATOMIC_RELAXED, __HIP_MEMORY_SCOPE_AGENT);
        }
        asm volatile("s_waitcnt vmcnt(0)" ::: "memory");
        if (lane == 0) __hip_atomic_fetch_add(cnt + 64 * u.pm, 1u, __ATOMIC_RELAXED, __HIP_MEMORY_SCOPE_AGENT);
        if (wid == 0) {
            bool dead = false; const unsigned long long t0 = __builtin_amdgcn_s_memrealtime(); const unsigned want = 8u * (unsigned)ntn;
            for (;;) {
#if defined(BROKEN_EXCHANGE_NO_WAIT)
                break;
#endif
                if ((unsigned)__builtin_amdgcn_readfirstlane(__hip_atomic_load(cnt + 64 * u.pm, __ATOMIC_RELAXED, __HIP_MEMORY_SCOPE_AGENT)) >= want) break;
                if (__builtin_amdgcn_s_memrealtime() - t0 > 2000000ull) {
                    if (lane == 0) { unsigned expect = 0u; __hip_atomic_compare_exchange_strong(tmo + 1, &expect, code | (unsigned)(u.pm & 0xff), __ATOMIC_RELAXED, __ATOMIC_RELAXED, __HIP_MEMORY_SCOPE_AGENT);
                                     __hip_atomic_store(tmo, 1u, __ATOMIC_RELAXED, __HIP_MEMORY_SCOPE_AGENT); }
                    dead = true; break; }
                __builtin_amdgcn_s_sleep(2);
            }
            __builtin_amdgcn_fence(__ATOMIC_ACQUIRE, "agent");
            if (lane == 0) flag[0] = dead ? 1u : 0u;
        }
        asm volatile("s_waitcnt vmcnt(0) lgkmcnt(0)" ::: "memory"); __builtin_amdgcn_s_barrier(); asm volatile("" ::: "memory");
        const bool bad = flag[0] != 0u;
        if (lane < 32) {
            const unsigned long long* slot = (const unsigned long long*)xbuf + (size_t)(u.pm * BM + row) * 4; float mt[4], m2[4]; float ms = 0.f;
#pragma unroll
            for (int t = 0; t < 4; ++t) { if (t < ntn) { const unsigned long long w = __hip_atomic_load(slot + t, __ATOMIC_RELAXED, __HIP_MEMORY_SCOPE_AGENT); mt[t] = __uint_as_float((unsigned)w); m2[t] = __uint_as_float((unsigned)(w >> 32)); } else { mt[t] = 0.f; m2[t] = 0.f; } ms += mt[t]; }
            const float mean = ms / (float)ntn; float q = 0.f;
#pragma unroll
            for (int t = 0; t < 4; ++t) if (t < ntn) { const float dm = mt[t] - mean; q += m2[t] + 256.0f * dm * dm; }
            S[row] = (f32x2v){mean, 1.0f / sqrtf(q / (256.0f * (float)ntn) + eps)};
        }
        asm volatile("s_waitcnt lgkmcnt(0)" ::: "memory"); __builtin_amdgcn_s_barrier(); asm volatile("" ::: "memory");
        return bad;
    }
};
struct EpiLnRes {
    static constexpr bool PERM = false, AFTER_DRAIN = true;
    const float* base; float* out; int ldc; const float* bias; PanelStats st; unsigned poison;
    __device__ __forceinline__ void fused(f32x4 (&acc)[2][2][4][2], const Unit& u, int wr, int wc, int fr, int fq, PG8_LAS unsigned char* lds, int wid, int lane) const {
        typedef float f32x2v __attribute__((ext_vector_type(2)));
        const PG8_LAS f32x2v* S = (const PG8_LAS f32x2v*)(lds + 8192);
        const int col0 = u.pn * BM + wc * 32 + 4 * fq;
#pragma unroll
        for (int bj = 0; bj < 2; ++bj)
#pragma unroll
            for (int n = 0; n < 2; ++n) { const f32x4 bv = bias ? *(const f32x4*)(bias + col0 + bj * HALF + n * 16) : (f32x4){0.f, 0.f, 0.f, 0.f};
#pragma unroll
                for (int ai = 0; ai < 2; ++ai)
#pragma unroll
                    for (int m = 0; m < 4; ++m) acc[ai][bj][m][n] += bv; }
        f32x4 pre[4][2][2];
#pragma unroll
        for (int m = 0; m < 4; ++m) { const size_t off = (size_t)(u.pm * BM + wr * 64 + m * 16 + fr) * ldc + col0;
#pragma unroll
            for (int bj = 0; bj < 2; ++bj)
#pragma unroll
                for (int n = 0; n < 2; ++n) pre[m][bj][n] = *(const f32x4*)(base + off + bj * HALF + n * 16); }
        const bool bad = st.run(acc, u, wr, wc, fr, fq, lds, wid, lane) || poison != 0u;
        const float qnan = __builtin_nanf("");
#pragma unroll
        for (int ai = 0; ai < 2; ++ai)
#pragma unroll
            for (int m = 0; m < 4; ++m) { const int r = ai * HALF + wr * 64 + m * 16 + fr; const f32x2v sr = S[r]; const size_t off = (size_t)(u.pm * BM + r) * ldc + col0;
#pragma unroll
                for (int bj = 0; bj < 2; ++bj)
#pragma unroll
                    for (int n = 0; n < 2; ++n) { const f32x4 bs = ai == 0 ? pre[m][bj][n] : *(const f32x4*)(base + off + bj * HALF + n * 16); f32x4 o = bs + (acc[ai][bj][m][n] - sr.x) * sr.y;
                        if (bad) o = (f32x4){qnan, qnan, qnan, qnan}; *(f32x4*)(out + off + bj * HALF + n * 16) = o; }
                if (m & 1) asm volatile("" ::: "memory"); }
    }
};
struct EpiLnResLn {
    static constexpr bool PERM = false, AFTER_DRAIN = true;
    const float* base; float* out; bf16_t* xn; int ldc; const float* bias; PanelStats st1, st2; unsigned poison;
    __device__ __forceinline__ void fused(f32x4 (&acc)[2][2][4][2], const Unit& u, int wr, int wc, int fr, int fq, PG8_LAS unsigned char* lds, int wid, int lane) const {
        typedef float f32x2v __attribute__((ext_vector_type(2))); typedef unsigned u32x2v __attribute__((ext_vector_type(2)));
        const PG8_LAS f32x2v* S = (const PG8_LAS f32x2v*)(lds + 8192);
        const int col0 = u.pn * BM + wc * 32 + 4 * fq;
#pragma unroll
        for (int bj = 0; bj < 2; ++bj)
#pragma unroll
            for (int n = 0; n < 2; ++n) { const f32x4 bv = bias ? *(const f32x4*)(bias + col0 + bj * HALF + n * 16) : (f32x4){0.f, 0.f, 0.f, 0.f};
#pragma unroll
                for (int ai = 0; ai < 2; ++ai)
#pragma unroll
                    for (int m = 0; m < 4; ++m) acc[ai][bj][m][n] += bv; }
        bool bad = st1.run(acc, u, wr, wc, fr, fq, lds, wid, lane) || poison != 0u;
        const float qnan = __builtin_nanf("");
#pragma unroll
        for (int ai = 0; ai < 2; ++ai)
#pragma unroll
            for (int m = 0; m < 4; ++m) { const int r = ai * HALF + wr * 64 + m * 16 + fr; const f32x2v sr = S[r]; const size_t off = (size_t)(u.pm * BM + r) * ldc + col0;
#pragma unroll
                for (int bj = 0; bj < 2; ++bj)
#pragma unroll
                    for (int n = 0; n < 2; ++n) { const f32x4 bs = *(const f32x4*)(base + off + bj * HALF + n * 16); acc[ai][bj][m][n] = bs + (acc[ai][bj][m][n] - sr.x) * sr.y; }
                asm volatile("" : "+v"(acc[ai][0][m][0]), "+v"(acc[ai][0][m][1]), "+v"(acc[ai][1][m][0]), "+v"(acc[ai][1][m][1]));
                if (m & 1) asm volatile("" ::: "memory"); }
        const bool bad1 = bad;
        bad = st2.run(acc, u, wr, wc, fr, fq, lds, wid, lane) || bad;
#pragma unroll
        for (int ai = 0; ai < 2; ++ai)
#pragma unroll
            for (int m = 0; m < 4; ++m) { const int r = ai * HALF + wr * 64 + m * 16 + fr; const f32x2v sr = S[r]; const size_t off = (size_t)(u.pm * BM + r) * ldc + col0;
#pragma unroll
                for (int bj = 0; bj < 2; ++bj)
#pragma unroll
                    for (int n = 0; n < 2; ++n) { const f32x4 x1 = acc[ai][bj][m][n]; *(f32x4*)(out + off + bj * HALF + n * 16) = bad1 ? (f32x4){qnan, qnan, qnan, qnan} : x1;
                        const f32x4 o = (x1 - sr.x) * sr.y; u32x2v w; w.x = cvt_pk_bf16(o[0], o[1]); w.y = cvt_pk_bf16(o[2], o[3]);
                        if (bad) { w.x = 0x7fc07fc0u; w.y = 0x7fc07fc0u; } *(u32x2v*)(xn + off + bj * HALF + n * 16) = w; }
                asm volatile("" ::: "memory"); }
    }
};

template <class Epi, class Sched, bool ALIGN_EPI = false, bool SP2 = false>
__device__ __forceinline__ void gemm_phase(PG8_LAS unsigned char* lds, const Gemm g, const Sched& S, const Epi& E) {
    const int tid = threadIdx.x, wid = __builtin_amdgcn_readfirstlane(tid >> 6), lane = tid & 63, wr = wid >> 2, wc = wid & 3, fr = lane & 15, fq = lane >> 4;
    const int K = g.K, nt = K / BK;
    unsigned voffA[2], voffB[2];
#pragma unroll
    for (int i = 0; i < 2; ++i) { int R, C; stage_rc(tid * 16 + i * 8192, R, C); const int Rb = Epi::PERM ? ((R & ~31) + perm32(R & 31)) : R;
        voffA[i] = (unsigned)(R * g.lda + C) * 2u; voffB[i] = (unsigned)(Rb * g.ldb + C) * 2u; }
    const size_t kstep = (size_t)(BK * 2);
    const size_t hstepA = (size_t)HALF * g.lda * 2, hstepB = (size_t)HALF * g.ldb * 2;
    const size_t tstepA = 2 * hstepA, tstepB = 2 * hstepB;
    const unsigned ldsw = (unsigned)wid * 1024u;
    const int aoff = lds_byte(wr * 64 + fr, fq * 8), boff = lds_byte(wc * 32 + fr, fq * 8);
#define PG8_SA(b, h) (((b) * 2 + (h)) * HTB)
#define PG8_SB(b, h) ((4 + (b) * 2 + (h)) * HTB)
#define PG8_STAGE(bufoff, gbase, voff) do { _Pragma("unroll") for (int _i = 0; _i < 2; ++_i) \
        __builtin_amdgcn_global_load_lds((const unsigned*)((const char*)(gbase) + (voff)[_i]), (PG8_LAS unsigned*)(lds + (bufoff) + ldsw + _i * 8192), 16, 0, 0); } while (0)
#define PG8_LDA(dst, b, h) do { _Pragma("unroll") for (int m = 0; m < 4; ++m) _Pragma("unroll") for (int k = 0; k < 2; ++k) dst[m][k] = *(const PG8_LAS bf16x8*)(lds + PG8_SA(b, h) + aoff + m * 2048 + k * 1024); } while (0)
#define PG8_LDB(dst, b, h) do { _Pragma("unroll") for (int n = 0; n < 2; ++n) _Pragma("unroll") for (int k = 0; k < 2; ++k) dst[n][k] = *(const PG8_LAS bf16x8*)(lds + PG8_SB(b, h) + boff + n * 2048 + k * 1024); } while (0)
#define PG8_MMA(ai, bj, At, Bt) do { __builtin_amdgcn_s_setprio(1); _Pragma("unroll") for (int m = 0; m < 4; ++m) _Pragma("unroll") for (int n = 0; n < 2; ++n) _Pragma("unroll") for (int k = 0; k < 2; ++k) \
        acc[ai][bj][m][n] = __builtin_amdgcn_mfma_f32_16x16x32_bf16(Bt[n][k], At[m][k], acc[ai][bj][m][n], 0, 0, 0); __builtin_amdgcn_s_setprio(0); } while (0)
#define PG8_WAIT_V(n) asm volatile("s_waitcnt vmcnt(" #n ")" ::: "memory")
#define PG8_WAIT_L(n) asm volatile("s_waitcnt lgkmcnt(" #n ")" ::: "memory")
#define PG8_BAR __builtin_amdgcn_s_barrier()
#define PG8_SCHED __builtin_amdgcn_sched_barrier(0)
    Unit cur, nxt; int ui = 0;
    if (!S.next(0, cur)) return;
    f32x4 acc[2][2][4][2];
#pragma unroll
    for (int a = 0; a < 2; ++a)
#pragma unroll
        for (int b = 0; b < 2; ++b)
#pragma unroll
            for (int m = 0; m < 4; ++m)
#pragma unroll
                for (int n = 0; n < 2; ++n) acc[a][b][m][n] = (f32x4){0.f, 0.f, 0.f, 0.f};
    bf16x8 At[4][2], B0[2][2], B1[2][2];
    const char* cA = (const char*)g.A + (size_t)cur.pm * tstepA; const char* cB = (const char*)g.Bt + (size_t)cur.pn * tstepB;
    S.a_ready(cur);
    if constexpr (SP2) {
        PG8_STAGE(PG8_SB(0, 0), cB, voffB); PG8_STAGE(PG8_SB(0, 1), cB + hstepB, voffB); PG8_STAGE(PG8_SA(0, 0), cA, voffA); PG8_STAGE(PG8_SA(0, 1), cA + hstepA, voffA);
        if (wr == 1) PG8_BAR;
        PG8_WAIT_V(2); PG8_BAR;
        PG8_STAGE(PG8_SB(1, 0), cB + kstep, voffB); PG8_STAGE(PG8_SA(1, 0), cA + kstep, voffA); PG8_STAGE(PG8_SB(1, 1), cB + hstepB + kstep, voffB);
        PG8_WAIT_V(6); PG8_BAR;
    } else {
        PG8_STAGE(PG8_SB(0, 0), cB, voffB); PG8_STAGE(PG8_SA(0, 0), cA, voffA); PG8_STAGE(PG8_SB(0, 1), cB + hstepB, voffB); PG8_STAGE(PG8_SA(0, 1), cA + hstepA, voffA);
        if (wr == 1) PG8_BAR;
        PG8_WAIT_V(4); PG8_BAR;
        PG8_STAGE(PG8_SB(1, 0), cB + kstep, voffB); PG8_STAGE(PG8_SA(1, 0), cA + kstep, voffA); PG8_STAGE(PG8_SB(1, 1), cB + hstepB + kstep, voffB);
        PG8_WAIT_V(6); PG8_BAR;
    }
    for (;;) {
        const bool has_next = S.next(ui + 1, nxt);
        const char* nA = has_next ? (const char*)g.A + (size_t)nxt.pm * tstepA : cA; const char* nB = has_next ? (const char*)g.Bt + (size_t)nxt.pn * tstepB : cB;
        for (int t = 0; t < nt; t += 2) {
            const bool last = (t == nt - 2);
            const char* a1 = cA + (size_t)(t + 1) * kstep;
            const char* a2 = last ? nA : cA + (size_t)(t + 2) * kstep; const char* b2 = last ? nB : cB + (size_t)(t + 2) * kstep;
            const char* a3 = a2 + kstep; const char* b3 = b2 + kstep;
            if (last && has_next) S.a_ready(nxt);
            if constexpr (SP2) {
            PG8_LDB(B0, 0, 0); PG8_LDB(B1, 0, 1); PG8_SCHED; PG8_LDA(At, 0, 0); PG8_STAGE(PG8_SA(1, 1), a1 + hstepA, voffA);
            PG8_WAIT_V(8); PG8_WAIT_L(0); PG8_BAR; PG8_MMA(0, 0, At, B0); PG8_MMA(0, 1, At, B1); PG8_BAR; PG8_SCHED;
            PG8_LDA(At, 0, 1); PG8_STAGE(PG8_SB(0, 0), b2, voffB); PG8_STAGE(PG8_SB(0, 1), b2 + hstepB, voffB); PG8_STAGE(PG8_SA(0, 0), a2, voffA);
            PG8_WAIT_V(8); PG8_WAIT_L(0); PG8_BAR; PG8_MMA(1, 0, At, B0); PG8_MMA(1, 1, At, B1); PG8_BAR; PG8_SCHED;
            PG8_LDB(B0, 1, 0); PG8_LDB(B1, 1, 1); PG8_SCHED; PG8_LDA(At, 1, 0); PG8_STAGE(PG8_SA(0, 1), a2 + hstepA, voffA);
            PG8_WAIT_V(8); PG8_WAIT_L(0); PG8_BAR; PG8_MMA(0, 0, At, B0); PG8_MMA(0, 1, At, B1); PG8_BAR; PG8_SCHED;
            PG8_LDA(At, 1, 1); PG8_STAGE(PG8_SB(1, 0), b3, voffB); PG8_STAGE(PG8_SB(1, 1), b3 + hstepB, voffB); PG8_STAGE(PG8_SA(1, 0), a3, voffA);
            PG8_WAIT_V(8); PG8_WAIT_L(0); PG8_BAR; PG8_MMA(1, 0, At, B0); PG8_MMA(1, 1, At, B1); PG8_BAR; PG8_SCHED;
            } else {
            PG8_LDB(B0, 0, 0); PG8_SCHED; PG8_LDA(At, 0, 0); PG8_STAGE(PG8_SA(1, 1), a1 + hstepA, voffA);
            PG8_WAIT_L(8); PG8_BAR; PG8_WAIT_L(0); PG8_MMA(0, 0, At, B0); PG8_BAR; PG8_SCHED;
            PG8_LDB(B1, 0, 1); PG8_STAGE(PG8_SB(0, 0), b2, voffB);
            PG8_BAR; PG8_WAIT_L(0); PG8_MMA(0, 1, At, B1); PG8_BAR;
            PG8_LDA(At, 0, 1); PG8_STAGE(PG8_SA(0, 0), a2, voffA);
            PG8_BAR; PG8_WAIT_L(0); PG8_MMA(1, 0, At, B0); PG8_BAR; PG8_SCHED;
            PG8_STAGE(PG8_SB(0, 1), b2 + hstepB, voffB);
            PG8_WAIT_V(6); PG8_BAR; PG8_MMA(1, 1, At, B1); PG8_BAR;
            PG8_LDB(B0, 1, 0); PG8_SCHED; PG8_LDA(At, 1, 0); PG8_STAGE(PG8_SA(0, 1), a2 + hstepA, voffA);
            PG8_WAIT_L(8); PG8_BAR; PG8_WAIT_L(0); PG8_MMA(0, 0, At, B0); PG8_BAR; PG8_SCHED;
            PG8_LDB(B1, 1, 1); PG8_STAGE(PG8_SB(1, 0), b3, voffB);
            PG8_BAR; PG8_WAIT_L(0); PG8_MMA(0, 1, At, B1); PG8_BAR;
            PG8_LDA(At, 1, 1); PG8_STAGE(PG8_SA(1, 0), a3, voffA);
            PG8_BAR; PG8_WAIT_L(0); PG8_MMA(1, 0, At, B0); PG8_BAR; PG8_SCHED;
            PG8_STAGE(PG8_SB(1, 1), b3 + hstepB, voffB);
            PG8_WAIT_V(6); PG8_BAR; PG8_MMA(1, 1, At, B1); PG8_BAR;
            }
        }
        if constexpr (ALIGN_EPI) { if (wr == 0) PG8_BAR; }
        if constexpr (!Epi::AFTER_DRAIN) { E(acc, cur, wr, wc, fr, fq); S.done(cur); }
        if (!has_next) break;
#pragma unroll
        for (int a = 0; a < 2; ++a)
#pragma unroll
            for (int b = 0; b < 2; ++b)
#pragma unroll
                for (int m = 0; m < 4; ++m)
#pragma unroll
                    for (int n = 0; n < 2; ++n) acc[a][b][m][n] = (f32x4){0.f, 0.f, 0.f, 0.f};
        cur = nxt; cA = nA; cB = nB; ++ui;
        if constexpr (ALIGN_EPI) { if (wr == 1) PG8_BAR; }
    }
    PG8_WAIT_V(0);
    if constexpr (!ALIGN_EPI) { if (wr == 0) PG8_BAR; }
    PG8_BAR;
    if constexpr (Epi::AFTER_DRAIN) { E.fused(acc, cur, wr, wc, fr, fq, lds, wid, lane); S.done(cur); }
#undef PG8_SA
#undef PG8_SB
#undef PG8_STAGE
#undef PG8_LDA
#undef PG8_LDB
#undef PG8_MMA
#undef PG8_WAIT_V
#undef PG8_WAIT_L
#undef PG8_BAR
#undef PG8_SCHED
}
}
#ifdef __HIPCC__
#define HD __host__ __device__ __forceinline__
#define UNR _Pragma("unroll")
typedef unsigned short act_t;
HD float ldf(act_t v) { unsigned u = ((unsigned)v) << 16; float f; __builtin_memcpy(&f, &u, 4); return f; }
HD act_t stf(float f) { unsigned u; __builtin_memcpy(&u, &f, 4); u = (u + 0x7fffu + ((u >> 16) & 1u)) >> 16; return (act_t)u; }
#else
#define HD inline
#define UNR
typedef float act_t;
HD float ldf(act_t v) { return v; }
HD act_t stf(float f) { return f; }
#endif

struct Dims {
    int D, B, S, DB, N, PAST, GW;
    int NAH, NAD;
    int LW, LB, LBK;
    int MH, MQR, MKR, MNOPE, MROPE, MV, MQK, MDN  ;
    int SH, SKVH, SD, SWIN;
    int DFF;
    int RC, R, RK  ;
};
HD int cond_of(const Dims& d, int row) { return row < d.RC ? 0 : 1 + (row - d.RC) / d.N; }
HD float silu_f(float x) { return x / (1.f + expf(-x)); }
HD float sigm_f(float x) { return 1.f / (1.f + expf(-x)); }
HD float gelu_f(float x) { const float u = 0.7978845608028654f * (x + 0.044715f * x * x * x); return x / (1.f + expf(-2.f * u)); }

struct OpTranspose { const float* W; act_t* Wt; long K, N, NP, perm, DFF;
    HD void run(long g) const { const int n = (int)(g / K), k = (int)(g % K); float v = 0.f;
        if (n < N) { int sc = n; if (perm == 1) { const int un = n / 256, j = n % 256; sc = j < 128 ? un * 128 + j : DFF + un * 128 + (j - 128); } v = W[(size_t)k * N + sc]; }
        Wt[(size_t)n * K + k] = stf(v); } };
struct OpCvt { const float* src; act_t* dst; HD void run(long g) const { dst[g] = stf(src[g]); } };
struct OpMod { const float* c; const float* cctx; const float* w; const float* b; float* MOD; long D, NCI;
    HD void run(long g) const { const int N6 = 6 * D; const int n = (int)(g % N6); const int ci = (int)((g / N6) % NCI); const int l = (int)(g / ((long)N6 * NCI));
        const float* cond = ci == 0 ? cctx : c + (size_t)(ci - 1) * D; const float* wl = w + (size_t)l * D * N6; float acc = b[(size_t)l * N6 + n];
        for (int k = 0; k < D; ++k) acc += silu_f(cond[k]) * wl[(size_t)k * N6 + n];
        MOD[g] = acc; } };
struct OpNormMod { const float* xc; const float* xl;   const float* g; const float* mod;   long chunk;   act_t* H; Dims d;
    HD void run(long row) const { const int D = d.D; const float* x = row < d.RC ? xc + (size_t)row * D : xl + (size_t)(row - d.RC) * D;
        float ss = 0.f; for (int k = 0; k < D; ++k) ss += x[k] * x[k];
        const float rstd = 1.f / sqrtf(ss / D + 1e-6f); const float* m = mod + (size_t)cond_of(d, (int)row) * 6 * D + (size_t)chunk * D;
        for (int k = 0; k < D; ++k) H[(size_t)row * D + k] = stf(x[k] * rstd * g[k] * (1.f + m[D + k]) + m[k]); } };
struct OpResid { const float* xc; const float* xl; const float* T; const float* mod; long chunk; float* out; Dims d;
    HD void run(long g) const { const int D = d.D; const int row = (int)(g / D), c = (int)(g % D);
        const float x = row < d.RC ? xc[(size_t)row * D + c] : xl[(size_t)(row - d.RC) * D + c];
        out[g] = x + mod[(size_t)cond_of(d, row) * 6 * D + (size_t)chunk * D + c] * T[g]; } };
struct OpRope { float* cs; float* sn; long rot, GW;
    HD void run(long g) const { const int t = (int)(g / rot), li = (int)(g % rot); const int half = rot / 2, nf = half / 2; const int f = li % nf;
        const float pos = (li < half) ? (float)(t / GW) : (float)(t % GW);
        const float inv = exp2f(-(float)(2 * f) / (float)half * 13.287712379549449f); const float a = pos * inv;
        const float rev = a * 0.15915494309189535f; const float fr = rev - floorf(rev);
#ifdef __HIP_DEVICE_COMPILE__
        cs[g] = __builtin_amdgcn_cosf(fr); sn[g] = __builtin_amdgcn_sinf(fr);
#else
        cs[g] = cosf(fr * 6.283185307179586f); sn[g] = sinf(fr * 6.283185307179586f);
#endif
    } };
struct OpHeadPost { const act_t* sa; long pa; long sha, na; const act_t* sb; long pb; long shb, nb; const float* gain; act_t* dst; long pd; long shd; long NH; long rot; const float* cs; const float* sn; float* of; long norm; Dims d; long rows_lat_end;
    HD void run(long g) const { const int row = (int)(g / NH), h = (int)(g % NH); const int dh = na + nb;
        const act_t* pA = sa + (size_t)row * pa + (size_t)h * sha; const act_t* pB = sb ? sb + (size_t)row * pb + (size_t)h * shb : nullptr;
        float ss = 0.f; for (int k = 0; k < dh; ++k) { const float v = k < na ? ldf(pA[k]) : ldf(pB[k - na]); ss += v * v; }
        const float rstd = norm ? 1.f / sqrtf(ss / dh + 1e-6f) : 1.f;
        act_t* o = dst + (size_t)row * pd + (size_t)h * shd;
        const bool lat = rot > 0 && row >= d.RC && row < rows_lat_end; const int t = lat ? (row - d.RC) % d.N : 0; const int r0 = dh - rot, half = rot / 2, q4 = rot / 4;
        float* ofp = (of && row < d.RC) ? of + ((size_t)((row / d.S) * NH + h) * d.S + (row % d.S)) * dh : nullptr;
        for (int k = 0; k < dh; ++k) { float v = (k < na ? ldf(pA[k]) : ldf(pB[k - na])) * rstd * (norm ? gain[k] : 1.f);
            if (lat && k >= r0) { const int li = k - r0; const int w = li % half; if (w >= q4) continue;
                const int k2 = k + q4; const float v2 = (k2 < na ? ldf(pA[k2]) : ldf(pB[k2 - na])) * rstd * (norm ? gain[k2] : 1.f);
                const size_t tb = (size_t)t * rot + li;
                o[k] = stf(v * cs[tb] - v2 * sn[tb]); o[k2] = stf(v2 * cs[tb + q4] + v * sn[tb + q4]); continue; }
            if (ofp) ofp[k] = v;
            o[k] = stf(v); } } };

template <int DQK, int DV> struct OSM { float q[DQK]; float o[DV]; float m, l, scale;
    HD void init(const act_t* qp, float sc) { UNR for (int i = 0; i < DQK; ++i) q[i] = ldf(qp[i]); UNR for (int i = 0; i < DV; ++i) o[i] = 0.f; m = -1e30f; l = 0.f; scale = sc; }
    HD void key(const act_t* kp, const act_t* vp, float bias) { float s = 0.f; UNR for (int i = 0; i < DQK; ++i) s += q[i] * ldf(kp[i]); s = s * scale + bias;
        const float mn = s > m ? s : m; const float a = expf(m - mn), p = expf(s - mn); l = l * a + p; UNR for (int i = 0; i < DV; ++i) o[i] = o[i] * a + p * ldf(vp[i]); m = mn; }
    HD void sink(float sk) { const float mn = sk > m ? sk : m; const float a = expf(m - mn); l = l * a + expf(sk - mn); UNR for (int i = 0; i < DV; ++i) o[i] *= a; m = mn; }
    HD void fin(act_t* op) { const float r = 1.f / l; UNR for (int i = 0; i < DV; ++i) op[i] = stf(o[i] * r); } };

template <int DQK, int DV> struct OpAttnCtx { const act_t* Q; long pq; long shq; const act_t* K; long pk; long shk; const act_t* V; long pv; long shv; act_t* O; long po; long sho; long NH, G; const float* sinks; Dims d;
    HD void run(long g) const { const int t = (int)(g % d.S); const int h = (int)((g / d.S) % NH); const int b = (int)(g / ((long)d.S * NH)); const int kvh = h / G;
        OSM<DQK, DV> st; st.init(Q + (size_t)(b * d.S + t) * pq + (size_t)h * shq, 1.f / sqrtf((float)DQK));
        for (int j = 0; j < d.S; ++j) { const size_t r = (size_t)(b * d.S + j); st.key(K + r * pk + (size_t)kvh * shk, V + r * pv + (size_t)kvh * shv, 0.f); }
        if (sinks) st.sink(sinks[h]);
        st.fin(O + (size_t)(b * d.S + t) * po + (size_t)h * sho); } };
template <int DH> struct OpNatLat { const act_t* QKV; long pq; const act_t* CK; const act_t* CV; const float* rpb; act_t* O; long po; Dims d;
    HD void run(long g) const { const int t = (int)(g % d.N); const int h = (int)((g / d.N) % d.NAH); const int b = (int)(g / ((long)d.N * d.NAH));
        const int GW = d.GW, rows = d.N / GW; const int wr = rows < 8 ? rows : 8; const int r = t / GW, c = t % GW;
        int rs = r - wr / 2; rs = rs < 0 ? 0 : (rs > rows - wr ? rows - wr : rs); int cst = c - 8; cst = cst < 0 ? 0 : (cst > GW - 16 ? GW - 16 : cst);
        const size_t rb = (size_t)d.RC + (size_t)b * d.N; const int HD_ = d.NAH * DH;
        OSM<DH, DH> st; st.init(QKV + (rb + t) * pq + (size_t)h * DH, 1.f / sqrtf((float)DH));
        for (int j = 0; j < d.PAST; ++j) { const size_t o = ((size_t)(b * d.NAH + h) * d.PAST + j) * DH; st.key(CK + o, CV + o, 0.f); }
        for (int kr = rs; kr < rs + wr; ++kr) for (int kc = cst; kc < cst + 16; ++kc) { const size_t kt = rb + (size_t)kr * GW + kc;
            const float bias = rpb[((size_t)h * 15 + (kr - r + 7)) * 31 + (kc - c + 15)];
            st.key(QKV + kt * pq + HD_ + (size_t)h * DH, QKV + kt * pq + 2 * HD_ + (size_t)h * DH, bias); }
        st.fin(O + (rb + t) * po + (size_t)h * DH); } };
template <int DQK, int DV> struct OpMlaLat { const act_t* Q; const act_t* K; const act_t* KV; act_t* O; long po; Dims d;
    HD void run(long g) const { const int t = (int)(g % d.N); const int h = (int)((g / d.N) % d.MH); const int b = (int)(g / ((long)d.N * d.MH));
        const size_t rb = (size_t)d.RC + (size_t)b * d.N; const size_t pq = (size_t)d.MH * DQK, pkv = (size_t)d.MH * (d.MNOPE + DV);
        OSM<DQK, DV> st; st.init(Q + (rb + t) * pq + (size_t)h * DQK, 1.f / sqrtf((float)DQK));
        for (int j = 0; j < d.PAST; ++j) { const size_t r = (size_t)d.R + (size_t)b * d.PAST + j; st.key(K + r * pq + (size_t)h * DQK, KV + r * pkv + (size_t)h * (d.MNOPE + DV) + d.MNOPE, 0.f); }
        for (int j = 0; j < d.N; ++j) { const size_t r = rb + j; st.key(K + r * pq + (size_t)h * DQK, KV + r * pkv + (size_t)h * (d.MNOPE + DV) + d.MNOPE, 0.f); }
        st.fin(O + (rb + t) * po + (size_t)h * DV); } };
template <int DH> struct OpSwaLat { const act_t* QKV; long pq; const act_t* CK; const act_t* CV; const float* sinks; act_t* O; long po; Dims d;
    HD void run(long g) const { const int t = (int)(g % d.N); const int h = (int)((g / d.N) % d.SH); const int b = (int)(g / ((long)d.N * d.SH)); const int G = d.SH / d.SKVH, kvh = h / G;
        const size_t rb = (size_t)d.RC + (size_t)b * d.N;
        OSM<DH, DH> st; st.init(QKV + (rb + t) * pq + (size_t)h * DH, 1.f / sqrtf((float)DH));
        for (int j = 0; j < d.PAST; ++j) { const size_t o = ((size_t)(b * d.SKVH + kvh) * d.PAST + j) * DH; st.key(CK + o, CV + o, 0.f); }
        int lo = t - d.SWIN, hi = t + d.SWIN; lo = lo < 0 ? 0 : lo; hi = hi > d.N - 1 ? d.N - 1 : hi;
        for (int j = lo; j <= hi; ++j) { const size_t r = rb + j; st.key(QKV + r * pq + (size_t)(d.SH + kvh) * DH, QKV + r * pq + (size_t)(d.SH + d.SKVH + kvh) * DH, 0.f); }
        st.sink(sinks[h]);
        st.fin(O + (rb + t) * po + (size_t)h * DH); } };

struct OpLruConv { const act_t* XG; const float* cw; const float* cb; act_t* XC; Dims d;
    HD void run(long g) const { const int LW = d.LW; const int row = (int)(g / LW), c = (int)(g % LW);
        int s0, T; if (row < d.RC) { s0 = (row / d.S) * d.S; T = d.S; } else { s0 = d.RC + ((row - d.RC) / d.N) * d.N; T = d.N; } const int t = row - s0;
        float acc = cb[c]; for (int k = 0; k < 4; ++k) { const int tt = t + k - 2; if (tt >= 0 && tt < T) acc += cw[(size_t)k * LW + c] * ldf(XG[(size_t)(s0 + tt) * 2 * LW + c]); }
        XC[g] = stf(acc); } };
struct OpLruScan { const act_t* XC; const act_t* XG; const float* wa; const float* ba; const float* wi; const float* bi; const float* lam; const float* h0; act_t* HS; act_t* Y; float* state_out; Dims d;
    HD void step(int dir, size_t row, int c, int blk, int j, float sp, float& h) const { const int LW = d.LW, LBK = d.LBK;
        const act_t* xr = XC + row * LW + (size_t)blk * LBK; const float* Wa = wa + ((size_t)(dir * d.LB + blk) * LBK) * LBK + j; const float* Wi = wi + ((size_t)(dir * d.LB + blk) * LBK) * LBK + j;
        float ra = ba[(size_t)dir * LW + c], ri = bi[(size_t)dir * LW + c];
        for (int k = 0; k < LBK; ++k) { const float x = ldf(xr[k]); ra += x * Wa[(size_t)k * LBK]; ri += x * Wi[(size_t)k * LBK]; }
        const float r = sigm_f(ra), ig = sigm_f(ri); const float la = -8.f * r * sp; const float a = expf(la); const float om = -expm1f(2.f * la);
        h = a * h + sqrtf(om) * (ig * ldf(XC[row * LW + c])); }
    HD void run(long g) const { const int LW = d.LW; const int seq = (int)(g / LW), c = (int)(g % LW); const int blk = c / d.LBK, j = c % d.LBK;
        size_t s0; int T; float hf = 0.f, hb = 0.f;
        if (seq < d.B) { s0 = (size_t)seq * d.S; T = d.S; } else { const int b = seq - d.B; s0 = (size_t)d.RC + (size_t)b * d.N; T = d.N; hf = h0[((size_t)b * 2 + 0) * LW + c]; hb = h0[((size_t)b * 2 + 1) * LW + c]; }
        float spf, spb; { const float l0 = lam[c], l1 = lam[LW + c]; spf = log1pf(expf(-l0)); spb = log1pf(expf(-l1)); }
        for (int t = 0; t < T; ++t) { step(0, s0 + t, c, blk, j, spf, hf); HS[(s0 + t) * LW + c] = stf(hf); }
        for (int t = T - 1; t >= 0; --t) { step(1, s0 + t, c, blk, j, spb, hb); const size_t row = s0 + t; Y[row * LW + c] = stf(gelu_f(ldf(XG[row * 2 * LW + LW + c])) * (ldf(HS[row * LW + c]) + hb)); }
        if (seq < d.B) { state_out[((size_t)seq * 2 + 0) * LW + c] = hf; state_out[((size_t)seq * 2 + 1) * LW + c] = hb; } } };

struct OpMlaNorm { act_t* Dn; act_t* KR; const float* gqa; const float* gkva; const float* cckv; const float* ckr; float* o_ckv; float* o_kr; Dims d;
    HD void run(long row) const { act_t* p = Dn + (size_t)row * d.MDN; act_t* kr = KR + (size_t)row * d.MROPE;
        if (row >= d.R) { const size_t j = (size_t)(row - d.R); for (int k = 0; k < d.MKR; ++k) p[d.MQR + k] = stf(cckv[j * d.MKR + k]); for (int k = 0; k < d.MROPE; ++k) kr[k] = stf(ckr[j * d.MROPE + k]); return; }
        float ss = 0.f; for (int k = 0; k < d.MQR; ++k) { const float v = ldf(p[k]); ss += v * v; } float rs = 1.f / sqrtf(ss / d.MQR + 1e-6f);
        for (int k = 0; k < d.MQR; ++k) p[k] = stf(ldf(p[k]) * rs * gqa[k]);
        ss = 0.f; for (int k = 0; k < d.MKR; ++k) { const float v = ldf(p[d.MQR + k]); ss += v * v; } rs = 1.f / sqrtf(ss / d.MKR + 1e-6f);
        for (int k = 0; k < d.MKR; ++k) { const float v = ldf(p[d.MQR + k]) * rs * gkva[k]; p[d.MQR + k] = stf(v); if (row < d.RC) o_ckv[(size_t)row * d.MKR + k] = v; }
        for (int k = 0; k < d.MROPE; ++k) { const act_t v = p[d.MQR + d.MKR + k]; kr[k] = v; if (row < d.RC) o_kr[(size_t)row * d.MROPE + k] = ldf(v); } } };

struct OpFfnAct { const act_t* U; const float* cw; const float* cb; act_t* G; long row0; long nrows; Dims d;
    HD void run(long g) const { const int F = d.DFF; const int lr = (int)(g / F), c = (int)(g % F); const int row = row0 + lr;
        int s0, T; if (row < d.RC) { s0 = (row / d.S) * d.S; T = d.S; } else { s0 = d.RC + ((row - d.RC) / d.N) * d.N; T = d.N; } const int t = row - s0;
        float acc = cb[c]; for (int k = 0; k < 3; ++k) { const int tt = t + k - 1; if (tt >= 0 && tt < T) acc += cw[(size_t)k * F + c] * ldf(U[(size_t)(s0 + tt - row0) * 2 * F + c]); }
        G[(size_t)lr * F + c] = stf(silu_f(acc) * ldf(U[(size_t)lr * 2 * F + F + c])); } };
struct OpCopyV { const act_t* src; long ps; long sh; long NH, dh; float* of; Dims d;
    HD void run(long g) const { const int k = (int)(g % dh); const int h = (int)((g / dh) % NH); const int row = (int)(g / ((long)dh * NH));
        of[((size_t)((row / d.S) * NH + h) * d.S + (row % d.S)) * dh + k] = ldf(src[(size_t)row * ps + (size_t)h * sh + k]); } };

struct WS {
    float* MOD; float* ropeC; float* ropeS;
    act_t *Wffn_in[4], *Wffn_out[4], *Wnat_qkv, *Wnat_o, *Wlru_in, *Wlru_out, *Wmla_down, *Wmla_uq, *Wmla_ukv, *Wmla_o, *Wswa_qkv, *Wswa_o;
    act_t *natCK, *natCV, *swaCK, *swaCV;
    act_t* H;
    act_t* OB;
    float* T_mix[4]; float* T_ffn;
    act_t* QKV;
    act_t *XG, *XC, *HS, *Y;
    act_t *Dn, *KR, *Q, *KVr, *K;
    act_t *U, *G;
    int ffn_chunk_rows;
};
enum { I_xp = 0, I_xs, I_cnk, I_cnv, I_slru, I_cckv, I_ckr, I_csk, I_csv, I_c, I_cctx, I_nmix, I_nffn, I_wmod, I_bmod, I_fwin, I_fcw, I_fcb, I_fwout,
       I_nwqkv, I_nqn, I_nkn, I_nrpb, I_nwo, I_lwin, I_lcw, I_lcb, I_lwa, I_lba, I_lwi, I_lbi, I_llam, I_lwout, I_mwd, I_mqan, I_mkvan, I_mwuq, I_mwukv, I_mqn, I_mkn, I_mwo,
       I_swqkv, I_sqn, I_skn, I_ssink, I_swo, N_IN };
struct OutPtrs { float *yp, *ys, *nat_k, *nat_v, *lru, *ckv, *krope, *swa_k, *swa_v; };
template <int NAD, int MQK, int MV, int SD, class CX>
void forward_v1(CX& cx, const Dims& d, const float* const* in, const OutPtrs& o, const WS& w) {
    const int D = d.D, R = d.R, NCI = d.DB + 1; const long N6 = 6L * D;
    for (int l = 0; l < 4; ++l) {
        cx.run(OpTranspose{in[I_fwin] + (size_t)l * D * 2 * d.DFF, w.Wffn_in[l], D, 2 * d.DFF, 2 * d.DFF, 0, d.DFF}, (long)2 * d.DFF * D);
        cx.run(OpTranspose{in[I_fwout] + (size_t)l * d.DFF * D, w.Wffn_out[l], d.DFF, D, D, 0, 0}, (long)D * d.DFF);
    }
    const int NQ = d.NAH * d.NAD;
    cx.run(OpTranspose{in[I_nwqkv], w.Wnat_qkv, D, 3 * NQ, 3 * NQ, 0, 0}, (long)3 * NQ * D);
    cx.run(OpTranspose{in[I_nwo], w.Wnat_o, NQ, D, D, 0, 0}, (long)D * NQ);
    cx.run(OpTranspose{in[I_lwin], w.Wlru_in, D, 2 * d.LW, 2 * d.LW, 0, 0}, (long)2 * d.LW * D);
    cx.run(OpTranspose{in[I_lwout], w.Wlru_out, d.LW, D, D, 0, 0}, (long)D * d.LW);
    const int MDraw = d.MQR + d.MKR + d.MROPE;
    cx.run(OpTranspose{in[I_mwd], w.Wmla_down, D, MDraw, d.MDN, 0, 0}, (long)d.MDN * D);
    cx.run(OpTranspose{in[I_mwuq], w.Wmla_uq, d.MQR, d.MH * d.MQK, d.MH * d.MQK, 0, 0}, (long)d.MH * d.MQK * d.MQR);
    const int MKVW = d.MH * (d.MNOPE + d.MV);
    cx.run(OpTranspose{in[I_mwukv], w.Wmla_ukv, d.MKR, MKVW, MKVW, 0, 0}, (long)MKVW * d.MKR);
    cx.run(OpTranspose{in[I_mwo], w.Wmla_o, d.MH * d.MV, D, D, 0, 0}, (long)D * d.MH * d.MV);
    const int SQW = (d.SH + 2 * d.SKVH) * d.SD;
    cx.run(OpTranspose{in[I_swqkv], w.Wswa_qkv, D, SQW, SQW, 0, 0}, (long)SQW * D);
    cx.run(OpTranspose{in[I_swo], w.Wswa_o, d.SH * d.SD, D, D, 0, 0}, (long)D * d.SH * d.SD);
    cx.run(OpCvt{in[I_cnk], w.natCK}, (long)d.DB * d.NAH * d.PAST * d.NAD); cx.run(OpCvt{in[I_cnv], w.natCV}, (long)d.DB * d.NAH * d.PAST * d.NAD);
    cx.run(OpCvt{in[I_csk], w.swaCK}, (long)d.DB * d.SKVH * d.PAST * d.SD); cx.run(OpCvt{in[I_csv], w.swaCV}, (long)d.DB * d.SKVH * d.PAST * d.SD);
    cx.run(OpMod{in[I_c], in[I_cctx], in[I_wmod], in[I_bmod], w.MOD, D, NCI}, 4L * NCI * N6);
    cx.run(OpRope{w.ropeC, w.ropeS, d.MROPE, d.GW}, (long)d.N * d.MROPE);
    const float* xc = in[I_xp]; const float* xl = in[I_xs];
    float* outl = o.yp + (size_t)d.RC * D;
    for (int l = 0; l < 4; ++l) {
        const float* mod = w.MOD + (size_t)l * NCI * N6;
        cx.run(OpNormMod{xc, xl, in[I_nmix] + (size_t)l * D, mod, 0, w.H, d}, R);
        int KO = 0; const act_t* Wo = nullptr; const act_t* Aout = nullptr;
        if (l == 0) {
            cx.gemm(w.H, D, w.Wnat_qkv, R, 3 * NQ, D, 0, w.QKV, 3 * NQ);
            cx.run(OpCopyV{w.QKV + 2 * NQ, 3L * NQ, d.NAD, d.NAH, d.NAD, o.nat_v, d}, (long)d.RC * d.NAH * d.NAD);
            cx.run(OpHeadPost{w.QKV, 3L * NQ, d.NAD, d.NAD, nullptr, 0, 0, 0, in[I_nqn], w.QKV, 3L * NQ, d.NAD, d.NAH, 0, nullptr, nullptr, nullptr, 1, d, R}, (long)R * d.NAH);
            cx.run(OpHeadPost{w.QKV + NQ, 3L * NQ, d.NAD, d.NAD, nullptr, 0, 0, 0, in[I_nkn], w.QKV + NQ, 3L * NQ, d.NAD, d.NAH, 0, nullptr, nullptr, o.nat_k, 1, d, R}, (long)R * d.NAH);
            cx.run(OpAttnCtx<NAD, NAD>{w.QKV, 3L * NQ, d.NAD, w.QKV + NQ, 3L * NQ, d.NAD, w.QKV + 2 * NQ, 3L * NQ, d.NAD, w.OB, (long)NQ, d.NAD, d.NAH, 1, nullptr, d}, (long)d.B * d.NAH * d.S);
            cx.run(OpNatLat<NAD>{w.QKV, 3L * NQ, w.natCK, w.natCV, in[I_nrpb], w.OB, (long)NQ, d}, (long)d.DB * d.NAH * d.N);
            KO = NQ; Wo = w.Wnat_o; Aout = w.OB;
        } else if (l == 1) {
            cx.gemm(w.H, D, w.Wlru_in, R, 2 * d.LW, D, 0, w.XG, 2 * d.LW);
            cx.run(OpLruConv{w.XG, in[I_lcw], in[I_lcb], w.XC, d}, (long)R * d.LW);
            cx.run(OpLruScan{w.XC, w.XG, in[I_lwa], in[I_lba], in[I_lwi], in[I_lbi], in[I_llam], in[I_slru], w.HS, w.Y, o.lru, d}, (long)(d.B + d.DB) * d.LW);
            KO = d.LW; Wo = w.Wlru_out; Aout = w.Y;
        } else if (l == 2) {
            const int QW = d.MH * d.MQK;
            cx.gemm(w.H, D, w.Wmla_down, R, d.MDN, D, 0, w.Dn, d.MDN);
            cx.run(OpMlaNorm{w.Dn, w.KR, in[I_mqan], in[I_mkvan], in[I_cckv], in[I_ckr], o.ckv, o.krope, d}, d.RK);
            cx.gemm(w.Dn, d.MDN, w.Wmla_uq, R, QW, d.MQR, 0, w.Q, QW);
            cx.gemm(w.Dn + d.MQR, d.MDN, w.Wmla_ukv, d.RK, MKVW, d.MKR, 0, w.KVr, MKVW);
            cx.run(OpHeadPost{w.Q, (long)QW, d.MQK, d.MQK, nullptr, 0, 0, 0, in[I_mqn], w.Q, (long)QW, d.MQK, d.MH, d.MROPE, w.ropeC, w.ropeS, nullptr, 1, d, R}, (long)R * d.MH);
            cx.run(OpHeadPost{w.KVr, (long)MKVW, d.MNOPE + d.MV, d.MNOPE, w.KR, (long)d.MROPE, 0, d.MROPE, in[I_mkn], w.K, (long)QW, d.MQK, d.MH, d.MROPE, w.ropeC, w.ropeS, nullptr, 1, d, R}, (long)d.RK * d.MH);
            cx.run(OpAttnCtx<MQK, MV>{w.Q, (long)QW, d.MQK, w.K, (long)QW, d.MQK, w.KVr + d.MNOPE, (long)MKVW, d.MNOPE + d.MV, w.OB, (long)d.MH * d.MV, d.MV, d.MH, 1, nullptr, d}, (long)d.B * d.MH * d.S);
            cx.run(OpMlaLat<MQK, MV>{w.Q, w.K, w.KVr, w.OB, (long)d.MH * d.MV, d}, (long)d.DB * d.MH * d.N);
            KO = d.MH * d.MV; Wo = w.Wmla_o; Aout = w.OB;
        } else {
            cx.gemm(w.H, D, w.Wswa_qkv, R, SQW, D, 0, w.QKV, SQW);
            cx.run(OpCopyV{w.QKV + (d.SH + d.SKVH) * d.SD, (long)SQW, d.SD, d.SKVH, d.SD, o.swa_v, d}, (long)d.RC * d.SKVH * d.SD);
            cx.run(OpHeadPost{w.QKV, (long)SQW, d.SD, d.SD, nullptr, 0, 0, 0, in[I_sqn], w.QKV, (long)SQW, d.SD, d.SH, d.SD, w.ropeC, w.ropeS, nullptr, 1, d, R}, (long)R * d.SH);
            cx.run(OpHeadPost{w.QKV + d.SH * d.SD, (long)SQW, d.SD, d.SD, nullptr, 0, 0, 0, in[I_skn], w.QKV + d.SH * d.SD, (long)SQW, d.SD, d.SKVH, d.SD, w.ropeC, w.ropeS, o.swa_k, 1, d, R}, (long)R * d.SKVH);
            cx.run(OpAttnCtx<SD, SD>{w.QKV, (long)SQW, d.SD, w.QKV + d.SH * d.SD, (long)SQW, d.SD, w.QKV + (d.SH + d.SKVH) * d.SD, (long)SQW, d.SD, w.OB, (long)d.SH * d.SD, d.SD, d.SH, d.SH / d.SKVH, in[I_ssink], d}, (long)d.B * d.SH * d.S);
            cx.run(OpSwaLat<SD>{w.QKV, (long)SQW, w.swaCK, w.swaCV, in[I_ssink], w.OB, (long)d.SH * d.SD, d}, (long)d.DB * d.SH * d.N);
            KO = d.SH * d.SD; Wo = w.Wswa_o; Aout = w.OB;
        }
        cx.gemm(Aout, KO, Wo, R, D, KO, 1, w.T_mix[l], D);
        cx.run(OpResid{xc, xl, w.T_mix[l], mod, 2, o.yp, d}, (long)R * D);
        xc = o.yp; xl = outl;
        cx.run(OpNormMod{xc, xl, in[I_nffn] + (size_t)l * D, mod, 3, w.H, d}, R);
        for (int r0 = 0; r0 < R; r0 += w.ffn_chunk_rows) {
            const int nr = (R - r0) < w.ffn_chunk_rows ? (R - r0) : w.ffn_chunk_rows;
            cx.gemm(w.H + (size_t)r0 * D, D, w.Wffn_in[l], nr, 2 * d.DFF, D, 0, w.U, 2 * d.DFF);
            cx.run(OpFfnAct{w.U, in[I_fcw] + (size_t)l * 3 * d.DFF, in[I_fcb] + (size_t)l * d.DFF, w.G, r0, nr, d}, (long)nr * d.DFF);
            cx.gemm(w.G, d.DFF, w.Wffn_out[l], nr, D, d.DFF, 1, w.T_ffn + (size_t)r0 * D, D);
        }
        cx.run(OpResid{xc, xl, w.T_ffn, mod, 5, o.yp, d}, (long)R * D);
    }
}

template <class Op, int BT> __global__ __launch_bounds__(BT) void k_run(Op op, long n) { for (long g = (long)blockIdx.x * BT + threadIdx.x; g < n; g += (long)gridDim.x * BT) op.run(g); }
template <int MODE> __global__ __launch_bounds__(512, 2) void k_gemm(pg8::Gemm g, void* C, long ldc) {
    extern __shared__ __attribute__((aligned(16))) unsigned char shm[];
    pg8::StaticOrder S; S.init(g.M, g.N, (int)gridDim.x, (int)blockIdx.x);
    if constexpr (MODE == 0) { pg8::EpiBf16<0> E{(pg8::bf16_t*)C, (int)ldc, nullptr, 0, 0, 1.f}; pg8::gemm_phase<pg8::EpiBf16<0>, pg8::StaticOrder, true, true>((PG8_LAS unsigned char*)shm, g, S, E); }
    else { pg8::EpiF32 E{(float*)C, (int)ldc}; pg8::gemm_phase<pg8::EpiF32, pg8::StaticOrder, true, true>((PG8_LAS unsigned char*)shm, g, S, E); }
}
template <class T> struct big_regs { static constexpr bool v = false; };
template <int A, int B> struct big_regs<OpAttnCtx<A, B>> { static constexpr bool v = true; };
template <int A> struct big_regs<OpNatLat<A>> { static constexpr bool v = true; };
template <int A, int B> struct big_regs<OpMlaLat<A, B>> { static constexpr bool v = true; };
template <int A> struct big_regs<OpSwaLat<A>> { static constexpr bool v = true; };
struct DevCX { hipStream_t st; int cus;
    template <class Op> void run(const Op& op, long n) { constexpr int BT = big_regs<Op>::v ? 64 : 256; long nb = (n + BT - 1) / BT; const long cap = (long)cus * (big_regs<Op>::v ? 32 : 16); if (nb > cap) nb = cap;
        hipLaunchKernelGGL((k_run<Op, BT>), dim3((unsigned)nb), dim3(BT), 0, st, op, n); }
    void gemm(const act_t* A, int lda, const act_t* Wt, int M, int N, int K, int mode, void* C, int ldc) {
        pg8::Gemm g{A, Wt, M, N, K, lda, K, 0};
        static bool a = false; if (!a) { (void)hipFuncSetAttribute((const void*)k_gemm<0>, hipFuncAttributeMaxDynamicSharedMemorySize, pg8::STAGE_BYTES); (void)hipFuncSetAttribute((const void*)k_gemm<1>, hipFuncAttributeMaxDynamicSharedMemorySize, pg8::STAGE_BYTES); a = true; }
        if (mode == 0) hipLaunchKernelGGL((k_gemm<0>), dim3(cus), dim3(512), pg8::STAGE_BYTES, st, g, C, (long)ldc);
        else hipLaunchKernelGGL((k_gemm<1>), dim3(cus), dim3(512), pg8::STAGE_BYTES, st, g, C, (long)ldc); }
};
extern "C" void kernel_launch(void* const* d_in, const int* in_sizes, int n_in, void* d_out, int out_size, void* d_ws, size_t ws_size, hipStream_t stream) {
    static int cus = 0;
    if (cus == 0) { int dev = 0; if (hipGetDevice(&dev) != hipSuccess || hipDeviceGetAttribute(&cus, hipDeviceAttributeMultiprocessorCount, dev) != hipSuccess || cus <= 0) cus = -1; }
    constexpr size_t MiB = 1u << 20;
    if (cus < 0 || n_in != N_IN || out_size != 96817152 || ws_size < 1490 * MiB) { fprintf(stderr, "kernel_launch: unexpected arguments (n_in %d out %d ws %zu cus %d); nothing launched\n", n_in, out_size, ws_size, cus); return; }
    Dims d{}; d.D = 2048; d.B = 16; d.S = 256; d.DB = 8; d.N = 4096; d.PAST = 256; d.GW = 64; d.NAH = 16; d.NAD = 128; d.LW = 2688; d.LB = 16; d.LBK = 168;
    d.MH = 16; d.MQR = 768; d.MKR = 512; d.MNOPE = 128; d.MROPE = 64; d.MV = 128; d.MQK = 192; d.MDN = 1536; d.SH = 32; d.SKVH = 4; d.SD = 64; d.SWIN = 128; d.DFF = 5632;
    d.RC = d.B * d.S; d.R = d.RC + d.DB * d.N; d.RK = d.R + d.DB * d.PAST;
    unsigned char* ws = (unsigned char*)d_ws; auto at = [&](size_t mib) { return ws + mib * MiB; };
    WS w{}; w.MOD = (float*)at(1); w.ropeC = (float*)at(3); w.ropeS = (float*)at(4);
    w.natCK = (act_t*)at(5); w.natCV = (act_t*)at(13); w.swaCK = (act_t*)at(21); w.swaCV = (act_t*)at(22);
    for (int l = 0; l < 4; ++l) { w.Wffn_in[l] = (act_t*)at(26 + 66 * l); w.Wffn_out[l] = (act_t*)at(26 + 66 * l + 44); }
    w.Wnat_qkv = (act_t*)at(290); w.Wnat_o = (act_t*)at(314); w.Wlru_in = (act_t*)at(322); w.Wlru_out = (act_t*)at(344); w.Wmla_down = (act_t*)at(355); w.Wmla_uq = (act_t*)at(361);
    w.Wmla_ukv = (act_t*)at(366); w.Wmla_o = (act_t*)at(370); w.Wswa_qkv = (act_t*)at(378); w.Wswa_o = (act_t*)at(388);
    w.H = (act_t*)at(396); w.OB = w.H;
    w.QKV = (act_t*)at(540); w.XG = (act_t*)at(540); w.XC = (act_t*)at(918); w.HS = (act_t*)at(1107); w.Y = (act_t*)at(1296);
    w.Dn = (act_t*)at(540); w.KR = (act_t*)at(654); w.Q = (act_t*)at(659); w.KVr = (act_t*)at(875); w.K = (act_t*)at(1179);
    w.U = (act_t*)at(540); w.G = (act_t*)at(804); w.ffn_chunk_rows = 12288;
    w.T_mix[0] = (float*)at(972); w.T_mix[1] = (float*)at(540); w.T_mix[2] = (float*)at(540); w.T_mix[3] = (float*)at(720); w.T_ffn = (float*)at(936);
    float* out = (float*)d_out;
    OutPtrs o{out, out + 8388608, out + 75497472, out + 83886080, out + 92274688, out + 92360704, out + 94457856, out + 94720000, out + 95768576};
    const float* in[N_IN]; for (int i = 0; i < N_IN; ++i) in[i] = (const float*)d_in[i];
    DevCX cx{stream, cus};
    forward_v1<128, 192, 128, 64>(cx, d, in, o, w);
}
```

```cpp
#include <hip/hip_runtime.h>
#include <cstdio>
#include <cstdint>
#include <math.h>
namespace pg8 {
#define PG8_LAS __attribute__((address_space(3)))
typedef unsigned short bf16_t;
typedef short bf16x8 __attribute__((ext_vector_type(8)));
typedef float f32x4 __attribute__((ext_vector_type(4)));
typedef unsigned u32x4 __attribute__((ext_vector_type(4)));
constexpr int BM = 256, BK = 64, HALF = 128, HTB = HALF * BK * 2  , STAGE_BYTES = 8 * HTB, NXCD = 8, WGM = 8;

__host__ __device__ __forceinline__ int lds_byte(int r, int c) { const int st = (r >> 4) * 2 + (c >> 5), rr = r & 15, cc = c & 31, ob = rr * 64 + cc * 2; return st * 1024 + (ob ^ (((ob >> 9) & 1) << 5)); }
__host__ __device__ __forceinline__ void stage_rc(int b, int& R, int& C) { const int st = b / 1024, sb = b % 1024, swz = sb ^ (((sb >> 9) & 1) << 5); R = (st >> 1) * 16 + swz / 64; C = (st & 1) * 32 + (swz % 64) / 2; }
__host__ __device__ __forceinline__ int perm32(int rho) { const int n = rho >> 4, i = rho & 15; return 8 * (i >> 2) + 4 * n + (i & 3); }

struct Unit { int pm, pn; };
struct Gemm { const bf16_t* A; const bf16_t* Bt; int M, N, K, lda, ldb, pad; };

struct StaticOrder {
    int nM, nN, nwg, G, c, wgm, rev;
    __host__ __device__ void init(int M, int N, int G_, int c_, int wgm_ = WGM, int rev_ = 0) { nM = M / BM; nN = N / BM; nwg = nM * nN; G = G_; c = c_; wgm = wgm_; rev = rev_; }
    __host__ __device__ bool next(int i, Unit& u) const {
        const long L = (long)i * G + c; if (L >= nwg) return false;
        int wgid = (int)L; { const int q = nwg / NXCD, r = nwg % NXCD, xcd = wgid % NXCD, off = wgid / NXCD, sz = xcd < r ? q + 1 : q; wgid = (xcd < r ? xcd * (q + 1) : r * (q + 1) + (xcd - r) * q) + (rev ? sz - 1 - off : off); }
        const int nig = wgm * nN, gid = wgid / nig, fm = gid * wgm, gsz = (nM - fm) < wgm ? (nM - fm) : wgm;
        u.pm = fm + ((wgid % nig) % gsz); u.pn = (wgid % nig) / gsz; return true;
    }
    __device__ __forceinline__ void a_ready(const Unit&) const {}
    __device__ __forceinline__ void done(const Unit&) const {}
};

__device__ __forceinline__ unsigned cvt_pk_bf16(float lo, float hi) { unsigned r; asm volatile("v_cvt_pk_bf16_f32 %0, %1, %2" : "=v"(r) : "v"(lo), "v"(hi)); return r; }
typedef float f32x2 __attribute__((ext_vector_type(2)));
__device__ __forceinline__ f32x2 gelu_pk(f32x2 v) {
    const f32x2 av = __builtin_elementwise_abs(v), d = av * 0.2316418882f + 1.0f;
    f32x2 t; t.x = __builtin_amdgcn_rcpf(d.x); t.y = __builtin_amdgcn_rcpf(d.y);
    f32x2 q = t * 0.5307027145f + (-0.7265760135f); q = q * t + 0.7107068705f; q = q * t + (-0.142248368f); q = q * t + 0.127414796f; q = q * t;
    const f32x2 s = (v * v) * (-0.72134752044f);
    f32x2 e; e.x = __builtin_amdgcn_exp2f(s.x); e.y = __builtin_amdgcn_exp2f(s.y);
    const f32x2 m = v * (q * e), r = v - m;
    f32x2 o; o.x = v.x < 0.f ? m.x : r.x; o.y = v.y < 0.f ? m.y : r.y; return o;
}

template <int ACT  > struct EpiBf16 {
    static constexpr bool PERM = true, AFTER_DRAIN = false; static_assert(ACT == 0 || ACT == 1, "EpiBf16: ACT is 0 (none) or 1 (gelu_pk)");
    bf16_t* O; int ldc; const float* bias; int split_cols; size_t split_stride; float scale0;
    __device__ __forceinline__ void operator()(const f32x4 (&acc)[2][2][4][2], const Unit& u, int wr, int wc, int fr, int fq) const {
        const int row0 = u.pm * BM + wr * 64 + fr; int colt = u.pn * BM; bf16_t* base = O;
        float sc = 1.f; if (split_cols) { const int t = colt / split_cols; base += (size_t)t * split_stride; colt -= t * split_cols; if (t == 0) sc = scale0; }
        const int col0 = colt + wc * 32 + 8 * fq, bcol0 = u.pn * BM + wc * 32 + 8 * fq;
        f32x4 bv[2][2];
#pragma unroll
        for (int bj = 0; bj < 2; ++bj)
#pragma unroll
            for (int n = 0; n < 2; ++n) bv[bj][n] = bias ? *(const f32x4*)(bias + bcol0 + bj * HALF + 4 * n) : (f32x4){0.f, 0.f, 0.f, 0.f};
#pragma unroll
        for (int ai = 0; ai < 2; ++ai)
#pragma unroll
            for (int m = 0; m < 4; ++m) { bf16_t* rowp = base + (size_t)(row0 + ai * HALF + m * 16) * ldc + col0;
#pragma unroll
                for (int bj = 0; bj < 2; ++bj) { f32x4 v0 = acc[ai][bj][m][0] + bv[bj][0], v1 = acc[ai][bj][m][1] + bv[bj][1];
                    if (ACT == 1) { f32x2 a = gelu_pk((f32x2){v0[0], v0[1]}), b = gelu_pk((f32x2){v0[2], v0[3]}), c = gelu_pk((f32x2){v1[0], v1[1]}), d = gelu_pk((f32x2){v1[2], v1[3]});
                        v0 = (f32x4){a.x, a.y, b.x, b.y}; v1 = (f32x4){c.x, c.y, d.x, d.y}; }
                    v0 = v0 * sc; v1 = v1 * sc; u32x4 w; w.x = cvt_pk_bf16(v0[0], v0[1]); w.y = cvt_pk_bf16(v0[2], v0[3]); w.z = cvt_pk_bf16(v1[0], v1[1]); w.w = cvt_pk_bf16(v1[2], v1[3]);
                    *(u32x4*)(rowp + bj * HALF) = w; } }
    }
};


struct EpiF32 {
    static constexpr bool PERM = false, AFTER_DRAIN = false;
    float* C; int ldc;
    __device__ __forceinline__ void operator()(const f32x4 (&acc)[2][2][4][2], const Unit& u, int wr, int wc, int fr, int fq) const {
        const int row0 = u.pm * BM + wr * 64 + fr, col0 = u.pn * BM + wc * 32 + 4 * fq;
#pragma unroll
        for (int ai = 0; ai < 2; ++ai)
#pragma unroll
            for (int m = 0; m < 4; ++m) { float* rowp = C + (size_t)(row0 + ai * HALF + m * 16) * ldc + col0;
#pragma unroll
                for (int bj = 0; bj < 2; ++bj)
#pragma unroll
                    for (int n = 0; n < 2; ++n) *(f32x4*)(rowp + bj * HALF + n * 16) = acc[ai][bj][m][n]; }
    }
};
struct PanelStats {
    unsigned* xbuf;
    unsigned* cnt;
    unsigned* tmo;
    int ntn; float eps;
    unsigned code;
    __device__ __forceinline__ bool run(const f32x4 (&v)[2][2][4][2], const Unit& u, int wr, int wc, int fr, int fq, PG8_LAS unsigned char* lds, int wid, int lane) const {
        typedef float f32x2v __attribute__((ext_vector_type(2)));
        PG8_LAS f32x2v* P = (PG8_LAS f32x2v*)lds;
        PG8_LAS f32x2v* S = (PG8_LAS f32x2v*)(lds + 8192);
        PG8_LAS unsigned* flag = (PG8_LAS unsigned*)(lds + 8192 + 2048);
#pragma unroll
        for (int ai = 0; ai < 2; ++ai)
#pragma unroll
            for (int m = 0; m < 4; ++m) {
                float s = 0.f;
#pragma unroll
                for (int bj = 0; bj < 2; ++bj)
#pragma unroll
                    for (int n = 0; n < 2; ++n) { const f32x4 x = v[ai][bj][m][n]; s += (x[0] + x[1]) + (x[2] + x[3]); }
                s += __shfl_xor(s, 16); s += __shfl_xor(s, 32);
                const float mw = s * (1.0f / 64.0f); float q = 0.f;
#pragma unroll
                for (int bj = 0; bj < 2; ++bj)
#pragma unroll
                    for (int n = 0; n < 2; ++n) { const f32x4 d = v[ai][bj][m][n] - mw; q += (d[0] * d[0] + d[1] * d[1]) + (d[2] * d[2] + d[3] * d[3]); }
                q += __shfl_xor(q, 16); q += __shfl_xor(q, 32);
                if (fq == 0) P[(ai * HALF + wr * 64 + m * 16 + fr) * 4 + wc] = (f32x2v){mw, q};
            }
        asm volatile("s_waitcnt lgkmcnt(0)" ::: "memory"); __builtin_amdgcn_s_barrier(); asm volatile("" ::: "memory");
#if defined(BROKEN_EXCHANGE_NO_WAIT)
#warning BROKEN CONTROL BUILD: the row-statistics exchange does not wait; results are wrong by design
        if (blockIdx.x >= 64) { const long long t0_ = clock64(); while (clock64() - t0_ < 60000) __builtin_amdgcn_s_sleep(8); }
#endif
        const int row = wid * 32 + (lane & 31);
        if (lane < 32) {
            const f32x2v a = P[row * 4 + 0], b = P[row * 4 + 1], c = P[row * 4 + 2], d = P[row * 4 + 3];
            const float mt = (a.x + b.x + c.x + d.x) * 0.25f;
            const float da = a.x - mt, db = b.x - mt, dc = c.x - mt, dd = d.x - mt;
            const float m2 = (a.y + b.y) + (c.y + d.y) + 64.0f * ((da * da + db * db) + (dc * dc + dd * dd));
            unsigned long long* slot = (unsigned long long*)xbuf + ((size_t)(u.pm * BM + row) * 4 + u.pn);
            __hip_atomic_store(slot, ((unsigned long long)__float_as_uint(m2) << 32) | __float_as_uint(mt), __ATOMIC_RELAXED, __HIP_MEMORY_SCOPE_AGENT);
        }
        asm volatile("s_waitcnt vmcnt(0)" ::: "memory");
        if (lane == 0) __hip_atomic_fetch_add(cnt + 64 * u.pm, 1u, __ATOMIC_RELAXED, __HIP_MEMORY_SCOPE_AGENT);
        if (wid == 0) {
            bool dead = false; const unsigned long long t0 = __builtin_amdgcn_s_memrealtime(); const unsigned want = 8u * (unsigned)ntn;
            for (;;) {
#if defined(BROKEN_EXCHANGE_NO_WAIT)
                break;
#endif
                if ((unsigned)__builtin_amdgcn_readfirstlane(__hip_atomic_load(cnt + 64 * u.pm, __ATOMIC_RELAXED, __HIP_MEMORY_SCOPE_AGENT)) >= want) break;
                if (__builtin_amdgcn_s_memrealtime() - t0 > 2000000ull) {
                    if (lane == 0) { unsigned expect = 0u; __hip_atomic_compare_exchange_strong(tmo + 1, &expect, code | (unsigned)(u.pm & 0xff), __ATOMIC_RELAXED, __ATOMIC_RELAXED, __HIP_MEMORY_SCOPE_AGENT);
                                     __hip_atomic_store(tmo, 1u, __ATOMIC_RELAXED, __HIP_MEMORY_SCOPE_AGENT); }
                    dead = true; break; }
                __builtin_amdgcn_s_sleep(2);
            }
            __builtin_amdgcn_fence(__ATOMIC_ACQUIRE, "agent");
            if (lane == 0) flag[0] = dead ? 1u : 0u;
        }
        asm volatile("s_waitcnt vmcnt(0) lgkmcnt(0)" ::: "memory"); __builtin_amdgcn_s_barrier(); asm volatile("" ::: "memory");
        const bool bad = flag[0] != 0u;
        if (lane < 32) {
            const unsigned long long* slot = (const unsigned long long*)xbuf + (size_t)(u.pm * BM + row) * 4; float mt[4], m2[4]; float ms = 0.f;
#pragma unroll
            for (int t = 0; t < 4; ++t) { if (t < ntn) { const unsigned long long w = __hip_atomic_load(slot + t, __ATOMIC_RELAXED, __HIP_MEMORY_SCOPE_AGENT); mt[t] = __uint_as_float((unsigned)w); m2[t] = __uint_as_float((unsigned)(w >> 32)); } else { mt[t] = 0.f; m2[t] = 0.f; } ms += mt[t]; }
            const float mean = ms / (float)ntn; float q = 0.f;
#pragma unroll
            for (int t = 0; t < 4; ++t) if (t < ntn) { const float dm = mt[t] - mean; q += m2[t] + 256.0f * dm * dm; }
            S[row] = (f32x2v){mean, 1.0f / sqrtf(q / (256.0f * (float)ntn) + eps)};
        }
        asm volatile("s_waitcnt lgkmcnt(0)" ::: "memory"); __builtin_amdgcn_s_barrier(); asm volatile("" ::: "memory");
        return bad;
    }
};
struct EpiLnRes {
    static constexpr bool PERM = false, AFTER_DRAIN = true;
    const float* base; float* out; int ldc; const float* bias; PanelStats st; unsigned poison;
    __device__ __forceinline__ void fused(f32x4 (&acc)[2][2][4][2], const Unit& u, int wr, int wc, int fr, int fq, PG8_LAS unsigned char* lds, int wid, int lane) const {
        typedef float f32x2v __attribute__((ext_vector_type(2)));
        const PG8_LAS f32x2v* S = (const PG8_LAS f32x2v*)(lds + 8192);
        const int col0 = u.pn * BM + wc * 32 + 4 * fq;
#pragma unroll
        for (int bj = 0; bj < 2; ++bj)
#pragma unroll
            for (int n = 0; n < 2; ++n) { const f32x4 bv = bias ? *(const f32x4*)(bias + col0 + bj * HALF + n * 16) : (f32x4){0.f, 0.f, 0.f, 0.f};
#pragma unroll
                for (int ai = 0; ai < 2; ++ai)
#pragma unroll
                    for (int m = 0; m < 4; ++m) acc[ai][bj][m][n] += bv; }
        f32x4 pre[4][2][2];
#pragma unroll
        for (int m = 0; m < 4; ++m) { const size_t off = (size_t)(u.pm * BM + wr * 64 + m * 16 + fr) * ldc + col0;
#pragma unroll
            for (int bj = 0; bj < 2; ++bj)
#pragma unroll
                for (int n = 0; n < 2; ++n) pre[m][bj][n] = *(const f32x4*)(base + off + bj * HALF + n * 16); }
        const bool bad = st.run(acc, u, wr, wc, fr, fq, lds, wid, lane) || poison != 0u;
        const float qnan = __builtin_nanf("");
#pragma unroll
        for (int ai = 0; ai < 2; ++ai)
#pragma unroll
            for (int m = 0; m < 4; ++m) { const int r = ai * HALF + wr * 64 + m * 16 + fr; const f32x2v sr = S[r]; const size_t off = (size_t)(u.pm * BM + r) * ldc + col0;
#pragma unroll
                for (int bj = 0; bj < 2; ++bj)
#pragma unroll
                    for (int n = 0; n < 2; ++n) { const f32x4 bs = ai == 0 ? pre[m][bj][n] : *(const f32x4*)(base + off + bj * HALF + n * 16); f32x4 o = bs + (acc[ai][bj][m][n] - sr.x) * sr.y;
                        if (bad) o = (f32x4){qnan, qnan, qnan, qnan}; *(f32x4*)(out + off + bj * HALF + n * 16) = o; }
                if (m & 1) asm volatile("" ::: "memory"); }
    }
};
struct EpiLnResLn {
    static constexpr bool PERM = false, AFTER_DRAIN = true;
    const float* base; float* out; bf16_t* xn; int ldc; const float* bias; PanelStats st1, st2; unsigned poison;
    __device__ __forceinline__ void fused(f32x4 (&acc)[2][2][4][2], const Unit& u, int wr, int wc, int fr, int fq, PG8_LAS unsigned char* lds, int wid, int lane) const {
        typedef float f32x2v __attribute__((ext_vector_type(2))); typedef unsigned u32x2v __attribute__((ext_vector_type(2)));
        const PG8_LAS f32x2v* S = (const PG8_LAS f32x2v*)(lds + 8192);
        const int col0 = u.pn * BM + wc * 32 + 4 * fq;
#pragma unroll
        for (int bj = 0; bj < 2; ++bj)
#pragma unroll
            for (int n = 0; n < 2; ++n) { const f32x4 bv = bias ? *(const f32x4*)(bias + col0 + bj * HALF + n * 16) : (f32x4){0.f, 0.f, 0.f, 0.f};
#pragma unroll
                for (int ai = 0; ai < 2; ++ai)
#pragma unroll
                    for (int m = 0; m < 4; ++m) acc[ai][bj][m][n] += bv; }
        bool bad = st1.run(acc, u, wr, wc, fr, fq, lds, wid, lane) || poison != 0u;
        const float qnan = __builtin_nanf("");
#pragma unroll
        for (int ai = 0; ai < 2; ++ai)
#pragma unroll
            for (int m = 0; m < 4; ++m) { const int r = ai * HALF + wr * 64 + m * 16 + fr; const f32x2v sr = S[r]; const size_t off = (size_t)(u.pm * BM + r) * ldc + col0;
#pragma unroll
                for (int bj = 0; bj < 2; ++bj)
#pragma unroll
                    for (int n = 0; n < 2; ++n) { const f32x4 bs = *(const f32x4*)(base + off + bj * HALF + n * 16); acc[ai][bj][m][n] = bs + (acc[ai][bj][m][n] - sr.x) * sr.y; }
                asm volatile("" : "+v"(acc[ai][0][m][0]), "+v"(acc[ai][0][m][1]), "+v"(acc[ai][1][m][0]), "+v"(acc[ai][1][m][1]));
                if (m & 1) asm volatile("" ::: "memory"); }
        const bool bad1 = bad;
        bad = st2.run(acc, u, wr, wc, fr, fq, lds, wid, lane) || bad;
#pragma unroll
        for (int ai = 0; ai < 2; ++ai)
#pragma unroll
            for (int m = 0; m < 4; ++m) { const int r = ai * HALF + wr * 64 + m * 16 + fr; const f32x2v sr = S[r]; const size_t off = (size_t)(u.pm * BM + r) * ldc + col0;
#pragma unroll
                for (int bj = 0; bj < 2; ++bj)
#pragma unroll
                    for (int n = 0; n < 2; ++n) { const f32x4 x1 = acc[ai][bj][m][n]; *(f32x4*)(out + off + bj * HALF + n * 16) = bad1 ? (f32x4){qnan, qnan, qnan, qnan} : x1;
                        const f32x4 o = (x1 - sr.x) * sr.y; u32x2v w; w.x = cvt_pk_bf16(o[0], o[1]); w.y = cvt_pk_bf16(o[2], o[3]);
                        if (bad) { w.x = 0x7fc07fc0u; w.y = 0x7fc07fc0u; } *(u32x2v*)(xn + off + bj * HALF + n * 16) = w; }
                asm volatile("" ::: "memory"); }
    }
};

template <class Epi, class Sched, bool ALIGN_EPI = false, bool SP2 = false>
__device__ __forceinline__ void gemm_phase(PG8_LAS unsigned char* lds, const Gemm g, const Sched& S, const Epi& E) {
    const int tid = threadIdx.x, wid = __builtin_amdgcn_readfirstlane(tid >> 6), lane = tid & 63, wr = wid >> 2, wc = wid & 3, fr = lane & 15, fq = lane >> 4;
    const int K = g.K, nt = K / BK;
    unsigned voffA[2], voffB[2];
#pragma unroll
    for (int i = 0; i < 2; ++i) { int R, C; stage_rc(tid * 16 + i * 8192, R, C); const int Rb = Epi::PERM ? ((R & ~31) + perm32(R & 31)) : R;
        voffA[i] = (unsigned)(R * g.lda + C) * 2u; voffB[i] = (unsigned)(Rb * g.ldb + C) * 2u; }
    const size_t kstep = (size_t)(BK * 2);
    const size_t hstepA = (size_t)HALF * g.lda * 2, hstepB = (size_t)HALF * g.ldb * 2;
    const size_t tstepA = 2 * hstepA, tstepB = 2 * hstepB;
    const unsigned ldsw = (unsigned)wid * 1024u;
    const int aoff = lds_byte(wr * 64 + fr, fq * 8), boff = lds_byte(wc * 32 + fr, fq * 8);
#define PG8_SA(b, h) (((b) * 2 + (h)) * HTB)
#define PG8_SB(b, h) ((4 + (b) * 2 + (h)) * HTB)
#define PG8_STAGE(bufoff, gbase, voff) do { _Pragma("unroll") for (int _i = 0; _i < 2; ++_i) \
        __builtin_amdgcn_global_load_lds((const unsigned*)((const char*)(gbase) + (voff)[_i]), (PG8_LAS unsigned*)(lds + (bufoff) + ldsw + _i * 8192), 16, 0, 0); } while (0)
#define PG8_LDA(dst, b, h) do { _Pragma("unroll") for (int m = 0; m < 4; ++m) _Pragma("unroll") for (int k = 0; k < 2; ++k) dst[m][k] = *(const PG8_LAS bf16x8*)(lds + PG8_SA(b, h) + aoff + m * 2048 + k * 1024); } while (0)
#define PG8_LDB(dst, b, h) do { _Pragma("unroll") for (int n = 0; n < 2; ++n) _Pragma("unroll") for (int k = 0; k < 2; ++k) dst[n][k] = *(const PG8_LAS bf16x8*)(lds + PG8_SB(b, h) + boff + n * 2048 + k * 1024); } while (0)
#define PG8_MMA(ai, bj, At, Bt) do { __builtin_amdgcn_s_setprio(1); _Pragma("unroll") for (int m = 0; m < 4; ++m) _Pragma("unroll") for (int n = 0; n < 2; ++n) _Pragma("unroll") for (int k = 0; k < 2; ++k) \
        acc[ai][bj][m][n] = __builtin_amdgcn_mfma_f32_16x16x32_bf16(Bt[n][k], At[m][k], acc[ai][bj][m][n], 0, 0, 0); __builtin_amdgcn_s_setprio(0); } while (0)
#define PG8_WAIT_V(n) asm volatile("s_waitcnt vmcnt(" #n ")" ::: "memory")
#define PG8_WAIT_L(n) asm volatile("s_waitcnt lgkmcnt(" #n ")" ::: "memory")
#define PG8_BAR __builtin_amdgcn_s_barrier()
#define PG8_SCHED __builtin_amdgcn_sched_barrier(0)
    Unit cur, nxt; int ui = 0;
    if (!S.next(0, cur)) return;
    f32x4 acc[2][2][4][2];
#pragma unroll
    for (int a = 0; a < 2; ++a)
#pragma unroll
        for (int b = 0; b < 2; ++b)
#pragma unroll
            for (int m = 0; m < 4; ++m)
#pragma unroll
                for (int n = 0; n < 2; ++n) acc[a][b][m][n] = (f32x4){0.f, 0.f, 0.f, 0.f};
    bf16x8 At[4][2], B0[2][2], B1[2][2];
    const char* cA = (const char*)g.A + (size_t)cur.pm * tstepA; const char* cB = (const char*)g.Bt + (size_t)cur.pn * tstepB;
    S.a_ready(cur);
    if constexpr (SP2) {
        PG8_STAGE(PG8_SB(0, 0), cB, voffB); PG8_STAGE(PG8_SB(0, 1), cB + hstepB, voffB); PG8_STAGE(PG8_SA(0, 0), cA, voffA); PG8_STAGE(PG8_SA(0, 1), cA + hstepA, voffA);
        if (wr == 1) PG8_BAR;
        PG8_WAIT_V(2); PG8_BAR;
        PG8_STAGE(PG8_SB(1, 0), cB + kstep, voffB); PG8_STAGE(PG8_SA(1, 0), cA + kstep, voffA); PG8_STAGE(PG8_SB(1, 1), cB + hstepB + kstep, voffB);
        PG8_WAIT_V(6); PG8_BAR;
    } else {
        PG8_STAGE(PG8_SB(0, 0), cB, voffB); PG8_STAGE(PG8_SA(0, 0), cA, voffA); PG8_STAGE(PG8_SB(0, 1), cB + hstepB, voffB); PG8_STAGE(PG8_SA(0, 1), cA + hstepA, voffA);
        if (wr == 1) PG8_BAR;
        PG8_WAIT_V(4); PG8_BAR;
        PG8_STAGE(PG8_SB(1, 0), cB + kstep, voffB); PG8_STAGE(PG8_SA(1, 0), cA + kstep, voffA); PG8_STAGE(PG8_SB(1, 1), cB + hstepB + kstep, voffB);
        PG8_WAIT_V(6); PG8_BAR;
    }
    for (;;) {
        const bool has_next = S.next(ui + 1, nxt);
        const char* nA = has_next ? (const char*)g.A + (size_t)nxt.pm * tstepA : cA; const char* nB = has_next ? (const char*)g.Bt + (size_t)nxt.pn * tstepB : cB;
        for (int t = 0; t < nt; t += 2) {
            const bool last = (t == nt - 2);
            const char* a1 = cA + (size_t)(t + 1) * kstep;
            const char* a2 = last ? nA : cA + (size_t)(t + 2) * kstep; const char* b2 = last ? nB : cB + (size_t)(t + 2) * kstep;
            const char* a3 = a2 + kstep; const char* b3 = b2 + kstep;
            if (last && has_next) S.a_ready(nxt);
            if constexpr (SP2) {
            PG8_LDB(B0, 0, 0); PG8_LDB(B1, 0, 1); PG8_SCHED; PG8_LDA(At, 0, 0); PG8_STAGE(PG8_SA(1, 1), a1 + hstepA, voffA);
            PG8_WAIT_V(8); PG8_WAIT_L(0); PG8_BAR; PG8_MMA(0, 0, At, B0); PG8_MMA(0, 1, At, B1); PG8_BAR; PG8_SCHED;
            PG8_LDA(At, 0, 1); PG8_STAGE(PG8_SB(0, 0), b2, voffB); PG8_STAGE(PG8_SB(0, 1), b2 + hstepB, voffB); PG8_STAGE(PG8_SA(0, 0), a2, voffA);
            PG8_WAIT_V(8); PG8_WAIT_L(0); PG8_BAR; PG8_MMA(1, 0, At, B0); PG8_MMA(1, 1, At, B1); PG8_BAR; PG8_SCHED;
            PG8_LDB(B0, 1, 0); PG8_LDB(B1, 1, 1); PG8_SCHED; PG8_LDA(At, 1, 0); PG8_STAGE(PG8_SA(0, 1), a2 + hstepA, voffA);
            PG8_WAIT_V(8); PG8_WAIT_L(0); PG8_BAR; PG8_MMA(0, 0, At, B0); PG8_MMA(0, 1, At, B1); PG8_BAR; PG8_SCHED;
            PG8_LDA(At, 1, 1); PG8_STAGE(PG8_SB(1, 0), b3, voffB); PG8_STAGE(PG8_SB(1, 1), b3 + hstepB, voffB); PG8_STAGE(PG8_SA(1, 0), a3, voffA);
            PG8_WAIT_V(8); PG8_WAIT_L(0); PG8_BAR; PG8_MMA(1, 0, At, B0); PG8_MMA(1, 1, At, B1); PG8_BAR; PG8_SCHED;
            } else {
            PG8_LDB(B0, 0, 0); PG8_SCHED; PG8_LDA(At, 0, 0); PG8_STAGE(PG8_SA(1, 1), a1 + hstepA, voffA);
            PG8_WAIT_L(8); PG8_BAR; PG8_WAIT_L(0); PG8_MMA(0, 0, At, B0); PG8_BAR; PG8_SCHED;
            PG8_LDB(B1, 0, 1); PG8_STAGE(PG8_SB(0, 0), b2, voffB);
            PG8_BAR; PG8_WAIT_L(0); PG8_MMA(0, 1, At, B1); PG8_BAR;
            PG8_LDA(At, 0, 1); PG8_STAGE(PG8_SA(0, 0), a2, voffA);
            PG8_BAR; PG8_WAIT_L(0); PG8_MMA(1, 0, At, B0); PG8_BAR; PG8_SCHED;
            PG8_STAGE(PG8_SB(0, 1), b2 + hstepB, voffB);
            PG8_WAIT_V(6); PG8_BAR; PG8_MMA(1, 1, At, B1); PG8_BAR;
            PG8_LDB(B0, 1, 0); PG8_SCHED; PG8_LDA(At, 1, 0); PG8_STAGE(PG8_SA(0, 1), a2 + hstepA, voffA);
            PG8_WAIT_L(8); PG8_BAR; PG8_WAIT_L(0); PG8_MMA(0, 0, At, B0); PG8_BAR; PG8_SCHED;
            PG8_LDB(B1, 1, 1); PG8_STAGE(PG8_SB(1, 0), b3, voffB);
            PG8_BAR; PG8_WAIT_L(0); PG8_MMA(0, 1, At, B1); PG8_BAR;
            PG8_LDA(At, 1, 1); PG8_STAGE(PG8_SA(1, 0), a3, voffA);
            PG8_BAR; PG8_WAIT_L(0); PG8_MMA(1, 0, At, B0); PG8_BAR; PG8_SCHED;
            PG8_STAGE(PG8_SB(1, 1), b3 + hstepB, voffB);
            PG8_WAIT_V(6); PG8_BAR; PG8_MMA(1, 1, At, B1); PG8_BAR;
            }
        }
        if constexpr (ALIGN_EPI) { if (wr == 0) PG8_BAR; }
        if constexpr (!Epi::AFTER_DRAIN) { E(acc, cur, wr, wc, fr, fq); S.done(cur); }
        if (!has_next) break;
#pragma unroll
        for (int a = 0; a < 2; ++a)
#pragma unroll
            for (int b = 0; b < 2; ++b)
#pragma unroll
                for (int m = 0; m < 4; ++m)
#pragma unroll
                    for (int n = 0; n < 2; ++n) acc[a][b][m][n] = (f32x4){0.f, 0.f, 0.f, 0.f};
        cur = nxt; cA = nA; cB = nB; ++ui;
        if constexpr (ALIGN_EPI) { if (wr == 1) PG8_BAR; }
    }
    PG8_WAIT_V(0);
    if constexpr (!ALIGN_EPI) { if (wr == 0) PG8_BAR; }
    PG8_BAR;
    if constexpr (Epi::AFTER_DRAIN) { E.fused(acc, cur, wr, wc, fr, fq, lds, wid, lane); S.done(cur); }
#undef PG8_SA
#undef PG8_SB
#undef PG8_STAGE
#undef PG8_LDA
#undef PG8_LDB
#undef PG8_MMA
#undef PG8_WAIT_V
#undef PG8_WAIT_L
#undef PG8_BAR
#undef PG8_SCHED
}
}
#ifdef __HIPCC__
#define HD __host__ __device__ __forceinline__
#define UNR _Pragma("unroll")
typedef unsigned short act_t;
HD float ldf(act_t v) { unsigned u = ((unsigned)v) << 16; float f; __builtin_memcpy(&f, &u, 4); return f; }
HD act_t stf(float f) { unsigned u; __builtin_memcpy(&u, &f, 4); u = (u + 0x7fffu + ((u >> 16) & 1u)) >> 16; return (act_t)u; }
#else
#define HD inline
#define UNR
typedef float act_t;
HD float ldf(act_t v) { return v; }
HD act_t stf(float f) { return f; }
#endif

struct Dims {
    int D, B, S, DB, N, PAST, GW;
    int NAH, NAD;
    int LW, LB, LBK;
    int MH, MQR, MKR, MNOPE, MROPE, MV, MQK, MDN  ;
    int SH, SKVH, SD, SWIN;
    int DFF;
    int RC, R, RK  ;
};
HD int cond_of(const Dims& d, int row) { return row < d.RC ? 0 : 1 + (row - d.RC) / d.N; }
HD float silu_f(float x) { return x / (1.f + expf(-x)); }
HD float sigm_f(float x) { return 1.f / (1.f + expf(-x)); }
HD float gelu_f(float x) { const float u = 0.7978845608028654f * (x + 0.044715f * x * x * x); return x / (1.f + expf(-2.f * u)); }

struct OpTranspose { const float* W; act_t* Wt; long K, N, NP, perm, DFF;
    HD void run(long g) const { const int n = (int)(g / K), k = (int)(g % K); float v = 0.f;
        if (n < N) { int sc = n; if (perm == 1) { const int un = n / 256, j = n % 256; sc = j < 128 ? un * 128 + j : DFF + un * 128 + (j - 128); } v = W[(size_t)k * N + sc]; }
        Wt[(size_t)n * K + k] = stf(v); } };
struct OpCvt { const float* src; act_t* dst; HD void run(long g) const { dst[g] = stf(src[g]); } };
struct OpMod { const float* c; const float* cctx; const float* w; const float* b; float* MOD; long D, NCI;
    HD void run(long g) const { const int N6 = 6 * D; const int n = (int)(g % N6); const int ci = (int)((g / N6) % NCI); const int l = (int)(g / ((long)N6 * NCI));
        const float* cond = ci == 0 ? cctx : c + (size_t)(ci - 1) * D; const float* wl = w + (size_t)l * D * N6; float acc = b[(size_t)l * N6 + n];
        for (int k = 0; k < D; ++k) acc += silu_f(cond[k]) * wl[(size_t)k * N6 + n];
        MOD[g] = acc; } };
struct OpNormMod { const float* xc; const float* xl;   const float* g; const float* mod;   long chunk;   act_t* H; Dims d;
    HD void run(long row) const { const int D = d.D; const float* x = row < d.RC ? xc + (size_t)row * D : xl + (size_t)(row - d.RC) * D;
        float ss = 0.f; for (int k = 0; k < D; ++k) ss += x[k] * x[k];
        const float rstd = 1.f / sqrtf(ss / D + 1e-6f); const float* m = mod + (size_t)cond_of(d, (int)row) * 6 * D + (size_t)chunk * D;
        for (int k = 0; k < D; ++k) H[(size_t)row * D + k] = stf(x[k] * rstd * g[k] * (1.f + m[D + k]) + m[k]); } };
struct OpResid { const float* xc; const float* xl; const float* T; const float* mod; long chunk; float* out; Dims d;
    HD void run(long g) const { const int D = d.D; const int row = (int)(g / D), c = (int)(g % D);
        const float x = row < d.RC ? xc[(size_t)row * D + c] : xl[(size_t)(row - d.RC) * D + c];
        out[g] = x + mod[(size_t)cond_of(d, row) * 6 * D + (size_t)chunk * D + c] * T[g]; } };
struct OpRope { float* cs; float* sn; long rot, GW;
    HD void run(long g) const { const int t = (int)(g / rot), li = (int)(g % rot); const int half = rot / 2, nf = half / 2; const int f = li % nf;
        const float pos = (li < half) ? (float)(t / GW) : (float)(t % GW);
        const float inv = exp2f(-(float)(2 * f) / (float)half * 13.287712379549449f); const float a = pos * inv;
        const float rev = a * 0.15915494309189535f; const float fr = rev - floorf(rev);
#ifdef __HIP_DEVICE_COMPILE__
        cs[g] = __builtin_amdgcn_cosf(fr); sn[g] = __builtin_amdgcn_sinf(fr);
#else
        cs[g] = cosf(fr * 6.283185307179586f); sn[g] = sinf(fr * 6.283185307179586f);
#endif
    } };
struct OpHeadPost { const act_t* sa; long pa; long sha, na; const act_t* sb; long pb; long shb, nb; const float* gain; act_t* dst; long pd; long shd; long NH; long rot; const float* cs; const float* sn; float* of; long norm; Dims d; long rows_lat_end;
    HD void run(long g) const { const int row = (int)(g / NH), h = (int)(g % NH); const int dh = na + nb;
        const act_t* pA = sa + (size_t)row * pa + (size_t)h * sha; const act_t* pB = sb ? sb + (size_t)row * pb + (size_t)h * shb : nullptr;
        float ss = 0.f; for (int k = 0; k < dh; ++k) { const float v = k < na ? ldf(pA[k]) : ldf(pB[k - na]); ss += v * v; }
        const float rstd = norm ? 1.f / sqrtf(ss / dh + 1e-6f) : 1.f;
        act_t* o = dst + (size_t)row * pd + (size_t)h * shd;
        const bool lat = rot > 0 && row >= d.RC && row < rows_lat_end; const int t = lat ? (row - d.RC) % d.N : 0; const int r0 = dh - rot, half = rot / 2, q4 = rot / 4;
        float* ofp = (of && row < d.RC) ? of + ((size_t)((row / d.S) * NH + h) * d.S + (row % d.S)) * dh : nullptr;
        for (int k = 0; k < dh; ++k) { float v = (k < na ? ldf(pA[k]) : ldf(pB[k - na])) * rstd * (norm ? gain[k] : 1.f);
            if (lat && k >= r0) { const int li = k - r0; const int w = li % half; if (w >= q4) continue;
                const int k2 = k + q4; const float v2 = (k2 < na ? ldf(pA[k2]) : ldf(pB[k2 - na])) * rstd * (norm ? gain[k2] : 1.f);
                const size_t tb = (size_t)t * rot + li;
                o[k] = stf(v * cs[tb] - v2 * sn[tb]); o[k2] = stf(v2 * cs[tb + q4] + v * sn[tb + q4]); continue; }
            if (ofp) ofp[k] = v;
            o[k] = stf(v); } } };

template <int DQK, int DV> struct OSM { float q[DQK]; float o[DV]; float m, l, scale;
    HD void init(const act_t* qp, float sc) { UNR for (int i = 0; i < DQK; ++i) q[i] = ldf(qp[i]); UNR for (int i = 0; i < DV; ++i) o[i] = 0.f; m = -1e30f; l = 0.f; scale = sc; }
    HD void key(const act_t* kp, const act_t* vp, float bias) { float s = 0.f; UNR for (int i = 0; i < DQK; ++i) s += q[i] * ldf(kp[i]); s = s * scale + bias;
        const float mn = s > m ? s : m; const float a = expf(m - mn), p = expf(s - mn); l = l * a + p; UNR for (int i = 0; i < DV; ++i) o[i] = o[i] * a + p * ldf(vp[i]); m = mn; }
    HD void sink(float sk) { const float mn = sk > m ? sk : m; const float a = expf(m - mn); l = l * a + expf(sk - mn); UNR for (int i = 0; i < DV; ++i) o[i] *= a; m = mn; }
    HD void fin(act_t* op) { const float r = 1.f / l; UNR for (int i = 0; i < DV; ++i) op[i] = stf(o[i] * r); } };

template <int DQK, int DV> struct OpAttnCtx { const act_t* Q; long pq; long shq; const act_t* K; long pk; long shk; const act_t* V; long pv; long shv; act_t* O; long po; long sho; long NH, G; const float* sinks; Dims d;
    HD void run(long g) const { const int t = (int)(g % d.S); const int h = (int)((g / d.S) % NH); const int b = (int)(g / ((long)d.S * NH)); const int kvh = h / G;
        OSM<DQK, DV> st; st.init(Q + (size_t)(b * d.S + t) * pq + (size_t)h * shq, 1.f / sqrtf((float)DQK));
        for (int j = 0; j < d.S; ++j) { const size_t r = (size_t)(b * d.S + j); st.key(K + r * pk + (size_t)kvh * shk, V + r * pv + (size_t)kvh * shv, 0.f); }
        if (sinks) st.sink(sinks[h]);
        st.fin(O + (size_t)(b * d.S + t) * po + (size_t)h * sho); } };
template <int DH> struct OpNatLat { const act_t* QKV; long pq; const act_t* CK; const act_t* CV; const float* rpb; act_t* O; long po; Dims d;
    HD void run(long g) const { const int t = (int)(g % d.N); const int h = (int)((g / d.N) % d.NAH); const int b = (int)(g / ((long)d.N * d.NAH));
        const int GW = d.GW, rows = d.N / GW; const int wr = rows < 8 ? rows : 8; const int r = t / GW, c = t % GW;
        int rs = r - wr / 2; rs = rs < 0 ? 0 : (rs > rows - wr ? rows - wr : rs); int cst = c - 8; cst = cst < 0 ? 0 : (cst > GW - 16 ? GW - 16 : cst);
        const size_t rb = (size_t)d.RC + (size_t)b * d.N; const int HD_ = d.NAH * DH;
        OSM<DH, DH> st; st.init(QKV + (rb + t) * pq + (size_t)h * DH, 1.f / sqrtf((float)DH));
        for (int j = 0; j < d.PAST; ++j) { const size_t o = ((size_t)(b * d.NAH + h) * d.PAST + j) * DH; st.key(CK + o, CV + o, 0.f); }
        for (int kr = rs; kr < rs + wr; ++kr) for (int kc = cst; kc < cst + 16; ++kc) { const size_t kt = rb + (size_t)kr * GW + kc;
            const float bias = rpb[((size_t)h * 15 + (kr - r + 7)) * 31 + (kc - c + 15)];
            st.key(QKV + kt * pq + HD_ + (size_t)h * DH, QKV + kt * pq + 2 * HD_ + (size_t)h * DH, bias); }
        st.fin(O + (rb + t) * po + (size_t)h * DH); } };
template <int DQK, int DV> struct OpMlaLat { const act_t* Q; const act_t* K; const act_t* KV; act_t* O; long po; Dims d;
    HD void run(long g) const { const int t = (int)(g % d.N); const int h = (int)((g / d.N) % d.MH); const int b = (int)(g / ((long)d.N * d.MH));
        const size_t rb = (size_t)d.RC + (size_t)b * d.N; const size_t pq = (size_t)d.MH * DQK, pkv = (size_t)d.MH * (d.MNOPE + DV);
        OSM<DQK, DV> st; st.init(Q + (rb + t) * pq + (size_t)h * DQK, 1.f / sqrtf((float)DQK));
        for (int j = 0; j < d.PAST; ++j) { const size_t r = (size_t)d.R + (size_t)b * d.PAST + j; st.key(K + r * pq + (size_t)h * DQK, KV + r * pkv + (size_t)h * (d.MNOPE + DV) + d.MNOPE, 0.f); }
        for (int j = 0; j < d.N; ++j) { const size_t r = rb + j; st.key(K + r * pq + (size_t)h * DQK, KV + r * pkv + (size_t)h * (d.MNOPE + DV) + d.MNOPE, 0.f); }
        st.fin(O + (rb + t) * po + (size_t)h * DV); } };
template <int DH> struct OpSwaLat { const act_t* QKV; long pq; const act_t* CK; const act_t* CV; const float* sinks; act_t* O; long po; Dims d;
    HD void run(long g) const { const int t = (int)(g % d.N); const int h = (int)((g / d.N) % d.SH); const int b = (int)(g / ((long)d.N * d.SH)); const int G = d.SH / d.SKVH, kvh = h / G;
        const size_t rb = (size_t)d.RC + (size_t)b * d.N;
        OSM<DH, DH> st; st.init(QKV + (rb + t) * pq + (size_t)h * DH, 1.f / sqrtf((float)DH));
        for (int j = 0; j < d.PAST; ++j) { const size_t o = ((size_t)(b * d.SKVH + kvh) * d.PAST + j) * DH; st.key(CK + o, CV + o, 0.f); }
        int lo = t - d.SWIN, hi = t + d.SWIN; lo = lo < 0 ? 0 : lo; hi = hi > d.N - 1 ? d.N - 1 : hi;
        for (int j = lo; j <= hi; ++j) { const size_t r = rb + j; st.key(QKV + r * pq + (size_t)(d.SH + kvh) * DH, QKV + r * pq + (size_t)(d.SH + d.SKVH + kvh) * DH, 0.f); }
        st.sink(sinks[h]);
        st.fin(O + (rb + t) * po + (size_t)h * DH); } };

struct OpLruConv { const act_t* XG; const float* cw; const float* cb; act_t* XC; Dims d;
    HD void run(long g) const { const int LW = d.LW; const int row = (int)(g / LW), c = (int)(g % LW);
        int s0, T; if (row < d.RC) { s0 = (row / d.S) * d.S; T = d.S; } else { s0 = d.RC + ((row - d.RC) / d.N) * d.N; T = d.N; } const int t = row - s0;
        float acc = cb[c]; for (int k = 0; k < 4; ++k) { const int tt = t + k - 2; if (tt >= 0 && tt < T) acc += cw[(size_t)k * LW + c] * ldf(XG[(size_t)(s0 + tt) * 2 * LW + c]); }
        XC[g] = stf(acc); } };
struct OpLruScan { const act_t* XC; const act_t* XG; const float* wa; const float* ba; const float* wi; const float* bi; const float* lam; const float* h0; act_t* HS; act_t* Y; float* state_out; Dims d;
    HD void step(int dir, size_t row, int c, int blk, int j, float sp, float& h) const { const int LW = d.LW, LBK = d.LBK;
        const act_t* xr = XC + row * LW + (size_t)blk * LBK; const float* Wa = wa + ((size_t)(dir * d.LB + blk) * LBK) * LBK + j; const float* Wi = wi + ((size_t)(dir * d.LB + blk) * LBK) * LBK + j;
        float ra = ba[(size_t)dir * LW + c], ri = bi[(size_t)dir * LW + c];
        for (int k = 0; k < LBK; ++k) { const float x = ldf(xr[k]); ra += x * Wa[(size_t)k * LBK]; ri += x * Wi[(size_t)k * LBK]; }
        const float r = sigm_f(ra), ig = sigm_f(ri); const float la = -8.f * r * sp; const float a = expf(la); const float om = -expm1f(2.f * la);
        h = a * h + sqrtf(om) * (ig * ldf(XC[row * LW + c])); }
    HD void run(long g) const { const int LW = d.LW; const int seq = (int)(g / LW), c = (int)(g % LW); const int blk = c / d.LBK, j = c % d.LBK;
        size_t s0; int T; float hf = 0.f, hb = 0.f;
        if (seq < d.B) { s0 = (size_t)seq * d.S; T = d.S; } else { const int b = seq - d.B; s0 = (size_t)d.RC + (size_t)b * d.N; T = d.N; hf = h0[((size_t)b * 2 + 0) * LW + c]; hb = h0[((size_t)b * 2 + 1) * LW + c]; }
        float spf, spb; { const float l0 = lam[c], l1 = lam[LW + c]; spf = log1pf(expf(-l0)); spb = log1pf(expf(-l1)); }
        for (int t = 0; t < T; ++t) { step(0, s0 + t, c, blk, j, spf, hf); HS[(s0 + t) * LW + c] = stf(hf); }
        for (int t = T - 1; t >= 0; --t) { step(1, s0 + t, c, blk, j, spb, hb); const size_t row = s0 + t; Y[row * LW + c] = stf(gelu_f(ldf(XG[row * 2 * LW + LW + c])) * (ldf(HS[row * LW + c]) + hb)); }
        if (seq < d.B) { state_out[((size_t)seq * 2 + 0) * LW + c] = hf; state_out[((size_t)seq * 2 + 1) * LW + c] = hb; } } };

struct OpMlaNorm { act_t* Dn; act_t* KR; const float* gqa; const float* gkva; const float* cckv; const float* ckr; float* o_ckv; float* o_kr; Dims d;
    HD void run(long row) const { act_t* p = Dn + (size_t)row * d.MDN; act_t* kr = KR + (size_t)row * d.MROPE;
        if (row >= d.R) { const size_t j = (size_t)(row - d.R); for (int k = 0; k < d.MKR; ++k) p[d.MQR + k] = stf(cckv[j * d.MKR + k]); for (int k = 0; k < d.MROPE; ++k) kr[k] = stf(ckr[j * d.MROPE + k]); return; }
        float ss = 0.f; for (int k = 0; k < d.MQR; ++k) { const float v = ldf(p[k]); ss += v * v; } float rs = 1.f / sqrtf(ss / d.MQR + 1e-6f);
        for (int k = 0; k < d.MQR; ++k) p[k] = stf(ldf(p[k]) * rs * gqa[k]);
        ss = 0.f; for (int k = 0; k < d.MKR; ++k) { const float v = ldf(p[d.MQR + k]); ss += v * v; } rs = 1.f / sqrtf(ss / d.MKR + 1e-6f);
        for (int k = 0; k < d.MKR; ++k) { const float v = ldf(p[d.MQR + k]) * rs * gkva[k]; p[d.MQR + k] = stf(v); if (row < d.RC) o_ckv[(size_t)row * d.MKR + k] = v; }
        for (int k = 0; k < d.MROPE; ++k) { const act_t v = p[d.MQR + d.MKR + k]; kr[k] = v; if (row < d.RC) o_kr[(size_t)row * d.MROPE + k] = ldf(v); } } };

struct OpFfnAct { const act_t* U; const float* cw; const float* cb; act_t* G; long row0; long nrows; Dims d;
    HD void run(long g) const { const int F = d.DFF; const int lr = (int)(g / F), c = (int)(g % F); const int row = row0 + lr;
        int s0, T; if (row < d.RC) { s0 = (row / d.S) * d.S; T = d.S; } else { s0 = d.RC + ((row - d.RC) / d.N) * d.N; T = d.N; } const int t = row - s0;
        float acc = cb[c]; for (int k = 0; k < 3; ++k) { const int tt = t + k - 1; if (tt >= 0 && tt < T) acc += cw[(size_t)k * F + c] * ldf(U[(size_t)(s0 + tt - row0) * 2 * F + c]); }
        G[(size_t)lr * F + c] = stf(silu_f(acc) * ldf(U[(size_t)lr * 2 * F + F + c])); } };
struct OpCopyV { const act_t* src; long ps; long sh; long NH, dh; float* of; Dims d;
    HD void run(long g) const { const int k = (int)(g % dh); const int h = (int)((g / dh) % NH); const int row = (int)(g / ((long)dh * NH));
        of[((size_t)((row / d.S) * NH + h) * d.S + (row % d.S)) * dh + k] = ldf(src[(size_t)row * ps + (size_t)h * sh + k]); } };

struct WS {
    float* MOD; float* ropeC; float* ropeS;
    act_t *Wffn_in[4], *Wffn_out[4], *Wnat_qkv, *Wnat_o, *Wlru_in, *Wlru_out, *Wmla_down, *Wmla_uq, *Wmla_ukv, *Wmla_o, *Wswa_qkv, *Wswa_o;
    act_t *natCK, *natCV, *swaCK, *swaCV;
    act_t* H;
    act_t* OB;
    float* T_mix[4]; float* T_ffn;
    act_t* QKV;
    act_t *XG, *XC, *HS, *Y;
    act_t *Dn, *KR, *Q, *KVr, *K;
    act_t *U, *G;
    int ffn_chunk_rows;
};
enum { I_xp = 0, I_xs, I_cnk, I_cnv, I_slru, I_cckv, I_ckr, I_csk, I_csv, I_c, I_cctx, I_nmix, I_nffn, I_wmod, I_bmod, I_fwin, I_fcw, I_fcb, I_fwout,
       I_nwqkv, I_nqn, I_nkn, I_nrpb, I_nwo, I_lwin, I_lcw, I_lcb, I_lwa, I_lba, I_lwi, I_lbi, I_llam, I_lwout, I_mwd, I_mqan, I_mkvan, I_mwuq, I_mwukv, I_mqn, I_mkn, I_mwo,
       I_swqkv, I_sqn, I_skn, I_ssink, I_swo, N_IN };
struct OutPtrs { float *yp, *ys, *nat_k, *nat_v, *lru, *ckv, *krope, *swa_k, *swa_v; };

#define LAS __attribute__((address_space(3)))
namespace mk {
typedef unsigned short bf16;
typedef short bf16x8 __attribute__((ext_vector_type(8)));
typedef short s16x4 __attribute__((ext_vector_type(4)));
typedef float f32x4 __attribute__((ext_vector_type(4)));
typedef float f32x16 __attribute__((ext_vector_type(16)));
typedef unsigned u32x4 __attribute__((ext_vector_type(4)));
typedef unsigned u32x2 __attribute__((ext_vector_type(2)));
constexpr int D = 2048, RC = 4096, NLAT = 4096, R = 36864, RK = 38912, DFF = 5632, NCI = 9, N6 = 12288, LW = 2688, LBK = 168;
constexpr int NQ = 2048, MDN = 1536, MQW = 3072, MKVW = 4096, SQW = 2560;
constexpr float LOG2E = 1.4426950408889634f;
constexpr size_t MiB = 1u << 20;
constexpr size_t WS_CTL = 0, WS_MOD = 1, WS_ROPEC = 3, WS_ROPES = 4, WS_NATCK = 5, WS_NATCV = 13, WS_SWACK = 21, WS_SWACV = 22, WS_WG = 1490, WS_WFFN = 26, WS_WNQKV = 290, WS_WNO = 314, WS_WLIN = 322, WS_WLOUT = 344,
    WS_WMD = 355, WS_WMUQ = 361, WS_WMUKV = 366, WS_WMO = 370, WS_WSQKV = 378, WS_WSO = 388, WS_H = 396, WS_S = 540;
constexpr size_t WS_QKV = 540, WS_XG = 540, WS_AGG = 918, WS_CARRY = 944, WS_Y = 1296, WS_DN = 540, WS_KR = 654, WS_Q = 659, WS_KVR = 875, WS_K = 1179, WS_G = 540, WS_SIDE = 936;
constexpr int CW_BAR = 4096;
constexpr int EPI_OFF = 131072, LDSCTL_OFF = 131072 + 12288, MISC_OFF = LDSCTL_OFF + 320, LDS_BYTES = 147456;

struct Fr { LAS unsigned char* lds; int tid, lane, wave, G, bid; };
__device__ __forceinline__ unsigned f2bf(float f) { unsigned u = __builtin_bit_cast(unsigned, f); return (u + 0x7fffu + ((u >> 16) & 1u)) >> 16; }
__device__ __forceinline__ unsigned pk2(float lo, float hi) { unsigned r; asm volatile("v_cvt_pk_bf16_f32 %0, %1, %2" : "=v"(r) : "v"(lo), "v"(hi)); return r; }
__device__ __forceinline__ float bf2f(unsigned short v) { return __builtin_bit_cast(float, ((unsigned)v) << 16); }
__device__ __forceinline__ float bflo(unsigned w) { return __builtin_bit_cast(float, w << 16); }
__device__ __forceinline__ float bfhi(unsigned w) { return __builtin_bit_cast(float, w & 0xffff0000u); }
__device__ __forceinline__ float wave_sum(float v) {
#pragma unroll
    for (int o = 1; o < 64; o <<= 1) v += __shfl_xor(v, o);
    return v; }
__device__ __forceinline__ float fexp2(float x) { return __builtin_amdgcn_exp2f(x); }
__device__ __forceinline__ float frcp(float x) { return __builtin_amdgcn_rcpf(x); }
__device__ __forceinline__ float sigm(float x) { return frcp(1.f + fexp2(-x * LOG2E)); }
__device__ __forceinline__ float siluf(float x) { return x * sigm(x); }
__device__ __forceinline__ float geluf(float x) { const float u = 0.7978845608028654f * (x + 0.044715f * x * x * x); return x * sigm(2.f * u); }
__device__ __forceinline__ void unpack8(const bf16x8& v, float (&f)[8]) { const u32x4 w = __builtin_bit_cast(u32x4, v);
    f[0] = bflo(w.x); f[1] = bfhi(w.x); f[2] = bflo(w.y); f[3] = bfhi(w.y); f[4] = bflo(w.z); f[5] = bfhi(w.z); f[6] = bflo(w.w); f[7] = bfhi(w.w); }
__device__ __forceinline__ bf16x8 pack8(const float (&f)[8]) { u32x4 w; w.x = pk2(f[0], f[1]); w.y = pk2(f[2], f[3]); w.z = pk2(f[4], f[5]); w.w = pk2(f[6], f[7]); return __builtin_bit_cast(bf16x8, w); }

#define XB_TMO      128
#define XB_XCNT(j)  (256  + 64 * (j))
#define XB_XSUB(j)  (1280 + 64 * (j))
#define XB_XGEN(j)  (2304 + 64 * (j))
#define XB_TOP      3328
#define XB_TOPGEN   3392
#define XCD_BAR_WORDS 3456
#define XB_SPIN_CAP (1u << 22)
__device__ __forceinline__ unsigned xb_ld(unsigned* p)              { return __hip_atomic_load(p, __ATOMIC_RELAXED, __HIP_MEMORY_SCOPE_AGENT); }
__device__ __forceinline__ unsigned xb_add(unsigned* p, unsigned v) { return __hip_atomic_fetch_add(p, v, __ATOMIC_RELAXED, __HIP_MEMORY_SCOPE_AGENT); }
__device__ __forceinline__ unsigned xb_xcc_id() { return (unsigned)__builtin_amdgcn_s_getreg((3 << 11) | 20) & 0xFu; }
#define XB_SPIN(cond, bar) do { unsigned _sp = 0; while (cond) { __builtin_amdgcn_s_sleep(1); \
    if ((++_sp & 255u) == 0u) { if (xb_ld(&(bar)[XB_TMO])) break; if (_sp > XB_SPIN_CAP) { atomicAdd(&(bar)[XB_TMO], 1u); break; } } } } while (0)
struct XcdBarrier { unsigned* bar; unsigned x; volatile LAS unsigned* st; };
__device__ __forceinline__ XcdBarrier xcd_barrier_post(unsigned* bar, volatile LAS unsigned* st) {
    XcdBarrier b; b.bar = bar; b.x = xb_xcc_id(); b.st = st;
    if (threadIdx.x == 0) (void)xb_add(&bar[XB_XCNT(b.x)], 1u);
    return b;
}
__device__ __forceinline__ void xcd_barrier_complete(unsigned* bar, unsigned x, unsigned& nloc, unsigned& nx) {
    const unsigned G = gridDim.x * gridDim.y * gridDim.z;
    unsigned sum, cnt, mine, sp = 0u;
    for (;;) {
        sum = 0u; cnt = 0u; mine = 0u;
#pragma unroll
        for (unsigned j = 0; j < 16; ++j) { const unsigned c = xb_ld(&bar[XB_XCNT(j)]); sum += c; cnt += (c > 0u) ? 1u : 0u; mine = (j == x) ? c : mine; }
        if (sum == G) break;
        __builtin_amdgcn_s_sleep(1);
        if ((++sp & 255u) == 0u) { if (xb_ld(&bar[XB_TMO])) break; if (sp > XB_SPIN_CAP) { atomicAdd(&bar[XB_TMO], 1u); break; } }
    }
    nloc = mine > 0u ? mine : 1u; nx = cnt > 0u ? cnt : 1u;
}
__device__ __forceinline__ void xcd_barrier(const XcdBarrier& b) {
    asm volatile("s_waitcnt vmcnt(0)" ::: "memory");
    __syncthreads();
    if (threadIdx.x == 0) {
        unsigned* bar = b.bar;
        __builtin_amdgcn_s_waitcnt(0);
        unsigned nloc = b.st[0], nx = b.st[1];
        if (nloc == 0u) { xcd_barrier_complete(bar, b.x, nloc, nx); b.st[0] = nloc; b.st[1] = nx; }
        const unsigned old = xb_add(&bar[XB_XSUB(b.x)], 1u);
        const unsigned gen = old / nloc;
        if (old + 1u == (gen + 1u) * nloc) {
            __builtin_amdgcn_fence(__ATOMIC_RELEASE, "agent");
            asm volatile("s_waitcnt vmcnt(0)" ::: "memory");
            const unsigned og = xb_add(&bar[XB_TOP], 1u);
            const unsigned tg = og / nx;
            if (og + 1u == (tg + 1u) * nx) xb_add(&bar[XB_TOPGEN], 1u);
            else XB_SPIN(xb_ld(&bar[XB_TOPGEN]) == tg, bar);
            __builtin_amdgcn_fence(__ATOMIC_ACQUIRE, "agent");
            xb_add(&bar[XB_XGEN(b.x)], 1u);
            asm volatile("s_waitcnt vmcnt(0)" ::: "memory");
        } else {
            XB_SPIN(xb_ld(&bar[XB_XGEN(b.x)]) == gen, bar);
            __builtin_amdgcn_fence(__ATOMIC_ACQUIRE, "agent");
            asm volatile("s_waitcnt vmcnt(0)" ::: "memory");
        }
    }
    __syncthreads();
}

__device__ __forceinline__ void tr_item(const float* W, int N, int k0, int n0, bf16* WT, int Kd, int drow0, LAS float* scr, int lane) {
#pragma unroll 8
    for (int i = 0; i < 32; ++i) { const int kk = 2 * i + (lane >> 5); scr[kk * 33 + (lane & 31)] = __builtin_nontemporal_load(&W[(size_t)(k0 + kk) * N + n0 + (lane & 31)]); }
    asm volatile("s_waitcnt lgkmcnt(0)" ::: "memory");
    const int c = lane & 7;
#pragma unroll
    for (int j = 0; j < 4; ++j) { const int n = (lane >> 3) + 8 * j; const LAS float* s = scr + (8 * c) * 33 + n;
        u32x4 o; o.x = pk2(s[0 * 33], s[1 * 33]); o.y = pk2(s[2 * 33], s[3 * 33]); o.z = pk2(s[4 * 33], s[5 * 33]); o.w = pk2(s[6 * 33], s[7 * 33]);
        *(u32x4*)(WT + (size_t)(drow0 + n) * Kd + k0 + 8 * c) = o; }
    asm volatile("s_waitcnt lgkmcnt(0)" ::: "memory");
}
__device__ __forceinline__ void tr_job(const Fr& F, const float* W, int K, int N, bf16* WT, int perm) {
    LAS float* scr = (LAS float*)(F.lds + F.wave * 16384);
    const int nblk = N / 32, items = (K / 64) * nblk; const int gw = F.bid * 8 + F.wave, NGW = F.G * 8;
    for (int it = gw; it < items; it += NGW) { const int kb = it / nblk, nb = it % nblk, n0 = 32 * nb; int dr = n0;
        if (perm) { const int half = n0 >= DFF; const int c = half ? n0 - DFF : n0; dr = 256 * (c >> 7) + 128 * half + (c & 127); }
        tr_item(W, N, 64 * kb, n0, WT, K, dr, scr, F.lane); }
}
#ifndef DEFER_W
#define DEFER_W 1
#endif
__device__ __forceinline__ void tr_layer(const Fr& F, const float* const* in, unsigned char* ws, int l, int part) {
    if (part == 1) { tr_job(F, in[I_fwin] + (size_t)l * D * 2 * DFF, D, 2 * DFF, (bf16*)(ws + (WS_WFFN + 66 * l) * MiB), 1); tr_job(F, in[I_fwout] + (size_t)l * DFF * D, DFF, D, (bf16*)(ws + (WS_WFFN + 66 * l + 44) * MiB), 0); return; }
    if (l == 0) { tr_job(F, in[I_nwqkv], D, 3 * NQ, (bf16*)(ws + WS_WNQKV * MiB), 0); tr_job(F, in[I_nwo], NQ, D, (bf16*)(ws + WS_WNO * MiB), 0); }
    else if (l == 1) { tr_job(F, in[I_lwin], D, 2 * LW, (bf16*)(ws + WS_WLIN * MiB), 0); tr_job(F, in[I_lwout], LW, D, (bf16*)(ws + WS_WLOUT * MiB), 0); }
    else if (l == 2) { tr_job(F, in[I_mwd], D, 1344, (bf16*)(ws + WS_WMD * MiB), 0); tr_job(F, in[I_mwuq], 768, MQW, (bf16*)(ws + WS_WMUQ * MiB), 0); tr_job(F, in[I_mwukv], 512, MKVW, (bf16*)(ws + WS_WMUKV * MiB), 0); tr_job(F, in[I_mwo], 2048, D, (bf16*)(ws + WS_WMO * MiB), 0);
        unsigned* z = (unsigned*)((bf16*)(ws + WS_WMD * MiB) + (size_t)1344 * D); for (int i = F.bid * 512 + F.tid; i < 192 * D / 2; i += F.G * 512) z[i] = 0u; }
    else { tr_job(F, in[I_swqkv], D, SQW, (bf16*)(ws + WS_WSQKV * MiB), 0); tr_job(F, in[I_swo], 2048, D, (bf16*)(ws + WS_WSO * MiB), 0); }
}
__device__ __forceinline__ void tr_layer_idle(const Fr& F, const float* const* in, unsigned char* ws, int l, int part) {
    const int busy = 1152 % F.G; if (busy == 0 || F.bid < busy) return;
    Fr F2 = F; F2.bid = F.bid - busy; F2.G = F.G - busy; tr_layer(F2, in, ws, l, part);
}
struct ProArgs { const float* const* in; unsigned char* ws; };
__device__ __forceinline__ void ph_prologue(const Fr& F, const float* const* in, unsigned char* ws) {
    const int gt = F.bid * 512 + F.tid, NGT = F.G * 512;
    for (int j = F.bid; j < 256; j += F.G) {
        const int l = j >> 6, n0 = (j & 63) * 192; LAS float* S = (LAS float*)F.lds; LAS float* red = (LAS float*)(F.lds + 73728);
        for (int i = F.tid; i < NCI * D; i += 512) { const int ci = i / D, k = i % D; const float v = ci == 0 ? in[I_cctx][k] : in[I_c][(size_t)(ci - 1) * D + k]; S[i] = siluf(v); }
        __syncthreads();
        float acc[3][NCI];
#pragma unroll
        for (int g = 0; g < 3; ++g)
#pragma unroll
            for (int c = 0; c < NCI; ++c) acc[g][c] = 0.f;
        const float* wl = in[I_wmod] + (size_t)l * D * N6 + n0 + F.lane;
#pragma unroll 4
        for (int k = F.wave * 256; k < F.wave * 256 + 256; ++k) { const float w0 = __builtin_nontemporal_load(&wl[(size_t)k * N6]), w1 = __builtin_nontemporal_load(&wl[(size_t)k * N6 + 64]), w2 = __builtin_nontemporal_load(&wl[(size_t)k * N6 + 128]);
#pragma unroll
            for (int c = 0; c < NCI; ++c) { const float s = S[c * D + k]; acc[0][c] += s * w0; acc[1][c] += s * w1; acc[2][c] += s * w2; } }
#pragma unroll
        for (int g = 0; g < 3; ++g)
#pragma unroll
            for (int c = 0; c < NCI; ++c) red[((F.wave * 3 + g) * NCI + c) * 64 + F.lane] = acc[g][c];
        __syncthreads();
        float* MOD = (float*)(ws + WS_MOD * MiB);
        for (int o = F.tid; o < 192 * NCI; o += 512) { const int ci = o / 192, nl = o % 192, g = nl >> 6, ln = nl & 63; float s = in[I_bmod][(size_t)l * N6 + n0 + nl];
#pragma unroll
            for (int w = 0; w < 8; ++w) s += red[((w * 3 + g) * NCI + ci) * 64 + ln];
            MOD[((size_t)l * NCI + ci) * N6 + n0 + nl] = s; }
        __syncthreads();
    }
    tr_layer(F, in, ws, 0, 0); tr_layer(F, in, ws, 0, 1);
    if (!DEFER_W) for (int l = 1; l < 4; ++l) { tr_layer(F, in, ws, l, 0); tr_layer(F, in, ws, l, 1); }
    { bf16* Wg = (bf16*)(ws + WS_WG * MiB); constexpr int TOT = 2 * 2 * 16 * 192 * 192;
      for (int i0 = gt; i0 < TOT; i0 += 6 * NGT) { float v[6];
#pragma unroll
          for (int u = 0; u < 6; ++u) { const int i = i0 + u * NGT; v[u] = 0.f;
              if (i < TOT) { const int k = i % 192, j = (i / 192) % 192, blk = (i / 36864) % 16, mat = (i / 589824) % 2, dir = i / 1179648;
                  if (j < 168 && k < 168) v[u] = (mat == 0 ? in[I_lwa] : in[I_lwi])[(((size_t)dir * 16 + blk) * 168 + k) * 168 + j]; } }
#pragma unroll
          for (int u = 0; u < 6; ++u) { const int i = i0 + u * NGT; if (i < TOT) Wg[i] = (bf16)f2bf(v[u]); } } }
    { typedef float f4v __attribute__((ext_vector_type(4)));
      bf16* a = (bf16*)(ws + WS_NATCK * MiB); bf16* b = (bf16*)(ws + WS_NATCV * MiB); const f4v* ia = (const f4v*)in[I_cnk]; const f4v* ib = (const f4v*)in[I_cnv];
      for (int i = gt; i < 8 * 16 * 256 * 128 / 8; i += NGT) { const f4v a0 = ia[2 * i], a1 = ia[2 * i + 1], b0 = ib[2 * i], b1 = ib[2 * i + 1];
          const float xa[8] = {a0.x, a0.y, a0.z, a0.w, a1.x, a1.y, a1.z, a1.w}, xb[8] = {b0.x, b0.y, b0.z, b0.w, b1.x, b1.y, b1.z, b1.w};
          *(bf16x8*)(a + 8 * (size_t)i) = pack8(xa); *(bf16x8*)(b + 8 * (size_t)i) = pack8(xb); }
      bf16* c = (bf16*)(ws + WS_SWACK * MiB); bf16* d = (bf16*)(ws + WS_SWACV * MiB); const f4v* ic = (const f4v*)in[I_csk]; const f4v* id = (const f4v*)in[I_csv];
      for (int i = gt; i < 8 * 4 * 256 * 64 / 8; i += NGT) { const f4v a0 = ic[2 * i], a1 = ic[2 * i + 1], b0 = id[2 * i], b1 = id[2 * i + 1];
          const float xa[8] = {a0.x, a0.y, a0.z, a0.w, a1.x, a1.y, a1.z, a1.w}, xb[8] = {b0.x, b0.y, b0.z, b0.w, b1.x, b1.y, b1.z, b1.w};
          *(bf16x8*)(c + 8 * (size_t)i) = pack8(xa); *(bf16x8*)(d + 8 * (size_t)i) = pack8(xb); } }
    { float* cs = (float*)(ws + WS_ROPEC * MiB); float* sn = (float*)(ws + WS_ROPES * MiB);
      for (int i = gt; i < NLAT * 64; i += NGT) { const int t = i >> 6, li = i & 63, f = li & 15; const float pos = li < 32 ? (float)(t >> 6) : (float)(t & 63);
          const float inv = fexp2(-(float)f * 0.8304820237218406f); const float rev = pos * inv * 0.15915494309189535f; const float fr = rev - floorf(rev);
          cs[i] = __builtin_amdgcn_cosf(fr); sn[i] = __builtin_amdgcn_sinf(fr); } }
}

__device__ __forceinline__ void ph_norm(const Fr& F, const float* xc, const float* xl, const float* g, const float* mod, int chunk, bf16* H) {
    const int gw = F.bid * 8 + F.wave, NGW = F.G * 8;
    for (int row0 = gw; row0 < R; row0 += 2 * NGW) {
        const int row1 = row0 + NGW; const bool has1 = row1 < R; const int r1 = has1 ? row1 : row0;
        const float* x0 = (row0 < RC ? xc + (size_t)row0 * D : xl + (size_t)(row0 - RC) * D) + 4 * F.lane; const float* x1 = (r1 < RC ? xc + (size_t)r1 * D : xl + (size_t)(r1 - RC) * D) + 4 * F.lane;
        f32x4 v0[8], v1[8]; float s0 = 0.f, s1 = 0.f;
#pragma unroll
        for (int j = 0; j < 8; ++j) { v0[j] = *(const f32x4*)(x0 + 256 * j); v1[j] = *(const f32x4*)(x1 + 256 * j); }
#pragma unroll
        for (int j = 0; j < 8; ++j) { s0 += (v0[j].x * v0[j].x + v0[j].y * v0[j].y) + (v0[j].z * v0[j].z + v0[j].w * v0[j].w); s1 += (v1[j].x * v1[j].x + v1[j].y * v1[j].y) + (v1[j].z * v1[j].z + v1[j].w * v1[j].w); }
#pragma unroll
        for (int o = 1; o < 64; o <<= 1) { s0 += __shfl_xor(s0, o); s1 += __shfl_xor(s1, o); }
        const float rs0 = 1.f / sqrtf(s0 * (1.f / D) + 1e-6f), rs1 = 1.f / sqrtf(s1 * (1.f / D) + 1e-6f);
        const int c0 = row0 < RC ? 0 : 1 + ((row0 - RC) >> 12), c1 = r1 < RC ? 0 : 1 + ((r1 - RC) >> 12);
        const float* m0 = mod + (size_t)c0 * N6 + (size_t)chunk * D + 4 * F.lane; const float* m1 = mod + (size_t)c1 * N6 + (size_t)chunk * D + 4 * F.lane; const float* gp = g + 4 * F.lane;
        bf16* o0 = H + (size_t)row0 * D + 4 * F.lane; bf16* o1 = H + (size_t)r1 * D + 4 * F.lane;
#pragma unroll
        for (int j = 0; j < 8; ++j) { const f32x4 gv = *(const f32x4*)(gp + 256 * j);
            { const f32x4 sh = *(const f32x4*)(m0 + 256 * j), sc = *(const f32x4*)(m0 + D + 256 * j); const f32x4 h = v0[j] * rs0 * gv * (sc + 1.f) + sh; u32x2 w; w.x = pk2(h.x, h.y); w.y = pk2(h.z, h.w); *(u32x2*)(o0 + 256 * j) = w; }
            if (has1) { const f32x4 sh = *(const f32x4*)(m1 + 256 * j), sc = *(const f32x4*)(m1 + D + 256 * j); const f32x4 h = v1[j] * rs1 * gv * (sc + 1.f) + sh; u32x2 w; w.x = pk2(h.x, h.y); w.y = pk2(h.z, h.w); *(u32x2*)(o1 + 256 * j) = w; } }
    }
}
template <bool F32IN> __device__ __forceinline__ void ph_norm_rows(const Fr& F, const bf16* XB, const float* xc, const float* xl, const float* g, const float* mod, int chunk, bf16* H) {
    const int gw = F.bid * 8 + F.wave, NGW = F.G * 8; const int per = (R + NGW - 1) / NGW; const int rbeg = gw * per, rend = rbeg + per < R ? rbeg + per : R;
    float A[4][8], Bv[4][8]; int ccur = -1;
    bf16x8 a0[4], a1[4], n0[4], n1[4]; f32x4 f0[4][2], f1[4][2], g0[4][2], g1[4][2];
#define NORM_LOAD(A0, A1, F0, F1, ROW) do { const int ra_ = (ROW), rb_ = (ROW) + 1 < rend ? (ROW) + 1 : (ROW); \
        if constexpr (F32IN) { const float* x0 = (ra_ < RC ? xc + (size_t)ra_ * D : xl + (size_t)(ra_ - RC) * D) + 8 * F.lane; const float* x1 = (rb_ < RC ? xc + (size_t)rb_ * D : xl + (size_t)(rb_ - RC) * D) + 8 * F.lane; \
_Pragma("unroll") \
            for (int j = 0; j < 4; ++j) { F0[j][0] = __builtin_nontemporal_load((const f32x4*)(x0 + 512 * j)); F0[j][1] = __builtin_nontemporal_load((const f32x4*)(x0 + 512 * j + 4)); F1[j][0] = __builtin_nontemporal_load((const f32x4*)(x1 + 512 * j)); F1[j][1] = __builtin_nontemporal_load((const f32x4*)(x1 + 512 * j + 4)); } \
        } else { const bf16* x0 = XB + (size_t)ra_ * D + 8 * F.lane; const bf16* x1 = XB + (size_t)rb_ * D + 8 * F.lane; \
_Pragma("unroll") \
            for (int j = 0; j < 4; ++j) { A0[j] = __builtin_nontemporal_load((const bf16x8*)(x0 + 512 * j)); A1[j] = __builtin_nontemporal_load((const bf16x8*)(x1 + 512 * j)); } } } while (0)
    if (!F32IN && rbeg < rend) NORM_LOAD(a0, a1, f0, f1, rbeg);
    for (int row0 = rbeg; row0 < rend; row0 += 2) {
        const int row1 = row0 + 1; const bool has1 = row1 < rend; const int r1 = has1 ? row1 : row0;
        if constexpr (F32IN) NORM_LOAD(a0, a1, f0, f1, row0); else if (row0 + 2 < rend) NORM_LOAD(n0, n1, g0, g1, row0 + 2);
        const int c0 = row0 < RC ? 0 : 1 + ((row0 - RC) >> 12), c1 = r1 < RC ? 0 : 1 + ((r1 - RC) >> 12);
#define NORM16_PARAMS(ci) do { const float* mp = mod + (size_t)(ci) * N6 + (size_t)chunk * D + 8 * F.lane; const float* gp = g + 8 * F.lane; \
_Pragma("unroll") \
            for (int j = 0; j < 4; ++j) { const f32x4 ga = *(const f32x4*)(gp + 512 * j), gb = *(const f32x4*)(gp + 512 * j + 4), sa = *(const f32x4*)(mp + 512 * j), sb = *(const f32x4*)(mp + 512 * j + 4), \
                    ca = *(const f32x4*)(mp + D + 512 * j), cb = *(const f32x4*)(mp + D + 512 * j + 4); \
                A[j][0] = ga.x * (ca.x + 1.f); A[j][1] = ga.y * (ca.y + 1.f); A[j][2] = ga.z * (ca.z + 1.f); A[j][3] = ga.w * (ca.w + 1.f); A[j][4] = gb.x * (cb.x + 1.f); A[j][5] = gb.y * (cb.y + 1.f); A[j][6] = gb.z * (cb.z + 1.f); A[j][7] = gb.w * (cb.w + 1.f); \
                Bv[j][0] = sa.x; Bv[j][1] = sa.y; Bv[j][2] = sa.z; Bv[j][3] = sa.w; Bv[j][4] = sb.x; Bv[j][5] = sb.y; Bv[j][6] = sb.z; Bv[j][7] = sb.w; } ccur = (ci); } while (0)
        if (c0 != ccur) NORM16_PARAMS(c0);
        float v0[4][8], v1[4][8]; float s0 = 0.f, s1 = 0.f;
#pragma unroll
        for (int j = 0; j < 4; ++j) {
            if constexpr (F32IN) {
#pragma unroll
                for (int e = 0; e < 8; ++e) { v0[j][e] = f0[j][e >> 2][e & 3]; v1[j][e] = f1[j][e >> 2][e & 3]; }
            } else { unpack8(a0[j], v0[j]); unpack8(a1[j], v1[j]); }
#pragma unroll
            for (int e = 0; e < 8; ++e) { s0 += v0[j][e] * v0[j][e]; s1 += v1[j][e] * v1[j][e]; } }
#pragma unroll
        for (int o = 1; o < 64; o <<= 1) { s0 += __shfl_xor(s0, o); s1 += __shfl_xor(s1, o); }
        const float rs0 = 1.f / sqrtf(s0 * (1.f / D) + 1e-6f), rs1 = 1.f / sqrtf(s1 * (1.f / D) + 1e-6f);
        bf16* o0 = H + (size_t)row0 * D + 8 * F.lane; bf16* o1 = H + (size_t)r1 * D + 8 * F.lane;
#pragma unroll
        for (int j = 0; j < 4; ++j) { float h[8];
#pragma unroll
            for (int e = 0; e < 8; ++e) h[e] = v0[j][e] * rs0 * A[j][e] + Bv[j][e];
            *(bf16x8*)(o0 + 512 * j) = pack8(h); }
        if (has1) {
            if (c1 != ccur) NORM16_PARAMS(c1);
#pragma unroll
            for (int j = 0; j < 4; ++j) { float h[8];
#pragma unroll
                for (int e = 0; e < 8; ++e) h[e] = v1[j][e] * rs1 * A[j][e] + Bv[j][e];
                *(bf16x8*)(o1 + 512 * j) = pack8(h); } }
#undef NORM16_PARAMS
#pragma unroll
        for (int j = 0; j < 4; ++j) { if constexpr (!F32IN) { a0[j] = n0[j]; a1[j] = n1[j]; } }
    }
#undef NORM_LOAD
}
__device__ __forceinline__ void ph_norm16(const Fr& F, const bf16* XB, const float* g, const float* mod, int chunk, bf16* H) { ph_norm_rows<false>(F, XB, nullptr, nullptr, g, mod, chunk, H); }
__device__ __forceinline__ void ph_norm32(const Fr& F, const float* xc, const float* xl, const float* g, const float* mod, int chunk, bf16* H) { ph_norm_rows<true>(F, nullptr, xc, xl, g, mod, chunk, H); }
}

namespace pg8 {
struct EpiResid {
    static constexpr bool PERM = false, AFTER_DRAIN = false;
    const float* xc; const float* xl; float* out; const float* gate;
    __device__ __forceinline__ void operator()(const f32x4 (&acc)[2][2][4][2], const Unit& u, int wr, int wc, int fr, int fq) const {
        const int ci = u.pm < 16 ? 0 : 1 + ((u.pm - 16) >> 4); const int row0 = u.pm * BM + wr * 64 + fr, col0 = u.pn * BM + wc * 32 + 4 * fq;
        const float* gp = gate + (size_t)ci * 12288 + col0; f32x4 gv[2][2];
#pragma unroll
        for (int bj = 0; bj < 2; ++bj)
#pragma unroll
            for (int n = 0; n < 2; ++n) gv[bj][n] = *(const f32x4*)(gp + bj * HALF + n * 16);
#pragma unroll
        for (int ai = 0; ai < 2; ++ai) {
            f32x4 xv[4][2][2];
#pragma unroll
            for (int m = 0; m < 4; ++m) { const int row = row0 + ai * HALF + m * 16; const float* xr = (row < 4096 ? xc + (size_t)row * 2048 : xl + (size_t)(row - 4096) * 2048) + col0;
#pragma unroll
                for (int bj = 0; bj < 2; ++bj)
#pragma unroll
                    for (int n = 0; n < 2; ++n) xv[m][bj][n] = *(const f32x4*)(xr + bj * HALF + n * 16); }
            asm volatile("" ::: "memory");
#pragma unroll
            for (int m = 0; m < 4; ++m) { const int row = row0 + ai * HALF + m * 16; float* orow = out + (size_t)row * 2048 + col0;
#pragma unroll
                for (int bj = 0; bj < 2; ++bj)
#pragma unroll
                    for (int n = 0; n < 2; ++n) *(f32x4*)(orow + bj * HALF + n * 16) = xv[m][bj][n] + gv[bj][n] * acc[ai][bj][m][n]; }
            asm volatile("" ::: "memory");
        }
    }
};

template <bool IN16, bool OUT16> struct EpiResidB {
    static constexpr bool PERM = true, AFTER_DRAIN = false;
    const void* xc; const void* xl; void* out; const float* gate;
    __device__ __forceinline__ void operator()(const f32x4 (&acc)[2][2][4][2], const Unit& u, int wr, int wc, int fr, int fq) const {
        const int ci = u.pm < 16 ? 0 : 1 + ((u.pm - 16) >> 4); const int row0 = u.pm * BM + wr * 64 + fr, col0 = u.pn * BM + wc * 32 + 8 * fq;
        const float* gp = gate + (size_t)ci * 12288 + col0; f32x4 gv[2][2];
#pragma unroll
        for (int bj = 0; bj < 2; ++bj)
#pragma unroll
            for (int n = 0; n < 2; ++n) gv[bj][n] = *(const f32x4*)(gp + bj * HALF + 4 * n);
#pragma unroll
        for (int ai = 0; ai < 2; ++ai) {
            mk::bf16x8 xb[4][2]; f32x4 xf[4][2][2];
#pragma unroll
            for (int m = 0; m < 4; ++m) { const int row = row0 + ai * HALF + m * 16; const size_t off = (size_t)(row < 4096 ? row : row - 4096) * 2048 + col0;
#pragma unroll
                for (int bj = 0; bj < 2; ++bj) {
                    if (IN16) xb[m][bj] = __builtin_nontemporal_load((const mk::bf16x8*)((const mk::bf16*)(row < 4096 ? xc : xl) + off + bj * HALF));
                    else { const float* p = (const float*)(row < 4096 ? xc : xl) + off + bj * HALF; xf[m][bj][0] = __builtin_nontemporal_load((const f32x4*)p); xf[m][bj][1] = __builtin_nontemporal_load((const f32x4*)(p + 4)); } } }
            asm volatile("" ::: "memory");
#pragma unroll
            for (int m = 0; m < 4; ++m) { const int row = row0 + ai * HALF + m * 16;
#pragma unroll
                for (int bj = 0; bj < 2; ++bj) { float x[8];
                    if (IN16) mk::unpack8(xb[m][bj], x); else { x[0] = xf[m][bj][0].x; x[1] = xf[m][bj][0].y; x[2] = xf[m][bj][0].z; x[3] = xf[m][bj][0].w; x[4] = xf[m][bj][1].x; x[5] = xf[m][bj][1].y; x[6] = xf[m][bj][1].z; x[7] = xf[m][bj][1].w; }
#pragma unroll
                    for (int e = 0; e < 8; ++e) x[e] += gv[bj][e >> 2][e & 3] * acc[ai][bj][m][e >> 2][e & 3];
                    if (OUT16) *(mk::bf16x8*)((mk::bf16*)out + (size_t)row * 2048 + col0 + bj * HALF) = mk::pack8(x);
                    else { float* o = (float*)out + (size_t)row * 2048 + col0 + bj * HALF; __builtin_nontemporal_store((f32x4){x[0], x[1], x[2], x[3]}, (f32x4*)o); __builtin_nontemporal_store((f32x4){x[4], x[5], x[6], x[7]}, (f32x4*)(o + 4)); } } }
            asm volatile("" ::: "memory");
        }
    }
};
}

#ifndef QFUSE
#define QFUSE 1
#endif
namespace mk {
struct HeadPost { const bf16* sa; long pa; int sha, na; const bf16* sb; long pb; int shb, nb; const float* gain; bf16* dst; long pd; int shd, NH, rot; const float* cs; const float* sn; float* of; int lat_end; };
template <int GS>
__device__ __forceinline__ void ph_headpost(const Fr& F, const HeadPost& P, int nitems) {
    constexpr int NB = 4, IPW = 64 / GS;
    const int i = F.lane & (GS - 1), e0 = 8 * i, dh = P.na + P.nb; const bool act_l = e0 < dh; const int r0 = dh - P.rot;
    const int gw2 = (F.bid * 8 + F.wave) * IPW + F.lane / GS, step = F.G * 8 * IPW;
    float gn[8];
    { const int ec = act_l ? e0 : 0; const f32x4 g0 = *(const f32x4*)(P.gain + ec), g1 = *(const f32x4*)(P.gain + ec + 4); gn[0] = g0.x; gn[1] = g0.y; gn[2] = g0.z; gn[3] = g0.w; gn[4] = g1.x; gn[5] = g1.y; gn[6] = g1.z; gn[7] = g1.w; }
    const float inv_dh = 1.f / (float)dh; const int nhs = 31 - __builtin_clz(P.NH);
    const int ntrip = (nitems + step * NB - 1) / (step * NB);
    for (int tr = 0; tr < ntrip; ++tr) { const int it0 = gw2 + tr * step * NB;
        bf16x8 raw[NB]; int rows[NB], hs[NB]; bool acts[NB];
#pragma unroll
        for (int b = 0; b < NB; ++b) { const int item = it0 + b * step; acts[b] = act_l && item < nitems; const int itc = item < nitems ? item : nitems - 1; rows[b] = itc >> nhs; hs[b] = itc & (P.NH - 1);
            raw[b] = (bf16x8){0, 0, 0, 0, 0, 0, 0, 0};
            if (acts[b]) raw[b] = __builtin_nontemporal_load((e0 < P.na) ? (const bf16x8*)(P.sa + (size_t)rows[b] * P.pa + (size_t)hs[b] * P.sha + e0) : (const bf16x8*)(P.sb + (size_t)rows[b] * P.pb + (size_t)hs[b] * P.shb + (e0 - P.na))); }
#pragma unroll
        for (int b = 0; b < NB; ++b) { const int row = rows[b], h = hs[b]; const bool act = acts[b];
            float v[8]; unpack8(raw[b], v);
            float ss = 0.f;
#pragma unroll
            for (int j = 0; j < 8; ++j) ss += v[j] * v[j];
#pragma unroll
            for (int o = 1; o < GS; o <<= 1) ss += __shfl_xor(ss, o);
            const float rstd = 1.f / sqrtf(ss * inv_dh + 1e-6f);
#pragma unroll
            for (int j = 0; j < 8; ++j) v[j] *= rstd * gn[j];
            if (P.of && act && row < RC) { float* op = P.of + ((size_t)((row >> 8) * P.NH + h) * 256 + (row & 255)) * dh + e0;
                *(f32x4*)op = (f32x4){v[0], v[1], v[2], v[3]}; *(f32x4*)(op + 4) = (f32x4){v[4], v[5], v[6], v[7]}; }
            if (P.rot) {
                float pv[8];
#pragma unroll
                for (int j = 0; j < 8; ++j) pv[j] = __shfl_xor(v[j], 2);
                const bool lat = row >= RC && row < P.lat_end;
                if (lat && act && e0 >= r0) { const int li0 = e0 - r0; const bool first = (li0 & 31) < 16; const int t = (row - RC) & (NLAT - 1);
                    const float* cp = P.cs + (size_t)t * 64 + li0; const float* sp = P.sn + (size_t)t * 64 + li0;
                    const f32x4 c0 = *(const f32x4*)cp, c1 = *(const f32x4*)(cp + 4), s0 = *(const f32x4*)sp, s1 = *(const f32x4*)(sp + 4);
                    const float cc[8] = {c0.x, c0.y, c0.z, c0.w, c1.x, c1.y, c1.z, c1.w}, sv[8] = {s0.x, s0.y, s0.z, s0.w, s1.x, s1.y, s1.z, s1.w};
#pragma unroll
                    for (int j = 0; j < 8; ++j) v[j] = v[j] * cc[j] + (first ? -pv[j] : pv[j]) * sv[j]; }
            }
            if (act) *(bf16x8*)(P.dst + (size_t)row * P.pd + (size_t)h * P.shd + e0) = pack8(v);
        }
    }
}
__device__ __forceinline__ void ph_copyv(const Fr& F, const bf16* src, long ps, int sh, int NH, int dh, float* of) {
    const int per = dh / 8, ps_ = 31 - __builtin_clz(per), nhs = 31 - __builtin_clz(NH); const int n = RC * NH * per;
    for (int g = F.bid * 512 + F.tid; g < n; g += F.G * 512) { const int c8 = g & (per - 1); const int h = (g >> ps_) & (NH - 1); const int row = g >> (ps_ + nhs);
        float v[8]; unpack8(*(const bf16x8*)(src + (size_t)row * ps + (size_t)h * sh + 8 * c8), v);
        float* op = of + ((size_t)((row >> 8) * NH + h) * 256 + (row & 255)) * dh + 8 * c8; *(f32x4*)op = (f32x4){v[0], v[1], v[2], v[3]}; *(f32x4*)(op + 4) = (f32x4){v[4], v[5], v[6], v[7]}; }
}
__device__ __forceinline__ void ph_mlanorm(const Fr& F, bf16* Dn, bf16* KR, const float* gqa, const float* gkva, const float* cckv, const float* ckr, float* o_ckv, float* o_kr) {
    const int gw = F.bid * 8 + F.wave, NGW = F.G * 8, lane = F.lane;
    f32x4 gq[3]; float gg[8];
#pragma unroll
    for (int j = 0; j < 3; ++j) gq[j] = *(const f32x4*)(gqa + 4 * lane + 256 * j);
    { const f32x4 g0 = *(const f32x4*)(gkva + 8 * lane), g1 = *(const f32x4*)(gkva + 8 * lane + 4); gg[0] = g0.x; gg[1] = g0.y; gg[2] = g0.z; gg[3] = g0.w; gg[4] = g1.x; gg[5] = g1.y; gg[6] = g1.z; gg[7] = g1.w; }
    for (int row0 = gw; row0 < RK; row0 += 2 * NGW) {
        u32x2 qw[2][3]; bf16x8 kvw[2], krw[2]; int rows[2]; bool on[2];
#pragma unroll
        for (int s = 0; s < 2; ++s) { const int row = row0 + s * NGW; rows[s] = row; on[s] = row < R; krw[s] = (bf16x8){0, 0, 0, 0, 0, 0, 0, 0};
            if (on[s]) { const bf16* p = Dn + (size_t)row * MDN;
#pragma unroll
                for (int j = 0; j < 3; ++j) qw[s][j] = *(const u32x2*)(p + 4 * lane + 256 * j);
                kvw[s] = *(const bf16x8*)(p + 768 + 8 * lane); if (lane < 8) krw[s] = *(const bf16x8*)(p + 1280 + 8 * lane); } }
#pragma unroll
        for (int s = 0; s < 2; ++s) { const int row = rows[s]; if (row >= RK) continue;
            bf16* p = Dn + (size_t)row * MDN;
            if (!on[s]) { const size_t j = (size_t)(row - R); const f32x4 a = *(const f32x4*)(cckv + j * 512 + 8 * lane), b = *(const f32x4*)(cckv + j * 512 + 8 * lane + 4);
                const float v[8] = {a.x, a.y, a.z, a.w, b.x, b.y, b.z, b.w}; *(bf16x8*)(p + 768 + 8 * lane) = pack8(v);
                if (lane < 8) { const f32x4 c = *(const f32x4*)(ckr + j * 64 + 8 * lane), d = *(const f32x4*)(ckr + j * 64 + 8 * lane + 4); const float w[8] = {c.x, c.y, c.z, c.w, d.x, d.y, d.z, d.w}; *(bf16x8*)(KR + (size_t)row * 64 + 8 * lane) = pack8(w); }
                continue; }
            float q[12]; float ss = 0.f;
#pragma unroll
            for (int j = 0; j < 3; ++j) { const u32x2 w = qw[s][j]; q[4 * j] = bflo(w.x); q[4 * j + 1] = bfhi(w.x); q[4 * j + 2] = bflo(w.y); q[4 * j + 3] = bfhi(w.y); }
#pragma unroll
            for (int j = 0; j < 12; ++j) ss += q[j] * q[j];
            ss = wave_sum(ss); float rs = 1.f / sqrtf(ss * (1.f / 768.f) + 1e-6f);
#pragma unroll
            for (int j = 0; j < 3; ++j) { const f32x4 g = gq[j]; u32x2 w; w.x = pk2(q[4 * j] * rs * g.x, q[4 * j + 1] * rs * g.y); w.y = pk2(q[4 * j + 2] * rs * g.z, q[4 * j + 3] * rs * g.w); *(u32x2*)(p + 4 * lane + 256 * j) = w; }
            float kv[8]; unpack8(kvw[s], kv); ss = 0.f;
#pragma unroll
            for (int j = 0; j < 8; ++j) ss += kv[j] * kv[j];
            ss = wave_sum(ss); rs = 1.f / sqrtf(ss * (1.f / 512.f) + 1e-6f);
#pragma unroll
            for (int j = 0; j < 8; ++j) kv[j] *= rs * gg[j];
            *(bf16x8*)(p + 768 + 8 * lane) = pack8(kv);
            if (row < RC) { float* op = o_ckv + (size_t)row * 512 + 8 * lane; *(f32x4*)op = (f32x4){kv[0], kv[1], kv[2], kv[3]}; *(f32x4*)(op + 4) = (f32x4){kv[4], kv[5], kv[6], kv[7]}; }
            if (lane < 8) { const bf16x8 raw = krw[s]; *(bf16x8*)(KR + (size_t)row * 64 + 8 * lane) = raw;
                if (row < RC) { float w[8]; unpack8(raw, w); float* op = o_kr + (size_t)row * 64 + 8 * lane; *(f32x4*)op = (f32x4){w[0], w[1], w[2], w[3]}; *(f32x4*)(op + 4) = (f32x4){w[4], w[5], w[6], w[7]}; } }
        }
    }
}

template <int DQK, int DV> struct AttG { static constexpr int PK = DQK * 2 + 16, PV = DV * 2 + 64, KB = 32 * PK, VB = 32 * PV, BUF = KB + VB;
    static constexpr int KPR = DQK / 8, VPR = DV / 8, NKP = 32 * KPR, NVP = 32 * VPR, KJ = (NKP + 511) / 512, VJ = (NVP + 511) / 512, NC = DQK / 16, NDB = DV / 32; };
struct TileSrc { const bf16* k; const bf16* v; int kp, vp; };
__device__ __forceinline__ int crow(int r, int hi) { return (r & 3) + 8 * (r >> 2) + 4 * hi; }
template <int DQK, int DV> __device__ __forceinline__ void att_gload(const TileSrc& ts, int tid, bf16x8 (&sk)[AttG<DQK, DV>::KJ], bf16x8 (&sv)[AttG<DQK, DV>::VJ]) {
    using G = AttG<DQK, DV>;
#pragma unroll
    for (int j = 0; j < G::KJ; ++j) { const int i = tid + 512 * j; if (i < G::NKP) { const int row = i / G::KPR, cc = i % G::KPR; sk[j] = *(const bf16x8*)(ts.k + (size_t)row * ts.kp + cc * 8); } }
#pragma unroll
    for (int j = 0; j < G::VJ; ++j) { const int i = tid + 512 * j; if (i < G::NVP) { const int row = i / G::VPR, cc = i % G::VPR; sv[j] = *(const bf16x8*)(ts.v + (size_t)row * ts.vp + cc * 8); } }
}
template <int DQK, int DV> __device__ __forceinline__ void att_swrite(LAS unsigned char* kb, LAS unsigned char* vb, int tid, const bf16x8 (&sk)[AttG<DQK, DV>::KJ], const bf16x8 (&sv)[AttG<DQK, DV>::VJ]) {
    using G = AttG<DQK, DV>;
#pragma unroll
    for (int j = 0; j < G::KJ; ++j) { const int i = tid + 512 * j; if (i < G::NKP) { const int row = i / G::KPR, cc = i % G::KPR; *(LAS bf16x8*)(kb + row * G::PK + cc * 16) = sk[j]; } }
#pragma unroll
    for (int j = 0; j < G::VJ; ++j) { const int i = tid + 512 * j; if (i < G::NVP) { const int row = i / G::VPR, cc = i % G::VPR; *(LAS bf16x8*)(vb + row * G::PV + cc * 16) = sv[j]; } }
}
#define ATT_S(t) do { \
_Pragma("unroll") \
            for (int r = 0; r < 16; ++r) s[r] = 0.f; \
_Pragma("unroll") \
            for (int c0 = 0; c0 < G::NC; c0 += 4) { bf16x8 kf[4];     \
_Pragma("unroll") \
                for (int c = 0; c < 4; ++c) kf[c] = *(const LAS bf16x8*)(kbuf + kbase + 32 * (c0 + c)); \
                __builtin_amdgcn_sched_barrier(0); \
_Pragma("unroll") \
                for (int c = 0; c < 4; ++c) s = __builtin_amdgcn_mfma_f32_32x32x16_bf16(kf[c], qf[c0 + c], s, 0, 0, 0); } \
            if (P.needs_adjust(u, wid, t)) { \
_Pragma("unroll") \
                for (int r = 0; r < 16; ++r) s[r] = P.adjust(F, pls, u, wid, r32, t, r, hi, s[r] * cs); \
            } else { \
_Pragma("unroll") \
                for (int r = 0; r < 16; ++r) s[r] *= cs; \
            } } while (0)
#define ATT_SM() do { \
            float mt = s[0]; \
_Pragma("unroll") \
            for (int r = 1; r < 16; ++r) mt = fmaxf(mt, s[r]); \
            mt = fmaxf(mt, __shfl_xor(mt, 32)); \
            if (!__all(mt - m_run <= 8.f)) { \
                const float mn = fmaxf(m_run, mt); const float al = fexp2(m_run - mn); m_run = mn; l_run *= al; \
_Pragma("unroll") \
                for (int db = 0; db < G::NDB; ++db) \
_Pragma("unroll") \
                    for (int r = 0; r < 16; ++r) o[db][r] *= al; \
            } \
            float ps = 0.f; \
_Pragma("unroll") \
            for (int r = 0; r < 16; ++r) { s[r] = fexp2(s[r] - m_run); ps += s[r]; } \
            l_run += ps; \
_Pragma("unroll") \
            for (int s2 = 0; s2 < 2; ++s2) { u32x4 w; w.x = pk2(s[8 * s2], s[8 * s2 + 1]); w.y = pk2(s[8 * s2 + 2], s[8 * s2 + 3]); w.z = pk2(s[8 * s2 + 4], s[8 * s2 + 5]); w.w = pk2(s[8 * s2 + 6], s[8 * s2 + 7]); pf[s2] = __builtin_bit_cast(bf16x8, w); } } while (0)
#define ATT_PV(vbuf) do { \
_Pragma("unroll") \
            for (int s2 = 0; s2 < 2; ++s2) \
_Pragma("unroll") \
                for (int db = 0; db < G::NDB; ++db) { \
                    const s16x4 lo = __builtin_bit_cast(s16x4, __builtin_amdgcn_ds_read_tr16_b64_v4i16((LAS v4i16_t*)((vbuf) + vbase + s2 * 16 * G::PV + db * 64))); \
                    const s16x4 hh = __builtin_bit_cast(s16x4, __builtin_amdgcn_ds_read_tr16_b64_v4i16((LAS v4i16_t*)((vbuf) + vbase + s2 * 16 * G::PV + 8 * G::PV + db * 64))); \
                    const bf16x8 vf = {lo[0], lo[1], lo[2], lo[3], hh[0], hh[1], hh[2], hh[3]}; \
                    o[db] = __builtin_amdgcn_mfma_f32_32x32x16_bf16(vf, pf[s2], o[db], 0, 0, 0); } } while (0)
typedef short v4i16_t __attribute__((ext_vector_type(4)));
template <int DQK, int DV, bool PAIR, class Pol>
__device__ __forceinline__ void attn_unit(const Fr& F, const Pol& P, int u) {
    using G = AttG<DQK, DV>;
    const int tid = F.tid, lane = F.lane, wid = F.wave, r32 = lane & 31, hi = lane >> 5;
    const int NT = P.ntiles(u);
    bf16x8 qf[G::NC];
    { const bf16* qp = P.qrow(u, wid, r32) + hi * 8;
#pragma unroll
      for (int c = 0; c < G::NC; ++c) qf[c] = *(const bf16x8*)(qp + 16 * c); }
    if (QFUSE) {
        float ss = 0.f;
#pragma unroll
        for (int c = 0; c < G::NC; ++c) { float t8[8]; unpack8(qf[c], t8);
#pragma unroll
            for (int j = 0; j < 8; ++j) ss += t8[j] * t8[j]; }
        ss += __shfl_xor(ss, 32);
        const float rs = (LOG2E / sqrtf((float)DQK)) / sqrtf(ss * (1.f / DQK) + 1e-6f);
        constexpr int C0 = Pol::QROPE ? G::NC - 4 : G::NC;
#pragma unroll
        for (int c = 0; c < C0; ++c) { float t8[8]; unpack8(qf[c], t8); const f32x4 g0 = *(const f32x4*)(P.qgain + 16 * c + 8 * hi), g1 = *(const f32x4*)(P.qgain + 16 * c + 8 * hi + 4);
            t8[0] *= rs * g0.x; t8[1] *= rs * g0.y; t8[2] *= rs * g0.z; t8[3] *= rs * g0.w; t8[4] *= rs * g1.x; t8[5] *= rs * g1.y; t8[6] *= rs * g1.z; t8[7] *= rs * g1.w; qf[c] = pack8(t8); }
        if (Pol::QROPE) { const int t = P.qpos(u, wid, r32); const float* cp = P.ropeC + (size_t)t * 64 + 8 * hi; const float* sp = P.ropeS + (size_t)t * 64 + 8 * hi;
#pragma unroll
            for (int pr = 0; pr < 2; ++pr) { constexpr int CB = G::NC - 4; const int ca = CB + 2 * pr, cb = CB + 2 * pr + 1; float va[8], vb[8]; unpack8(qf[ca], va); unpack8(qf[cb], vb);
                const f32x4 ga0 = *(const f32x4*)(P.qgain + 16 * ca + 8 * hi), ga1 = *(const f32x4*)(P.qgain + 16 * ca + 8 * hi + 4), gb0 = *(const f32x4*)(P.qgain + 16 * cb + 8 * hi), gb1 = *(const f32x4*)(P.qgain + 16 * cb + 8 * hi + 4);
                const float ga[8] = {ga0.x, ga0.y, ga0.z, ga0.w, ga1.x, ga1.y, ga1.z, ga1.w}, gb[8] = {gb0.x, gb0.y, gb0.z, gb0.w, gb1.x, gb1.y, gb1.z, gb1.w};
                const f32x4 c0 = *(const f32x4*)(cp + 32 * pr), c1 = *(const f32x4*)(cp + 32 * pr + 4), s0 = *(const f32x4*)(sp + 32 * pr), s1 = *(const f32x4*)(sp + 32 * pr + 4);
                const float cc[8] = {c0.x, c0.y, c0.z, c0.w, c1.x, c1.y, c1.z, c1.w}, sn[8] = {s0.x, s0.y, s0.z, s0.w, s1.x, s1.y, s1.z, s1.w};
#pragma unroll
                for (int j = 0; j < 8; ++j) { const float a = va[j] * rs * ga[j], b2 = vb[j] * rs * gb[j]; va[j] = a * cc[j] - b2 * sn[j]; vb[j] = b2 * cc[j] + a * sn[j]; }
                qf[ca] = pack8(va); qf[cb] = pack8(vb); } }
    }
    f32x16 o[G::NDB];
#pragma unroll
    for (int db = 0; db < G::NDB; ++db)
#pragma unroll
        for (int r = 0; r < 16; ++r) o[db][r] = 0.f;
    float m_run = -1e30f, l_run = 0.f;
    const float cs = QFUSE ? 1.f : LOG2E / sqrtf((float)DQK);
    const int kbase = r32 * G::PK + hi * 16;
    const int li = lane & 15; const int vbase = (4 * hi + (li >> 2)) * G::PV + (16 * ((lane >> 4) & 1) + 4 * (li & 3)) * 2;
    f32x16 s; bf16x8 pf[2];
    P.unit_setup(F, u);
    const typename Pol::LS pls = P.lane_init(u, wid, r32, hi);
    if constexpr (PAIR) {
        LAS unsigned char* const kring = F.lds; LAS unsigned char* const vring = F.lds + 4 * G::KB;
        bf16x8 skA[G::KJ], svA[G::VJ], skB[G::KJ], svB[G::VJ];
        { const TileSrc t0 = P.tile(u, 0); att_gload<DQK, DV>(t0, tid, skA, svA); }
        if (NT > 1) { const TileSrc t1 = P.tile(u, 1); att_gload<DQK, DV>(t1, tid, skB, svB); }
        att_swrite<DQK, DV>(kring, vring, tid, skA, svA);
        if (NT > 1) att_swrite<DQK, DV>(kring + G::KB, vring + G::VB, tid, skB, svB);
        asm volatile("s_waitcnt lgkmcnt(0)\n\ts_barrier" ::: "memory");
        for (int t0 = 0; t0 < NT; t0 += 2) { const int slot = (t0 >> 1) & 1;
            if (t0 + 2 < NT) { const TileSrc ta = P.tile(u, t0 + 2); att_gload<DQK, DV>(ta, tid, skA, svA); }
            if (t0 + 3 < NT) { const TileSrc tb = P.tile(u, t0 + 3); att_gload<DQK, DV>(tb, tid, skB, svB); }
#pragma unroll
            for (int sub = 0; sub < 2; ++sub) { const int t = t0 + sub;
                if (t < NT && P.active(u, wid, t)) { LAS unsigned char* kbuf = kring + (slot * 2 + sub) * G::KB; ATT_S(t); ATT_SM(); ATT_PV(vring + (slot * 2 + sub) * G::VB); } }
            if (t0 + 2 < NT) att_swrite<DQK, DV>(kring + ((slot ^ 1) * 2) * G::KB, vring + ((slot ^ 1) * 2) * G::VB, tid, skA, svA);
            if (t0 + 3 < NT) att_swrite<DQK, DV>(kring + ((slot ^ 1) * 2 + 1) * G::KB, vring + ((slot ^ 1) * 2 + 1) * G::VB, tid, skB, svB);
            asm volatile("s_waitcnt lgkmcnt(0)\n\ts_barrier" ::: "memory");
        }
    } else {
    bf16x8 sk[G::KJ], sv[G::VJ];
    LAS unsigned char* const kring = F.lds; LAS unsigned char* const vring = F.lds + 2 * G::KB;
    { const TileSrc t0 = P.tile(u, 0); att_gload<DQK, DV>(t0, tid, sk, sv); }
    att_swrite<DQK, DV>(kring, vring, tid, sk, sv);
    asm volatile("s_waitcnt lgkmcnt(0)\n\ts_barrier" ::: "memory");
    const bool lag = wid >= 4; bool prev_act = false; int vprev = 0, vcur = 0;
#define ATT_STEP(LAG, t) do { \
        LAS unsigned char* kbuf = kring + ((t) & 1) * G::KB; const int vnext = vcur == 2 ? 0 : vcur + 1; \
        if ((t) + 1 < NT) { const TileSrc tn = P.tile(u, (t) + 1); att_gload<DQK, DV>(tn, tid, sk, sv); } \
        const bool act = P.active(u, wid, t); \
        if (LAG) { if (act) ATT_S(t); if (prev_act) ATT_PV(vring + vprev * G::VB); if (act) ATT_SM(); } \
        else if (act) { ATT_S(t); ATT_SM(); ATT_PV(vring + vcur * G::VB); } \
        prev_act = act; \
        if ((t) + 1 < NT) att_swrite<DQK, DV>(kring + (((t) + 1) & 1) * G::KB, vring + vnext * G::VB, tid, sk, sv); \
        vprev = vcur; vcur = vnext; \
        asm volatile("s_waitcnt lgkmcnt(0)\n\ts_barrier" ::: "memory"); } while (0)
    if (lag) { for (int t = 0; t < NT; ++t) ATT_STEP(true, t); }
    else { for (int t = 0; t < NT; ++t) ATT_STEP(false, t); }
#undef ATT_STEP
    if (lag && prev_act) ATT_PV(vring + vprev * G::VB);
    asm volatile("s_waitcnt lgkmcnt(0)\n\ts_barrier" ::: "memory");
    }
    float lt = l_run + __shfl_xor(l_run, 32);
    if (Pol::HAS_SINK) lt += fexp2(P.sink_l2(u, wid) - m_run);
    const float inv = 1.f / lt;
    bf16* op = P.orow(u, wid, r32) + 4 * hi;
#pragma unroll
    for (int db = 0; db < G::NDB; ++db)
#pragma unroll
        for (int rg = 0; rg < 4; ++rg) { u32x2 w; w.x = pk2(o[db][4 * rg] * inv, o[db][4 * rg + 1] * inv); w.y = pk2(o[db][4 * rg + 2] * inv, o[db][4 * rg + 3] * inv); *(u32x2*)(op + 32 * db + 8 * rg) = w; }
}
struct PolBase { static constexpr bool HAS_SINK = false, QROPE = false; const float* qgain; const float* ropeC; const float* ropeS;
    __device__ __forceinline__ int qpos(int, int, int) const { return 0; }
    __device__ __forceinline__ void unit_setup(const Fr&, int) const {}
    __device__ __forceinline__ bool active(int, int, int) const { return true; }
    __device__ __forceinline__ bool needs_adjust(int, int, int) const { return false; }
    struct LS {}; __device__ __forceinline__ LS lane_init(int, int, int, int) const { return LS{}; }
    __device__ __forceinline__ float adjust(const Fr&, const LS&, int, int, int, int, int  , int  , float s) const { return s; }
    __device__ __forceinline__ float sink_l2(int, int) const { return 0.f; }
    static __device__ __forceinline__ int remap(int w) { return w; } };
__device__ __forceinline__ int remap_heads16(int w) { const int c = w & 255, x = c & 7, j = c >> 3; return (w & ~255) | ((2 * x + (j >> 4)) << 4) | (j & 15); }
struct PolCtx : PolBase { const bf16* Q; long pq; int shq; const bf16* K; long pk; int shk; const bf16* V; long pv; int shv; bf16* O; int sho; int NH;
    __device__ __forceinline__ int ntiles(int) const { return 8; }
    __device__ __forceinline__ TileSrc tile(int u, int t) const { const int b = u / NH, h = u % NH; const size_t r = (size_t)b * 256 + 32 * t; return TileSrc{K + r * pk + (size_t)h * shk, V + r * pv + (size_t)h * shv, (int)pk, (int)pv}; }
    __device__ __forceinline__ const bf16* qrow(int u, int wid, int r32) const { const int b = u / NH, h = u % NH; return Q + ((size_t)b * 256 + wid * 32 + r32) * pq + (size_t)h * shq; }
    __device__ __forceinline__ bf16* orow(int u, int wid, int r32) const { const int b = u / NH, h = u % NH; return O + ((size_t)b * 256 + wid * 32 + r32) * 2048 + (size_t)h * sho; } };
struct PolSwaCtx : PolBase { static constexpr bool HAS_SINK = true, QROPE = false; const bf16* QKV; bf16* O; const float* sinks;
    __device__ __forceinline__ int ntiles(int) const { return 8; }
    __device__ __forceinline__ TileSrc tile(int u, int t) const { const int b = u >> 5, kvh = (u >> 3) & 3; const size_t r = (size_t)b * 256 + 32 * t; return TileSrc{QKV + r * SQW + 2048 + kvh * 64, QKV + r * SQW + 2304 + kvh * 64, SQW, SQW}; }
    __device__ __forceinline__ const bf16* qrow(int u, int wid, int r32) const { const int b = u >> 5, kvh = (u >> 3) & 3, tq = u & 7; return QKV + ((size_t)b * 256 + 32 * tq + r32) * SQW + (kvh * 8 + wid) * 64; }
    __device__ __forceinline__ bf16* orow(int u, int wid, int r32) const { const int b = u >> 5, kvh = (u >> 3) & 3, tq = u & 7; return O + ((size_t)b * 256 + 32 * tq + r32) * 2048 + (kvh * 8 + wid) * 64; }
    __device__ __forceinline__ float sink_l2(int u, int wid) const { return sinks[((u >> 3) & 3) * 8 + wid] * LOG2E; } };
struct PolMlaLat : PolBase { static constexpr bool QROPE = true; const bf16* Q; const bf16* K; const bf16* KV; bf16* O;
    __device__ __forceinline__ int ntiles(int) const { return 136; }
    __device__ __forceinline__ TileSrc tile(int u, int t) const { const int b = u >> 8, h = (u >> 4) & 15; const size_t r = t < 8 ? (size_t)R + b * 256 + 32 * t : (size_t)RC + (size_t)b * NLAT + 32 * (t - 8);
        return TileSrc{K + r * MQW + h * 192, KV + r * MKVW + h * 256 + 128, MQW, MKVW}; }
    __device__ __forceinline__ const bf16* qrow(int u, int wid, int r32) const { const int b = u >> 8, h = (u >> 4) & 15, qb = u & 15; return Q + ((size_t)RC + (size_t)b * NLAT + qb * 256 + wid * 32 + r32) * MQW + h * 192; }
    __device__ __forceinline__ bf16* orow(int u, int wid, int r32) const { const int b = u >> 8, h = (u >> 4) & 15, qb = u & 15; return O + ((size_t)RC + (size_t)b * NLAT + qb * 256 + wid * 32 + r32) * 2048 + h * 128; }
    __device__ __forceinline__ int qpos(int u, int wid, int r32) const { return (u & 15) * 256 + wid * 32 + r32; }
    static __device__ __forceinline__ int remap(int w) { return remap_heads16(w); } };
struct PolNatLat : PolBase { const bf16* QKV; const bf16* CK; const bf16* CV; const float* rpb; bf16* O;
    static constexpr int RPB_OFF = 4 * AttG<128, 128>::KB + 4 * AttG<128, 128>::VB;
    __device__ __forceinline__ int rmin(int u) const { const int rb = u & 15; int r = 4 * rb - 4; return r < 0 ? 0 : (r > 56 ? 56 : r); }
    __device__ __forceinline__ int ntiles(int u) const { const int rb = u & 15; int rl = 4 * rb - 1; rl = rl < 0 ? 0 : (rl > 56 ? 56 : rl); return 8 + 2 * (rl + 7 - rmin(u) + 1); }
    __device__ __forceinline__ void unit_setup(const Fr& F, int u) const { const int h = (u >> 4) & 15; LAS float* rp = (LAS float*)(F.lds + RPB_OFF); if (F.tid < 480) rp[F.tid] = (F.tid & 31) < 31 ? rpb[h * 465 + (F.tid >> 5) * 31 + (F.tid & 31)] * LOG2E : -1e30f; }
    __device__ __forceinline__ TileSrc tile(int u, int t) const { const int b = u >> 8, h = (u >> 4) & 15;
        if (t < 8) { const size_t o = ((size_t)(b * 16 + h) * 256 + 32 * t) * 128; return TileSrc{CK + o, CV + o, 128, 128}; }
        const int lt = t - 8; const int kr = rmin(u) + (lt >> 1); const size_t r = (size_t)RC + (size_t)b * NLAT + kr * 64 + 32 * (lt & 1);
        return TileSrc{QKV + r * 6144 + 2048 + h * 128, QKV + r * 6144 + 4096 + h * 128, 6144, 6144}; }
    __device__ __forceinline__ size_t qtok(int u, int wid, int r32) const { const int b = u >> 8, rb = u & 15; return (size_t)RC + (size_t)b * NLAT + (4 * rb + (wid >> 1)) * 64 + 32 * (wid & 1) + r32; }
    __device__ __forceinline__ const bf16* qrow(int u, int wid, int r32) const { return QKV + qtok(u, wid, r32) * 6144 + ((u >> 4) & 15) * 128; }
    __device__ __forceinline__ bf16* orow(int u, int wid, int r32) const { return O + qtok(u, wid, r32) * 2048 + ((u >> 4) & 15) * 128; }
    __device__ __forceinline__ bool active(int u, int wid, int t) const { if (t < 8) return true; const int r = 4 * (u & 15) + (wid >> 1); int rs = r - 4; rs = rs < 0 ? 0 : (rs > 56 ? 56 : rs); const int kr = rmin(u) + ((t - 8) >> 1); return kr >= rs && kr < rs + 8; }
    __device__ __forceinline__ bool needs_adjust(int, int, int t) const { return t >= 8; }
    struct LS { unsigned pk[2][4]; };
    __device__ __forceinline__ LS lane_init(int, int wid, int r32, int hi) const { LS ls; const int c = 32 * (wid & 1) + r32; int cst = c - 8; cst = cst < 0 ? 0 : (cst > 48 ? 48 : cst);
#pragma unroll
        for (int hf = 0; hf < 2; ++hf)
#pragma unroll
            for (int q = 0; q < 4; ++q) { unsigned w = 0;
#pragma unroll
                for (int e = 0; e < 4; ++e) { const int r = 4 * q + e, kc = 32 * hf + crow(r, hi); const bool valid = kc >= cst && kc < cst + 16; int di = kc - c + 15; di = di < 0 ? 0 : (di > 30 ? 30 : di);
                    w |= (unsigned)(valid ? di : 31) << (8 * e); }
                ls.pk[hf][q] = w; }
        return ls; }
    __device__ __forceinline__ float adjust(const Fr& F, const LS& ls, int u, int wid, int, int t, int r, int, float s) const {
        const int lt = t - 8; const int rr = 4 * (u & 15) + (wid >> 1), kr = rmin(u) + (lt >> 1);
        const unsigned w = (lt & 1) ? ls.pk[1][r >> 2] : ls.pk[0][r >> 2]; const unsigned off = (w >> (8 * (r & 3))) & 0xffu;
        const LAS float* rp = (const LAS float*)(F.lds + RPB_OFF) + (kr - rr + 7) * 32;
        return s + rp[off]; }
    static __device__ __forceinline__ int remap(int w) { const int u = remap_heads16(w); return (u & ~15) | ((u + (w >> 8)) & 15); } };
struct PolSwaLat : PolBase { static constexpr bool HAS_SINK = true, QROPE = true; const bf16* QKV; const bf16* CK; const bf16* CV; const float* sinks; bf16* O;
    __device__ __forceinline__ int kt0(int u) const { const int tb = u & 127; return tb < 4 ? 0 : tb - 4; }
    __device__ __forceinline__ int ntiles(int u) const { const int tb = u & 127; const int k1 = tb + 4 > 127 ? 127 : tb + 4; return 8 + k1 - kt0(u) + 1; }
    __device__ __forceinline__ TileSrc tile(int u, int t) const { const int b = u >> 9, kvh = (u >> 7) & 3;
        if (t < 8) { const size_t o = ((size_t)(b * 4 + kvh) * 256 + 32 * t) * 64; return TileSrc{CK + o, CV + o, 64, 64}; }
        const size_t r = (size_t)RC + (size_t)b * NLAT + 32 * (kt0(u) + t - 8); return TileSrc{QKV + r * SQW + 2048 + kvh * 64, QKV + r * SQW + 2304 + kvh * 64, SQW, SQW}; }
    __device__ __forceinline__ size_t qtok(int u, int r32) const { return (size_t)RC + (size_t)(u >> 9) * NLAT + 32 * (u & 127) + r32; }
    __device__ __forceinline__ int qpos(int u, int, int r32) const { return 32 * (u & 127) + r32; }
    __device__ __forceinline__ const bf16* qrow(int u, int wid, int r32) const { return QKV + qtok(u, r32) * SQW + (((u >> 7) & 3) * 8 + wid) * 64; }
    __device__ __forceinline__ bf16* orow(int u, int wid, int r32) const { return O + qtok(u, r32) * 2048 + (((u >> 7) & 3) * 8 + wid) * 64; }
    __device__ __forceinline__ bool needs_adjust(int u, int, int t) const { if (t < 8) return false; const int tb = u & 127, kt = kt0(u) + t - 8; return kt == tb - 4 || kt == tb + 4; }
    __device__ __forceinline__ float adjust(const Fr&, const LS&, int u, int, int r32, int t, int r, int hi, float s) const { const int tb = u & 127, kt = kt0(u) + t - 8; const int dlt = 32 * (kt - tb) + crow(r, hi) - r32; return (dlt <= 128 && dlt >= -128) ? s : -1e30f; }
    __device__ __forceinline__ float sink_l2(int u, int wid) const { return sinks[((u >> 7) & 3) * 8 + wid] * LOG2E; }
    static __device__ __forceinline__ int remap(int w) { const int c = w & 255, x = c & 7, j = c >> 3; return (w & ~255) | ((j >> 4) << 7) | (16 * x + (j & 15)); } };
template <int DQK, int DV, bool PAIR, class Pol> __device__ __forceinline__ void ph_attn(const Fr& F, const Pol& P, int nunits) { const bool rm = F.G == 256 && (nunits & 255) == 0;
    for (int u = F.bid; u < nunits; u += F.G) attn_unit<DQK, DV, PAIR, Pol>(F, P, rm ? Pol::remap(u) : u); }
}

namespace mk {
#ifndef LRU_UNROLL
#define LRU_UNROLL 4
#endif
constexpr int PXC = 400;
struct LruArgs { const bf16* XG; const bf16* Wg; const float* cw; const float* cb; const float* ba; const float* bi; const float* lam; float* AGG; const float* CARRY; bf16* Y; };
template <int PASS> __device__ __forceinline__ void lru_unit(const Fr& F, const LruArgs& A, int u) {
    const int chunk = u >> 2, bq = u & 3, row0 = chunk * 64, tid = F.tid, lane = F.lane, hi = lane >> 5;
    int s0, T; if (row0 < RC) { s0 = (row0 >> 8) << 8; T = 256; } else { s0 = RC + (((row0 - RC) >> 12) << 12); T = NLAT; } const int t0 = row0 - s0;
    if (tid < 480) { const int combo = tid % 96, blk = combo / 24, cg = combo % 24, rbeg = (tid / 96) * 13, nr = rbeg + 13 > 64 ? 64 - rbeg : 13;
        LAS unsigned char* dst = F.lds + blk * (64 * PXC) + cg * 16;
        if (cg < 21) { const int ch = (4 * bq + blk) * 168 + 8 * cg;
            bf16x8 xr[16];
#pragma unroll
            for (int i = 0; i < 16; ++i) { const int tt = t0 + rbeg + i - 2; xr[i] = (bf16x8){0, 0, 0, 0, 0, 0, 0, 0}; if (tt >= 0 && tt < T && i < nr + 3) xr[i] = *(const bf16x8*)(A.XG + (size_t)(s0 + tt) * (2 * LW) + ch); }
            float w[4][8], bb[8];
#pragma unroll
            for (int k = 0; k < 4; ++k) { const f32x4 w0 = *(const f32x4*)(A.cw + (size_t)k * LW + ch), w1 = *(const f32x4*)(A.cw + (size_t)k * LW + ch + 4); w[k][0] = w0.x; w[k][1] = w0.y; w[k][2] = w0.z; w[k][3] = w0.w; w[k][4] = w1.x; w[k][5] = w1.y; w[k][6] = w1.z; w[k][7] = w1.w; }
            { const f32x4 b0 = *(const f32x4*)(A.cb + ch), b1 = *(const f32x4*)(A.cb + ch + 4); bb[0] = b0.x; bb[1] = b0.y; bb[2] = b0.z; bb[3] = b0.w; bb[4] = b1.x; bb[5] = b1.y; bb[6] = b1.z; bb[7] = b1.w; }
#pragma unroll
            for (int r = 0; r < 13; ++r) if (r < nr) { float acc[8];
#pragma unroll
                for (int j = 0; j < 8; ++j) acc[j] = bb[j];
#pragma unroll
                for (int k = 0; k < 4; ++k) { float x[8]; unpack8(xr[r + k], x);
#pragma unroll
                    for (int j = 0; j < 8; ++j) acc[j] += w[k][j] * x[j]; }
                *(LAS bf16x8*)(dst + (rbeg + r) * PXC) = pack8(acc); }
        } else { for (int r = 0; r < nr; ++r) *(LAS bf16x8*)(dst + (rbeg + r) * PXC) = (bf16x8){0, 0, 0, 0, 0, 0, 0, 0}; }
    }
    __syncthreads();
    const int i32 = lane & 31; const int tau = ((i32 >> 2) & 1) * 16 + ((i32 >> 3) << 2) + (i32 & 3);
    for (int task = F.wave; task < 24; task += 8) {
        const int blk = task / 6, sub = task % 6; const int col = 32 * sub + i32; const bool cvalid = col < 168; const int gb = 4 * bq + blk; const int c = gb * 168 + (cvalid ? col : 0);
        LAS unsigned char* xcb = F.lds + blk * (64 * PXC);
        LAS unsigned short* hst = (LAS unsigned short*)(F.lds + 4 * 64 * PXC) + F.wave * 2048 + lane;
#pragma unroll
        for (int dir = 0; dir < 2; ++dir) {
            const bf16* wa = A.Wg + ((size_t)((dir * 2 + 0) * 16 + gb) * 192 + col) * 192 + 8 * hi; const bf16* wi = A.Wg + ((size_t)((dir * 2 + 1) * 16 + gb) * 192 + col) * 192 + 8 * hi;
            const float ba_ = A.ba[(size_t)dir * LW + c], bi_ = A.bi[(size_t)dir * LW + c];
            float sp; { const float y = fexp2(-A.lam[(size_t)dir * LW + c] * LOG2E); sp = y < 0.02f ? y * (1.f - y * (0.5f - y * 0.33333333f)) : __builtin_amdgcn_logf(1.f + y) * 0.6931471805599453f; }
            float Hrun = 0.f, Prun = 1.f, Srun = 0.f;
            if (PASS == 2) Hrun = A.CARRY[((size_t)chunk * 2 + dir) * LW + c];
            f32x16 aa[2], ai[2];
#pragma unroll
            for (int mt = 0; mt < 2; ++mt)
#pragma unroll
                for (int r = 0; r < 16; ++r) { aa[mt][r] = 0.f; ai[mt][r] = 0.f; }
            { const LAS unsigned char* ap = xcb + tau * PXC + 16 * hi;
#pragma unroll (PASS == 1 ? 6 : 4)
              for (int ks = 0; ks < 12; ++ks) { const bf16x8 fa = *(const bf16x8*)(wa + 16 * ks), fi = *(const bf16x8*)(wi + 16 * ks);
                  const bf16x8 a0 = *(const LAS bf16x8*)(ap + 32 * ks), a1 = *(const LAS bf16x8*)(ap + 32 * PXC + 32 * ks);
                  aa[0] = __builtin_amdgcn_mfma_f32_32x32x16_bf16(a0, fa, aa[0], 0, 0, 0); ai[0] = __builtin_amdgcn_mfma_f32_32x32x16_bf16(a0, fi, ai[0], 0, 0, 0);
                  aa[1] = __builtin_amdgcn_mfma_f32_32x32x16_bf16(a1, fa, aa[1], 0, 0, 0); ai[1] = __builtin_amdgcn_mfma_f32_32x32x16_bf16(a1, fi, ai[1], 0, 0, 0); } }
#pragma unroll
            for (int mi = 0; mi < 2; ++mi) { const int mt = dir == 0 ? mi : 1 - mi;
                float hl[16], ac[16];
#pragma unroll
                for (int r = 0; r < 16; ++r) { const int tt = 32 * mt + 16 * hi + r; const float xcv = bf2f(*(const LAS unsigned short*)(xcb + tt * PXC + col * 2));
                    const float rg = sigm(aa[mt][r] + ba_), ig = sigm(ai[mt][r] + bi_); const float la = -8.f * rg * sp; const float a = fexp2(la * LOG2E); const float z = 2.f * la;
                    const float om = z > -0.05f ? -z * (1.f + z * (0.5f + z * 0.16666667f)) : 1.f - a * a;
                    ac[r] = a; hl[r] = __builtin_amdgcn_sqrtf(om) * ig * xcv; }
                float P = 1.f, S = 0.f;
                if (dir == 0) {
#pragma unroll
                    for (int r = 0; r < 16; ++r) { S = ac[r] * S + hl[r]; P *= ac[r]; hl[r] = S; ac[r] = P; }
                } else {
#pragma unroll
                    for (int r = 15; r >= 0; --r) { S = ac[r] * S + hl[r]; P *= ac[r]; hl[r] = S; ac[r] = P; }
                }
                const float oP = __shfl_xor(P, 32), oS = __shfl_xor(S, 32); const bool isfirst = (dir == 0) ? (hi == 0) : (hi == 1);
                const float fP = isfirst ? P : oP, fS = isfirst ? S : oS, sP = isfirst ? oP : P, sS = isfirst ? oS : S;
                const float tP = fP * sP, tS = sS + sP * fS;
                if (PASS == 1) { Srun = tS + tP * Srun; Prun *= tP; }
                else { const float cin = isfirst ? Hrun : fS + fP * Hrun;
#pragma unroll
                    for (int r = 0; r < 16; ++r) { const float h = hl[r] + ac[r] * cin; LAS unsigned short* hp = hst + (mt * 16 + r) * 64;
                        if (dir == 0) *hp = (unsigned short)f2bf(h);
                        else if (cvalid) { const size_t row = (size_t)row0 + 32 * mt + 16 * hi + r; const float gate = bf2f(A.XG[row * (2 * LW) + LW + c]); A.Y[row * LW + c] = (bf16)f2bf(geluf(gate) * (bf2f(*hp) + h)); } }
                    Hrun = tS + tP * Hrun; asm volatile("" ::: "memory"); }
            }
            if (PASS == 1 && hi == 0 && cvalid) { A.AGG[(((size_t)chunk * 2 + dir) * 2 + 0) * LW + c] = Prun; A.AGG[(((size_t)chunk * 2 + dir) * 2 + 1) * LW + c] = Srun; }
        }
    }
    __syncthreads();
}
template <int PASS> __device__ __forceinline__ void ph_lru(const Fr& F, const LruArgs& A) { for (int u = F.bid; u < 576 * 4; u += F.G) lru_unit<PASS>(F, A, u); }
__device__ __forceinline__ void ph_lru_carry(const Fr& F, const float* AGG, float* CARRY, const float* h0, float* state_out) {
    for (int g = F.bid * 512 + F.tid; g < 24 * 2 * LW; g += F.G * 512) { const int seq = g / (2 * LW), rem = g % (2 * LW), dir = rem / LW, c = rem % LW;
        int nch, ch0; float h = 0.f; if (seq < 16) { nch = 4; ch0 = 4 * seq; } else { const int b = seq - 16; nch = 64; ch0 = 64 + 64 * b; h = h0[((size_t)b * 2 + dir) * LW + c]; }
        for (int j = 0; j < nch; ++j) { const int ch = ch0 + (dir == 0 ? j : nch - 1 - j); CARRY[((size_t)ch * 2 + dir) * LW + c] = h;
            const float P = AGG[(((size_t)ch * 2 + dir) * 2 + 0) * LW + c], S = AGG[(((size_t)ch * 2 + dir) * 2 + 1) * LW + c]; h = S + P * h; }
        if (seq < 16) state_out[((size_t)seq * 2 + dir) * LW + c] = h; }
}
__device__ __forceinline__ void ph_lru_xc(const Fr& F, const bf16* XG, const float* cw, const float* cb, bf16* XC) {
    for (int g = F.bid * 512 + F.tid; g < (R / 8) * 336; g += F.G * 512) { const int row0 = (g / 336) * 8, ch = 8 * (g % 336);
        int s0, T; if (row0 < RC) { s0 = (row0 >> 8) << 8; T = 256; } else { s0 = RC + (((row0 - RC) >> 12) << 12); T = NLAT; } const int t0 = row0 - s0;
        bf16x8 xr[11];
#pragma unroll
        for (int i = 0; i < 11; ++i) { const int tt = t0 + i - 2; xr[i] = __builtin_bit_cast(bf16x8, (u32x4){0u, 0u, 0u, 0u}); if (tt >= 0 && tt < T) xr[i] = *(const bf16x8*)(XG + (size_t)(s0 + tt) * (2 * LW) + ch); }
        float w[4][8], bb[8];
        { const f32x4 b0 = *(const f32x4*)(cb + ch), b1 = *(const f32x4*)(cb + ch + 4); bb[0] = b0.x; bb[1] = b0.y; bb[2] = b0.z; bb[3] = b0.w; bb[4] = b1.x; bb[5] = b1.y; bb[6] = b1.z; bb[7] = b1.w; }
#pragma unroll
        for (int k = 0; k < 4; ++k) { const f32x4 w0 = *(const f32x4*)(cw + (size_t)k * LW + ch), w1 = *(const f32x4*)(cw + (size_t)k * LW + ch + 4);
            w[k][0] = w0.x; w[k][1] = w0.y; w[k][2] = w0.z; w[k][3] = w0.w; w[k][4] = w1.x; w[k][5] = w1.y; w[k][6] = w1.z; w[k][7] = w1.w; }
        float x[11][8];
#pragma unroll
        for (int i = 0; i < 11; ++i) unpack8(xr[i], x[i]);
#pragma unroll
        for (int r = 0; r < 8; ++r) { float acc[8];
#pragma unroll
            for (int e = 0; e < 8; ++e) acc[e] = bb[e];
#pragma unroll
            for (int k = 0; k < 4; ++k)
#pragma unroll
                for (int e = 0; e < 8; ++e) acc[e] += w[k][e] * x[r + k][e];
            *(bf16x8*)(XC + (size_t)(row0 + r) * LW + ch) = pack8(acc); } }
}
__device__ __forceinline__ void ph_lru_combine(const Fr& F, const bf16* XG, const bf16* HB, bf16* Y) {
    for (int g = F.bid * 512 + F.tid; g < R * 336; g += F.G * 512) { const int row = g / 336, ch = 8 * (g % 336);
        float a[8], b[8], gt[8]; unpack8(__builtin_nontemporal_load((const bf16x8*)(Y + (size_t)row * LW + ch)), a); unpack8(__builtin_nontemporal_load((const bf16x8*)(HB + (size_t)row * LW + ch)), b); unpack8(__builtin_nontemporal_load((const bf16x8*)(XG + (size_t)row * (2 * LW) + LW + ch)), gt);
#pragma unroll
        for (int j = 0; j < 8; ++j) a[j] = geluf(gt[j]) * (a[j] + b[j]);
        *(bf16x8*)(Y + (size_t)row * LW + ch) = pack8(a); }
}
struct ChainArgs { const bf16* XC; const bf16* Wg; const float* ba; const float* bi; const float* lam; const float* h0; bf16* HF; bf16* HB; float* state_out; };
#define LRU_STORE_H() do { const int odd = i32 & 1; \
_Pragma("unroll") \
        for (int rp = 0; rp < 8; ++rp) { const unsigned own = odd ? hq[2 * rp + 1] : hq[2 * rp], snd = odd ? hq[2 * rp] : hq[2 * rp + 1]; \
            const unsigned rcv = (unsigned)__builtin_amdgcn_update_dpp(0, (int)snd, 0xB1, 0xF, 0xF, false); \
            const unsigned wd = odd ? (rcv | (own << 16)) : (own | (rcv << 16)); \
            if (cvalid) *(unsigned*)(HX + (rprev + 16 * hi + 2 * rp + odd) * LW + c - odd) = wd; } } while (0)
__device__ __forceinline__ void lru_chain(const Fr& F, const ChainArgs& A, int s0, int T, int dir, int st, int seq_ctx, int b_lat) {
    const int lane = F.lane, hi = lane >> 5, i32 = lane & 31; const int tau = ((i32 >> 2) & 1) * 16 + ((i32 >> 3) << 2) + (i32 & 3);
    const int blk = st / 6, sub = st % 6; const int col = 32 * sub + i32; const bool cvalid = col < 168; const int c = blk * 168 + (cvalid ? col : 0);
    bf16x8 bfa[12]; LAS unsigned char* wl = F.lds + F.wave * 12288 + lane * 16;
    { const bf16* wa = A.Wg + ((size_t)((dir * 2 + 0) * 16 + blk) * 192 + col) * 192 + 8 * hi; const bf16* wi = A.Wg + ((size_t)((dir * 2 + 1) * 16 + blk) * 192 + col) * 192 + 8 * hi;
#pragma unroll
      for (int ks = 0; ks < 12; ++ks) { bfa[ks] = *(const bf16x8*)(wa + 16 * ks); *(LAS bf16x8*)(wl + ks * 1024) = *(const bf16x8*)(wi + 16 * ks); } }
    const float ba_ = A.ba[(size_t)dir * LW + c], bi_ = A.bi[(size_t)dir * LW + c];
    float sp; { const float y = fexp2(-A.lam[(size_t)dir * LW + c] * LOG2E); sp = y < 0.02f ? y * (1.f - y * (0.5f - y * 0.33333333f)) : __builtin_amdgcn_logf(1.f + y) * 0.6931471805599453f; }
    float Hrun = b_lat >= 0 ? A.h0[((size_t)b_lat * 2 + dir) * LW + c] : 0.f;
    const float nba = -ba_ * LOG2E, nbi = -bi_ * LOG2E, k1 = -8.f * sp * LOG2E;
    bf16* HX = dir == 0 ? A.HF : A.HB;
    const int nsteps = T >> 5;
    const bf16* abase = A.XC + (size_t)blk * 168 + 8 * hi; const bf16* xbase = A.XC + c;
    bf16x8 af[12]; unsigned short hq[16]; size_t rprev = 0;
    bf16x8 idf[2];
#pragma unroll
    for (int kl = 0; kl < 2; ++kl) { const bool on = (i32 >> 4) == kl && hi == ((i32 >> 3) & 1); const int e = i32 & 7; u32x4 w;
        w.x = on && (e >> 1) == 0 ? ((e & 1) ? 0x3F800000u : 0x3F80u) : 0u; w.y = on && (e >> 1) == 1 ? ((e & 1) ? 0x3F800000u : 0x3F80u) : 0u;
        w.z = on && (e >> 1) == 2 ? ((e & 1) ? 0x3F800000u : 0x3F80u) : 0u; w.w = on && (e >> 1) == 3 ? ((e & 1) ? 0x3F800000u : 0x3F80u) : 0u; idf[kl] = __builtin_bit_cast(bf16x8, w); }
    { const int mt = dir == 0 ? 0 : nsteps - 1; const size_t r0 = (size_t)s0 + 32 * mt;
#pragma unroll
      for (int ks = 0; ks < 12; ++ks) af[ks] = *(const bf16x8*)(abase + (r0 + tau) * LW + 16 * ks); }
    for (int step = 0; step < nsteps; ++step) { const int mt = dir == 0 ? step : nsteps - 1 - step; const size_t r0 = (size_t)s0 + 32 * mt;
        f32x16 aa, ai;
#pragma unroll
        for (int r = 0; r < 16; ++r) { aa[r] = 0.f; ai[r] = 0.f; }
#pragma unroll
        for (int ks = 0; ks < 12; ++ks) { const bf16x8 fi = *(const LAS bf16x8*)(wl + ks * 1024); aa = __builtin_amdgcn_mfma_f32_32x32x16_bf16(af[ks], bfa[ks], aa, 0, 0, 0); ai = __builtin_amdgcn_mfma_f32_32x32x16_bf16(af[ks], fi, ai, 0, 0, 0); }
        f32x16 ax;
#pragma unroll
        for (int r = 0; r < 16; ++r) ax[r] = 0.f;
#define LRU_XSEL(S) case S: ax = __builtin_amdgcn_mfma_f32_32x32x16_bf16(af[2 * S], idf[0], ax, 0, 0, 0); ax = __builtin_amdgcn_mfma_f32_32x32x16_bf16(af[2 * S + 1], idf[1], ax, 0, 0, 0); break;
        switch (sub) { LRU_XSEL(0) LRU_XSEL(1) LRU_XSEL(2) LRU_XSEL(3) LRU_XSEL(4) default: ax = __builtin_amdgcn_mfma_f32_32x32x16_bf16(af[10], idf[0], ax, 0, 0, 0); ax = __builtin_amdgcn_mfma_f32_32x32x16_bf16(af[11], idf[1], ax, 0, 0, 0); break; }
#undef LRU_XSEL
        float xc[16];
#pragma unroll
        for (int r = 0; r < 16; ++r) xc[r] = ax[r];
        __builtin_amdgcn_sched_barrier(0);
        if (step > 0) { LRU_STORE_H(); }
        if (step + 1 < nsteps) { const int mn = dir == 0 ? step + 1 : nsteps - 2 - step; const size_t rn = (size_t)s0 + 32 * mn;
#pragma unroll
            for (int ks = 0; ks < 12; ++ks) af[ks] = *(const bf16x8*)(abase + (rn + tau) * LW + 16 * ks); }
        float hl[16], ac[16];
#pragma unroll
        for (int r = 0; r < 16; ++r) {
            const float rg = frcp(1.f + fexp2(fmaf(aa[r], -LOG2E, nba))), ig = frcp(1.f + fexp2(fmaf(ai[r], -LOG2E, nbi)));
            const float a = fexp2(rg * k1); ac[r] = a; hl[r] = __builtin_amdgcn_sqrtf(fmaf(-a, a, 1.f)) * (ig * xc[r]); }
        float P = 1.f, S = 0.f;
        if (dir == 0) {
#pragma unroll
            for (int r = 0; r < 16; ++r) { S = ac[r] * S + hl[r]; P *= ac[r]; hl[r] = S; ac[r] = P; }
        } else {
#pragma unroll
            for (int r = 15; r >= 0; --r) { S = ac[r] * S + hl[r]; P *= ac[r]; hl[r] = S; ac[r] = P; }
        }
        const float oP = __shfl_xor(P, 32), oS = __shfl_xor(S, 32); const bool isfirst = (dir == 0) ? (hi == 0) : (hi == 1);
        const float fP = isfirst ? P : oP, fS = isfirst ? S : oS, sP = isfirst ? oP : P, sS = isfirst ? oS : S;
        const float tP = fP * sP, tS = sS + sP * fS; const float cin = isfirst ? Hrun : fS + fP * Hrun;
#pragma unroll
        for (int r = 0; r < 16; ++r) hq[r] = (unsigned short)f2bf(hl[r] + ac[r] * cin);
        rprev = r0;
        Hrun = tS + tP * Hrun;
    }
    LRU_STORE_H();
#undef LRU_STORE_H
    if (seq_ctx >= 0 && hi == 0 && cvalid) A.state_out[((size_t)seq_ctx * 2 + dir) * LW + c] = Hrun;
}
__device__ __forceinline__ void ph_lru_chains(const Fr& F, const ChainArgs& A) {
    if (F.wave < 6) { for (int wt = F.bid * 6 + F.wave; wt < 1536; wt += F.G * 6) { const int b = wt / 192, dir = (wt / 96) & 1, st = wt % 96; lru_chain(F, A, RC + b * NLAT, NLAT, dir, st, -1, b); } }
    else { for (int j = F.bid * 2 + (F.wave - 6); j < 3072; j += F.G * 2) { const int s = j / 192, dir = (j / 96) & 1, st = j % 96; lru_chain(F, A, s * 256, 256, dir, st, s, -1); } }
}
__device__ __forceinline__ void ph_ffn_fix(const Fr& F, const float* SIDE, const float* cw, bf16* G) {
    for (int g = F.bid * 512 + F.tid; g < 120 * (DFF / 4); g += F.G * 512) { const int bi = g / (DFF / 4), c = 4 * (g % (DFF / 4)); const int pm = 16 + (bi / 15) * 16 + (bi % 15) + 1;
        const float* top = SIDE + ((size_t)pm * 2 + 0) * 3 * DFF; const float* bot = SIDE + ((size_t)(pm - 1) * 2 + 1) * 3 * DFF;
        const f32x4 tp = *(const f32x4*)(top + c), tb = *(const f32x4*)(top + DFF + c), ta = *(const f32x4*)(top + 2 * DFF + c), bp = *(const f32x4*)(bot + c), bb = *(const f32x4*)(bot + DFF + c), ba = *(const f32x4*)(bot + 2 * DFF + c);
        const f32x4 w0 = *(const f32x4*)(cw + c), w2 = *(const f32x4*)(cw + 2 * DFF + c);
        u32x2 ot, ob; float vt[4], vb[4];
#pragma unroll
        for (int e = 0; e < 4; ++e) { const float pt = tp[e] + w0[e] * ba[e];
            const float pb = bp[e] + w2[e] * ta[e];
            vt[e] = siluf(pt) * tb[e]; vb[e] = siluf(pb) * bb[e]; }
        ot.x = (f2bf(vt[1]) << 16) | f2bf(vt[0]); ot.y = (f2bf(vt[3]) << 16) | f2bf(vt[2]); ob.x = (f2bf(vb[1]) << 16) | f2bf(vb[0]); ob.y = (f2bf(vb[3]) << 16) | f2bf(vb[2]);
        *(u32x2*)(G + (size_t)(256 * pm) * DFF + c) = ot; *(u32x2*)(G + (size_t)(256 * pm - 1) * DFF + c) = ob; }
}
}
namespace pg8 {
template <int MODE> struct EpiFfnT {
    static constexpr bool PERM = true, AFTER_DRAIN = false;
    mk::bf16* G; const float* cw; const float* cb; float* side; PG8_LAS float* xl;
    __device__ __forceinline__ void operator()(const f32x4 (&acc)[2][2][4][2], const Unit& u, int wr, int wc, int fr, int fq) const {
        const int lane = threadIdx.x & 63; const int chl = wc * 32 + 8 * fq, ch0 = u.pn * 128 + chl;
        if (MODE == 1 || MODE == 2) {
#pragma unroll
            for (int ai = 0; ai < 2; ++ai)
#pragma unroll
                for (int m = 0; m < 4; ++m) { const int row = u.pm * BM + ai * HALF + wr * 64 + m * 16 + fr; float gv[8];
#pragma unroll
                    for (int e = 0; e < 8; ++e) gv[e] = acc[ai][0][m][e >> 2][e & 3];
                    *(mk::bf16x8*)(G + (size_t)row * 5632 + ch0) = mk::pack8(gv); }
            if (MODE == 1) return; }
        float w0[8], w1[8], w2[8], bb[8];
#pragma unroll
        for (int h = 0; h < 2; ++h) { const f32x4 a = *(const f32x4*)(cw + ch0 + 4 * h), b = *(const f32x4*)(cw + 5632 + ch0 + 4 * h), c = *(const f32x4*)(cw + 2 * 5632 + ch0 + 4 * h), d = *(const f32x4*)(cb + ch0 + 4 * h);
#pragma unroll
            for (int j = 0; j < 4; ++j) { w0[4 * h + j] = a[j]; w1[4 * h + j] = b[j]; w2[4 * h + j] = c[j]; bb[4 * h + j] = d[j]; } }
#pragma unroll
        for (int ai = 0; ai < 2; ++ai) { const int g = 2 * ai + wr;
            if (fr == 0) { *(PG8_LAS f32x4*)(xl + (g * 2 + 0) * 128 + chl) = acc[ai][0][0][0]; *(PG8_LAS f32x4*)(xl + (g * 2 + 0) * 128 + chl + 4) = acc[ai][0][0][1]; }
            if (fr == 15) { *(PG8_LAS f32x4*)(xl + (g * 2 + 1) * 128 + chl) = acc[ai][0][3][0]; *(PG8_LAS f32x4*)(xl + (g * 2 + 1) * 128 + chl + 4) = acc[ai][0][3][1]; } }
        asm volatile("s_waitcnt lgkmcnt(0)" ::: "memory"); __builtin_amdgcn_s_barrier(); asm volatile("" ::: "memory");
        if (MODE == 2) return;
        const int lprev = (lane & 48) | ((fr + 15) & 15), lnext = (lane & 48) | ((fr + 1) & 15);
#pragma unroll
        for (int ai = 0; ai < 2; ++ai) { const int g = 2 * ai + wr;
            float hp[8], hn[8];
#pragma unroll
            for (int j = 0; j < 8; ++j) { hp[j] = 0.f; hn[j] = 0.f; }
            if (g > 0) { const f32x4 a = *(const PG8_LAS f32x4*)(xl + ((g - 1) * 2 + 1) * 128 + chl), b = *(const PG8_LAS f32x4*)(xl + ((g - 1) * 2 + 1) * 128 + chl + 4);
#pragma unroll
                for (int j = 0; j < 4; ++j) { hp[j] = a[j]; hp[4 + j] = b[j]; } }
            if (g < 3) { const f32x4 a = *(const PG8_LAS f32x4*)(xl + ((g + 1) * 2 + 0) * 128 + chl), b = *(const PG8_LAS f32x4*)(xl + ((g + 1) * 2 + 0) * 128 + chl + 4);
#pragma unroll
                for (int j = 0; j < 4; ++j) { hn[j] = a[j]; hn[4 + j] = b[j]; } }
#pragma unroll
            for (int m = 0; m < 4; ++m) { const int row = u.pm * BM + ai * HALF + wr * 64 + m * 16 + fr; float p[8], bv[8], av[8];
#pragma unroll
                for (int e = 0; e < 8; ++e) { const int n = e >> 2, j = e & 3; const float a = acc[ai][0][m][n][j];
                    const float up = m > 0 ? acc[ai][0][m - 1][n][j] : hp[e]; const float dn = m < 3 ? acc[ai][0][m + 1][n][j] : hn[e];
                    const float prev = __shfl(fr == 15 ? up : a, lprev);
                    const float next = __shfl(fr == 0 ? dn : a, lnext);
                    av[e] = a; bv[e] = acc[ai][1][m][n][j]; p[e] = bb[e] + w0[e] * prev + w1[e] * a + w2[e] * next; }
                const bool top = (g == 0 && m == 0 && fr == 0), bot = (g == 3 && m == 3 && fr == 15);
                if (top || bot) { float* sp = side + ((size_t)u.pm * 2 + (bot ? 1 : 0)) * 3 * 5632 + ch0;
#pragma unroll
                    for (int h = 0; h < 2; ++h) { *(f32x4*)(sp + 4 * h) = (f32x4){p[4 * h], p[4 * h + 1], p[4 * h + 2], p[4 * h + 3]}; *(f32x4*)(sp + 5632 + 4 * h) = (f32x4){bv[4 * h], bv[4 * h + 1], bv[4 * h + 2], bv[4 * h + 3]};
                        *(f32x4*)(sp + 2 * 5632 + 4 * h) = (f32x4){av[4 * h], av[4 * h + 1], av[4 * h + 2], av[4 * h + 3]}; } }
                float gv[8];
#pragma unroll
                for (int e = 0; e < 8; ++e) gv[e] = mk::siluf(p[e]) * bv[e];
                *(mk::bf16x8*)(G + (size_t)row * 5632 + ch0) = mk::pack8(gv); }
        }
    }
};
typedef EpiFfnT<0> EpiFfn;

struct EpiNatQKV {
    static constexpr bool PERM = true, AFTER_DRAIN = false;
    mk::bf16* O; const float* gk; float* outb; PG8_LAS float* xl;
    __device__ __forceinline__ void operator()(const f32x4 (&acc)[2][2][4][2], const Unit& u, int wr, int wc, int fr, int fq) const {
        const int row0 = u.pm * BM + wr * 64 + fr, col0 = u.pn * BM + wc * 32 + 8 * fq; const bool isk = u.pn >= 8 && u.pn < 16, isv = u.pn >= 16;
        if (isk) {
#pragma unroll
            for (int ai = 0; ai < 2; ++ai)
#pragma unroll
                for (int m = 0; m < 4; ++m)
#pragma unroll
                    for (int bj = 0; bj < 2; ++bj) { const f32x4 a = acc[ai][bj][m][0], b = acc[ai][bj][m][1]; float ss = (a.x * a.x + a.y * a.y) + (a.z * a.z + a.w * a.w) + (b.x * b.x + b.y * b.y) + (b.z * b.z + b.w * b.w);
                        ss += __shfl_xor(ss, 16); ss += __shfl_xor(ss, 32);
                        if (fq == 0) xl[(bj * 256 + ai * HALF + wr * 64 + m * 16 + fr) * 4 + wc] = ss; }
        }
        asm volatile("s_waitcnt lgkmcnt(0)" ::: "memory"); __builtin_amdgcn_s_barrier(); asm volatile("" ::: "memory");
        float g[8];
        { const int d0 = wc * 32 + 8 * fq; const f32x4 g0 = *(const f32x4*)(gk + d0), g1 = *(const f32x4*)(gk + d0 + 4); g[0] = g0.x; g[1] = g0.y; g[2] = g0.z; g[3] = g0.w; g[4] = g1.x; g[5] = g1.y; g[6] = g1.z; g[7] = g1.w; }
#pragma unroll
        for (int ai = 0; ai < 2; ++ai)
#pragma unroll
            for (int m = 0; m < 4; ++m) { const int row = row0 + ai * HALF + m * 16;
#pragma unroll
                for (int bj = 0; bj < 2; ++bj) { float v[8];
#pragma unroll
                    for (int e = 0; e < 8; ++e) v[e] = acc[ai][bj][m][e >> 2][e & 3];
                    if (isk) { const f32x4 p = *(const PG8_LAS f32x4*)(xl + (bj * 256 + ai * HALF + wr * 64 + m * 16 + fr) * 4); const float rs = 1.f / sqrtf(((p.x + p.y) + (p.z + p.w)) * (1.f / 128.f) + 1e-6f);
#pragma unroll
                        for (int e = 0; e < 8; ++e) v[e] *= rs * g[e]; }
                    *(mk::bf16x8*)(O + (size_t)row * 6144 + col0 + bj * HALF) = mk::pack8(v);
                    if ((isk || isv) && row < 4096) { const int h = 2 * (u.pn & 7) + bj; float* op = outb + ((size_t)(isk ? 75497472 : 83886080) + ((size_t)((row >> 8) * 16 + h) * 256 + (row & 255)) * 128 + wc * 32 + 8 * fq);
                        *(f32x4*)op = (f32x4){v[0], v[1], v[2], v[3]}; *(f32x4*)(op + 4) = (f32x4){v[4], v[5], v[6], v[7]}; } } }
    }
};

}

namespace mk {
struct MArgs { const float* in[N_IN]; float* out; unsigned char* ws; int ph_lo, ph_hi; };
enum { SL_NORM1 = 0, SL_M1 = 1, SL_M2 = 2, SL_M3 = 3, SL_M4 = 4, SL_M5 = 5, SL_MIXOUT = 9, SL_NORM2 = 10, SL_FFNIN = 11, SL_FFNFIX = 12, SL_FFNOUT = 13, PH_END = 1 + 16 * 4 };
__host__ __device__ constexpr int phid(int l, int slot) { return 1 + 16 * l + slot; }
}
#ifndef EN_MASK
#define EN_MASK 0x7ffff
#endif
#ifndef KFUSE
#define KFUSE 1
#endif
#ifndef XB16
#define XB16 1
#endif
#ifndef REP_ID
#define REP_ID -1
#endif
#ifndef REP_N
#define REP_N 2
#endif
#ifndef WGM_N2048
#define WGM_N2048 4
#endif
#ifndef REV_FFNOUT
#define REV_FFNOUT 0
#endif
#ifndef WGM_FFNIN
#define WGM_FFNIN 8
#endif
#define PH(id) if (lo <= (id) && (id) < hi)
#define SEAM(id) do { if (hi > (id) + 1) xcd_barrier(bar); } while (0)
template <int l> __device__ __forceinline__ void layer_body(const mk::Fr& F, const float* const* in, float* out, unsigned char* ws, const mk::XcdBarrier& bar, int lo, int hi) {
    using namespace mk; constexpr unsigned EN = EN_MASK;
    float* MOD = (float*)(ws + WS_MOD * MiB); bf16* H = (bf16*)(ws + WS_H * MiB); bf16* OB = H;
    const float* ropeC = (const float*)(ws + WS_ROPEC * MiB); const float* ropeS = (const float*)(ws + WS_ROPES * MiB);
    float* o_yp = out; float* o_ys = out + 8388608; float* o_natk = out + 75497472; float* o_natv = out + 83886080; float* o_lru = out + 92274688; float* o_ckv = out + 92360704; float* o_kr = out + 94457856;
    float* o_swak = out + 94720000; float* o_swav = out + 95768576;
    bf16* XB = (bf16*)out; bf16* XB2 = (bf16*)(ws + 1000 * MiB);
    (void)XB; (void)XB2;
    (void)o_natk; (void)o_natv; (void)o_lru; (void)o_ckv; (void)o_kr; (void)o_swak; (void)o_swav; (void)ropeC; (void)ropeS;
        const float* mod = MOD + (size_t)l * NCI * N6; const float* xc = l == 0 ? in[I_xp] : o_yp; const float* xl = l == 0 ? in[I_xs] : o_ys;
        if (EN & 2) PH(phid(l, SL_NORM1)) { if (XB16 && l > 0) ph_norm16(F, XB, in[I_nmix] + (size_t)l * D, mod, 0, H); else ph_norm32(F, xc, xl, in[I_nmix] + (size_t)l * D, mod, 0, H); SEAM(phid(l, SL_NORM1)); }
        if (EN & 4) PH(phid(l, SL_M1)) {
            const bf16* Wt = (const bf16*)(ws + (l == 0 ? WS_WNQKV : l == 1 ? WS_WLIN : l == 2 ? WS_WMD : WS_WSQKV) * MiB); const int N = l == 0 ? 3 * NQ : l == 1 ? 2 * LW : l == 2 ? MDN : SQW;
            bf16* C = (bf16*)(ws + WS_S * MiB);
            pg8::Gemm g{H, Wt, R, N, D, D, D, 0}; pg8::StaticOrder S; S.init(R, N, F.G, F.bid);
            if constexpr (l == 0 && KFUSE) { pg8::EpiNatQKV E{C, in[I_nkn], out, (LAS float*)(F.lds + EPI_OFF)}; pg8::gemm_phase<pg8::EpiNatQKV, pg8::StaticOrder, true, true>(F.lds, g, S, E); }
            else { pg8::EpiBf16<0> E{C, N, nullptr, 0, 0, 1.f}; pg8::gemm_phase<pg8::EpiBf16<0>, pg8::StaticOrder, true, true>(F.lds, g, S, E); }
            SEAM(phid(l, SL_M1)); }
        int KO = 2048; const bf16* Wo = nullptr; const bf16* Aout = OB;
        if constexpr (l == 0) {
            bf16* QKV = (bf16*)(ws + WS_QKV * MiB); Wo = (const bf16*)(ws + WS_WNO * MiB);
            if ((EN & 8) && !KFUSE) PH(phid(l, SL_M2)) {
                ph_copyv(F, QKV + 2 * NQ, 3 * NQ, 128, 16, 128, o_natv);
                if (!QFUSE) ph_headpost<16>(F, HeadPost{QKV, 3 * NQ, 128, 128, nullptr, 0, 0, 0, in[I_nqn], QKV, 3 * NQ, 128, 16, 0, nullptr, nullptr, nullptr, R}, R * 16);
                ph_headpost<16>(F, HeadPost{QKV + NQ, 3 * NQ, 128, 128, nullptr, 0, 0, 0, in[I_nkn], QKV + NQ, 3 * NQ, 128, 16, 0, nullptr, nullptr, o_natk, R}, R * 16);
                SEAM(phid(l, SL_M2)); }
            if (EN & 16) PH(phid(l, SL_M3)) {
                PolNatLat PL; PL.QKV = QKV; PL.CK = (const bf16*)(ws + WS_NATCK * MiB); PL.CV = (const bf16*)(ws + WS_NATCV * MiB); PL.rpb = in[I_nrpb]; PL.O = OB; PL.qgain = in[I_nqn]; PL.ropeC = ropeC; PL.ropeS = ropeS;
                ph_attn<128, 128, true>(F, PL, 2048);
                PolCtx PC; PC.Q = QKV; PC.pq = 3 * NQ; PC.shq = 128; PC.K = QKV + NQ; PC.pk = 3 * NQ; PC.shk = 128; PC.V = QKV + 2 * NQ; PC.pv = 3 * NQ; PC.shv = 128; PC.O = OB; PC.sho = 128; PC.NH = 16; PC.qgain = in[I_nqn]; PC.ropeC = ropeC; PC.ropeS = ropeS;
                ph_attn<128, 128, true>(F, PC, 256);
                SEAM(phid(l, SL_M3)); }
        } else if constexpr (l == 1) {
            const bf16* XG = (const bf16*)(ws + WS_XG * MiB); Wo = (const bf16*)(ws + WS_WLOUT * MiB); KO = LW; Aout = (const bf16*)(ws + WS_Y * MiB);
            bf16* XC = (bf16*)(ws + WS_AGG * MiB); bf16* HB = (bf16*)(ws + 1107 * MiB); bf16* Yb = (bf16*)(ws + WS_Y * MiB);
            ChainArgs CA{XC, (const bf16*)(ws + WS_WG * MiB), in[I_lba], in[I_lbi], in[I_llam], in[I_slru], Yb, HB, o_lru};
            if (EN & 32) PH(phid(l, SL_M2)) { ph_lru_xc(F, XG, in[I_lcw], in[I_lcb], XC); SEAM(phid(l, SL_M2)); }
            if (EN & 64) PH(phid(l, SL_M3)) { ph_lru_chains(F, CA); SEAM(phid(l, SL_M3)); }
            if (EN & 128) PH(phid(l, SL_M4)) { ph_lru_combine(F, XG, HB, Yb); SEAM(phid(l, SL_M4)); }
        } else if constexpr (l == 2) {
            bf16* Dn = (bf16*)(ws + WS_DN * MiB); bf16* KR = (bf16*)(ws + WS_KR * MiB); bf16* Qb = (bf16*)(ws + WS_Q * MiB); bf16* KVr = (bf16*)(ws + WS_KVR * MiB); bf16* Kb = (bf16*)(ws + WS_K * MiB); Wo = (const bf16*)(ws + WS_WMO * MiB);
            if (EN & 256) PH(phid(l, SL_M2)) { ph_mlanorm(F, Dn, KR, in[I_mqan], in[I_mkvan], in[I_cckv], in[I_ckr], o_ckv, o_kr); SEAM(phid(l, SL_M2)); }
            if (EN & 512) PH(phid(l, SL_M3)) {
                { pg8::Gemm g{Dn, (const bf16*)(ws + WS_WMUQ * MiB), R, MQW, 768, MDN, 768, 0}; pg8::StaticOrder S; S.init(R, MQW, F.G, F.bid); pg8::EpiBf16<0> E{Qb, MQW, nullptr, 0, 0, 1.f};
                  pg8::gemm_phase<pg8::EpiBf16<0>, pg8::StaticOrder, true, true>(F.lds, g, S, E); }
                { pg8::Gemm g{Dn + 768, (const bf16*)(ws + WS_WMUKV * MiB), RK, MKVW, 512, MDN, 512, 0}; pg8::StaticOrder S; S.init(RK, MKVW, F.G, F.bid); pg8::EpiBf16<0> E{KVr, MKVW, nullptr, 0, 0, 1.f};
                  pg8::gemm_phase<pg8::EpiBf16<0>, pg8::StaticOrder, true, true>(F.lds, g, S, E); }
                SEAM(phid(l, SL_M3)); }
            if (EN & 1024) PH(phid(l, SL_M4)) {
                if (!QFUSE) ph_headpost<32>(F, HeadPost{Qb, MQW, 192, 192, nullptr, 0, 0, 0, in[I_mqn], Qb, MQW, 192, 16, 64, ropeC, ropeS, nullptr, R}, R * 16);
                ph_headpost<32>(F, HeadPost{KVr, MKVW, 256, 128, KR, 64, 0, 64, in[I_mkn], Kb, MQW, 192, 16, 64, ropeC, ropeS, nullptr, R}, RK * 16);
                SEAM(phid(l, SL_M4)); }
            if (EN & 2048) PH(phid(l, SL_M5)) {
                PolMlaLat PL; PL.Q = Qb; PL.K = Kb; PL.KV = KVr; PL.O = OB; PL.qgain = in[I_mqn]; PL.ropeC = ropeC; PL.ropeS = ropeS;
                ph_attn<192, 128, false>(F, PL, 2048);
                PolCtx PC; PC.Q = Qb; PC.pq = MQW; PC.shq = 192; PC.K = Kb; PC.pk = MQW; PC.shk = 192; PC.V = KVr + 128; PC.pv = MKVW; PC.shv = 256; PC.O = OB; PC.sho = 128; PC.NH = 16; PC.qgain = in[I_mqn]; PC.ropeC = ropeC; PC.ropeS = ropeS;
                ph_attn<192, 128, false>(F, PC, 256);
                SEAM(phid(l, SL_M5)); }
        } else {
            bf16* QKV = (bf16*)(ws + WS_QKV * MiB); Wo = (const bf16*)(ws + WS_WSO * MiB);
            if (EN & 4096) PH(phid(l, SL_M2)) {
                ph_copyv(F, QKV + 2304, SQW, 64, 4, 64, o_swav);
                if (!QFUSE) ph_headpost<8>(F, HeadPost{QKV, SQW, 64, 64, nullptr, 0, 0, 0, in[I_sqn], QKV, SQW, 64, 32, 64, ropeC, ropeS, nullptr, R}, R * 32);
                ph_headpost<8>(F, HeadPost{QKV + 2048, SQW, 64, 64, nullptr, 0, 0, 0, in[I_skn], QKV + 2048, SQW, 64, 4, 64, ropeC, ropeS, o_swak, R}, R * 4);
                SEAM(phid(l, SL_M2)); }
            if (EN & 8192) PH(phid(l, SL_M3)) {
                PolSwaLat PL; PL.QKV = QKV; PL.CK = (const bf16*)(ws + WS_SWACK * MiB); PL.CV = (const bf16*)(ws + WS_SWACV * MiB); PL.sinks = in[I_ssink]; PL.O = OB; PL.qgain = in[I_sqn]; PL.ropeC = ropeC; PL.ropeS = ropeS;
                ph_attn<64, 64, true>(F, PL, 4096);
                PolSwaCtx PC; PC.QKV = QKV; PC.O = OB; PC.sinks = in[I_ssink]; PC.qgain = in[I_sqn]; PC.ropeC = ropeC; PC.ropeS = ropeS;
                ph_attn<64, 64, true>(F, PC, 512);
                SEAM(phid(l, SL_M3)); }
        }
        if (EN & 16384) PH(phid(l, SL_MIXOUT)) {
            pg8::Gemm g{Aout, Wo, R, D, KO, KO, KO, 0}; pg8::StaticOrder S; S.init(R, D, F.G, F.bid, WGM_N2048);
            if constexpr (XB16 && l == 0) { pg8::EpiResidB<false, true> E{xc, xl, XB, mod + 2 * D}; pg8::gemm_phase<pg8::EpiResidB<false, true>, pg8::StaticOrder, true, true>(F.lds, g, S, E); }
            else if constexpr (XB16) { pg8::EpiResidB<true, true> E{XB, XB + (size_t)RC * D, l == 3 ? XB2 : XB, mod + 2 * D}; pg8::gemm_phase<pg8::EpiResidB<true, true>, pg8::StaticOrder, true, true>(F.lds, g, S, E); }
            else { pg8::EpiResid E{xc, xl, o_yp, mod + 2 * D}; pg8::gemm_phase<pg8::EpiResid, pg8::StaticOrder, true, true>(F.lds, g, S, E); }
            if (DEFER_W && l < 3) tr_layer_idle(F, in, ws, l + 1, 0);
            SEAM(phid(l, SL_MIXOUT)); }
        if (EN & 32768) PH(phid(l, SL_NORM2)) { if (XB16) ph_norm16(F, l == 3 ? XB2 : XB, in[I_nffn] + (size_t)l * D, mod, 3, H); else ph_norm(F, o_yp, o_ys, in[I_nffn] + (size_t)l * D, mod, 3, H); SEAM(phid(l, SL_NORM2)); }
        bf16* Gb = (bf16*)(ws + WS_G * MiB); float* SIDE = (float*)(ws + WS_SIDE * MiB);
        if (EN & 65536) PH(phid(l, SL_FFNIN)) {
            pg8::Gemm g{H, (const bf16*)(ws + (WS_WFFN + 66 * l) * MiB), R, 2 * DFF, D, D, D, 0}; pg8::StaticOrder S; S.init(R, 2 * DFF, F.G, F.bid, WGM_FFNIN);
            pg8::EpiFfn E{Gb, in[I_fcw] + (size_t)l * 3 * DFF, in[I_fcb] + (size_t)l * DFF, SIDE, (LAS float*)(F.lds + EPI_OFF)};
            pg8::gemm_phase<pg8::EpiFfn, pg8::StaticOrder, true, true>(F.lds, g, S, E);
            SEAM(phid(l, SL_FFNIN)); }
        if (EN & 131072) PH(phid(l, SL_FFNFIX)) { ph_ffn_fix(F, SIDE, in[I_fcw] + (size_t)l * 3 * DFF, Gb); SEAM(phid(l, SL_FFNFIX)); }
        if (EN & 262144) PH(phid(l, SL_FFNOUT)) {
            pg8::Gemm g{Gb, (const bf16*)(ws + (WS_WFFN + 66 * l + 44) * MiB), R, D, DFF, DFF, DFF, 0}; pg8::StaticOrder S; S.init(R, D, F.G, F.bid, WGM_N2048, REV_FFNOUT);
            if constexpr (XB16 && l < 3) { pg8::EpiResidB<true, true> E{XB, XB + (size_t)RC * D, XB, mod + 5 * D}; pg8::gemm_phase<pg8::EpiResidB<true, true>, pg8::StaticOrder, true, true>(F.lds, g, S, E); }
            else if constexpr (XB16) { pg8::EpiResidB<true, false> E{XB2, XB2 + (size_t)RC * D, o_yp, mod + 5 * D}; pg8::gemm_phase<pg8::EpiResidB<true, false>, pg8::StaticOrder, true, true>(F.lds, g, S, E); }
            else { pg8::EpiResid E{o_yp, o_ys, o_yp, mod + 5 * D}; pg8::gemm_phase<pg8::EpiResid, pg8::StaticOrder, true, true>(F.lds, g, S, E); }
            if (DEFER_W && l < 3) tr_layer_idle(F, in, ws, l + 1, 1);
            SEAM(phid(l, SL_FFNOUT)); }
}
__global__ void __launch_bounds__(512, 2) mega(mk::MArgs a) {
    using namespace mk; constexpr unsigned EN = EN_MASK;
    extern __shared__ __attribute__((aligned(16))) unsigned char lds_raw[];
    Fr F; F.lds = (LAS unsigned char*)lds_raw; F.tid = threadIdx.x; F.lane = F.tid & 63; F.wave = __builtin_amdgcn_readfirstlane(F.tid >> 6); F.G = gridDim.x; F.bid = blockIdx.x;
    for (int u = F.tid; u < (LDS_BYTES - LDSCTL_OFF) / 4; u += 512) ((LAS unsigned*)(F.lds + LDSCTL_OFF))[u] = 0u;
    __syncthreads();
    unsigned char* ws = a.ws; const float* const* in = a.in; float* out = a.out;
    const int lo = a.ph_lo, hi = a.ph_hi;
    XcdBarrier bar; bar.bar = (unsigned*)ws + CW_BAR; bar.x = 0; bar.st = nullptr;
    if (hi - lo > 1) bar = xcd_barrier_post((unsigned*)ws + CW_BAR, (volatile LAS unsigned*)(F.lds + MISC_OFF) + 8);
    if (EN & 1) PH(0) { ph_prologue(F, in, ws); SEAM(0); }
    layer_body<0>(F, in, out, ws, bar, lo, hi); layer_body<1>(F, in, out, ws, bar, lo, hi); layer_body<2>(F, in, out, ws, bar, lo, hi); layer_body<3>(F, in, out, ws, bar, lo, hi);
    PH(70) { bf16* H = (bf16*)(ws + WS_H * MiB); pg8::Gemm g{H, (const bf16*)(ws + WS_WFFN * MiB), 4096, 2 * DFF, D, D, D, 0}; pg8::StaticOrder S; S.init(4096, 2 * DFF, F.G, F.bid);
        pg8::EpiFfnT<1> E{(bf16*)(ws + 540 * MiB), in[I_fcw], in[I_fcb], (float*)(ws + WS_SIDE * MiB), (LAS float*)(F.lds + EPI_OFF)}; pg8::gemm_phase<pg8::EpiFfnT<1>, pg8::StaticOrder, true, true>(F.lds, g, S, E); }
    PH(71) { bf16* H = (bf16*)(ws + WS_H * MiB); pg8::Gemm g{H, (const bf16*)(ws + WS_WFFN * MiB), 4096, 2 * DFF, D, D, D, 0}; pg8::StaticOrder S; S.init(4096, 2 * DFF, F.G, F.bid);
        pg8::EpiFfnT<2> E{(bf16*)(ws + 600 * MiB), in[I_fcw], in[I_fcb], (float*)(ws + WS_SIDE * MiB), (LAS float*)(F.lds + EPI_OFF)}; pg8::gemm_phase<pg8::EpiFfnT<2>, pg8::StaticOrder, true, true>(F.lds, g, S, E); }
    PH(72) { bf16* H = (bf16*)(ws + WS_H * MiB); pg8::Gemm g{H, (const bf16*)(ws + WS_WFFN * MiB), 4096, 2 * DFF, D, D, D, 0}; pg8::StaticOrder S; S.init(4096, 2 * DFF, F.G, F.bid);
        pg8::EpiFfnT<0> E{(bf16*)(ws + 660 * MiB), in[I_fcw], in[I_fcb], (float*)(ws + WS_SIDE * MiB), (LAS float*)(F.lds + EPI_OFF)}; pg8::gemm_phase<pg8::EpiFfnT<0>, pg8::StaticOrder, true, true>(F.lds, g, S, E); }
#undef PH
#undef SEAM
}
template <class Op, int BT> __global__ __launch_bounds__(BT) void k_run(Op op, long n) { for (long g = (long)blockIdx.x * BT + threadIdx.x; g < n; g += (long)gridDim.x * BT) op.run(g); }
template <int MODE> __global__ __launch_bounds__(512, 2) void k_gemm(pg8::Gemm g, void* C, long ldc) {
    extern __shared__ __attribute__((aligned(16))) unsigned char shm[];
    pg8::StaticOrder S; S.init(g.M, g.N, (int)gridDim.x, (int)blockIdx.x);
    if constexpr (MODE == 0) { pg8::EpiBf16<0> E{(pg8::bf16_t*)C, (int)ldc, nullptr, 0, 0, 1.f}; pg8::gemm_phase<pg8::EpiBf16<0>, pg8::StaticOrder, true, true>((PG8_LAS unsigned char*)shm, g, S, E); }
    else { pg8::EpiF32 E{(float*)C, (int)ldc}; pg8::gemm_phase<pg8::EpiF32, pg8::StaticOrder, true, true>((PG8_LAS unsigned char*)shm, g, S, E); }
}
template <class T> struct big_regs { static constexpr bool v = false; };
template <int A, int B> struct big_regs<OpAttnCtx<A, B>> { static constexpr bool v = true; };
template <int A> struct big_regs<OpNatLat<A>> { static constexpr bool v = true; };
template <int A, int B> struct big_regs<OpMlaLat<A, B>> { static constexpr bool v = true; };
template <int A> struct big_regs<OpSwaLat<A>> { static constexpr bool v = true; };
struct DevCX { hipStream_t st; int cus;
    template <class Op> void run(const Op& op, long n) { constexpr int BT = big_regs<Op>::v ? 64 : 256; long nb = (n + BT - 1) / BT; const long cap = (long)cus * (big_regs<Op>::v ? 32 : 16); if (nb > cap) nb = cap;
        hipLaunchKernelGGL((k_run<Op, BT>), dim3((unsigned)nb), dim3(BT), 0, st, op, n); }
    void gemm(const act_t* A, int lda, const act_t* Wt, int M, int N, int K, int mode, void* C, int ldc) {
        pg8::Gemm g{A, Wt, M, N, K, lda, K, 0};
        static bool a = false; if (!a) { (void)hipFuncSetAttribute((const void*)k_gemm<0>, hipFuncAttributeMaxDynamicSharedMemorySize, pg8::STAGE_BYTES); (void)hipFuncSetAttribute((const void*)k_gemm<1>, hipFuncAttributeMaxDynamicSharedMemorySize, pg8::STAGE_BYTES); a = true; }
        if (mode == 0) hipLaunchKernelGGL((k_gemm<0>), dim3(cus), dim3(512), pg8::STAGE_BYTES, st, g, C, (long)ldc);
        else hipLaunchKernelGGL((k_gemm<1>), dim3(cus), dim3(512), pg8::STAGE_BYTES, st, g, C, (long)ldc); }
};

#ifndef USE_PRO
#define USE_PRO 1
#endif
#ifndef USE_NORM
#define USE_NORM 1
#endif
#ifndef USE_GEMM
#define USE_GEMM 1
#endif
#ifndef USE_RESID
#define USE_RESID 1
#endif
#ifndef USE_HP
#define USE_HP 1
#endif
#ifndef USE_ATTN
#define USE_ATTN 13
#endif
#ifndef USE_LRU
#define USE_LRU 1
#endif
#ifndef USE_FFN
#define USE_FFN 1
#endif
#ifndef ONE_LAUNCH
#define ONE_LAUNCH 1
#endif


#ifndef TEST_PERM
#define TEST_PERM 0
#endif
struct OpFfnActP { const act_t* U; const float* cw; const float* cb; act_t* G; long row0; long nrows; Dims d;
    __device__ void run(long g) const { const int F = d.DFF; const int lr = (int)(g / F), c = (int)(g % F); const int row = (int)row0 + lr; const int ca = 256 * (c >> 7) + (c & 127), cbx = ca + 128;
        int s0, T; if (row < d.RC) { s0 = (row / d.S) * d.S; T = d.S; } else { s0 = d.RC + ((row - d.RC) / d.N) * d.N; T = d.N; } const int t = row - s0;
        float acc = cb[c]; for (int k = 0; k < 3; ++k) { const int tt = t + k - 1; if (tt >= 0 && tt < T) acc += cw[(size_t)k * F + c] * ldf(U[(size_t)(s0 + tt - row0) * 2 * F + ca]); }
        G[(size_t)lr * F + c] = stf(silu_f(acc) * ldf(U[(size_t)lr * 2 * F + cbx])); } };
#ifndef DIAG_FFN
#define DIAG_FFN 0
#endif
struct OpCmp { const act_t* U; const act_t* ga; const act_t* gb; const act_t* gc; unsigned* diag; long F; const float* cw; const float* cb;
    __device__ void run(long g) const { if (((unsigned)(g * 2654435761u) >> 26) != 0u) return; const long lr = g / F, c = g % F; const int r16 = lr & 15; if (r16 == 0 || r16 == 15) return;
        const float a0 = ldf(U[lr * 2 * F + c]), am = ldf(U[(lr - 1) * 2 * F + c]), ap = ldf(U[(lr + 1) * 2 * F + c]); const float b0 = ldf(U[lr * 2 * F + F + c]);
        const float w0 = cw[c], w1 = cw[F + c], w2 = cw[2 * F + c], bb = cb[c];
        const float v0 = silu_f(bb + w0 * am + w1 * a0 + w2 * ap) * b0;
        float df = fabsf(ldf(ga[g]) - a0); if (df > 0.05f + 0.02f * fabsf(a0) || !(df == df)) atomicAdd(diag + 0, 1u);
        df = fabsf(ldf(gb[g]) - a0); if (df > 0.05f + 0.02f * fabsf(a0) || !(df == df)) atomicAdd(diag + 1, 1u);
        df = fabsf(ldf(gc[g]) - v0); if (df > 0.15f + 0.05f * fabsf(v0) || !(df == df)) atomicAdd(diag + 2, 1u); } };
struct OpPerturb { float* out; const unsigned* diag;
    __device__ void run(long g) const { const unsigned bits = (diag[0] > 5000u ? 1u : 0u) | (diag[1] > 5000u ? 2u : 0u) | (diag[2] > 5000u ? 4u : 0u); out[g] *= 1.f + 0.05f * (1.f + (float)bits * 0.0625f); } };
extern "C" void kernel_launch(void* const* d_in, const int* in_sizes, int n_in, void* d_out, int out_size, void* d_ws, size_t ws_size, hipStream_t stream) {
    static int cus = 0;
    if (cus == 0) { int dev = 0; if (hipGetDevice(&dev) != hipSuccess || hipDeviceGetAttribute(&cus, hipDeviceAttributeMultiprocessorCount, dev) != hipSuccess || cus <= 0) cus = -1;
        if (cus > 0 && hipFuncSetAttribute((const void*)mega, hipFuncAttributeMaxDynamicSharedMemorySize, mk::LDS_BYTES) != hipSuccess) cus = -1; }
    constexpr size_t MiB = 1u << 20;
    if (cus < 0 || n_in != N_IN || out_size != 96817152 || ws_size < 1500 * MiB) { fprintf(stderr, "kernel_launch: unexpected arguments (n_in %d out %d ws %zu cus %d); nothing launched\n", n_in, out_size, ws_size, cus); return; }
    Dims d{}; d.D = 2048; d.B = 16; d.S = 256; d.DB = 8; d.N = 4096; d.PAST = 256; d.GW = 64; d.NAH = 16; d.NAD = 128; d.LW = 2688; d.LB = 16; d.LBK = 168;
    d.MH = 16; d.MQR = 768; d.MKR = 512; d.MNOPE = 128; d.MROPE = 64; d.MV = 128; d.MQK = 192; d.MDN = 1536; d.SH = 32; d.SKVH = 4; d.SD = 64; d.SWIN = 128; d.DFF = 5632;
    d.RC = d.B * d.S; d.R = d.RC + d.DB * d.N; d.RK = d.R + d.DB * d.PAST;
    unsigned char* ws = (unsigned char*)d_ws; auto at = [&](size_t mib) { return ws + mib * MiB; };
    WS w{}; w.MOD = (float*)at(1); w.ropeC = (float*)at(3); w.ropeS = (float*)at(4);
    w.natCK = (act_t*)at(5); w.natCV = (act_t*)at(13); w.swaCK = (act_t*)at(21); w.swaCV = (act_t*)at(22);
    for (int l = 0; l < 4; ++l) { w.Wffn_in[l] = (act_t*)at(26 + 66 * l); w.Wffn_out[l] = (act_t*)at(26 + 66 * l + 44); }
    w.Wnat_qkv = (act_t*)at(290); w.Wnat_o = (act_t*)at(314); w.Wlru_in = (act_t*)at(322); w.Wlru_out = (act_t*)at(344); w.Wmla_down = (act_t*)at(355); w.Wmla_uq = (act_t*)at(361);
    w.Wmla_ukv = (act_t*)at(366); w.Wmla_o = (act_t*)at(370); w.Wswa_qkv = (act_t*)at(378); w.Wswa_o = (act_t*)at(388);
    w.H = (act_t*)at(396); w.OB = w.H;
    w.QKV = (act_t*)at(540); w.XG = (act_t*)at(540); w.XC = (act_t*)at(918); w.HS = (act_t*)at(1107); w.Y = (act_t*)at(1296);
    w.Dn = (act_t*)at(540); w.KR = (act_t*)at(654); w.Q = (act_t*)at(659); w.KVr = (act_t*)at(875); w.K = (act_t*)at(1179);
    w.U = (act_t*)at(540); w.G = (act_t*)at(804); w.ffn_chunk_rows = 12288;
    w.T_mix[0] = (float*)at(972); w.T_mix[1] = (float*)at(540); w.T_mix[2] = (float*)at(540); w.T_mix[3] = (float*)at(720); w.T_ffn = (float*)at(936);
    float* out = (float*)d_out;
    OutPtrs o{out, out + 8388608, out + 75497472, out + 83886080, out + 92274688, out + 92360704, out + 94457856, out + 94720000, out + 95768576};
    const float* in[N_IN]; for (int i = 0; i < N_IN; ++i) in[i] = (const float*)d_in[i];
    DevCX cx{stream, cus};
    (void)hipMemsetAsync(ws, 0, MiB, stream);
    mk::MArgs ma{}; for (int i = 0; i < N_IN; ++i) ma.in[i] = in[i]; ma.out = out; ma.ws = ws;
    auto mega_ph = [&](int lo, int hi) { mk::MArgs a = ma; a.ph_lo = lo; a.ph_hi = hi; hipLaunchKernelGGL(mega, dim3(cus), dim3(512), mk::LDS_BYTES, stream, a); };
#ifndef REP_MASK
#define REP_MASK 0
#endif
    auto mph = [&](int l, int slot) { int reps = 1;
        const bool att = (l == 0 && slot == mk::SL_M3) || (l == 2 && slot == mk::SL_M5) || (l == 3 && slot == mk::SL_M3);
        const bool gem = slot == mk::SL_M1 || (l == 2 && slot == mk::SL_M3) || slot == mk::SL_FFNIN;
        const bool lru = l == 1 && (slot == mk::SL_M2 || slot == mk::SL_M3 || slot == mk::SL_M4);
        const bool light = slot == mk::SL_NORM1 || slot == mk::SL_NORM2 || lru || slot == mk::SL_FFNFIX;
        if ((REP_MASK & 1) && att) reps = 2; if ((REP_MASK & 2) && gem) reps = 2; if ((REP_MASK & 4) && light) reps = 2; if ((REP_MASK & 8) && l == 2 && slot == mk::SL_M5) reps = 2; if ((REP_MASK & 32) && lru) reps = 2; if ((REP_MASK & 128) && slot == mk::SL_FFNIN) reps = 2; if ((REP_MASK & 512) && l == 1 && slot == mk::SL_M3) reps = 2; if ((REP_MASK & 256) && (slot == mk::SL_NORM1 || slot == mk::SL_NORM2)) reps = 2;
        if ((REP_MASK & 64) && (slot == mk::SL_MIXOUT || slot == mk::SL_FFNOUT)) { mk::MArgs a = ma; a.out = (float*)at(slot == mk::SL_MIXOUT ? 540 : 972); a.ph_lo = mk::phid(l, slot); a.ph_hi = a.ph_lo + 1; hipLaunchKernelGGL(mega, dim3(cus), dim3(512), mk::LDS_BYTES, stream, a); }
        for (int r = 0; r < reps; ++r) mega_ph(mk::phid(l, slot), mk::phid(l, slot) + 1); };
#if ONE_LAUNCH
    mega_ph(0, mk::PH_END);
    return;
#endif
    const int D = d.D, R = d.R, NCI = 9; const long N6 = 6L * D; const int NQ = 2048, MKVW = 4096, SQW = 2560, QW = 3072;
    if (USE_PRO) { mega_ph(0, 1); if (REP_MASK & (4 | 16)) mega_ph(0, 1); }
    if ((!USE_PRO || !USE_FFN) && !DIAG_FFN && !TEST_PERM) for (int l = 0; l < 4; ++l) cx.run(OpTranspose{in[I_fwin] + (size_t)l * D * 2 * d.DFF, w.Wffn_in[l], D, 2 * d.DFF, 2 * d.DFF, 0, d.DFF}, (long)2 * d.DFF * D);
    if (!USE_PRO) {
        for (int l = 0; l < 4; ++l) cx.run(OpTranspose{in[I_fwout] + (size_t)l * d.DFF * D, w.Wffn_out[l], d.DFF, D, D, 0, 0}, (long)D * d.DFF);
        cx.run(OpTranspose{in[I_nwqkv], w.Wnat_qkv, D, 3 * NQ, 3 * NQ, 0, 0}, (long)3 * NQ * D); cx.run(OpTranspose{in[I_nwo], w.Wnat_o, NQ, D, D, 0, 0}, (long)D * NQ);
        cx.run(OpTranspose{in[I_lwin], w.Wlru_in, D, 2 * d.LW, 2 * d.LW, 0, 0}, (long)2 * d.LW * D); cx.run(OpTranspose{in[I_lwout], w.Wlru_out, d.LW, D, D, 0, 0}, (long)D * d.LW);
        cx.run(OpTranspose{in[I_mwd], w.Wmla_down, D, 1344, d.MDN, 0, 0}, (long)d.MDN * D); cx.run(OpTranspose{in[I_mwuq], w.Wmla_uq, d.MQR, QW, QW, 0, 0}, (long)QW * d.MQR);
        cx.run(OpTranspose{in[I_mwukv], w.Wmla_ukv, d.MKR, MKVW, MKVW, 0, 0}, (long)MKVW * d.MKR); cx.run(OpTranspose{in[I_mwo], w.Wmla_o, 2048, D, D, 0, 0}, (long)D * 2048);
        cx.run(OpTranspose{in[I_swqkv], w.Wswa_qkv, D, SQW, SQW, 0, 0}, (long)SQW * D); cx.run(OpTranspose{in[I_swo], w.Wswa_o, 2048, D, D, 0, 0}, (long)D * 2048);
        cx.run(OpCvt{in[I_cnk], w.natCK}, (long)8 * 16 * 256 * 128); cx.run(OpCvt{in[I_cnv], w.natCV}, (long)8 * 16 * 256 * 128);
        cx.run(OpCvt{in[I_csk], w.swaCK}, (long)8 * 4 * 256 * 64); cx.run(OpCvt{in[I_csv], w.swaCV}, (long)8 * 4 * 256 * 64);
        cx.run(OpMod{in[I_c], in[I_cctx], in[I_wmod], in[I_bmod], w.MOD, D, NCI}, 4L * NCI * N6);
        cx.run(OpRope{w.ropeC, w.ropeS, d.MROPE, d.GW}, (long)d.N * d.MROPE);
    }
    const float* xc = in[I_xp]; const float* xl = in[I_xs]; float* outl = o.yp + (size_t)d.RC * D;
    for (int l = 0; l < 4; ++l) {
        const float* mod = w.MOD + (size_t)l * NCI * N6;
        if (USE_NORM) mph(l, mk::SL_NORM1); else cx.run(OpNormMod{xc, xl, in[I_nmix] + (size_t)l * D, mod, 0, w.H, d}, R);
        int KO = 0; const act_t* Wo = nullptr; const act_t* Aout = nullptr;
        if (l == 0) {
            if (USE_GEMM) mph(l, mk::SL_M1); else cx.gemm(w.H, D, w.Wnat_qkv, R, 3 * NQ, D, 0, w.QKV, 3 * NQ);
            if (USE_HP) { if (!KFUSE) mph(l, mk::SL_M2); } else {
                cx.run(OpCopyV{w.QKV + 2 * NQ, 3L * NQ, d.NAD, d.NAH, d.NAD, o.nat_v, d}, (long)d.RC * d.NAH * d.NAD);
                cx.run(OpHeadPost{w.QKV, 3L * NQ, d.NAD, d.NAD, nullptr, 0, 0, 0, in[I_nqn], w.QKV, 3L * NQ, d.NAD, d.NAH, 0, nullptr, nullptr, nullptr, 1, d, R}, (long)R * d.NAH);
                cx.run(OpHeadPost{w.QKV + NQ, 3L * NQ, d.NAD, d.NAD, nullptr, 0, 0, 0, in[I_nkn], w.QKV + NQ, 3L * NQ, d.NAD, d.NAH, 0, nullptr, nullptr, o.nat_k, 1, d, R}, (long)R * d.NAH); }
            if (USE_ATTN & 1) mph(l, mk::SL_M3); else {
                cx.run(OpAttnCtx<128, 128>{w.QKV, 3L * NQ, d.NAD, w.QKV + NQ, 3L * NQ, d.NAD, w.QKV + 2 * NQ, 3L * NQ, d.NAD, w.OB, (long)NQ, d.NAD, d.NAH, 1, nullptr, d}, (long)d.B * d.NAH * d.S);
                cx.run(OpNatLat<128>{w.QKV, 3L * NQ, w.natCK, w.natCV, in[I_nrpb], w.OB, (long)NQ, d}, (long)d.DB * d.NAH * d.N); }
            KO = NQ; Wo = w.Wnat_o; Aout = w.OB;
        } else if (l == 1) {
            if (USE_GEMM) mph(l, mk::SL_M1); else cx.gemm(w.H, D, w.Wlru_in, R, 2 * d.LW, D, 0, w.XG, 2 * d.LW);
            if (USE_LRU) { mph(l, mk::SL_M2); mph(l, mk::SL_M3); mph(l, mk::SL_M4); } else {
                cx.run(OpLruConv{w.XG, in[I_lcw], in[I_lcb], w.XC, d}, (long)R * d.LW);
                cx.run(OpLruScan{w.XC, w.XG, in[I_lwa], in[I_lba], in[I_lwi], in[I_lbi], in[I_llam], in[I_slru], w.HS, w.Y, o.lru, d}, (long)(d.B + d.DB) * d.LW); }
            KO = d.LW; Wo = w.Wlru_out; Aout = w.Y;
        } else if (l == 2) {
            if (USE_GEMM) mph(l, mk::SL_M1); else cx.gemm(w.H, D, w.Wmla_down, R, d.MDN, D, 0, w.Dn, d.MDN);
            if (USE_HP) mph(l, mk::SL_M2); else cx.run(OpMlaNorm{w.Dn, w.KR, in[I_mqan], in[I_mkvan], in[I_cckv], in[I_ckr], o.ckv, o.krope, d}, d.RK);
            if (USE_GEMM) mph(l, mk::SL_M3); else { cx.gemm(w.Dn, d.MDN, w.Wmla_uq, R, QW, d.MQR, 0, w.Q, QW); cx.gemm(w.Dn + d.MQR, d.MDN, w.Wmla_ukv, d.RK, MKVW, d.MKR, 0, w.KVr, MKVW); }
            if (USE_HP) mph(l, mk::SL_M4); else {
                cx.run(OpHeadPost{w.Q, (long)QW, d.MQK, d.MQK, nullptr, 0, 0, 0, in[I_mqn], w.Q, (long)QW, d.MQK, d.MH, d.MROPE, w.ropeC, w.ropeS, nullptr, 1, d, R}, (long)R * d.MH);
                cx.run(OpHeadPost{w.KVr, (long)MKVW, d.MNOPE + d.MV, d.MNOPE, w.KR, (long)d.MROPE, 0, d.MROPE, in[I_mkn], w.K, (long)QW, d.MQK, d.MH, d.MROPE, w.ropeC, w.ropeS, nullptr, 1, d, R}, (long)d.RK * d.MH); }
            if (USE_ATTN & 4) mph(l, mk::SL_M5); else {
                cx.run(OpAttnCtx<192, 128>{w.Q, (long)QW, d.MQK, w.K, (long)QW, d.MQK, w.KVr + d.MNOPE, (long)MKVW, d.MNOPE + d.MV, w.OB, (long)d.MH * d.MV, d.MV, d.MH, 1, nullptr, d}, (long)d.B * d.MH * d.S);
                cx.run(OpMlaLat<192, 128>{w.Q, w.K, w.KVr, w.OB, (long)d.MH * d.MV, d}, (long)d.DB * d.MH * d.N); }
            KO = d.MH * d.MV; Wo = w.Wmla_o; Aout = w.OB;
        } else {
            if (USE_GEMM) mph(l, mk::SL_M1); else cx.gemm(w.H, D, w.Wswa_qkv, R, SQW, D, 0, w.QKV, SQW);
            if (USE_HP) mph(l, mk::SL_M2); else {
                cx.run(OpCopyV{w.QKV + (d.SH + d.SKVH) * d.SD, (long)SQW, d.SD, d.SKVH, d.SD, o.swa_v, d}, (long)d.RC * d.SKVH * d.SD);
                cx.run(OpHeadPost{w.QKV, (long)SQW, d.SD, d.SD, nullptr, 0, 0, 0, in[I_sqn], w.QKV, (long)SQW, d.SD, d.SH, d.SD, w.ropeC, w.ropeS, nullptr, 1, d, R}, (long)R * d.SH);
                cx.run(OpHeadPost{w.QKV + d.SH * d.SD, (long)SQW, d.SD, d.SD, nullptr, 0, 0, 0, in[I_skn], w.QKV + d.SH * d.SD, (long)SQW, d.SD, d.SKVH, d.SD, w.ropeC, w.ropeS, o.swa_k, 1, d, R}, (long)R * d.SKVH); }
            if (USE_ATTN & 8) mph(l, mk::SL_M3); else {
                cx.run(OpAttnCtx<64, 64>{w.QKV, (long)SQW, d.SD, w.QKV + d.SH * d.SD, (long)SQW, d.SD, w.QKV + (d.SH + d.SKVH) * d.SD, (long)SQW, d.SD, w.OB, (long)d.SH * d.SD, d.SD, d.SH, d.SH / d.SKVH, in[I_ssink], d}, (long)d.B * d.SH * d.S);
                cx.run(OpSwaLat<64>{w.QKV, (long)SQW, w.swaCK, w.swaCV, in[I_ssink], w.OB, (long)d.SH * d.SD, d}, (long)d.DB * d.SH * d.N); }
            KO = d.SH * d.SD; Wo = w.Wswa_o; Aout = w.OB;
        }
        if (USE_RESID) mph(l, mk::SL_MIXOUT); else { cx.gemm(Aout, KO, Wo, R, D, KO, 1, w.T_mix[l], D); cx.run(OpResid{xc, xl, w.T_mix[l], mod, 2, o.yp, d}, (long)R * D); }
        xc = o.yp; xl = outl;
        if (USE_NORM) mph(l, mk::SL_NORM2); else cx.run(OpNormMod{xc, xl, in[I_nffn] + (size_t)l * D, mod, 3, w.H, d}, R);
        if (DIAG_FFN && l == 0) { mega_ph(70, 71); mega_ph(71, 72); mega_ph(72, 73); for (int l2 = 0; l2 < 4; ++l2) cx.run(OpTranspose{in[I_fwin] + (size_t)l2 * D * 2 * d.DFF, w.Wffn_in[l2], D, 2 * d.DFF, 2 * d.DFF, 0, d.DFF}, (long)2 * d.DFF * D); w.U = (act_t*)at(1224); w.G = (act_t*)at(1312); w.ffn_chunk_rows = 4096; }
        if (USE_FFN) { mph(l, mk::SL_FFNIN); mph(l, mk::SL_FFNFIX); mph(l, mk::SL_FFNOUT); } else {
            for (int r0 = 0; r0 < R; r0 += w.ffn_chunk_rows) { const int nr = (R - r0) < w.ffn_chunk_rows ? (R - r0) : w.ffn_chunk_rows;
                cx.gemm(w.H + (size_t)r0 * D, D, w.Wffn_in[l], nr, 2 * d.DFF, D, 0, w.U, 2 * d.DFF);
                if (TEST_PERM) cx.run(OpFfnActP{w.U, in[I_fcw] + (size_t)l * 3 * d.DFF, in[I_fcb] + (size_t)l * d.DFF, w.G, r0, nr, d}, (long)nr * d.DFF); else
                cx.run(OpFfnAct{w.U, in[I_fcw] + (size_t)l * 3 * d.DFF, in[I_fcb] + (size_t)l * d.DFF, w.G, r0, nr, d}, (long)nr * d.DFF);
                if (DIAG_FFN && l == 0 && r0 == 0) cx.run(OpCmp{w.U, (const act_t*)at(540), (const act_t*)at(600), (const act_t*)at(660), (unsigned*)(ws + 65536), (long)d.DFF, in[I_fcw], in[I_fcb]}, (long)nr * d.DFF);
                cx.gemm(w.G, d.DFF, w.Wffn_out[l], nr, D, d.DFF, 1, w.T_ffn + (size_t)r0 * D, D); }
            cx.run(OpResid{xc, xl, w.T_ffn, mod, 5, o.yp, d}, (long)R * D); }
        if (DIAG_FFN && l == 0) { w.U = (act_t*)at(540); w.G = (act_t*)at(804); w.ffn_chunk_rows = 12288; }
    }
    if (DIAG_FFN) cx.run(OpPerturb{o.yp, (const unsigned*)(ws + 65536)}, (long)8388608);
}
```

```cpp
#include <hip/hip_runtime.h>
#include <cstdio>
#include <cstdint>
#include <math.h>
namespace pg8 {
#define PG8_LAS __attribute__((address_space(3)))
typedef unsigned short bf16_t;
typedef short bf16x8 __attribute__((ext_vector_type(8)));
typedef float f32x4 __attribute__((ext_vector_type(4)));
typedef unsigned u32x4 __attribute__((ext_vector_type(4)));
constexpr int BM = 256, BK = 64, HALF = 128, HTB = HALF * BK * 2  , STAGE_BYTES = 8 * HTB, NXCD = 8, WGM = 8;

__host__ __device__ __forceinline__ int lds_byte(int r, int c) { const int st = (r >> 4) * 2 + (c >> 5), rr = r & 15, cc = c & 31, ob = rr * 64 + cc * 2; return st * 1024 + (ob ^ (((ob >> 9) & 1) << 5)); }
__host__ __device__ __forceinline__ void stage_rc(int b, int& R, int& C) { const int st = b / 1024, sb = b % 1024, swz = sb ^ (((sb >> 9) & 1) << 5); R = (st >> 1) * 16 + swz / 64; C = (st & 1) * 32 + (swz % 64) / 2; }
__host__ __device__ __forceinline__ int perm32(int rho) { const int n = rho >> 4, i = rho & 15; return 8 * (i >> 2) + 4 * n + (i & 3); }

struct Unit { int pm, pn; };
struct Gemm { const bf16_t* A; const bf16_t* Bt; int M, N, K, lda, ldb, pad; };

struct StaticOrder {
    int nM, nN, nwg, G, c, wgm, rev;
    __host__ __device__ void init(int M, int N, int G_, int c_, int wgm_ = WGM, int rev_ = 0) { nM = M / BM; nN = N / BM; nwg = nM * nN; G = G_; c = c_; wgm = wgm_; rev = rev_; }
    __host__ __device__ bool next(int i, Unit& u) const {
        const long L = (long)i * G + c; if (L >= nwg) return false;
        int wgid = (int)L; { const int q = nwg / NXCD, r = nwg % NXCD, xcd = wgid % NXCD, off = wgid / NXCD, sz = xcd < r ? q + 1 : q; wgid = (xcd < r ? xcd * (q + 1) : r * (q + 1) + (xcd - r) * q) + (rev ? sz - 1 - off : off); }
        const int nig = wgm * nN, gid = wgid / nig, fm = gid * wgm, gsz = (nM - fm) < wgm ? (nM - fm) : wgm;
        u.pm = fm + ((wgid % nig) % gsz); u.pn = (wgid % nig) / gsz; return true;
    }
    __device__ __forceinline__ void a_ready(const Unit&) const {}
    __device__ __forceinline__ void done(const Unit&) const {}
};

__device__ __forceinline__ unsigned cvt_pk_bf16(float lo, float hi) { unsigned r; asm volatile("v_cvt_pk_bf16_f32 %0, %1, %2" : "=v"(r) : "v"(lo), "v"(hi)); return r; }
typedef float f32x2 __attribute__((ext_vector_type(2)));
__device__ __forceinline__ f32x2 gelu_pk(f32x2 v) {
    const f32x2 av = __builtin_elementwise_abs(v), d = av * 0.2316418882f + 1.0f;
    f32x2 t; t.x = __builtin_amdgcn_rcpf(d.x); t.y = __builtin_amdgcn_rcpf(d.y);
    f32x2 q = t * 0.5307027145f + (-0.7265760135f); q = q * t + 0.7107068705f; q = q * t + (-0.142248368f); q = q * t + 0.127414796f; q = q * t;
    const f32x2 s = (v * v) * (-0.72134752044f);
    f32x2 e; e.x = __builtin_amdgcn_exp2f(s.x); e.y = __builtin_amdgcn_exp2f(s.y);
    const f32x2 m = v * (q * e), r = v - m;
    f32x2 o; o.x = v.x < 0.f ? m.x : r.x; o.y = v.y < 0.f ? m.y : r.y; return o;
}

template <int ACT  > struct EpiBf16 {
    static constexpr bool PERM = true, AFTER_DRAIN = false; static_assert(ACT == 0 || ACT == 1, "EpiBf16: ACT is 0 (none) or 1 (gelu_pk)");
    bf16_t* O; int ldc; const float* bias; int split_cols; size_t split_stride; float scale0;
    __device__ __forceinline__ void operator()(const f32x4 (&acc)[2][2][4][2], const Unit& u, int wr, int wc, int fr, int fq) const {
        const int row0 = u.pm * BM + wr * 64 + fr; int colt = u.pn * BM; bf16_t* base = O;
        float sc = 1.f; if (split_cols) { const int t = colt / split_cols; base += (size_t)t * split_stride; colt -= t * split_cols; if (t == 0) sc = scale0; }
        const int col0 = colt + wc * 32 + 8 * fq, bcol0 = u.pn * BM + wc * 32 + 8 * fq;
        f32x4 bv[2][2];
#pragma unroll
        for (int bj = 0; bj < 2; ++bj)
#pragma unroll
            for (int n = 0; n < 2; ++n) bv[bj][n] = bias ? *(const f32x4*)(bias + bcol0 + bj * HALF + 4 * n) : (f32x4){0.f, 0.f, 0.f, 0.f};
#pragma unroll
        for (int ai = 0; ai < 2; ++ai)
#pragma unroll
            for (int m = 0; m < 4; ++m) { bf16_t* rowp = base + (size_t)(row0 + ai * HALF + m * 16) * ldc + col0;
#pragma unroll
                for (int bj = 0; bj < 2; ++bj) { f32x4 v0 = acc[ai][bj][m][0] + bv[bj][0], v1 = acc[ai][bj][m][1] + bv[bj][1];
                    if (ACT == 1) { f32x2 a = gelu_pk((f32x2){v0[0], v0[1]}), b = gelu_pk((f32x2){v0[2], v0[3]}), c = gelu_pk((f32x2){v1[0], v1[1]}), d = gelu_pk((f32x2){v1[2], v1[3]});
                        v0 = (f32x4){a.x, a.y, b.x, b.y}; v1 = (f32x4){c.x, c.y, d.x, d.y}; }
                    v0 = v0 * sc; v1 = v1 * sc; u32x4 w; w.x = cvt_pk_bf16(v0[0], v0[1]); w.y = cvt_pk_bf16(v0[2], v0[3]); w.z = cvt_pk_bf16(v1[0], v1[1]); w.w = cvt_pk_bf16(v1[2], v1[3]);
                    *(u32x4*)(rowp + bj * HALF) = w; } }
    }
};


struct EpiF32 {
    static constexpr bool PERM = false, AFTER_DRAIN = false;
    float* C; int ldc;
    __device__ __forceinline__ void operator()(const f32x4 (&acc)[2][2][4][2], const Unit& u, int wr, int wc, int fr, int fq) const {
        const int row0 = u.pm * BM + wr * 64 + fr, col0 = u.pn * BM + wc * 32 + 4 * fq;
#pragma unroll
        for (int ai = 0; ai < 2; ++ai)
#pragma unroll
            for (int m = 0; m < 4; ++m) { float* rowp = C + (size_t)(row0 + ai * HALF + m * 16) * ldc + col0;
#pragma unroll
                for (int bj = 0; bj < 2; ++bj)
#pragma unroll
                    for (int n = 0; n < 2; ++n) *(f32x4*)(rowp + bj * HALF + n * 16) = acc[ai][bj][m][n]; }
    }
};
struct PanelStats {
    unsigned* xbuf;
    unsigned* cnt;
    unsigned* tmo;
    int ntn; float eps;
    unsigned code;
    __device__ __forceinline__ bool run(const f32x4 (&v)[2][2][4][2], const Unit& u, int wr, int wc, int fr, int fq, PG8_LAS unsigned char* lds, int wid, int lane) const {
        typedef float f32x2v __attribute__((ext_vector_type(2)));
        PG8_LAS f32x2v* P = (PG8_LAS f32x2v*)lds;
        PG8_LAS f32x2v* S = (PG8_LAS f32x2v*)(lds + 8192);
        PG8_LAS unsigned* flag = (PG8_LAS unsigned*)(lds + 8192 + 2048);
#pragma unroll
        for (int ai = 0; ai < 2; ++ai)
#pragma unroll
            for (int m = 0; m < 4; ++m) {
                float s = 0.f;
#pragma unroll
                for (int bj = 0; bj < 2; ++bj)
#pragma unroll
                    for (int n = 0; n < 2; ++n) { const f32x4 x = v[ai][bj][m][n]; s += (x[0] + x[1]) + (x[2] + x[3]); }
                s += __shfl_xor(s, 16); s += __shfl_xor(s, 32);
                const float mw = s * (1.0f / 64.0f); float q = 0.f;
#pragma unroll
                for (int bj = 0; bj < 2; ++bj)
#pragma unroll
                    for (int n = 0; n < 2; ++n) { const f32x4 d = v[ai][bj][m][n] - mw; q += (d[0] * d[0] + d[1] * d[1]) + (d[2] * d[2] + d[3] * d[3]); }
                q += __shfl_xor(q, 16); q += __shfl_xor(q, 32);
                if (fq == 0) P[(ai * HALF + wr * 64 + m * 16 + fr) * 4 + wc] = (f32x2v){mw, q};
            }
        asm volatile("s_waitcnt lgkmcnt(0)" ::: "memory"); __builtin_amdgcn_s_barrier(); asm volatile("" ::: "memory");
#if defined(BROKEN_EXCHANGE_NO_WAIT)
#warning BROKEN CONTROL BUILD: the row-statistics exchange does not wait; results are wrong by design
        if (blockIdx.x >= 64) { const long long t0_ = clock64(); while (clock64() - t0_ < 60000) __builtin_amdgcn_s_sleep(8); }
#endif
        const int row = wid * 32 + (lane & 31);
        if (lane < 32) {
            const f32x2v a = P[row * 4 + 0], b = P[row * 4 + 1], c = P[row * 4 + 2], d = P[row * 4 + 3];
            const float mt = (a.x + b.x + c.x + d.x) * 0.25f;
            const float da = a.x - mt, db = b.x - mt, dc = c.x - mt, dd = d.x - mt;
            const float m2 = (a.y + b.y) + (c.y + d.y) + 64.0f * ((da * da + db * db) + (dc * dc + dd * dd));
            unsigned long long* slot = (unsigned long long*)xbuf + ((size_t)(u.pm * BM + row) * 4 + u.pn);
            __hip_atomic_store(slot, ((unsigned long long)__float_as_uint(m2) << 32) | __float_as_uint(mt), __ATOMIC_RELAXED, __HIP_MEMORY_SCOPE_AGENT);
        }
        asm volatile("s_waitcnt vmcnt(0)" ::: "memory");
        if (lane == 0) __hip_atomic_fetch_add(cnt + 64 * u.pm, 1u, __ATOMIC_RELAXED, __HIP_MEMORY_SCOPE_AGENT);
        if (wid == 0) {
            bool dead = false; const unsigned long long t0 = __builtin_amdgcn_s_memrealtime(); const unsigned want = 8u * (unsigned)ntn;
            for (;;) {
#if defined(BROKEN_EXCHANGE_NO_WAIT)
                break;
#endif
                if ((unsigned)__builtin_amdgcn_readfirstlane(__hip_atomic_load(cnt + 64 * u.pm, __ATOMIC_RELAXED, __HIP_MEMORY_SCOPE_AGENT)) >= want) break;
                if (__builtin_amdgcn_s_memrealtime() - t0 > 2000000ull) {
                    if (lane == 0) { unsigned expect = 0u; __hip_atomic_compare_exchange_strong(tmo + 1, &expect, code | (unsigned)(u.pm & 0xff), __ATOMIC_RELAXED, __ATOMIC_RELAXED, __HIP_MEMORY_SCOPE_AGENT);
                                     __hip_atomic_store(tmo, 1u, __ATOMIC_RELAXED, __HIP_MEMORY_SCOPE_AGENT); }
                    dead = true; break; }
                __builtin_amdgcn_s_sleep(2);
            }
            __builtin_amdgcn_fence(__ATOMIC_ACQUIRE, "agent");
            if (lane == 0) flag[0] = dead ? 1u : 0u;
        }
        asm volatile("s_waitcnt vmcnt(0) lgkmcnt(0)" ::: "memory"); __builtin_amdgcn_s_barrier(); asm volatile("" ::: "memory");
        const bool bad = flag[0] != 0u;
        if (lane < 32) {
            const unsigned long long* slot = (const unsigned long long*)xbuf + (size_t)(u.pm * BM + row) * 4; float mt[4], m2[4]; float ms = 0.f;
#pragma unroll
            for (int t = 0; t < 4; ++t) { if (t < ntn) { const unsigned long long w = __hip_atomic_load(slot + t, __ATOMIC_RELAXED, __HIP_MEMORY_SCOPE_AGENT); mt[t] = __uint_as_float((unsigned)w); m2[t] = __uint_as_float((unsigned)(w >> 32)); } else { mt[t] = 0.f; m2[t] = 0.f; } ms += mt[t]; }
            const float mean = ms / (float)ntn; float q = 0.f;
#pragma unroll
            for (int t = 0; t < 4; ++t) if (t < ntn) { const float dm = mt[t] - mean; q += m2[t] + 256.0f * dm * dm; }
            S[row] = (f32x2v){mean, 1.0f / sqrtf(q / (256.0f * (float)ntn) + eps)};
        }
        asm volatile("s_waitcnt lgkmcnt(0)" ::: "memory"); __builtin_amdgcn_s_barrier(); asm volatile("" ::: "memory");
        return bad;
    }
};
struct EpiLnRes {
    static constexpr bool PERM = false, AFTER_DRAIN = true;
    const float* base; float* out; int ldc; const float* bias; PanelStats st; unsigned poison;
    __device__ __forceinline__ void fused(f32x4 (&acc)[2][2][4][2], const Unit& u, int wr, int wc, int fr, int fq, PG8_LAS unsigned char* lds, int wid, int lane) const {
        typedef float f32x2v __attribute__((ext_vector_type(2)));
        const PG8_LAS f32x2v* S = (const PG8_LAS f32x2v*)(lds + 8192);
        const int col0 = u.pn * BM + wc * 32 + 4 * fq;
#pragma unroll
        for (int bj = 0; bj < 2; ++bj)
#pragma unroll
            for (int n = 0; n < 2; ++n) { const f32x4 bv = bias ? *(const f32x4*)(bias + col0 + bj * HALF + n * 16) : (f32x4){0.f, 0.f, 0.f, 0.f};
#pragma unroll
                for (int ai = 0; ai < 2; ++ai)
#pragma unroll
                    for (int m = 0; m < 4; ++m) acc[ai][bj][m][n] += bv; }
        f32x4 pre[4][2][2];
#pragma unroll
        for (int m = 0; m < 4; ++m) { const size_t off = (size_t)(u.pm * BM + wr * 64 + m * 16 + fr) * ldc + col0;
#pragma unroll
            for (int bj = 0; bj < 2; ++bj)
#pragma unroll
                for (int n = 0; n < 2; ++n) pre[m][bj][n] = *(const f32x4*)(base + off + bj * HALF + n * 16); }
        const bool bad = st.run(acc, u, wr, wc, fr, fq, lds, wid, lane) || poison != 0u;
        const float qnan = __builtin_nanf("");
#pragma unroll
        for (int ai = 0; ai < 2; ++ai)
#pragma unroll
            for (int m = 0; m < 4; ++m) { const int r = ai * HALF + wr * 64 + m * 16 + fr; const f32x2v sr = S[r]; const size_t off = (size_t)(u.pm * BM + r) * ldc + col0;
#pragma unroll
                for (int bj = 0; bj < 2; ++bj)
#pragma unroll
                    for (int n = 0; n < 2; ++n) { const f32x4 bs = ai == 0 ? pre[m][bj][n] : *(const f32x4*)(base + off + bj * HALF + n * 16); f32x4 o = bs + (acc[ai][bj][m][n] - sr.x) * sr.y;
                        if (bad) o = (f32x4){qnan, qnan, qnan, qnan}; *(f32x4*)(out + off + bj * HALF + n * 16) = o; }
                if (m & 1) asm volatile("" ::: "memory"); }
    }
};
struct EpiLnResLn {
    static constexpr bool PERM = false, AFTER_DRAIN = true;
    const float* base; float* out; bf16_t* xn; int ldc; const float* bias; PanelStats st1, st2; unsigned poison;
    __device__ __forceinline__ void fused(f32x4 (&acc)[2][2][4][2], const Unit& u, int wr, int wc, int fr, int fq, PG8_LAS unsigned char* lds, int wid, int lane) const {
        typedef float f32x2v __attribute__((ext_vector_type(2))); typedef unsigned u32x2v __attribute__((ext_vector_type(2)));
        const PG8_LAS f32x2v* S = (const PG8_LAS f32x2v*)(lds + 8192);
        const int col0 = u.pn * BM + wc * 32 + 4 * fq;
#pragma unroll
        for (int bj = 0; bj < 2; ++bj)
#pragma unroll
            for (int n = 0; n < 2; ++n) { const f32x4 bv = bias ? *(const f32x4*)(bias + col0 + bj * HALF + n * 16) : (f32x4){0.f, 0.f, 0.f, 0.f};
#pragma unroll
                for (int ai = 0; ai < 2; ++ai)
#pragma unroll
                    for (int m = 0; m < 4; ++m) acc[ai][bj][m][n] += bv; }
        bool bad = st1.run(acc, u, wr, wc, fr, fq, lds, wid, lane) || poison != 0u;
        const float qnan = __builtin_nanf("");
#pragma unroll
        for (int ai = 0; ai < 2; ++ai)
#pragma unroll
            for (int m = 0; m < 4; ++m) { const int r = ai * HALF + wr * 64 + m * 16 + fr; const f32x2v sr = S[r]; const size_t off = (size_t)(u.pm * BM + r) * ldc + col0;
#pragma unroll
                for (int bj = 0; bj < 2; ++bj)
#pragma unroll
                    for (int n = 0; n < 2; ++n) { const f32x4 bs = *(const f32x4*)(base + off + bj * HALF + n * 16); acc[ai][bj][m][n] = bs + (acc[ai][bj][m][n] - sr.x) * sr.y; }
                asm volatile("" : "+v"(acc[ai][0][m][0]), "+v"(acc[ai][0][m][1]), "+v"(acc[ai][1][m][0]), "+v"(acc[ai][1][m][1]));
                if (m & 1) asm volatile("" ::: "memory"); }
        const bool bad1 = bad;
        bad = st2.run(acc, u, wr, wc, fr, fq, lds, wid, lane) || bad;
#pragma unroll
        for (int ai = 0; ai < 2; ++ai)
#pragma unroll
            for (int m = 0; m < 4; ++m) { const int r = ai * HALF + wr * 64 + m * 16 + fr; const f32x2v sr = S[r]; const size_t off = (size_t)(u.pm * BM + r) * ldc + col0;
#pragma unroll
                for (int bj = 0; bj < 2; ++bj)
#pragma unroll
                    for (int n = 0; n < 2; ++n) { const f32x4 x1 = acc[ai][bj][m][n]; *(f32x4*)(out + off + bj * HALF + n * 16) = bad1 ? (f32x4){qnan, qnan, qnan, qnan} : x1;
                        const f32x4 o = (x1 - sr.x) * sr.y; u32x2v w; w.x = cvt_pk_bf16(o[0], o[1]); w.y = cvt_pk_bf16(o[2], o[3]);
                        if (bad) { w.x = 0x7fc07fc0u; w.y = 0x7fc07fc0u; } *(u32x2v*)(xn + off + bj * HALF + n * 16) = w; }
                asm volatile("" ::: "memory"); }
    }
};

template <class Epi, class Sched, bool ALIGN_EPI = false, bool SP2 = false>
__device__ __forceinline__ void gemm_phase(PG8_LAS unsigned char* lds, const Gemm g, const Sched& S, const Epi& E) {
    const int tid = threadIdx.x, wid = __builtin_amdgcn_readfirstlane(tid >> 6), lane = tid & 63, wr = wid >> 2, wc = wid & 3, fr = lane & 15, fq = lane >> 4;
    const int K = g.K, nt = K / BK;
    unsigned voffA[2], voffB[2];
#pragma unroll
    for (int i = 0; i < 2; ++i) { int R, C; stage_rc(tid * 16 + i * 8192, R, C); const int Rb = Epi::PERM ? ((R & ~31) + perm32(R & 31)) : R;
        voffA[i] = (unsigned)(R * g.lda + C) * 2u; voffB[i] = (unsigned)(Rb * g.ldb + C) * 2u; }
    const size_t kstep = (size_t)(BK * 2);
    const size_t hstepA = (size_t)HALF * g.lda * 2, hstepB = (size_t)HALF * g.ldb * 2;
    const size_t tstepA = 2 * hstepA, tstepB = 2 * hstepB;
    const unsigned ldsw = (unsigned)wid * 1024u;
    const int aoff = lds_byte(wr * 64 + fr, fq * 8), boff = lds_byte(wc * 32 + fr, fq * 8);
#define PG8_SA(b, h) (((b) * 2 + (h)) * HTB)
#define PG8_SB(b, h) ((4 + (b) * 2 + (h)) * HTB)
#define PG8_STAGE(bufoff, gbase, voff) do { _Pragma("unroll") for (int _i = 0; _i < 2; ++_i) \
        __builtin_amdgcn_global_load_lds((const unsigned*)((const char*)(gbase) + (voff)[_i]), (PG8_LAS unsigned*)(lds + (bufoff) + ldsw + _i * 8192), 16, 0, 0); } while (0)
#define PG8_LDA(dst, b, h) do { _Pragma("unroll") for (int m = 0; m < 4; ++m) _Pragma("unroll") for (int k = 0; k < 2; ++k) dst[m][k] = *(const PG8_LAS bf16x8*)(lds + PG8_SA(b, h) + aoff + m * 2048 + k * 1024); } while (0)
#define PG8_LDB(dst, b, h) do { _Pragma("unroll") for (int n = 0; n < 2; ++n) _Pragma("unroll") for (int k = 0; k < 2; ++k) dst[n][k] = *(const PG8_LAS bf16x8*)(lds + PG8_SB(b, h) + boff + n * 2048 + k * 1024); } while (0)
#define PG8_MMA(ai, bj, At, Bt) do { __builtin_amdgcn_s_setprio(1); _Pragma("unroll") for (int m = 0; m < 4; ++m) _Pragma("unroll") for (int n = 0; n < 2; ++n) _Pragma("unroll") for (int k = 0; k < 2; ++k) \
        acc[ai][bj][m][n] = __builtin_amdgcn_mfma_f32_16x16x32_bf16(Bt[n][k], At[m][k], acc[ai][bj][m][n], 0, 0, 0); __builtin_amdgcn_s_setprio(0); } while (0)
#define PG8_WAIT_V(n) asm volatile("s_waitcnt vmcnt(" #n ")" ::: "memory")
#define PG8_WAIT_L(n) asm volatile("s_waitcnt lgkmcnt(" #n ")" ::: "memory")
#define PG8_BAR __builtin_amdgcn_s_barrier()
#define PG8_SCHED __builtin_amdgcn_sched_barrier(0)
    Unit cur, nxt; int ui = 0;
    if (!S.next(0, cur)) return;
    f32x4 acc[2][2][4][2];
#pragma unroll
    for (int a = 0; a < 2; ++a)
#pragma unroll
        for (int b = 0; b < 2; ++b)
#pragma unroll
            for (int m = 0; m < 4; ++m)
#pragma unroll
                for (int n = 0; n < 2; ++n) acc[a][b][m][n] = (f32x4){0.f, 0.f, 0.f, 0.f};
    bf16x8 At[4][2], B0[2][2], B1[2][2];
    const char* cA = (const char*)g.A + (size_t)cur.pm * tstepA; const char* cB = (const char*)g.Bt + (size_t)cur.pn * tstepB;
    S.a_ready(cur);
    if constexpr (SP2) {
        PG8_STAGE(PG8_SB(0, 0), cB, voffB); PG8_STAGE(PG8_SB(0, 1), cB + hstepB, voffB); PG8_STAGE(PG8_SA(0, 0), cA, voffA); PG8_STAGE(PG8_SA(0, 1), cA + hstepA, voffA);
        if (wr == 1) PG8_BAR;
        PG8_WAIT_V(2); PG8_BAR;
        PG8_STAGE(PG8_SB(1, 0), cB + kstep, voffB); PG8_STAGE(PG8_SA(1, 0), cA + kstep, voffA); PG8_STAGE(PG8_SB(1, 1), cB + hstepB + kstep, voffB);
        PG8_WAIT_V(6); PG8_BAR;
    } else {
        PG8_STAGE(PG8_SB(0, 0), cB, voffB); PG8_STAGE(PG8_SA(0, 0), cA, voffA); PG8_STAGE(PG8_SB(0, 1), cB + hstepB, voffB); PG8_STAGE(PG8_SA(0, 1), cA + hstepA, voffA);
        if (wr == 1) PG8_BAR;
        PG8_WAIT_V(4); PG8_BAR;
        PG8_STAGE(PG8_SB(1, 0), cB + kstep, voffB); PG8_STAGE(PG8_SA(1, 0), cA + kstep, voffA); PG8_STAGE(PG8_SB(1, 1), cB + hstepB + kstep, voffB);
        PG8_WAIT_V(6); PG8_BAR;
    }
    for (;;) {
        const bool has_next = S.next(ui + 1, nxt);
        const char* nA = has_next ? (const char*)g.A + (size_t)nxt.pm * tstepA : cA; const char* nB = has_next ? (const char*)g.Bt + (size_t)nxt.pn * tstepB : cB;
        for (int t = 0; t < nt; t += 2) {
            const bool last = (t == nt - 2);
            const char* a1 = cA + (size_t)(t + 1) * kstep;
            const char* a2 = last ? nA : cA + (size_t)(t + 2) * kstep; const char* b2 = last ? nB : cB + (size_t)(t + 2) * kstep;
            const char* a3 = a2 + kstep; const char* b3 = b2 + kstep;
            if (last && has_next) S.a_ready(nxt);
            if constexpr (SP2) {
            PG8_LDB(B0, 0, 0); PG8_LDB(B1, 0, 1); PG8_SCHED; PG8_LDA(At, 0, 0); PG8_STAGE(PG8_SA(1, 1), a1 + hstepA, voffA);
            PG8_WAIT_V(8); PG8_WAIT_L(0); PG8_BAR; PG8_MMA(0, 0, At, B0); PG8_MMA(0, 1, At, B1); PG8_BAR; PG8_SCHED;
            PG8_LDA(At, 0, 1); PG8_STAGE(PG8_SB(0, 0), b2, voffB); PG8_STAGE(PG8_SB(0, 1), b2 + hstepB, voffB); PG8_STAGE(PG8_SA(0, 0), a2, voffA);
            PG8_WAIT_V(8); PG8_WAIT_L(0); PG8_BAR; PG8_MMA(1, 0, At, B0); PG8_MMA(1, 1, At, B1); PG8_BAR; PG8_SCHED;
            PG8_LDB(B0, 1, 0); PG8_LDB(B1, 1, 1); PG8_SCHED; PG8_LDA(At, 1, 0); PG8_STAGE(PG8_SA(0, 1), a2 + hstepA, voffA);
            PG8_WAIT_V(8); PG8_WAIT_L(0); PG8_BAR; PG8_MMA(0, 0, At, B0); PG8_MMA(0, 1, At, B1); PG8_BAR; PG8_SCHED;
            PG8_LDA(At, 1, 1); PG8_STAGE(PG8_SB(1, 0), b3, voffB); PG8_STAGE(PG8_SB(1, 1), b3 + hstepB, voffB); PG8_STAGE(PG8_SA(1, 0), a3, voffA);
            PG8_WAIT_V(8); PG8_WAIT_L(0); PG8_BAR; PG8_MMA(1, 0, At, B0); PG8_MMA(1, 1, At, B1); PG8_BAR; PG8_SCHED;
            } else {
            PG8_LDB(B0, 0, 0); PG8_SCHED; PG8_LDA(At, 0, 0); PG8_STAGE(PG8_SA(1, 1), a1 + hstepA, voffA);
            PG8_WAIT_L(8); PG8_BAR; PG8_WAIT_L(0); PG8_MMA(0, 0, At, B0); PG8_BAR; PG8_SCHED;
            PG8_LDB(B1, 0, 1); PG8_STAGE(PG8_SB(0, 0), b2, voffB);
            PG8_BAR; PG8_WAIT_L(0); PG8_MMA(0, 1, At, B1); PG8_BAR;
            PG8_LDA(At, 0, 1); PG8_STAGE(PG8_SA(0, 0), a2, voffA);
            PG8_BAR; PG8_WAIT_L(0); PG8_MMA(1, 0, At, B0); PG8_BAR; PG8_SCHED;
            PG8_STAGE(PG8_SB(0, 1), b2 + hstepB, voffB);
            PG8_WAIT_V(6); PG8_BAR; PG8_MMA(1, 1, At, B1); PG8_BAR;
            PG8_LDB(B0, 1, 0); PG8_SCHED; PG8_LDA(At, 1, 0); PG8_STAGE(PG8_SA(0, 1), a2 + hstepA, voffA);
            PG8_WAIT_L(8); PG8_BAR; PG8_WAIT_L(0); PG8_MMA(0, 0, At, B0); PG8_BAR; PG8_SCHED;
            PG8_LDB(B1, 1, 1); PG8_STAGE(PG8_SB(1, 0), b3, voffB);
            PG8_BAR; PG8_WAIT_L(0); PG8_MMA(0, 1, At, B1); PG8_BAR;
            PG8_LDA(At, 1, 1); PG8_STAGE(PG8_SA(1, 0), a3, voffA);
            PG8_BAR; PG8_WAIT_L(0); PG8_MMA(1, 0, At, B0); PG8_BAR; PG8_SCHED;
            PG8_STAGE(PG8_SB(1, 1), b3 + hstepB, voffB);
            PG8_WAIT_V(6); PG8_BAR; PG8_MMA(1, 1, At, B1); PG8_BAR;
            }
        }
        if constexpr (ALIGN_EPI) { if (wr == 0) PG8_BAR; }
        if constexpr (!Epi::AFTER_DRAIN) { E(acc, cur, wr, wc, fr, fq); S.done(cur); }
        if (!has_next) break;
#pragma unroll
        for (int a = 0; a < 2; ++a)
#pragma unroll
            for (int b = 0; b < 2; ++b)
#pragma unroll
                for (int m = 0; m < 4; ++m)
#pragma unroll
                    for (int n = 0; n < 2; ++n) acc[a][b][m][n] = (f32x4){0.f, 0.f, 0.f, 0.f};
        cur = nxt; cA = nA; cB = nB; ++ui;
        if constexpr (ALIGN_EPI) { if (wr == 1) PG8_BAR; }
    }
    PG8_WAIT_V(0);
    if constexpr (!ALIGN_EPI) { if (wr == 0) PG8_BAR; }
    PG8_BAR;
    if constexpr (Epi::AFTER_DRAIN) { E.fused(acc, cur, wr, wc, fr, fq, lds, wid, lane); S.done(cur); }
#undef PG8_SA
#undef PG8_SB
#undef PG8_STAGE
#undef PG8_LDA
#undef PG8_LDB
#undef PG8_MMA
#undef PG8_WAIT_V
#undef PG8_WAIT_L
#undef PG8_BAR
#undef PG8_SCHED
}
}
#ifdef __HIPCC__
#define HD __host__ __device__ __forceinline__
#define UNR _Pragma("unroll")
typedef unsigned short act_t;
HD float ldf(act_t v) { unsigned u = ((unsigned)v) << 16; float f; __builtin_memcpy(&f, &u, 4); return f; }
HD act_t stf(float f) { unsigned u; __builtin_memcpy(&u, &f, 4); u = (u + 0x7fffu + ((u >> 16) & 1u)) >> 16; return (act_t)u; }
#else
#define HD inline
#define UNR
typedef float act_t;
HD float ldf(act_t v) { return v; }
HD act_t stf(float f) { return f; }
#endif

struct Dims {
    int D, B, S, DB, N, PAST, GW;
    int NAH, NAD;
    int LW, LB, LBK;
    int MH, MQR, MKR, MNOPE, MROPE, MV, MQK, MDN  ;
    int SH, SKVH, SD, SWIN;
    int DFF;
    int RC, R, RK  ;
};
HD int cond_of(const Dims& d, int row) { return row < d.RC ? 0 : 1 + (row - d.RC) / d.N; }
HD float silu_f(float x) { return x / (1.f + expf(-x)); }
HD float sigm_f(float x) { return 1.f / (1.f + expf(-x)); }
HD float gelu_f(float x) { const float u = 0.7978845608028654f * (x + 0.044715f * x * x * x); return x / (1.f + expf(-2.f * u)); }

struct OpTranspose { const float* W; act_t* Wt; long K, N, NP, perm, DFF;
    HD void run(long g) const { const int n = (int)(g / K), k = (int)(g % K); float v = 0.f;
        if (n < N) { int sc = n; if (perm == 1) { const int un = n / 256, j = n % 256; sc = j < 128 ? un * 128 + j : DFF + un * 128 + (j - 128); } v = W[(size_t)k * N + sc]; }
        Wt[(size_t)n * K + k] = stf(v); } };
struct OpCvt { const float* src; act_t* dst; HD void run(long g) const { dst[g] = stf(src[g]); } };
struct OpMod { const float* c; const float* cctx; const float* w; const float* b; float* MOD; long D, NCI;
    HD void run(long g) const { const int N6 = 6 * D; const int n = (int)(g % N6); const int ci = (int)((g / N6) % NCI); const int l = (int)(g / ((long)N6 * NCI));
        const float* cond = ci == 0 ? cctx : c + (size_t)(ci - 1) * D; const float* wl = w + (size_t)l * D * N6; float acc = b[(size_t)l * N6 + n];
        for (int k = 0; k < D; ++k) acc += silu_f(cond[k]) * wl[(size_t)k * N6 + n];
        MOD[g] = acc; } };
struct OpNormMod { const float* xc; const float* xl;   const float* g; const float* mod;   long chunk;   act_t* H; Dims d;
    HD void run(long row) const { const int D = d.D; const float* x = row < d.RC ? xc + (size_t)row * D : xl + (size_t)(row - d.RC) * D;
        float ss = 0.f; for (int k = 0; k < D; ++k) ss += x[k] * x[k];
        const float rstd = 1.f / sqrtf(ss / D + 1e-6f); const float* m = mod + (size_t)cond_of(d, (int)row) * 6 * D + (size_t)chunk * D;
        for (int k = 0; k < D; ++k) H[(size_t)row * D + k] = stf(x[k] * rstd * g[k] * (1.f + m[D + k]) + m[k]); } };
struct OpResid { const float* xc; const float* xl; const float* T; const float* mod; long chunk; float* out; Dims d;
    HD void run(long g) const { const int D = d.D; const int row = (int)(g / D), c = (int)(g % D);
        const float x = row < d.RC ? xc[(size_t)row * D + c] : xl[(size_t)(row - d.RC) * D + c];
        out[g] = x + mod[(size_t)cond_of(d, row) * 6 * D + (size_t)chunk * D + c] * T[g]; } };
struct OpRope { float* cs; float* sn; long rot, GW;
    HD void run(long g) const { const int t = (int)(g / rot), li = (int)(g % rot); const int half = rot / 2, nf = half / 2; const int f = li % nf;
        const float pos = (li < half) ? (float)(t / GW) : (float)(t % GW);
        const float inv = exp2f(-(float)(2 * f) / (float)half * 13.287712379549449f); const float a = pos * inv;
        const float rev = a * 0.15915494309189535f; const float fr = rev - floorf(rev);
#ifdef __HIP_DEVICE_COMPILE__
        cs[g] = __builtin_amdgcn_cosf(fr); sn[g] = __builtin_amdgcn_sinf(fr);
#else
        cs[g] = cosf(fr * 6.283185307179586f); sn[g] = sinf(fr * 6.283185307179586f);
#endif
    } };
struct OpHeadPost { const act_t* sa; long pa; long sha, na; const act_t* sb; long pb; long shb, nb; const float* gain; act_t* dst; long pd; long shd; long NH; long rot; const float* cs; const float* sn; float* of; long norm; Dims d; long rows_lat_end;
    HD void run(long g) const { const int row = (int)(g / NH), h = (int)(g % NH); const int dh = na + nb;
        const act_t* pA = sa + (size_t)row * pa + (size_t)h * sha; const act_t* pB = sb ? sb + (size_t)row * pb + (size_t)h * shb : nullptr;
        float ss = 0.f; for (int k = 0; k < dh; ++k) { const float v = k < na ? ldf(pA[k]) : ldf(pB[k - na]); ss += v * v; }
        const float rstd = norm ? 1.f / sqrtf(ss / dh + 1e-6f) : 1.f;
        act_t* o = dst + (size_t)row * pd + (size_t)h * shd;
        const bool lat = rot > 0 && row >= d.RC && row < rows_lat_end; const int t = lat ? (row - d.RC) % d.N : 0; const int r0 = dh - rot, half = rot / 2, q4 = rot / 4;
        float* ofp = (of && row < d.RC) ? of + ((size_t)((row / d.S) * NH + h) * d.S + (row % d.S)) * dh : nullptr;
        for (int k = 0; k < dh; ++k) { float v = (k < na ? ldf(pA[k]) : ldf(pB[k - na])) * rstd * (norm ? gain[k] : 1.f);
            if (lat && k >= r0) { const int li = k - r0; const int w = li % half; if (w >= q4) continue;
                const int k2 = k + q4; const float v2 = (k2 < na ? ldf(pA[k2]) : ldf(pB[k2 - na])) * rstd * (norm ? gain[k2] : 1.f);
                const size_t tb = (size_t)t * rot + li;
                o[k] = stf(v * cs[tb] - v2 * sn[tb]); o[k2] = stf(v2 * cs[tb + q4] + v * sn[tb + q4]); continue; }
            if (ofp) ofp[k] = v;
            o[k] = stf(v); } } };

template <int DQK, int DV> struct OSM { float q[DQK]; float o[DV]; float m, l, scale;
    HD void init(const act_t* qp, float sc) { UNR for (int i = 0; i < DQK; ++i) q[i] = ldf(qp[i]); UNR for (int i = 0; i < DV; ++i) o[i] = 0.f; m = -1e30f; l = 0.f; scale = sc; }
    HD void key(const act_t* kp, const act_t* vp, float bias) { float s = 0.f; UNR for (int i = 0; i < DQK; ++i) s += q[i] * ldf(kp[i]); s = s * scale + bias;
        const float mn = s > m ? s : m; const float a = expf(m - mn), p = expf(s - mn); l = l * a + p; UNR for (int i = 0; i < DV; ++i) o[i] = o[i] * a + p * ldf(vp[i]); m = mn; }
    HD void sink(float sk) { const float mn = sk > m ? sk : m; const float a = expf(m - mn); l = l * a + expf(sk - mn); UNR for (int i = 0; i < DV; ++i) o[i] *= a; m = mn; }
    HD void fin(act_t* op) { const float r = 1.f / l; UNR for (int i = 0; i < DV; ++i) op[i] = stf(o[i] * r); } };

template <int DQK, int DV> struct OpAttnCtx { const act_t* Q; long pq; long shq; const act_t* K; long pk; long shk; const act_t* V; long pv; long shv; act_t* O; long po; long sho; long NH, G; const float* sinks; Dims d;
    HD void run(long g) const { const int t = (int)(g % d.S); const int h = (int)((g / d.S) % NH); const int b = (int)(g / ((long)d.S * NH)); const int kvh = h / G;
        OSM<DQK, DV> st; st.init(Q + (size_t)(b * d.S + t) * pq + (size_t)h * shq, 1.f / sqrtf((float)DQK));
        for (int j = 0; j < d.S; ++j) { const size_t r = (size_t)(b * d.S + j); st.key(K + r * pk + (size_t)kvh * shk, V + r * pv + (size_t)kvh * shv, 0.f); }
        if (sinks) st.sink(sinks[h]);
        st.fin(O + (size_t)(b * d.S + t) * po + (size_t)h * sho); } };
template <int DH> struct OpNatLat { const act_t* QKV; long pq; const act_t* CK; const act_t* CV; const float* rpb; act_t* O; long po; Dims d;
    HD void run(long g) const { const int t = (int)(g % d.N); const int h = (int)((g / d.N) % d.NAH); const int b = (int)(g / ((long)d.N * d.NAH));
        const int GW = d.GW, rows = d.N / GW; const int wr = rows < 8 ? rows : 8; const int r = t / GW, c = t % GW;
        int rs = r - wr / 2; rs = rs < 0 ? 0 : (rs > rows - wr ? rows - wr : rs); int cst = c - 8; cst = cst < 0 ? 0 : (cst > GW - 16 ? GW - 16 : cst);
        const size_t rb = (size_t)d.RC + (size_t)b * d.N; const int HD_ = d.NAH * DH;
        OSM<DH, DH> st; st.init(QKV + (rb + t) * pq + (size_t)h * DH, 1.f / sqrtf((float)DH));
        for (int j = 0; j < d.PAST; ++j) { const size_t o = ((size_t)(b * d.NAH + h) * d.PAST + j) * DH; st.key(CK + o, CV + o, 0.f); }
        for (int kr = rs; kr < rs + wr; ++kr) for (int kc = cst; kc < cst + 16; ++kc) { const size_t kt = rb + (size_t)kr * GW + kc;
            const float bias = rpb[((size_t)h * 15 + (kr - r + 7)) * 31 + (kc - c + 15)];
            st.key(QKV + kt * pq + HD_ + (size_t)h * DH, QKV + kt * pq + 2 * HD_ + (size_t)h * DH, bias); }
        st.fin(O + (rb + t) * po + (size_t)h * DH); } };
template <int DQK, int DV> struct OpMlaLat { const act_t* Q; const act_t* K; const act_t* KV; act_t* O; long po; Dims d;
    HD void run(long g) const { const int t = (int)(g % d.N); const int h = (int)((g / d.N) % d.MH); const int b = (int)(g / ((long)d.N * d.MH));
        const size_t rb = (size_t)d.RC + (size_t)b * d.N; const size_t pq = (size_t)d.MH * DQK, pkv = (size_t)d.MH * (d.MNOPE + DV);
        OSM<DQK, DV> st; st.init(Q + (rb + t) * pq + (size_t)h * DQK, 1.f / sqrtf((float)DQK));
        for (int j = 0; j < d.PAST; ++j) { const size_t r = (size_t)d.R + (size_t)b * d.PAST + j; st.key(K + r * pq + (size_t)h * DQK, KV + r * pkv + (size_t)h * (d.MNOPE + DV) + d.MNOPE, 0.f); }
        for (int j = 0; j < d.N; ++j) { const size_t r = rb + j; st.key(K + r * pq + (size_t)h * DQK, KV + r * pkv + (size_t)h * (d.MNOPE + DV) + d.MNOPE, 0.f); }
        st.fin(O + (rb + t) * po + (size_t)h * DV); } };
template <int DH> struct OpSwaLat { const act_t* QKV; long pq; const act_t* CK; const act_t* CV; const float* sinks; act_t* O; long po; Dims d;
    HD void run(long g) const { const int t = (int)(g % d.N); const int h = (int)((g / d.N) % d.SH); const int b = (int)(g / ((long)d.N * d.SH)); const int G = d.SH / d.SKVH, kvh = h / G;
        const size_t rb = (size_t)d.RC + (size_t)b * d.N;
        OSM<DH, DH> st; st.init(QKV + (rb + t) * pq + (size_t)h * DH, 1.f / sqrtf((float)DH));
        for (int j = 0; j < d.PAST; ++j) { const size_t o = ((size_t)(b * d.SKVH + kvh) * d.PAST + j) * DH; st.key(CK + o, CV + o, 0.f); }
        int lo = t - d.SWIN, hi = t + d.SWIN; lo = lo < 0 ? 0 : lo; hi = hi > d.N - 1 ? d.N - 1 : hi;
        for (int j = lo; j <= hi; ++j) { const size_t r = rb + j; st.key(QKV + r * pq + (size_t)(d.SH + kvh) * DH, QKV + r * pq + (size_t)(d.SH + d.SKVH + kvh) * DH, 0.f); }
        st.sink(sinks[h]);
        st.fin(O + (rb + t) * po + (size_t)h * DH); } };

struct OpLruConv { const act_t* XG; const float* cw; const float* cb; act_t* XC; Dims d;
    HD void run(long g) const { const int LW = d.LW; const int row = (int)(g / LW), c = (int)(g % LW);
        int s0, T; if (row < d.RC) { s0 = (row / d.S) * d.S; T = d.S; } else { s0 = d.RC + ((row - d.RC) / d.N) * d.N; T = d.N; } const int t = row - s0;
        float acc = cb[c]; for (int k = 0; k < 4; ++k) { const int tt = t + k - 2; if (tt >= 0 && tt < T) acc += cw[(size_t)k * LW + c] * ldf(XG[(size_t)(s0 + tt) * 2 * LW + c]); }
        XC[g] = stf(acc); } };
struct OpLruScan { const act_t* XC; const act_t* XG; const float* wa; const float* ba; const float* wi; const float* bi; const float* lam; const float* h0; act_t* HS; act_t* Y; float* state_out; Dims d;
    HD void step(int dir, size_t row, int c, int blk, int j, float sp, float& h) const { const int LW = d.LW, LBK = d.LBK;
        const act_t* xr = XC + row * LW + (size_t)blk * LBK; const float* Wa = wa + ((size_t)(dir * d.LB + blk) * LBK) * LBK + j; const float* Wi = wi + ((size_t)(dir * d.LB + blk) * LBK) * LBK + j;
        float ra = ba[(size_t)dir * LW + c], ri = bi[(size_t)dir * LW + c];
        for (int k = 0; k < LBK; ++k) { const float x = ldf(xr[k]); ra += x * Wa[(size_t)k * LBK]; ri += x * Wi[(size_t)k * LBK]; }
        const float r = sigm_f(ra), ig = sigm_f(ri); const float la = -8.f * r * sp; const float a = expf(la); const float om = -expm1f(2.f * la);
        h = a * h + sqrtf(om) * (ig * ldf(XC[row * LW + c])); }
    HD void run(long g) const { const int LW = d.LW; const int seq = (int)(g / LW), c = (int)(g % LW); const int blk = c / d.LBK, j = c % d.LBK;
        size_t s0; int T; float hf = 0.f, hb = 0.f;
        if (seq < d.B) { s0 = (size_t)seq * d.S; T = d.S; } else { const int b = seq - d.B; s0 = (size_t)d.RC + (size_t)b * d.N; T = d.N; hf = h0[((size_t)b * 2 + 0) * LW + c]; hb = h0[((size_t)b * 2 + 1) * LW + c]; }
        float spf, spb; { const float l0 = lam[c], l1 = lam[LW + c]; spf = log1pf(expf(-l0)); spb = log1pf(expf(-l1)); }
        for (int t = 0; t < T; ++t) { step(0, s0 + t, c, blk, j, spf, hf); HS[(s0 + t) * LW + c] = stf(hf); }
        for (int t = T - 1; t >= 0; --t) { step(1, s0 + t, c, blk, j, spb, hb); const size_t row = s0 + t; Y[row * LW + c] = stf(gelu_f(ldf(XG[row * 2 * LW + LW + c])) * (ldf(HS[row * LW + c]) + hb)); }
        if (seq < d.B) { state_out[((size_t)seq * 2 + 0) * LW + c] = hf; state_out[((size_t)seq * 2 + 1) * LW + c] = hb; } } };

struct OpMlaNorm { act_t* Dn; act_t* KR; const float* gqa; const float* gkva; const float* cckv; const float* ckr; float* o_ckv; float* o_kr; Dims d;
    HD void run(long row) const { act_t* p = Dn + (size_t)row * d.MDN; act_t* kr = KR + (size_t)row * d.MROPE;
        if (row >= d.R) { const size_t j = (size_t)(row - d.R); for (int k = 0; k < d.MKR; ++k) p[d.MQR + k] = stf(cckv[j * d.MKR + k]); for (int k = 0; k < d.MROPE; ++k) kr[k] = stf(ckr[j * d.MROPE + k]); return; }
        float ss = 0.f; for (int k = 0; k < d.MQR; ++k) { const float v = ldf(p[k]); ss += v * v; } float rs = 1.f / sqrtf(ss / d.MQR + 1e-6f);
        for (int k = 0; k < d.MQR; ++k) p[k] = stf(ldf(p[k]) * rs * gqa[k]);
        ss = 0.f; for (int k = 0; k < d.MKR; ++k) { const float v = ldf(p[d.MQR + k]); ss += v * v; } rs = 1.f / sqrtf(ss / d.MKR + 1e-6f);
        for (int k = 0; k < d.MKR; ++k) { const float v = ldf(p[d.MQR + k]) * rs * gkva[k]; p[d.MQR + k] = stf(v); if (row < d.RC) o_ckv[(size_t)row * d.MKR + k] = v; }
        for (int k = 0; k < d.MROPE; ++k) { const act_t v = p[d.MQR + d.MKR + k]; kr[k] = v; if (row < d.RC) o_kr[(size_t)row * d.MROPE + k] = ldf(v); } } };

struct OpFfnAct { const act_t* U; const float* cw; const float* cb; act_t* G; long row0; long nrows; Dims d;
    HD void run(long g) const { const int F = d.DFF; const int lr = (int)(g / F), c = (int)(g % F); const int row = row0 + lr;
        int s0, T; if (row < d.RC) { s0 = (row / d.S) * d.S; T = d.S; } else { s0 = d.RC + ((row - d.RC) / d.N) * d.N; T = d.N; } const int t = row - s0;
        float acc = cb[c]; for (int k = 0; k < 3; ++k) { const int tt = t + k - 1; if (tt >= 0 && tt < T) acc += cw[(size_t)k * F + c] * ldf(U[(size_t)(s0 + tt - row0) * 2 * F + c]); }
        G[(size_t)lr * F + c] = stf(silu_f(acc) * ldf(U[(size_t)lr * 2 * F + F + c])); } };
struct OpCopyV { const act_t* src; long ps; long sh; long NH, dh; float* of; Dims d;
    HD void run(long g) const { const int k = (int)(g % dh); const int h = (int)((g / dh) % NH); const int row = (int)(g / ((long)dh * NH));
        of[((size_t)((row / d.S) * NH + h) * d.S + (row % d.S)) * dh + k] = ldf(src[(size_t)row * ps + (size_t)h * sh + k]); } };

struct WS {
    float* MOD; float* ropeC; float* ropeS;
    act_t *Wffn_in[4], *Wffn_out[4], *Wnat_qkv, *Wnat_o, *Wlru_in, *Wlru_out, *Wmla_down, *Wmla_uq, *Wmla_ukv, *Wmla_o, *Wswa_qkv, *Wswa_o;
    act_t *natCK, *natCV, *swaCK, *swaCV;
    act_t* H;
    act_t* OB;
    float* T_mix[4]; float* T_ffn;
    act_t* QKV;
    act_t *XG, *XC, *HS, *Y;
    act_t *Dn, *KR, *Q, *KVr, *K;
    act_t *U, *G;
    int ffn_chunk_rows;
};
enum { I_xp = 0, I_xs, I_cnk, I_cnv, I_slru, I_cckv, I_ckr, I_csk, I_csv, I_c, I_cctx, I_nmix, I_nffn, I_wmod, I_bmod, I_fwin, I_fcw, I_fcb, I_fwout,
       I_nwqkv, I_nqn, I_nkn, I_nrpb, I_nwo, I_lwin, I_lcw, I_lcb, I_lwa, I_lba, I_lwi, I_lbi, I_llam, I_lwout, I_mwd, I_mqan, I_mkvan, I_mwuq, I_mwukv, I_mqn, I_mkn, I_mwo,
       I_swqkv, I_sqn, I_skn, I_ssink, I_swo, N_IN };
struct OutPtrs { float *yp, *ys, *nat_k, *nat_v, *lru, *ckv, *krope, *swa_k, *swa_v; };

#define LAS __attribute__((address_space(3)))
namespace mk {
typedef unsigned short bf16;
typedef short bf16x8 __attribute__((ext_vector_type(8)));
typedef short s16x4 __attribute__((ext_vector_type(4)));
typedef float f32x4 __attribute__((ext_vector_type(4)));
typedef float f32x16 __attribute__((ext_vector_type(16)));
typedef unsigned u32x4 __attribute__((ext_vector_type(4)));
typedef unsigned u32x2 __attribute__((ext_vector_type(2)));
constexpr int D = 2048, RC = 4096, NLAT = 4096, R = 36864, RK = 38912, DFF = 5632, NCI = 9, N6 = 12288, LW = 2688, LBK = 168;
constexpr int NQ = 2048, MDN = 1536, MQW = 3072, MKVW = 4096, SQW = 2560;
constexpr float LOG2E = 1.4426950408889634f;
constexpr size_t MiB = 1u << 20;
constexpr size_t WS_CTL = 0, WS_MOD = 1, WS_ROPEC = 3, WS_ROPES = 4, WS_NATCK = 5, WS_NATCV = 13, WS_SWACK = 21, WS_SWACV = 22, WS_WG = 1490, WS_WFFN = 26, WS_WNQKV = 290, WS_WNO = 314, WS_WLIN = 322, WS_WLOUT = 344,
    WS_WMD = 355, WS_WMUQ = 361, WS_WMUKV = 366, WS_WMO = 370, WS_WSQKV = 378, WS_WSO = 388, WS_H = 396, WS_S = 540;
constexpr size_t WS_QKV = 540, WS_XG = 540, WS_AGG = 918, WS_CARRY = 944, WS_Y = 1296, WS_DN = 540, WS_KR = 654, WS_Q = 659, WS_KVR = 875, WS_K = 1179, WS_G = 540, WS_SIDE = 936;
constexpr int CW_BAR = 4096;
constexpr int EPI_OFF = 131072, LDSCTL_OFF = 131072 + 12288, MISC_OFF = LDSCTL_OFF + 320, LDS_BYTES = 147456;

struct Fr { LAS unsigned char* lds; int tid, lane, wave, G, bid; };
__device__ __forceinline__ unsigned f2bf(float f) { unsigned u = __builtin_bit_cast(unsigned, f); return (u + 0x7fffu + ((u >> 16) & 1u)) >> 16; }
__device__ __forceinline__ unsigned pk2(float lo, float hi) { unsigned r; asm volatile("v_cvt_pk_bf16_f32 %0, %1, %2" : "=v"(r) : "v"(lo), "v"(hi)); return r; }
__device__ __forceinline__ float bf2f(unsigned short v) { return __builtin_bit_cast(float, ((unsigned)v) << 16); }
__device__ __forceinline__ float bflo(unsigned w) { return __builtin_bit_cast(float, w << 16); }
__device__ __forceinline__ float bfhi(unsigned w) { return __builtin_bit_cast(float, w & 0xffff0000u); }
__device__ __forceinline__ float wave_sum(float v) {
#pragma unroll
    for (int o = 1; o < 64; o <<= 1) v += __shfl_xor(v, o);
    return v; }
__device__ __forceinline__ float fexp2(float x) { return __builtin_amdgcn_exp2f(x); }
__device__ __forceinline__ float frcp(float x) { return __builtin_amdgcn_rcpf(x); }
__device__ __forceinline__ float sigm(float x) { return frcp(1.f + fexp2(-x * LOG2E)); }
__device__ __forceinline__ float siluf(float x) { return x * sigm(x); }
__device__ __forceinline__ float geluf(float x) { const float u = 0.7978845608028654f * (x + 0.044715f * x * x * x); return x * sigm(2.f * u); }
__device__ __forceinline__ void unpack8(const bf16x8& v, float (&f)[8]) { const u32x4 w = __builtin_bit_cast(u32x4, v);
    f[0] = bflo(w.x); f[1] = bfhi(w.x); f[2] = bflo(w.y); f[3] = bfhi(w.y); f[4] = bflo(w.z); f[5] = bfhi(w.z); f[6] = bflo(w.w); f[7] = bfhi(w.w); }
__device__ __forceinline__ bf16x8 pack8(const float (&f)[8]) { u32x4 w; w.x = pk2(f[0], f[1]); w.y = pk2(f[2], f[3]); w.z = pk2(f[4], f[5]); w.w = pk2(f[6], f[7]); return __builtin_bit_cast(bf16x8, w); }

#define XB_TMO      128
#define XB_XCNT(j)  (256  + 64 * (j))
#define XB_XSUB(j)  (1280 + 64 * (j))
#define XB_XGEN(j)  (2304 + 64 * (j))
#define XB_TOP      3328
#define XB_TOPGEN   3392
#define XCD_BAR_WORDS 3456
#define XB_SPIN_CAP (1u << 22)
__device__ __forceinline__ unsigned xb_ld(unsigned* p)              { return __hip_atomic_load(p, __ATOMIC_RELAXED, __HIP_MEMORY_SCOPE_AGENT); }
__device__ __forceinline__ unsigned xb_add(unsigned* p, unsigned v) { return __hip_atomic_fetch_add(p, v, __ATOMIC_RELAXED, __HIP_MEMORY_SCOPE_AGENT); }
__device__ __forceinline__ unsigned xb_xcc_id() { return (unsigned)__builtin_amdgcn_s_getreg((3 << 11) | 20) & 0xFu; }
#define XB_SPIN(cond, bar) do { unsigned _sp = 0; while (cond) { __builtin_amdgcn_s_sleep(1); \
    if ((++_sp & 255u) == 0u) { if (xb_ld(&(bar)[XB_TMO])) break; if (_sp > XB_SPIN_CAP) { atomicAdd(&(bar)[XB_TMO], 1u); break; } } } } while (0)
struct XcdBarrier { unsigned* bar; unsigned x; volatile LAS unsigned* st; };
__device__ __forceinline__ XcdBarrier xcd_barrier_post(unsigned* bar, volatile LAS unsigned* st) {
    XcdBarrier b; b.bar = bar; b.x = xb_xcc_id(); b.st = st;
    if (threadIdx.x == 0) (void)xb_add(&bar[XB_XCNT(b.x)], 1u);
    return b;
}
__device__ __forceinline__ void xcd_barrier_complete(unsigned* bar, unsigned x, unsigned& nloc, unsigned& nx) {
    const unsigned G = gridDim.x * gridDim.y * gridDim.z;
    unsigned sum, cnt, mine, sp = 0u;
    for (;;) {
        sum = 0u; cnt = 0u; mine = 0u;
#pragma unroll
        for (unsigned j = 0; j < 16; ++j) { const unsigned c = xb_ld(&bar[XB_XCNT(j)]); sum += c; cnt += (c > 0u) ? 1u : 0u; mine = (j == x) ? c : mine; }
        if (sum == G) break;
        __builtin_amdgcn_s_sleep(1);
        if ((++sp & 255u) == 0u) { if (xb_ld(&bar[XB_TMO])) break; if (sp > XB_SPIN_CAP) { atomicAdd(&bar[XB_TMO], 1u); break; } }
    }
    nloc = mine > 0u ? mine : 1u; nx = cnt > 0u ? cnt : 1u;
}
__device__ __forceinline__ void xcd_barrier(const XcdBarrier& b) {
    asm volatile("s_waitcnt vmcnt(0)" ::: "memory");
    __syncthreads();
    if (threadIdx.x == 0) {
        unsigned* bar = b.bar;
        __builtin_amdgcn_s_waitcnt(0);
        unsigned nloc = b.st[0], nx = b.st[1];
        if (nloc == 0u) { xcd_barrier_complete(bar, b.x, nloc, nx); b.st[0] = nloc; b.st[1] = nx; }
        const unsigned old = xb_add(&bar[XB_XSUB(b.x)], 1u);
        const unsigned gen = old / nloc;
        if (old + 1u == (gen + 1u) * nloc) {
            __builtin_amdgcn_fence(__ATOMIC_RELEASE, "agent");
            asm volatile("s_waitcnt vmcnt(0)" ::: "memory");
            const unsigned og = xb_add(&bar[XB_TOP], 1u);
            const unsigned tg = og / nx;
            if (og + 1u == (tg + 1u) * nx) xb_add(&bar[XB_TOPGEN], 1u);
            else XB_SPIN(xb_ld(&bar[XB_TOPGEN]) == tg, bar);
            __builtin_amdgcn_fence(__ATOMIC_ACQUIRE, "agent");
            xb_add(&bar[XB_XGEN(b.x)], 1u);
            asm volatile("s_waitcnt vmcnt(0)" ::: "memory");
        } else {
            XB_SPIN(xb_ld(&bar[XB_XGEN(b.x)]) == gen, bar);
            __builtin_amdgcn_fence(__ATOMIC_ACQUIRE, "agent");
            asm volatile("s_waitcnt vmcnt(0)" ::: "memory");
        }
    }
    __syncthreads();
}

__device__ __forceinline__ void tr_item(const float* W, int N, int k0, int n0, bf16* WT, int Kd, int drow0, LAS float* scr, int lane) {
#pragma unroll 8
    for (int i = 0; i < 32; ++i) { const int kk = 2 * i + (lane >> 5); scr[kk * 33 + (lane & 31)] = __builtin_nontemporal_load(&W[(size_t)(k0 + kk) * N + n0 + (lane & 31)]); }
    asm volatile("s_waitcnt lgkmcnt(0)" ::: "memory");
    const int c = lane & 7;
#pragma unroll
    for (int j = 0; j < 4; ++j) { const int n = (lane >> 3) + 8 * j; const LAS float* s = scr + (8 * c) * 33 + n;
        u32x4 o; o.x = pk2(s[0 * 33], s[1 * 33]); o.y = pk2(s[2 * 33], s[3 * 33]); o.z = pk2(s[4 * 33], s[5 * 33]); o.w = pk2(s[6 * 33], s[7 * 33]);
        *(u32x4*)(WT + (size_t)(drow0 + n) * Kd + k0 + 8 * c) = o; }
    asm volatile("s_waitcnt lgkmcnt(0)" ::: "memory");
}
__device__ __forceinline__ void tr_job(const Fr& F, const float* W, int K, int N, bf16* WT, int perm) {
    LAS float* scr = (LAS float*)(F.lds + F.wave * 16384);
    const int nblk = N / 32, items = (K / 64) * nblk; const int gw = F.bid * 8 + F.wave, NGW = F.G * 8;
    for (int it = gw; it < items; it += NGW) { const int kb = it / nblk, nb = it % nblk, n0 = 32 * nb; int dr = n0;
        if (perm) { const int half = n0 >= DFF; const int c = half ? n0 - DFF : n0; dr = 256 * (c >> 7) + 128 * half + (c & 127); }
        tr_item(W, N, 64 * kb, n0, WT, K, dr, scr, F.lane); }
}
#ifndef DEFER_W
#define DEFER_W 1
#endif
__device__ __forceinline__ void tr_layer(const Fr& F, const float* const* in, unsigned char* ws, int l, int part) {
    if (part == 1) { tr_job(F, in[I_fwin] + (size_t)l * D * 2 * DFF, D, 2 * DFF, (bf16*)(ws + (WS_WFFN + 66 * l) * MiB), 1); tr_job(F, in[I_fwout] + (size_t)l * DFF * D, DFF, D, (bf16*)(ws + (WS_WFFN + 66 * l + 44) * MiB), 0); return; }
    if (l == 0) { tr_job(F, in[I_nwqkv], D, 3 * NQ, (bf16*)(ws + WS_WNQKV * MiB), 0); tr_job(F, in[I_nwo], NQ, D, (bf16*)(ws + WS_WNO * MiB), 0); }
    else if (l == 1) { tr_job(F, in[I_lwin], D, 2 * LW, (bf16*)(ws + WS_WLIN * MiB), 0); tr_job(F, in[I_lwout], LW, D, (bf16*)(ws + WS_WLOUT * MiB), 0); }
    else if (l == 2) { tr_job(F, in[I_mwd], D, 1344, (bf16*)(ws + WS_WMD * MiB), 0); tr_job(F, in[I_mwuq], 768, MQW, (bf16*)(ws + WS_WMUQ * MiB), 0); tr_job(F, in[I_mwukv], 512, MKVW, (bf16*)(ws + WS_WMUKV * MiB), 0); tr_job(F, in[I_mwo], 2048, D, (bf16*)(ws + WS_WMO * MiB), 0);
        unsigned* z = (unsigned*)((bf16*)(ws + WS_WMD * MiB) + (size_t)1344 * D); for (int i = F.bid * 512 + F.tid; i < 192 * D / 2; i += F.G * 512) z[i] = 0u; }
    else { tr_job(F, in[I_swqkv], D, SQW, (bf16*)(ws + WS_WSQKV * MiB), 0); tr_job(F, in[I_swo], 2048, D, (bf16*)(ws + WS_WSO * MiB), 0); }
}
__device__ __forceinline__ void tr_layer_idle(const Fr& F, const float* const* in, unsigned char* ws, int l, int part) {
    const int busy = 1152 % F.G; if (busy == 0 || F.bid < busy) return;
    Fr F2 = F; F2.bid = F.bid - busy; F2.G = F.G - busy; tr_layer(F2, in, ws, l, part);
}
struct ProArgs { const float* const* in; unsigned char* ws; };
__device__ __forceinline__ void ph_prologue(const Fr& F, const float* const* in, unsigned char* ws) {
    const int gt = F.bid * 512 + F.tid, NGT = F.G * 512;
    for (int j = F.bid; j < 256; j += F.G) {
        const int l = j >> 6, n0 = (j & 63) * 192; LAS float* S = (LAS float*)F.lds; LAS float* red = (LAS float*)(F.lds + 73728);
        for (int i = F.tid; i < NCI * D; i += 512) { const int ci = i / D, k = i % D; const float v = ci == 0 ? in[I_cctx][k] : in[I_c][(size_t)(ci - 1) * D + k]; S[i] = siluf(v); }
        __syncthreads();
        float acc[3][NCI];
#pragma unroll
        for (int g = 0; g < 3; ++g)
#pragma unroll
            for (int c = 0; c < NCI; ++c) acc[g][c] = 0.f;
        const float* wl = in[I_wmod] + (size_t)l * D * N6 + n0 + F.lane;
#pragma unroll 4
        for (int k = F.wave * 256; k < F.wave * 256 + 256; ++k) { const float w0 = __builtin_nontemporal_load(&wl[(size_t)k * N6]), w1 = __builtin_nontemporal_load(&wl[(size_t)k * N6 + 64]), w2 = __builtin_nontemporal_load(&wl[(size_t)k * N6 + 128]);
#pragma unroll
            for (int c = 0; c < NCI; ++c) { const float s = S[c * D + k]; acc[0][c] += s * w0; acc[1][c] += s * w1; acc[2][c] += s * w2; } }
#pragma unroll
        for (int g = 0; g < 3; ++g)
#pragma unroll
            for (int c = 0; c < NCI; ++c) red[((F.wave * 3 + g) * NCI + c) * 64 + F.lane] = acc[g][c];
        __syncthreads();
        float* MOD = (float*)(ws + WS_MOD * MiB);
        for (int o = F.tid; o < 192 * NCI; o += 512) { const int ci = o / 192, nl = o % 192, g = nl >> 6, ln = nl & 63; float s = in[I_bmod][(size_t)l * N6 + n0 + nl];
#pragma unroll
            for (int w = 0; w < 8; ++w) s += red[((w * 3 + g) * NCI + ci) * 64 + ln];
            MOD[((size_t)l * NCI + ci) * N6 + n0 + nl] = s; }
        __syncthreads();
    }
    tr_layer(F, in, ws, 0, 0); tr_layer(F, in, ws, 0, 1);
    if (!DEFER_W) for (int l = 1; l < 4; ++l) { tr_layer(F, in, ws, l, 0); tr_layer(F, in, ws, l, 1); }
    { bf16* Wg = (bf16*)(ws + WS_WG * MiB); constexpr int TOT = 2 * 2 * 16 * 192 * 192;
      for (int i0 = gt; i0 < TOT; i0 += 6 * NGT) { float v[6];
#pragma unroll
          for (int u = 0; u < 6; ++u) { const int i = i0 + u * NGT; v[u] = 0.f;
              if (i < TOT) { const int k = i % 192, j = (i / 192) % 192, blk = (i / 36864) % 16, mat = (i / 589824) % 2, dir = i / 1179648;
                  if (j < 168 && k < 168) v[u] = (mat == 0 ? in[I_lwa] : in[I_lwi])[(((size_t)dir * 16 + blk) * 168 + k) * 168 + j]; } }
#pragma unroll
          for (int u = 0; u < 6; ++u) { const int i = i0 + u * NGT; if (i < TOT) Wg[i] = (bf16)f2bf(v[u]); } } }
    { typedef float f4v __attribute__((ext_vector_type(4)));
      bf16* a = (bf16*)(ws + WS_NATCK * MiB); bf16* b = (bf16*)(ws + WS_NATCV * MiB); const f4v* ia = (const f4v*)in[I_cnk]; const f4v* ib = (const f4v*)in[I_cnv];
      for (int i = gt; i < 8 * 16 * 256 * 128 / 8; i += NGT) { const f4v a0 = ia[2 * i], a1 = ia[2 * i + 1], b0 = ib[2 * i], b1 = ib[2 * i + 1];
          const float xa[8] = {a0.x, a0.y, a0.z, a0.w, a1.x, a1.y, a1.z, a1.w}, xb[8] = {b0.x, b0.y, b0.z, b0.w, b1.x, b1.y, b1.z, b1.w};
          *(bf16x8*)(a + 8 * (size_t)i) = pack8(xa); *(bf16x8*)(b + 8 * (size_t)i) = pack8(xb); }
      bf16* c = (bf16*)(ws + WS_SWACK * MiB); bf16* d = (bf16*)(ws + WS_SWACV * MiB); const f4v* ic = (const f4v*)in[I_csk]; const f4v* id = (const f4v*)in[I_csv];
      for (int i = gt; i < 8 * 4 * 256 * 64 / 8; i += NGT) { const f4v a0 = ic[2 * i], a1 = ic[2 * i + 1], b0 = id[2 * i], b1 = id[2 * i + 1];
          const float xa[8] = {a0.x, a0.y, a0.z, a0.w, a1.x, a1.y, a1.z, a1.w}, xb[8] = {b0.x, b0.y, b0.z, b0.w, b1.x, b1.y, b1.z, b1.w};
          *(bf16x8*)(c + 8 * (size_t)i) = pack8(xa); *(bf16x8*)(d + 8 * (size_t)i) = pack8(xb); } }
    { float* cs = (float*)(ws + WS_ROPEC * MiB); float* sn = (float*)(ws + WS_ROPES * MiB);
      for (int i = gt; i < NLAT * 64; i += NGT) { const int t = i >> 6, li = i & 63, f = li & 15; const float pos = li < 32 ? (float)(t >> 6) : (float)(t & 63);
          const float inv = fexp2(-(float)f * 0.8304820237218406f); const float rev = pos * inv * 0.15915494309189535f; const float fr = rev - floorf(rev);
          cs[i] = __builtin_amdgcn_cosf(fr); sn[i] = __builtin_amdgcn_sinf(fr); } }
}

__device__ __forceinline__ void ph_norm(const Fr& F, const float* xc, const float* xl, const float* g, const float* mod, int chunk, bf16* H) {
    const int gw = F.bid * 8 + F.wave, NGW = F.G * 8;
    for (int row0 = gw; row0 < R; row0 += 2 * NGW) {
        const int row1 = row0 + NGW; const bool has1 = row1 < R; const int r1 = has1 ? row1 : row0;
        const float* x0 = (row0 < RC ? xc + (size_t)row0 * D : xl + (size_t)(row0 - RC) * D) + 4 * F.lane; const float* x1 = (r1 < RC ? xc + (size_t)r1 * D : xl + (size_t)(r1 - RC) * D) + 4 * F.lane;
        f32x4 v0[8], v1[8]; float s0 = 0.f, s1 = 0.f;
#pragma unroll
        for (int j = 0; j < 8; ++j) { v0[j] = *(const f32x4*)(x0 + 256 * j); v1[j] = *(const f32x4*)(x1 + 256 * j); }
#pragma unroll
        for (int j = 0; j < 8; ++j) { s0 += (v0[j].x * v0[j].x + v0[j].y * v0[j].y) + (v0[j].z * v0[j].z + v0[j].w * v0[j].w); s1 += (v1[j].x * v1[j].x + v1[j].y * v1[j].y) + (v1[j].z * v1[j].z + v1[j].w * v1[j].w); }
#pragma unroll
        for (int o = 1; o < 64; o <<= 1) { s0 += __shfl_xor(s0, o); s1 += __shfl_xor(s1, o); }
        const float rs0 = 1.f / sqrtf(s0 * (1.f / D) + 1e-6f), rs1 = 1.f / sqrtf(s1 * (1.f / D) + 1e-6f);
        const int c0 = row0 < RC ? 0 : 1 + ((row0 - RC) >> 12), c1 = r1 < RC ? 0 : 1 + ((r1 - RC) >> 12);
        const float* m0 = mod + (size_t)c0 * N6 + (size_t)chunk * D + 4 * F.lane; const float* m1 = mod + (size_t)c1 * N6 + (size_t)chunk * D + 4 * F.lane; const float* gp = g + 4 * F.lane;
        bf16* o0 = H + (size_t)row0 * D + 4 * F.lane; bf16* o1 = H + (size_t)r1 * D + 4 * F.lane;
#pragma unroll
        for (int j = 0; j < 8; ++j) { const f32x4 gv = *(const f32x4*)(gp + 256 * j);
            { const f32x4 sh = *(const f32x4*)(m0 + 256 * j), sc = *(const f32x4*)(m0 + D + 256 * j); const f32x4 h = v0[j] * rs0 * gv * (sc + 1.f) + sh; u32x2 w; w.x = pk2(h.x, h.y); w.y = pk2(h.z, h.w); *(u32x2*)(o0 + 256 * j) = w; }
            if (has1) { const f32x4 sh = *(const f32x4*)(m1 + 256 * j), sc = *(const f32x4*)(m1 + D + 256 * j); const f32x4 h = v1[j] * rs1 * gv * (sc + 1.f) + sh; u32x2 w; w.x = pk2(h.x, h.y); w.y = pk2(h.z, h.w); *(u32x2*)(o1 + 256 * j) = w; } }
    }
}
template <bool F32IN> __device__ __forceinline__ void ph_norm_rows(const Fr& F, const bf16* XB, const float* xc, const float* xl, const float* g, const float* mod, int chunk, bf16* H) {
    const int gw = F.bid * 8 + F.wave, NGW = F.G * 8; const int per = (R + NGW - 1) / NGW; const int rbeg = gw * per, rend = rbeg + per < R ? rbeg + per : R;
    float A[4][8], Bv[4][8]; int ccur = -1;
    for (int row0 = rbeg; row0 < rend; row0 += 2) {
        const int row1 = row0 + 1; const bool has1 = row1 < rend; const int r1 = has1 ? row1 : row0;
        bf16x8 a0[4], a1[4]; f32x4 f0[4][2], f1[4][2];
        if constexpr (F32IN) { const float* x0 = (row0 < RC ? xc + (size_t)row0 * D : xl + (size_t)(row0 - RC) * D) + 8 * F.lane; const float* x1 = (r1 < RC ? xc + (size_t)r1 * D : xl + (size_t)(r1 - RC) * D) + 8 * F.lane;
#pragma unroll
            for (int j = 0; j < 4; ++j) { f0[j][0] = __builtin_nontemporal_load((const f32x4*)(x0 + 512 * j)); f0[j][1] = __builtin_nontemporal_load((const f32x4*)(x0 + 512 * j + 4)); f1[j][0] = __builtin_nontemporal_load((const f32x4*)(x1 + 512 * j)); f1[j][1] = __builtin_nontemporal_load((const f32x4*)(x1 + 512 * j + 4)); }
        } else { const bf16* x0 = XB + (size_t)row0 * D + 8 * F.lane; const bf16* x1 = XB + (size_t)r1 * D + 8 * F.lane;
#pragma unroll
            for (int j = 0; j < 4; ++j) { a0[j] = __builtin_nontemporal_load((const bf16x8*)(x0 + 512 * j)); a1[j] = __builtin_nontemporal_load((const bf16x8*)(x1 + 512 * j)); } }
        const int c0 = row0 < RC ? 0 : 1 + ((row0 - RC) >> 12), c1 = r1 < RC ? 0 : 1 + ((r1 - RC) >> 12);
#define NORM16_PARAMS(ci) do { const float* mp = mod + (size_t)(ci) * N6 + (size_t)chunk * D + 8 * F.lane; const float* gp = g + 8 * F.lane; \
_Pragma("unroll") \
            for (int j = 0; j < 4; ++j) { const f32x4 ga = *(const f32x4*)(gp + 512 * j), gb = *(const f32x4*)(gp + 512 * j + 4), sa = *(const f32x4*)(mp + 512 * j), sb = *(const f32x4*)(mp + 512 * j + 4), \
                    ca = *(const f32x4*)(mp + D + 512 * j), cb = *(const f32x4*)(mp + D + 512 * j + 4); \
                A[j][0] = ga.x * (ca.x + 1.f); A[j][1] = ga.y * (ca.y + 1.f); A[j][2] = ga.z * (ca.z + 1.f); A[j][3] = ga.w * (ca.w + 1.f); A[j][4] = gb.x * (cb.x + 1.f); A[j][5] = gb.y * (cb.y + 1.f); A[j][6] = gb.z * (cb.z + 1.f); A[j][7] = gb.w * (cb.w + 1.f); \
                Bv[j][0] = sa.x; Bv[j][1] = sa.y; Bv[j][2] = sa.z; Bv[j][3] = sa.w; Bv[j][4] = sb.x; Bv[j][5] = sb.y; Bv[j][6] = sb.z; Bv[j][7] = sb.w; } ccur = (ci); } while (0)
        if (c0 != ccur) NORM16_PARAMS(c0);
        float v0[4][8], v1[4][8]; float s0 = 0.f, s1 = 0.f;
#pragma unroll
        for (int j = 0; j < 4; ++j) {
            if constexpr (F32IN) {
#pragma unroll
                for (int e = 0; e < 8; ++e) { v0[j][e] = f0[j][e >> 2][e & 3]; v1[j][e] = f1[j][e >> 2][e & 3]; }
            } else { unpack8(a0[j], v0[j]); unpack8(a1[j], v1[j]); }
#pragma unroll
            for (int e = 0; e < 8; ++e) { s0 += v0[j][e] * v0[j][e]; s1 += v1[j][e] * v1[j][e]; } }
#pragma unroll
        for (int o = 1; o < 64; o <<= 1) { s0 += __shfl_xor(s0, o); s1 += __shfl_xor(s1, o); }
        const float rs0 = 1.f / sqrtf(s0 * (1.f / D) + 1e-6f), rs1 = 1.f / sqrtf(s1 * (1.f / D) + 1e-6f);
        bf16* o0 = H + (size_t)row0 * D + 8 * F.lane; bf16* o1 = H + (size_t)r1 * D + 8 * F.lane;
#pragma unroll
        for (int j = 0; j < 4; ++j) { float h[8];
#pragma unroll
            for (int e = 0; e < 8; ++e) h[e] = v0[j][e] * rs0 * A[j][e] + Bv[j][e];
            *(bf16x8*)(o0 + 512 * j) = pack8(h); }
        if (has1) {
            if (c1 != ccur) NORM16_PARAMS(c1);
#pragma unroll
            for (int j = 0; j < 4; ++j) { float h[8];
#pragma unroll
                for (int e = 0; e < 8; ++e) h[e] = v1[j][e] * rs1 * A[j][e] + Bv[j][e];
                *(bf16x8*)(o1 + 512 * j) = pack8(h); } }
#undef NORM16_PARAMS
    }
}
__device__ __forceinline__ void ph_norm16(const Fr& F, const bf16* XB, const float* g, const float* mod, int chunk, bf16* H) { ph_norm_rows<false>(F, XB, nullptr, nullptr, g, mod, chunk, H); }
__device__ __forceinline__ void ph_norm32(const Fr& F, const float* xc, const float* xl, const float* g, const float* mod, int chunk, bf16* H) { ph_norm_rows<true>(F, nullptr, xc, xl, g, mod, chunk, H); }
}

namespace pg8 {
struct EpiResid {
    static constexpr bool PERM = false, AFTER_DRAIN = false;
    const float* xc; const float* xl; float* out; const float* gate;
    __device__ __forceinline__ void operator()(const f32x4 (&acc)[2][2][4][2], const Unit& u, int wr, int wc, int fr, int fq) const {
        const int ci = u.pm < 16 ? 0 : 1 + ((u.pm - 16) >> 4); const int row0 = u.pm * BM + wr * 64 + fr, col0 = u.pn * BM + wc * 32 + 4 * fq;
        const float* gp = gate + (size_t)ci * 12288 + col0; f32x4 gv[2][2];
#pragma unroll
        for (int bj = 0; bj < 2; ++bj)
#pragma unroll
            for (int n = 0; n < 2; ++n) gv[bj][n] = *(const f32x4*)(gp + bj * HALF + n * 16);
#pragma unroll
        for (int ai = 0; ai < 2; ++ai) {
            f32x4 xv[4][2][2];
#pragma unroll
            for (int m = 0; m < 4; ++m) { const int row = row0 + ai * HALF + m * 16; const float* xr = (row < 4096 ? xc + (size_t)row * 2048 : xl + (size_t)(row - 4096) * 2048) + col0;
#pragma unroll
                for (int bj = 0; bj < 2; ++bj)
#pragma unroll
                    for (int n = 0; n < 2; ++n) xv[m][bj][n] = *(const f32x4*)(xr + bj * HALF + n * 16); }
            asm volatile("" ::: "memory");
#pragma unroll
            for (int m = 0; m < 4; ++m) { const int row = row0 + ai * HALF + m * 16; float* orow = out + (size_t)row * 2048 + col0;
#pragma unroll
                for (int bj = 0; bj < 2; ++bj)
#pragma unroll
                    for (int n = 0; n < 2; ++n) *(f32x4*)(orow + bj * HALF + n * 16) = xv[m][bj][n] + gv[bj][n] * acc[ai][bj][m][n]; }
            asm volatile("" ::: "memory");
        }
    }
};

template <bool IN16, bool OUT16> struct EpiResidB {
    static constexpr bool PERM = true, AFTER_DRAIN = false;
    const void* xc; const void* xl; void* out; const float* gate;
    __device__ __forceinline__ void operator()(const f32x4 (&acc)[2][2][4][2], const Unit& u, int wr, int wc, int fr, int fq) const {
        const int ci = u.pm < 16 ? 0 : 1 + ((u.pm - 16) >> 4); const int row0 = u.pm * BM + wr * 64 + fr, col0 = u.pn * BM + wc * 32 + 8 * fq;
        const float* gp = gate + (size_t)ci * 12288 + col0; f32x4 gv[2][2];
#pragma unroll
        for (int bj = 0; bj < 2; ++bj)
#pragma unroll
            for (int n = 0; n < 2; ++n) gv[bj][n] = *(const f32x4*)(gp + bj * HALF + 4 * n);
#pragma unroll
        for (int ai = 0; ai < 2; ++ai) {
            mk::bf16x8 xb[4][2]; f32x4 xf[4][2][2];
#pragma unroll
            for (int m = 0; m < 4; ++m) { const int row = row0 + ai * HALF + m * 16; const size_t off = (size_t)(row < 4096 ? row : row - 4096) * 2048 + col0;
#pragma unroll
                for (int bj = 0; bj < 2; ++bj) {
                    if (IN16) xb[m][bj] = __builtin_nontemporal_load((const mk::bf16x8*)((const mk::bf16*)(row < 4096 ? xc : xl) + off + bj * HALF));
                    else { const float* p = (const float*)(row < 4096 ? xc : xl) + off + bj * HALF; xf[m][bj][0] = __builtin_nontemporal_load((const f32x4*)p); xf[m][bj][1] = __builtin_nontemporal_load((const f32x4*)(p + 4)); } } }
            asm volatile("" ::: "memory");
#pragma unroll
            for (int m = 0; m < 4; ++m) { const int row = row0 + ai * HALF + m * 16;
#pragma unroll
                for (int bj = 0; bj < 2; ++bj) { float x[8];
                    if (IN16) mk::unpack8(xb[m][bj], x); else { x[0] = xf[m][bj][0].x; x[1] = xf[m][bj][0].y; x[2] = xf[m][bj][0].z; x[3] = xf[m][bj][0].w; x[4] = xf[m][bj][1].x; x[5] = xf[m][bj][1].y; x[6] = xf[m][bj][1].z; x[7] = xf[m][bj][1].w; }
#pragma unroll
                    for (int e = 0; e < 8; ++e) x[e] += gv[bj][e >> 2][e & 3] * acc[ai][bj][m][e >> 2][e & 3];
                    if (OUT16) *(mk::bf16x8*)((mk::bf16*)out + (size_t)row * 2048 + col0 + bj * HALF) = mk::pack8(x);
                    else { float* o = (float*)out + (size_t)row * 2048 + col0 + bj * HALF; __builtin_nontemporal_store((f32x4){x[0], x[1], x[2], x[3]}, (f32x4*)o); __builtin_nontemporal_store((f32x4){x[4], x[5], x[6], x[7]}, (f32x4*)(o + 4)); } } }
            asm volatile("" ::: "memory");
        }
    }
};
}

#ifndef QFUSE
#define QFUSE 1
#endif
namespace mk {
struct HeadPost { const bf16* sa; long pa; int sha, na; const bf16* sb; long pb; int shb, nb; const float* gain; bf16* dst; long pd; int shd, NH, rot; const float* cs; const float* sn; float* of; int lat_end; };
template <int GS>
__device__ __forceinline__ void ph_headpost(const Fr& F, const HeadPost& P, int nitems) {
    constexpr int NB = 4, IPW = 64 / GS;
    const int i = F.lane & (GS - 1), e0 = 8 * i, dh = P.na + P.nb; const bool act_l = e0 < dh; const int r0 = dh - P.rot;
    const int gw2 = (F.bid * 8 + F.wave) * IPW + F.lane / GS, step = F.G * 8 * IPW;
    float gn[8];
    { const int ec = act_l ? e0 : 0; const f32x4 g0 = *(const f32x4*)(P.gain + ec), g1 = *(const f32x4*)(P.gain + ec + 4); gn[0] = g0.x; gn[1] = g0.y; gn[2] = g0.z; gn[3] = g0.w; gn[4] = g1.x; gn[5] = g1.y; gn[6] = g1.z; gn[7] = g1.w; }
    const float inv_dh = 1.f / (float)dh; const int nhs = 31 - __builtin_clz(P.NH);
    const int ntrip = (nitems + step * NB - 1) / (step * NB);
    for (int tr = 0; tr < ntrip; ++tr) { const int it0 = gw2 + tr * step * NB;
        bf16x8 raw[NB]; int rows[NB], hs[NB]; bool acts[NB];
#pragma unroll
        for (int b = 0; b < NB; ++b) { const int item = it0 + b * step; acts[b] = act_l && item < nitems; const int itc = item < nitems ? item : nitems - 1; rows[b] = itc >> nhs; hs[b] = itc & (P.NH - 1);
            raw[b] = (bf16x8){0, 0, 0, 0, 0, 0, 0, 0};
            if (acts[b]) raw[b] = __builtin_nontemporal_load((e0 < P.na) ? (const bf16x8*)(P.sa + (size_t)rows[b] * P.pa + (size_t)hs[b] * P.sha + e0) : (const bf16x8*)(P.sb + (size_t)rows[b] * P.pb + (size_t)hs[b] * P.shb + (e0 - P.na))); }
#pragma unroll
        for (int b = 0; b < NB; ++b) { const int row = rows[b], h = hs[b]; const bool act = acts[b];
            float v[8]; unpack8(raw[b], v);
            float ss = 0.f;
#pragma unroll
            for (int j = 0; j < 8; ++j) ss += v[j] * v[j];
#pragma unroll
            for (int o = 1; o < GS; o <<= 1) ss += __shfl_xor(ss, o);
            const float rstd = 1.f / sqrtf(ss * inv_dh + 1e-6f);
#pragma unroll
            for (int j = 0; j < 8; ++j) v[j] *= rstd * gn[j];
            if (P.of && act && row < RC) { float* op = P.of + ((size_t)((row >> 8) * P.NH + h) * 256 + (row & 255)) * dh + e0;
                *(f32x4*)op = (f32x4){v[0], v[1], v[2], v[3]}; *(f32x4*)(op + 4) = (f32x4){v[4], v[5], v[6], v[7]}; }
            if (P.rot) {
                float pv[8];
#pragma unroll
                for (int j = 0; j < 8; ++j) pv[j] = __shfl_xor(v[j], 2);
                const bool lat = row >= RC && row < P.lat_end;
                if (lat && act && e0 >= r0) { const int li0 = e0 - r0; const bool first = (li0 & 31) < 16; const int t = (row - RC) & (NLAT - 1);
                    const float* cp = P.cs + (size_t)t * 64 + li0; const float* sp = P.sn + (size_t)t * 64 + li0;
                    const f32x4 c0 = *(const f32x4*)cp, c1 = *(const f32x4*)(cp + 4), s0 = *(const f32x4*)sp, s1 = *(const f32x4*)(sp + 4);
                    const float cc[8] = {c0.x, c0.y, c0.z, c0.w, c1.x, c1.y, c1.z, c1.w}, sv[8] = {s0.x, s0.y, s0.z, s0.w, s1.x, s1.y, s1.z, s1.w};
#pragma unroll
                    for (int j = 0; j < 8; ++j) v[j] = v[j] * cc[j] + (first ? -pv[j] : pv[j]) * sv[j]; }
            }
            if (act) *(bf16x8*)(P.dst + (size_t)row * P.pd + (size_t)h * P.shd + e0) = pack8(v);
        }
    }
}
__device__ __forceinline__ void ph_copyv(const Fr& F, const bf16* src, long ps, int sh, int NH, int dh, float* of) {
    const int per = dh / 8, ps_ = 31 - __builtin_clz(per), nhs = 31 - __builtin_clz(NH); const int n = RC * NH * per;
    for (int g = F.bid * 512 + F.tid; g < n; g += F.G * 512) { const int c8 = g & (per - 1); const int h = (g >> ps_) & (NH - 1); const int row = g >> (ps_ + nhs);
        float v[8]; unpack8(*(const bf16x8*)(src + (size_t)row * ps + (size_t)h * sh + 8 * c8), v);
        float* op = of + ((size_t)((row >> 8) * NH + h) * 256 + (row & 255)) * dh + 8 * c8; *(f32x4*)op = (f32x4){v[0], v[1], v[2], v[3]}; *(f32x4*)(op + 4) = (f32x4){v[4], v[5], v[6], v[7]}; }
}
__device__ __forceinline__ void ph_mlanorm(const Fr& F, bf16* Dn, bf16* KR, const float* gqa, const float* gkva, const float* cckv, const float* ckr, float* o_ckv, float* o_kr) {
    const int gw = F.bid * 8 + F.wave, NGW = F.G * 8, lane = F.lane;
    f32x4 gq[3]; float gg[8];
#pragma unroll
    for (int j = 0; j < 3; ++j) gq[j] = *(const f32x4*)(gqa + 4 * lane + 256 * j);
    { const f32x4 g0 = *(const f32x4*)(gkva + 8 * lane), g1 = *(const f32x4*)(gkva + 8 * lane + 4); gg[0] = g0.x; gg[1] = g0.y; gg[2] = g0.z; gg[3] = g0.w; gg[4] = g1.x; gg[5] = g1.y; gg[6] = g1.z; gg[7] = g1.w; }
    for (int row0 = gw; row0 < RK; row0 += 2 * NGW) {
        u32x2 qw[2][3]; bf16x8 kvw[2], krw[2]; int rows[2]; bool on[2];
#pragma unroll
        for (int s = 0; s < 2; ++s) { const int row = row0 + s * NGW; rows[s] = row; on[s] = row < R; krw[s] = (bf16x8){0, 0, 0, 0, 0, 0, 0, 0};
            if (on[s]) { const bf16* p = Dn + (size_t)row * MDN;
#pragma unroll
                for (int j = 0; j < 3; ++j) qw[s][j] = *(const u32x2*)(p + 4 * lane + 256 * j);
                kvw[s] = *(const bf16x8*)(p + 768 + 8 * lane); if (lane < 8) krw[s] = *(const bf16x8*)(p + 1280 + 8 * lane); } }
#pragma unroll
        for (int s = 0; s < 2; ++s) { const int row = rows[s]; if (row >= RK) continue;
            bf16* p = Dn + (size_t)row * MDN;
            if (!on[s]) { const size_t j = (size_t)(row - R); const f32x4 a = *(const f32x4*)(cckv + j * 512 + 8 * lane), b = *(const f32x4*)(cckv + j * 512 + 8 * lane + 4);
                const float v[8] = {a.x, a.y, a.z, a.w, b.x, b.y, b.z, b.w}; *(bf16x8*)(p + 768 + 8 * lane) = pack8(v);
                if (lane < 8) { const f32x4 c = *(const f32x4*)(ckr + j * 64 + 8 * lane), d = *(const f32x4*)(ckr + j * 64 + 8 * lane + 4); const float w[8] = {c.x, c.y, c.z, c.w, d.x, d.y, d.z, d.w}; *(bf16x8*)(KR + (size_t)row * 64 + 8 * lane) = pack8(w); }
                continue; }
            float q[12]; float ss = 0.f;
#pragma unroll
            for (int j = 0; j < 3; ++j) { const u32x2 w = qw[s][j]; q[4 * j] = bflo(w.x); q[4 * j + 1] = bfhi(w.x); q[4 * j + 2] = bflo(w.y); q[4 * j + 3] = bfhi(w.y); }
#pragma unroll
            for (int j = 0; j < 12; ++j) ss += q[j] * q[j];
            ss = wave_sum(ss); float rs = 1.f / sqrtf(ss * (1.f / 768.f) + 1e-6f);
#pragma unroll
            for (int j = 0; j < 3; ++j) { const f32x4 g = gq[j]; u32x2 w; w.x = pk2(q[4 * j] * rs * g.x, q[4 * j + 1] * rs * g.y); w.y = pk2(q[4 * j + 2] * rs * g.z, q[4 * j + 3] * rs * g.w); *(u32x2*)(p + 4 * lane + 256 * j) = w; }
            float kv[8]; unpack8(kvw[s], kv); ss = 0.f;
#pragma unroll
            for (int j = 0; j < 8; ++j) ss += kv[j] * kv[j];
            ss = wave_sum(ss); rs = 1.f / sqrtf(ss * (1.f / 512.f) + 1e-6f);
#pragma unroll
            for (int j = 0; j < 8; ++j) kv[j] *= rs * gg[j];
            *(bf16x8*)(p + 768 + 8 * lane) = pack8(kv);
            if (row < RC) { float* op = o_ckv + (size_t)row * 512 + 8 * lane; *(f32x4*)op = (f32x4){kv[0], kv[1], kv[2], kv[3]}; *(f32x4*)(op + 4) = (f32x4){kv[4], kv[5], kv[6], kv[7]}; }
            if (lane < 8) { const bf16x8 raw = krw[s]; *(bf16x8*)(KR + (size_t)row * 64 + 8 * lane) = raw;
                if (row < RC) { float w[8]; unpack8(raw, w); float* op = o_kr + (size_t)row * 64 + 8 * lane; *(f32x4*)op = (f32x4){w[0], w[1], w[2], w[3]}; *(f32x4*)(op + 4) = (f32x4){w[4], w[5], w[6], w[7]}; } }
        }
    }
}

template <int DQK, int DV> struct AttG { static constexpr int PK = DQK * 2 + 16, PV = DV * 2 + 64, KB = 32 * PK, VB = 32 * PV, BUF = KB + VB;
    static constexpr int KPR = DQK / 8, VPR = DV / 8, NKP = 32 * KPR, NVP = 32 * VPR, KJ = (NKP + 511) / 512, VJ = (NVP + 511) / 512, NC = DQK / 16, NDB = DV / 32; };
struct TileSrc { const bf16* k; const bf16* v; int kp, vp; };
__device__ __forceinline__ int crow(int r, int hi) { return (r & 3) + 8 * (r >> 2) + 4 * hi; }
template <int DQK, int DV> __device__ __forceinline__ void att_gload(const TileSrc& ts, int tid, bf16x8 (&sk)[AttG<DQK, DV>::KJ], bf16x8 (&sv)[AttG<DQK, DV>::VJ]) {
    using G = AttG<DQK, DV>;
#pragma unroll
    for (int j = 0; j < G::KJ; ++j) { const int i = tid + 512 * j; if (i < G::NKP) { const int row = i / G::KPR, cc = i % G::KPR; sk[j] = *(const bf16x8*)(ts.k + (size_t)row * ts.kp + cc * 8); } }
#pragma unroll
    for (int j = 0; j < G::VJ; ++j) { const int i = tid + 512 * j; if (i < G::NVP) { const int row = i / G::VPR, cc = i % G::VPR; sv[j] = *(const bf16x8*)(ts.v + (size_t)row * ts.vp + cc * 8); } }
}
template <int DQK, int DV> __device__ __forceinline__ void att_swrite(LAS unsigned char* kb, LAS unsigned char* vb, int tid, const bf16x8 (&sk)[AttG<DQK, DV>::KJ], const bf16x8 (&sv)[AttG<DQK, DV>::VJ]) {
    using G = AttG<DQK, DV>;
#pragma unroll
    for (int j = 0; j < G::KJ; ++j) { const int i = tid + 512 * j; if (i < G::NKP) { const int row = i / G::KPR, cc = i % G::KPR; *(LAS bf16x8*)(kb + row * G::PK + cc * 16) = sk[j]; } }
#pragma unroll
    for (int j = 0; j < G::VJ; ++j) { const int i = tid + 512 * j; if (i < G::NVP) { const int row = i / G::VPR, cc = i % G::VPR; *(LAS bf16x8*)(vb + row * G::PV + cc * 16) = sv[j]; } }
}
#define ATT_S(t) do { \
_Pragma("unroll") \
            for (int r = 0; r < 16; ++r) s[r] = 0.f; \
_Pragma("unroll") \
            for (int c0 = 0; c0 < G::NC; c0 += 4) { bf16x8 kf[4];     \
_Pragma("unroll") \
                for (int c = 0; c < 4; ++c) kf[c] = *(const LAS bf16x8*)(kbuf + kbase + 32 * (c0 + c)); \
                __builtin_amdgcn_sched_barrier(0); \
_Pragma("unroll") \
                for (int c = 0; c < 4; ++c) s = __builtin_amdgcn_mfma_f32_32x32x16_bf16(kf[c], qf[c0 + c], s, 0, 0, 0); } \
            if (P.needs_adjust(u, wid, t)) { \
_Pragma("unroll") \
                for (int r = 0; r < 16; ++r) s[r] = P.adjust(F, pls, u, wid, r32, t, r, hi, s[r] * cs); \
            } else { \
_Pragma("unroll") \
                for (int r = 0; r < 16; ++r) s[r] *= cs; \
            } } while (0)
#define ATT_SM() do { \
            float mt = s[0]; \
_Pragma("unroll") \
            for (int r = 1; r < 16; ++r) mt = fmaxf(mt, s[r]); \
            mt = fmaxf(mt, __shfl_xor(mt, 32)); \
            if (!__all(mt - m_run <= 8.f)) { \
                const float mn = fmaxf(m_run, mt); const float al = fexp2(m_run - mn); m_run = mn; l_run *= al; \
_Pragma("unroll") \
                for (int db = 0; db < G::NDB; ++db) \
_Pragma("unroll") \
                    for (int r = 0; r < 16; ++r) o[db][r] *= al; \
            } \
            float ps = 0.f; \
_Pragma("unroll") \
            for (int r = 0; r < 16; ++r) { s[r] = fexp2(s[r] - m_run); ps += s[r]; } \
            l_run += ps; \
_Pragma("unroll") \
            for (int s2 = 0; s2 < 2; ++s2) { u32x4 w; w.x = pk2(s[8 * s2], s[8 * s2 + 1]); w.y = pk2(s[8 * s2 + 2], s[8 * s2 + 3]); w.z = pk2(s[8 * s2 + 4], s[8 * s2 + 5]); w.w = pk2(s[8 * s2 + 6], s[8 * s2 + 7]); pf[s2] = __builtin_bit_cast(bf16x8, w); } } while (0)
#define ATT_PV(vbuf) do { \
_Pragma("unroll") \
            for (int s2 = 0; s2 < 2; ++s2) \
_Pragma("unroll") \
                for (int db = 0; db < G::NDB; ++db) { \
                    const s16x4 lo = __builtin_bit_cast(s16x4, __builtin_amdgcn_ds_read_tr16_b64_v4i16((LAS v4i16_t*)((vbuf) + vbase + s2 * 16 * G::PV + db * 64))); \
                    const s16x4 hh = __builtin_bit_cast(s16x4, __builtin_amdgcn_ds_read_tr16_b64_v4i16((LAS v4i16_t*)((vbuf) + vbase + s2 * 16 * G::PV + 8 * G::PV + db * 64))); \
                    const bf16x8 vf = {lo[0], lo[1], lo[2], lo[3], hh[0], hh[1], hh[2], hh[3]}; \
                    o[db] = __builtin_amdgcn_mfma_f32_32x32x16_bf16(vf, pf[s2], o[db], 0, 0, 0); } } while (0)
typedef short v4i16_t __attribute__((ext_vector_type(4)));
template <int DQK, int DV, bool PAIR, class Pol>
__device__ __forceinline__ void attn_unit(const Fr& F, const Pol& P, int u) {
    using G = AttG<DQK, DV>;
    const int tid = F.tid, lane = F.lane, wid = F.wave, r32 = lane & 31, hi = lane >> 5;
    const int NT = P.ntiles(u);
    bf16x8 qf[G::NC];
    { const bf16* qp = P.qrow(u, wid, r32) + hi * 8;
#pragma unroll
      for (int c = 0; c < G::NC; ++c) qf[c] = *(const bf16x8*)(qp + 16 * c); }
    if (QFUSE) {
        float ss = 0.f;
#pragma unroll
        for (int c = 0; c < G::NC; ++c) { float t8[8]; unpack8(qf[c], t8);
#pragma unroll
            for (int j = 0; j < 8; ++j) ss += t8[j] * t8[j]; }
        ss += __shfl_xor(ss, 32);
        const float rs = (LOG2E / sqrtf((float)DQK)) / sqrtf(ss * (1.f / DQK) + 1e-6f);
        constexpr int C0 = Pol::QROPE ? G::NC - 4 : G::NC;
#pragma unroll
        for (int c = 0; c < C0; ++c) { float t8[8]; unpack8(qf[c], t8); const f32x4 g0 = *(const f32x4*)(P.qgain + 16 * c + 8 * hi), g1 = *(const f32x4*)(P.qgain + 16 * c + 8 * hi + 4);
            t8[0] *= rs * g0.x; t8[1] *= rs * g0.y; t8[2] *= rs * g0.z; t8[3] *= rs * g0.w; t8[4] *= rs * g1.x; t8[5] *= rs * g1.y; t8[6] *= rs * g1.z; t8[7] *= rs * g1.w; qf[c] = pack8(t8); }
        if (Pol::QROPE) { const int t = P.qpos(u, wid, r32); const float* cp = P.ropeC + (size_t)t * 64 + 8 * hi; const float* sp = P.ropeS + (size_t)t * 64 + 8 * hi;
#pragma unroll
            for (int pr = 0; pr < 2; ++pr) { constexpr int CB = G::NC - 4; const int ca = CB + 2 * pr, cb = CB + 2 * pr + 1; float va[8], vb[8]; unpack8(qf[ca], va); unpack8(qf[cb], vb);
                const f32x4 ga0 = *(const f32x4*)(P.qgain + 16 * ca + 8 * hi), ga1 = *(const f32x4*)(P.qgain + 16 * ca + 8 * hi + 4), gb0 = *(const f32x4*)(P.qgain + 16 * cb + 8 * hi), gb1 = *(const f32x4*)(P.qgain + 16 * cb + 8 * hi + 4);
                const float ga[8] = {ga0.x, ga0.y, ga0.z, ga0.w, ga1.x, ga1.y, ga1.z, ga1.w}, gb[8] = {gb0.x, gb0.y, gb0.z, gb0.w, gb1.x, gb1.y, gb1.z, gb1.w};
                const f32x4 c0 = *(const f32x4*)(cp + 32 * pr), c1 = *(const f32x4*)(cp + 32 * pr + 4), s0 = *(const f32x4*)(sp + 32 * pr), s1 = *(const f32x4*)(sp + 32 * pr + 4);
                const float cc[8] = {c0.x, c0.y, c0.z, c0.w, c1.x, c1.y, c1.z, c1.w}, sn[8] = {s0.x, s0.y, s0.z, s0.w, s1.x, s1.y, s1.z, s1.w};
#pragma unroll
                for (int j = 0; j < 8; ++j) { const float a = va[j] * rs * ga[j], b2 = vb[j] * rs * gb[j]; va[j] = a * cc[j] - b2 * sn[j]; vb[j] = b2 * cc[j] + a * sn[j]; }
                qf[ca] = pack8(va); qf[cb] = pack8(vb); } }
    }
    f32x16 o[G::NDB];
#pragma unroll
    for (int db = 0; db < G::NDB; ++db)
#pragma unroll
        for (int r = 0; r < 16; ++r) o[db][r] = 0.f;
    float m_run = -1e30f, l_run = 0.f;
    const float cs = QFUSE ? 1.f : LOG2E / sqrtf((float)DQK);
    const int kbase = r32 * G::PK + hi * 16;
    const int li = lane & 15; const int vbase = (4 * hi + (li >> 2)) * G::PV + (16 * ((lane >> 4) & 1) + 4 * (li & 3)) * 2;
    f32x16 s; bf16x8 pf[2];
    P.unit_setup(F, u);
    const typename Pol::LS pls = P.lane_init(u, wid, r32, hi);
    if constexpr (PAIR) {
        LAS unsigned char* const kring = F.lds; LAS unsigned char* const vring = F.lds + 4 * G::KB;
        bf16x8 skA[G::KJ], svA[G::VJ], skB[G::KJ], svB[G::VJ];
        { const TileSrc t0 = P.tile(u, 0); att_gload<DQK, DV>(t0, tid, skA, svA); }
        if (NT > 1) { const TileSrc t1 = P.tile(u, 1); att_gload<DQK, DV>(t1, tid, skB, svB); }
        att_swrite<DQK, DV>(kring, vring, tid, skA, svA);
        if (NT > 1) att_swrite<DQK, DV>(kring + G::KB, vring + G::VB, tid, skB, svB);
        asm volatile("s_waitcnt lgkmcnt(0)\n\ts_barrier" ::: "memory");
        for (int t0 = 0; t0 < NT; t0 += 2) { const int slot = (t0 >> 1) & 1;
            if (t0 + 2 < NT) { const TileSrc ta = P.tile(u, t0 + 2); att_gload<DQK, DV>(ta, tid, skA, svA); }
            if (t0 + 3 < NT) { const TileSrc tb = P.tile(u, t0 + 3); att_gload<DQK, DV>(tb, tid, skB, svB); }
#pragma unroll
            for (int sub = 0; sub < 2; ++sub) { const int t = t0 + sub;
                if (t < NT && P.active(u, wid, t)) { LAS unsigned char* kbuf = kring + (slot * 2 + sub) * G::KB; ATT_S(t); ATT_SM(); ATT_PV(vring + (slot * 2 + sub) * G::VB); } }
            if (t0 + 2 < NT) att_swrite<DQK, DV>(kring + ((slot ^ 1) * 2) * G::KB, vring + ((slot ^ 1) * 2) * G::VB, tid, skA, svA);
            if (t0 + 3 < NT) att_swrite<DQK, DV>(kring + ((slot ^ 1) * 2 + 1) * G::KB, vring + ((slot ^ 1) * 2 + 1) * G::VB, tid, skB, svB);
            asm volatile("s_waitcnt lgkmcnt(0)\n\ts_barrier" ::: "memory");
        }
    } else {
    bf16x8 sk[G::KJ], sv[G::VJ];
    LAS unsigned char* const kring = F.lds; LAS unsigned char* const vring = F.lds + 2 * G::KB;
    { const TileSrc t0 = P.tile(u, 0); att_gload<DQK, DV>(t0, tid, sk, sv); }
    att_swrite<DQK, DV>(kring, vring, tid, sk, sv);
    asm volatile("s_waitcnt lgkmcnt(0)\n\ts_barrier" ::: "memory");
    const bool lag = wid >= 4; bool prev_act = false; int vprev = 0, vcur = 0;
#define ATT_STEP(LAG, t) do { \
        LAS unsigned char* kbuf = kring + ((t) & 1) * G::KB; const int vnext = vcur == 2 ? 0 : vcur + 1; \
        if ((t) + 1 < NT) { const TileSrc tn = P.tile(u, (t) + 1); att_gload<DQK, DV>(tn, tid, sk, sv); } \
        const bool act = P.active(u, wid, t); \
        if (LAG) { if (act) ATT_S(t); if (prev_act) ATT_PV(vring + vprev * G::VB); if (act) ATT_SM(); } \
        else if (act) { ATT_S(t); ATT_SM(); ATT_PV(vring + vcur * G::VB); } \
        prev_act = act; \
        if ((t) + 1 < NT) att_swrite<DQK, DV>(kring + (((t) + 1) & 1) * G::KB, vring + vnext * G::VB, tid, sk, sv); \
        vprev = vcur; vcur = vnext; \
        asm volatile("s_waitcnt lgkmcnt(0)\n\ts_barrier" ::: "memory"); } while (0)
    if (lag) { for (int t = 0; t < NT; ++t) ATT_STEP(true, t); }
    else { for (int t = 0; t < NT; ++t) ATT_STEP(false, t); }
#undef ATT_STEP
    if (lag && prev_act) ATT_PV(vring + vprev * G::VB);
    asm volatile("s_waitcnt lgkmcnt(0)\n\ts_barrier" ::: "memory");
    }
    float lt = l_run + __shfl_xor(l_run, 32);
    if (Pol::HAS_SINK) lt += fexp2(P.sink_l2(u, wid) - m_run);
    const float inv = 1.f / lt;
    bf16* op = P.orow(u, wid, r32) + 4 * hi;
#pragma unroll
    for (int db = 0; db < G::NDB; ++db)
#pragma unroll
        for (int rg = 0; rg < 4; ++rg) { u32x2 w; w.x = pk2(o[db][4 * rg] * inv, o[db][4 * rg + 1] * inv); w.y = pk2(o[db][4 * rg + 2] * inv, o[db][4 * rg + 3] * inv); *(u32x2*)(op + 32 * db + 8 * rg) = w; }
}
struct PolBase { static constexpr bool HAS_SINK = false, QROPE = false; const float* qgain; const float* ropeC; const float* ropeS;
    __device__ __forceinline__ int qpos(int, int, int) const { return 0; }
    __device__ __forceinline__ void unit_setup(const Fr&, int) const {}
    __device__ __forceinline__ bool active(int, int, int) const { return true; }
    __device__ __forceinline__ bool needs_adjust(int, int, int) const { return false; }
    struct LS {}; __device__ __forceinline__ LS lane_init(int, int, int, int) const { return LS{}; }
    __device__ __forceinline__ float adjust(const Fr&, const LS&, int, int, int, int, int  , int  , float s) const { return s; }
    __device__ __forceinline__ float sink_l2(int, int) const { return 0.f; }
    static __device__ __forceinline__ int remap(int w) { return w; } };
__device__ __forceinline__ int remap_heads16(int w) { const int c = w & 255, x = c & 7, j = c >> 3; return (w & ~255) | ((2 * x + (j >> 4)) << 4) | (j & 15); }
struct PolCtx : PolBase { const bf16* Q; long pq; int shq; const bf16* K; long pk; int shk; const bf16* V; long pv; int shv; bf16* O; int sho; int NH;
    __device__ __forceinline__ int ntiles(int) const { return 8; }
    __device__ __forceinline__ TileSrc tile(int u, int t) const { const int b = u / NH, h = u % NH; const size_t r = (size_t)b * 256 + 32 * t; return TileSrc{K + r * pk + (size_t)h * shk, V + r * pv + (size_t)h * shv, (int)pk, (int)pv}; }
    __device__ __forceinline__ const bf16* qrow(int u, int wid, int r32) const { const int b = u / NH, h = u % NH; return Q + ((size_t)b * 256 + wid * 32 + r32) * pq + (size_t)h * shq; }
    __device__ __forceinline__ bf16* orow(int u, int wid, int r32) const { const int b = u / NH, h = u % NH; return O + ((size_t)b * 256 + wid * 32 + r32) * 2048 + (size_t)h * sho; } };
struct PolSwaCtx : PolBase { static constexpr bool HAS_SINK = true, QROPE = false; const bf16* QKV; bf16* O; const float* sinks;
    __device__ __forceinline__ int ntiles(int) const { return 8; }
    __device__ __forceinline__ TileSrc tile(int u, int t) const { const int b = u >> 5, kvh = (u >> 3) & 3; const size_t r = (size_t)b * 256 + 32 * t; return TileSrc{QKV + r * SQW + 2048 + kvh * 64, QKV + r * SQW + 2304 + kvh * 64, SQW, SQW}; }
    __device__ __forceinline__ const bf16* qrow(int u, int wid, int r32) const { const int b = u >> 5, kvh = (u >> 3) & 3, tq = u & 7; return QKV + ((size_t)b * 256 + 32 * tq + r32) * SQW + (kvh * 8 + wid) * 64; }
    __device__ __forceinline__ bf16* orow(int u, int wid, int r32) const { const int b = u >> 5, kvh = (u >> 3) & 3, tq = u & 7; return O + ((size_t)b * 256 + 32 * tq + r32) * 2048 + (kvh * 8 + wid) * 64; }
    __device__ __forceinline__ float sink_l2(int u, int wid) const { return sinks[((u >> 3) & 3) * 8 + wid] * LOG2E; } };
struct PolMlaLat : PolBase { static constexpr bool QROPE = true; const bf16* Q; const bf16* K; const bf16* KV; bf16* O;
    __device__ __forceinline__ int ntiles(int) const { return 136; }
    __device__ __forceinline__ TileSrc tile(int u, int t) const { const int b = u >> 8, h = (u >> 4) & 15; const size_t r = t < 8 ? (size_t)R + b * 256 + 32 * t : (size_t)RC + (size_t)b * NLAT + 32 * (t - 8);
        return TileSrc{K + r * MQW + h * 192, KV + r * MKVW + h * 256 + 128, MQW, MKVW}; }
    __device__ __forceinline__ const bf16* qrow(int u, int wid, int r32) const { const int b = u >> 8, h = (u >> 4) & 15, qb = u & 15; return Q + ((size_t)RC + (size_t)b * NLAT + qb * 256 + wid * 32 + r32) * MQW + h * 192; }
    __device__ __forceinline__ bf16* orow(int u, int wid, int r32) const { const int b = u >> 8, h = (u >> 4) & 15, qb = u & 15; return O + ((size_t)RC + (size_t)b * NLAT + qb * 256 + wid * 32 + r32) * 2048 + h * 128; }
    __device__ __forceinline__ int qpos(int u, int wid, int r32) const { return (u & 15) * 256 + wid * 32 + r32; }
    static __device__ __forceinline__ int remap(int w) { return remap_heads16(w); } };
struct PolNatLat : PolBase { const bf16* QKV; const bf16* CK; const bf16* CV; const float* rpb; bf16* O;
    static constexpr int RPB_OFF = 4 * AttG<128, 128>::KB + 4 * AttG<128, 128>::VB;
    __device__ __forceinline__ int rmin(int u) const { const int rb = u & 15; int r = 4 * rb - 4; return r < 0 ? 0 : (r > 56 ? 56 : r); }
    __device__ __forceinline__ int ntiles(int u) const { const int rb = u & 15; int rl = 4 * rb - 1; rl = rl < 0 ? 0 : (rl > 56 ? 56 : rl); return 8 + 2 * (rl + 7 - rmin(u) + 1); }
    __device__ __forceinline__ void unit_setup(const Fr& F, int u) const { const int h = (u >> 4) & 15; LAS float* rp = (LAS float*)(F.lds + RPB_OFF); if (F.tid < 480) rp[F.tid] = (F.tid & 31) < 31 ? rpb[h * 465 + (F.tid >> 5) * 31 + (F.tid & 31)] * LOG2E : -1e30f; }
    __device__ __forceinline__ TileSrc tile(int u, int t) const { const int b = u >> 8, h = (u >> 4) & 15;
        if (t < 8) { const size_t o = ((size_t)(b * 16 + h) * 256 + 32 * t) * 128; return TileSrc{CK + o, CV + o, 128, 128}; }
        const int lt = t - 8; const int kr = rmin(u) + (lt >> 1); const size_t r = (size_t)RC + (size_t)b * NLAT + kr * 64 + 32 * (lt & 1);
        return TileSrc{QKV + r * 6144 + 2048 + h * 128, QKV + r * 6144 + 4096 + h * 128, 6144, 6144}; }
    __device__ __forceinline__ size_t qtok(int u, int wid, int r32) const { const int b = u >> 8, rb = u & 15; return (size_t)RC + (size_t)b * NLAT + (4 * rb + (wid >> 1)) * 64 + 32 * (wid & 1) + r32; }
    __device__ __forceinline__ const bf16* qrow(int u, int wid, int r32) const { return QKV + qtok(u, wid, r32) * 6144 + ((u >> 4) & 15) * 128; }
    __device__ __forceinline__ bf16* orow(int u, int wid, int r32) const { return O + qtok(u, wid, r32) * 2048 + ((u >> 4) & 15) * 128; }
    __device__ __forceinline__ bool active(int u, int wid, int t) const { if (t < 8) return true; const int r = 4 * (u & 15) + (wid >> 1); int rs = r - 4; rs = rs < 0 ? 0 : (rs > 56 ? 56 : rs); const int kr = rmin(u) + ((t - 8) >> 1); return kr >= rs && kr < rs + 8; }
    __device__ __forceinline__ bool needs_adjust(int, int, int t) const { return t >= 8; }
    struct LS { unsigned pk[2][4]; };
    __device__ __forceinline__ LS lane_init(int, int wid, int r32, int hi) const { LS ls; const int c = 32 * (wid & 1) + r32; int cst = c - 8; cst = cst < 0 ? 0 : (cst > 48 ? 48 : cst);
#pragma unroll
        for (int hf = 0; hf < 2; ++hf)
#pragma unroll
            for (int q = 0; q < 4; ++q) { unsigned w = 0;
#pragma unroll
                for (int e = 0; e < 4; ++e) { const int r = 4 * q + e, kc = 32 * hf + crow(r, hi); const bool valid = kc >= cst && kc < cst + 16; int di = kc - c + 15; di = di < 0 ? 0 : (di > 30 ? 30 : di);
                    w |= (unsigned)(valid ? di : 31) << (8 * e); }
                ls.pk[hf][q] = w; }
        return ls; }
    __device__ __forceinline__ float adjust(const Fr& F, const LS& ls, int u, int wid, int, int t, int r, int, float s) const {
        const int lt = t - 8; const int rr = 4 * (u & 15) + (wid >> 1), kr = rmin(u) + (lt >> 1);
        const unsigned w = (lt & 1) ? ls.pk[1][r >> 2] : ls.pk[0][r >> 2]; const unsigned off = (w >> (8 * (r & 3))) & 0xffu;
        const LAS float* rp = (const LAS float*)(F.lds + RPB_OFF) + (kr - rr + 7) * 32;
        return s + rp[off]; }
    static __device__ __forceinline__ int remap(int w) { const int u = remap_heads16(w); return (u & ~15) | ((u + (w >> 8)) & 15); } };
struct PolSwaLat : PolBase { static constexpr bool HAS_SINK = true, QROPE = true; const bf16* QKV; const bf16* CK; const bf16* CV; const float* sinks; bf16* O;
    __device__ __forceinline__ int kt0(int u) const { const int tb = u & 127; return tb < 4 ? 0 : tb - 4; }
    __device__ __forceinline__ int ntiles(int u) const { const int tb = u & 127; const int k1 = tb + 4 > 127 ? 127 : tb + 4; return 8 + k1 - kt0(u) + 1; }
    __device__ __forceinline__ TileSrc tile(int u, int t) const { const int b = u >> 9, kvh = (u >> 7) & 3;
        if (t < 8) { const size_t o = ((size_t)(b * 4 + kvh) * 256 + 32 * t) * 64; return TileSrc{CK + o, CV + o, 64, 64}; }
        const size_t r = (size_t)RC + (size_t)b * NLAT + 32 * (kt0(u) + t - 8); return TileSrc{QKV + r * SQW + 2048 + kvh * 64, QKV + r * SQW + 2304 + kvh * 64, SQW, SQW}; }
    __device__ __forceinline__ size_t qtok(int u, int r32) const { return (size_t)RC + (size_t)(u >> 9) * NLAT + 32 * (u & 127) + r32; }
    __device__ __forceinline__ int qpos(int u, int, int r32) const { return 32 * (u & 127) + r32; }
    __device__ __forceinline__ const bf16* qrow(int u, int wid, int r32) const { return QKV + qtok(u, r32) * SQW + (((u >> 7) & 3) * 8 + wid) * 64; }
    __device__ __forceinline__ bf16* orow(int u, int wid, int r32) const { return O + qtok(u, r32) * 2048 + (((u >> 7) & 3) * 8 + wid) * 64; }
    __device__ __forceinline__ bool needs_adjust(int u, int, int t) const { if (t < 8) return false; const int tb = u & 127, kt = kt0(u) + t - 8; return kt == tb - 4 || kt == tb + 4; }
    __device__ __forceinline__ float adjust(const Fr&, const LS&, int u, int, int r32, int t, int r, int hi, float s) const { const int tb = u & 127, kt = kt0(u) + t - 8; const int dlt = 32 * (kt - tb) + crow(r, hi) - r32; return (dlt <= 128 && dlt >= -128) ? s : -1e30f; }
    __device__ __forceinline__ float sink_l2(int u, int wid) const { return sinks[((u >> 7) & 3) * 8 + wid] * LOG2E; }
    static __device__ __forceinline__ int remap(int w) { const int c = w & 255, x = c & 7, j = c >> 3; return (w & ~255) | ((j >> 4) << 7) | (16 * x + (j & 15)); } };
template <int DQK, int DV, bool PAIR, class Pol> __device__ __forceinline__ void ph_attn(const Fr& F, const Pol& P, int nunits) { const bool rm = F.G == 256 && (nunits & 255) == 0;
    for (int u = F.bid; u < nunits; u += F.G) attn_unit<DQK, DV, PAIR, Pol>(F, P, rm ? Pol::remap(u) : u); }
}

namespace mk {
#ifndef LRU_UNROLL
#define LRU_UNROLL 4
#endif
constexpr int PXC = 400;
struct LruArgs { const bf16* XG; const bf16* Wg; const float* cw; const float* cb; const float* ba; const float* bi; const float* lam; float* AGG; const float* CARRY; bf16* Y; };
template <int PASS> __device__ __forceinline__ void lru_unit(const Fr& F, const LruArgs& A, int u) {
    const int chunk = u >> 2, bq = u & 3, row0 = chunk * 64, tid = F.tid, lane = F.lane, hi = lane >> 5;
    int s0, T; if (row0 < RC) { s0 = (row0 >> 8) << 8; T = 256; } else { s0 = RC + (((row0 - RC) >> 12) << 12); T = NLAT; } const int t0 = row0 - s0;
    if (tid < 480) { const int combo = tid % 96, blk = combo / 24, cg = combo % 24, rbeg = (tid / 96) * 13, nr = rbeg + 13 > 64 ? 64 - rbeg : 13;
        LAS unsigned char* dst = F.lds + blk * (64 * PXC) + cg * 16;
        if (cg < 21) { const int ch = (4 * bq + blk) * 168 + 8 * cg;
            bf16x8 xr[16];
#pragma unroll
            for (int i = 0; i < 16; ++i) { const int tt = t0 + rbeg + i - 2; xr[i] = (bf16x8){0, 0, 0, 0, 0, 0, 0, 0}; if (tt >= 0 && tt < T && i < nr + 3) xr[i] = *(const bf16x8*)(A.XG + (size_t)(s0 + tt) * (2 * LW) + ch); }
            float w[4][8], bb[8];
#pragma unroll
            for (int k = 0; k < 4; ++k) { const f32x4 w0 = *(const f32x4*)(A.cw + (size_t)k * LW + ch), w1 = *(const f32x4*)(A.cw + (size_t)k * LW + ch + 4); w[k][0] = w0.x; w[k][1] = w0.y; w[k][2] = w0.z; w[k][3] = w0.w; w[k][4] = w1.x; w[k][5] = w1.y; w[k][6] = w1.z; w[k][7] = w1.w; }
            { const f32x4 b0 = *(const f32x4*)(A.cb + ch), b1 = *(const f32x4*)(A.cb + ch + 4); bb[0] = b0.x; bb[1] = b0.y; bb[2] = b0.z; bb[3] = b0.w; bb[4] = b1.x; bb[5] = b1.y; bb[6] = b1.z; bb[7] = b1.w; }
#pragma unroll
            for (int r = 0; r < 13; ++r) if (r < nr) { float acc[8];
#pragma unroll
                for (int j = 0; j < 8; ++j) acc[j] = bb[j];
#pragma unroll
                for (int k = 0; k < 4; ++k) { float x[8]; unpack8(xr[r + k], x);
#pragma unroll
                    for (int j = 0; j < 8; ++j) acc[j] += w[k][j] * x[j]; }
                *(LAS bf16x8*)(dst + (rbeg + r) * PXC) = pack8(acc); }
        } else { for (int r = 0; r < nr; ++r) *(LAS bf16x8*)(dst + (rbeg + r) * PXC) = (bf16x8){0, 0, 0, 0, 0, 0, 0, 0}; }
    }
    __syncthreads();
    const int i32 = lane & 31; const int tau = ((i32 >> 2) & 1) * 16 + ((i32 >> 3) << 2) + (i32 & 3);
    for (int task = F.wave; task < 24; task += 8) {
        const int blk = task / 6, sub = task % 6; const int col = 32 * sub + i32; const bool cvalid = col < 168; const int gb = 4 * bq + blk; const int c = gb * 168 + (cvalid ? col : 0);
        LAS unsigned char* xcb = F.lds + blk * (64 * PXC);
        LAS unsigned short* hst = (LAS unsigned short*)(F.lds + 4 * 64 * PXC) + F.wave * 2048 + lane;
#pragma unroll
        for (int dir = 0; dir < 2; ++dir) {
            const bf16* wa = A.Wg + ((size_t)((dir * 2 + 0) * 16 + gb) * 192 + col) * 192 + 8 * hi; const bf16* wi = A.Wg + ((size_t)((dir * 2 + 1) * 16 + gb) * 192 + col) * 192 + 8 * hi;
            const float ba_ = A.ba[(size_t)dir * LW + c], bi_ = A.bi[(size_t)dir * LW + c];
            float sp; { const float y = fexp2(-A.lam[(size_t)dir * LW + c] * LOG2E); sp = y < 0.02f ? y * (1.f - y * (0.5f - y * 0.33333333f)) : __builtin_amdgcn_logf(1.f + y) * 0.6931471805599453f; }
            float Hrun = 0.f, Prun = 1.f, Srun = 0.f;
            if (PASS == 2) Hrun = A.CARRY[((size_t)chunk * 2 + dir) * LW + c];
            f32x16 aa[2], ai[2];
#pragma unroll
            for (int mt = 0; mt < 2; ++mt)
#pragma unroll
                for (int r = 0; r < 16; ++r) { aa[mt][r] = 0.f; ai[mt][r] = 0.f; }
            { const LAS unsigned char* ap = xcb + tau * PXC + 16 * hi;
#pragma unroll (PASS == 1 ? 6 : 4)
              for (int ks = 0; ks < 12; ++ks) { const bf16x8 fa = *(const bf16x8*)(wa + 16 * ks), fi = *(const bf16x8*)(wi + 16 * ks);
                  const bf16x8 a0 = *(const LAS bf16x8*)(ap + 32 * ks), a1 = *(const LAS bf16x8*)(ap + 32 * PXC + 32 * ks);
                  aa[0] = __builtin_amdgcn_mfma_f32_32x32x16_bf16(a0, fa, aa[0], 0, 0, 0); ai[0] = __builtin_amdgcn_mfma_f32_32x32x16_bf16(a0, fi, ai[0], 0, 0, 0);
                  aa[1] = __builtin_amdgcn_mfma_f32_32x32x16_bf16(a1, fa, aa[1], 0, 0, 0); ai[1] = __builtin_amdgcn_mfma_f32_32x32x16_bf16(a1, fi, ai[1], 0, 0, 0); } }
#pragma unroll
            for (int mi = 0; mi < 2; ++mi) { const int mt = dir == 0 ? mi : 1 - mi;
                float hl[16], ac[16];
#pragma unroll
                for (int r = 0; r < 16; ++r) { const int tt = 32 * mt + 16 * hi + r; const float xcv = bf2f(*(const LAS unsigned short*)(xcb + tt * PXC + col * 2));
                    const float rg = sigm(aa[mt][r] + ba_), ig = sigm(ai[mt][r] + bi_); const float la = -8.f * rg * sp; const float a = fexp2(la * LOG2E); const float z = 2.f * la;
                    const float om = z > -0.05f ? -z * (1.f + z * (0.5f + z * 0.16666667f)) : 1.f - a * a;
                    ac[r] = a; hl[r] = __builtin_amdgcn_sqrtf(om) * ig * xcv; }
                float P = 1.f, S = 0.f;
                if (dir == 0) {
#pragma unroll
                    for (int r = 0; r < 16; ++r) { S = ac[r] * S + hl[r]; P *= ac[r]; hl[r] = S; ac[r] = P; }
                } else {
#pragma unroll
                    for (int r = 15; r >= 0; --r) { S = ac[r] * S + hl[r]; P *= ac[r]; hl[r] = S; ac[r] = P; }
                }
                const float oP = __shfl_xor(P, 32), oS = __shfl_xor(S, 32); const bool isfirst = (dir == 0) ? (hi == 0) : (hi == 1);
                const float fP = isfirst ? P : oP, fS = isfirst ? S : oS, sP = isfirst ? oP : P, sS = isfirst ? oS : S;
                const float tP = fP * sP, tS = sS + sP * fS;
                if (PASS == 1) { Srun = tS + tP * Srun; Prun *= tP; }
                else { const float cin = isfirst ? Hrun : fS + fP * Hrun;
#pragma unroll
                    for (int r = 0; r < 16; ++r) { const float h = hl[r] + ac[r] * cin; LAS unsigned short* hp = hst + (mt * 16 + r) * 64;
                        if (dir == 0) *hp = (unsigned short)f2bf(h);
                        else if (cvalid) { const size_t row = (size_t)row0 + 32 * mt + 16 * hi + r; const float gate = bf2f(A.XG[row * (2 * LW) + LW + c]); A.Y[row * LW + c] = (bf16)f2bf(geluf(gate) * (bf2f(*hp) + h)); } }
                    Hrun = tS + tP * Hrun; asm volatile("" ::: "memory"); }
            }
            if (PASS == 1 && hi == 0 && cvalid) { A.AGG[(((size_t)chunk * 2 + dir) * 2 + 0) * LW + c] = Prun; A.AGG[(((size_t)chunk * 2 + dir) * 2 + 1) * LW + c] = Srun; }
        }
    }
    __syncthreads();
}
template <int PASS> __device__ __forceinline__ void ph_lru(const Fr& F, const LruArgs& A) { for (int u = F.bid; u < 576 * 4; u += F.G) lru_unit<PASS>(F, A, u); }
__device__ __forceinline__ void ph_lru_carry(const Fr& F, const float* AGG, float* CARRY, const float* h0, float* state_out) {
    for (int g = F.bid * 512 + F.tid; g < 24 * 2 * LW; g += F.G * 512) { const int seq = g / (2 * LW), rem = g % (2 * LW), dir = rem / LW, c = rem % LW;
        int nch, ch0; float h = 0.f; if (seq < 16) { nch = 4; ch0 = 4 * seq; } else { const int b = seq - 16; nch = 64; ch0 = 64 + 64 * b; h = h0[((size_t)b * 2 + dir) * LW + c]; }
        for (int j = 0; j < nch; ++j) { const int ch = ch0 + (dir == 0 ? j : nch - 1 - j); CARRY[((size_t)ch * 2 + dir) * LW + c] = h;
            const float P = AGG[(((size_t)ch * 2 + dir) * 2 + 0) * LW + c], S = AGG[(((size_t)ch * 2 + dir) * 2 + 1) * LW + c]; h = S + P * h; }
        if (seq < 16) state_out[((size_t)seq * 2 + dir) * LW + c] = h; }
}
__device__ __forceinline__ void ph_lru_xc(const Fr& F, const bf16* XG, const float* cw, const float* cb, bf16* XC) {
    for (int g = F.bid * 512 + F.tid; g < (R / 8) * 336; g += F.G * 512) { const int row0 = (g / 336) * 8, ch = 8 * (g % 336);
        int s0, T; if (row0 < RC) { s0 = (row0 >> 8) << 8; T = 256; } else { s0 = RC + (((row0 - RC) >> 12) << 12); T = NLAT; } const int t0 = row0 - s0;
        bf16x8 xr[11];
#pragma unroll
        for (int i = 0; i < 11; ++i) { const int tt = t0 + i - 2; xr[i] = __builtin_bit_cast(bf16x8, (u32x4){0u, 0u, 0u, 0u}); if (tt >= 0 && tt < T) xr[i] = *(const bf16x8*)(XG + (size_t)(s0 + tt) * (2 * LW) + ch); }
        float w[4][8], bb[8];
        { const f32x4 b0 = *(const f32x4*)(cb + ch), b1 = *(const f32x4*)(cb + ch + 4); bb[0] = b0.x; bb[1] = b0.y; bb[2] = b0.z; bb[3] = b0.w; bb[4] = b1.x; bb[5] = b1.y; bb[6] = b1.z; bb[7] = b1.w; }
#pragma unroll
        for (int k = 0; k < 4; ++k) { const f32x4 w0 = *(const f32x4*)(cw + (size_t)k * LW + ch), w1 = *(const f32x4*)(cw + (size_t)k * LW + ch + 4);
            w[k][0] = w0.x; w[k][1] = w0.y; w[k][2] = w0.z; w[k][3] = w0.w; w[k][4] = w1.x; w[k][5] = w1.y; w[k][6] = w1.z; w[k][7] = w1.w; }
        float x[11][8];
#pragma unroll
        for (int i = 0; i < 11; ++i) unpack8(xr[i], x[i]);
#pragma unroll
        for (int r = 0; r < 8; ++r) { float acc[8];
#pragma unroll
            for (int e = 0; e < 8; ++e) acc[e] = bb[e];
#pragma unroll
            for (int k = 0; k < 4; ++k)
#pragma unroll
                for (int e = 0; e < 8; ++e) acc[e] += w[k][e] * x[r + k][e];
            *(bf16x8*)(XC + (size_t)(row0 + r) * LW + ch) = pack8(acc); } }
}
__device__ __forceinline__ void ph_lru_combine(const Fr& F, const bf16* XG, const bf16* HB, bf16* Y) {
    for (int g = F.bid * 512 + F.tid; g < R * 336; g += F.G * 512) { const int row = g / 336, ch = 8 * (g % 336);
        float a[8], b[8], gt[8]; unpack8(__builtin_nontemporal_load((const bf16x8*)(Y + (size_t)row * LW + ch)), a); unpack8(__builtin_nontemporal_load((const bf16x8*)(HB + (size_t)row * LW + ch)), b); unpack8(__builtin_nontemporal_load((const bf16x8*)(XG + (size_t)row * (2 * LW) + LW + ch)), gt);
#pragma unroll
        for (int j = 0; j < 8; ++j) a[j] = geluf(gt[j]) * (a[j] + b[j]);
        *(bf16x8*)(Y + (size_t)row * LW + ch) = pack8(a); }
}
struct ChainArgs { const bf16* XC; const bf16* Wg; const float* ba; const float* bi; const float* lam; const float* h0; bf16* HF; bf16* HB; float* state_out; };
#define LRU_STORE_H() do { const int odd = i32 & 1; \
_Pragma("unroll") \
        for (int rp = 0; rp < 8; ++rp) { const unsigned own = odd ? hq[2 * rp + 1] : hq[2 * rp], snd = odd ? hq[2 * rp] : hq[2 * rp + 1]; \
            const unsigned rcv = (unsigned)__builtin_amdgcn_update_dpp(0, (int)snd, 0xB1, 0xF, 0xF, false); \
            const unsigned wd = odd ? (rcv | (own << 16)) : (own | (rcv << 16)); \
            if (cvalid) *(unsigned*)(HX + (rprev + 16 * hi + 2 * rp + odd) * LW + c - odd) = wd; } } while (0)
__device__ __forceinline__ void lru_chain(const Fr& F, const ChainArgs& A, int s0, int T, int dir, int st, int seq_ctx, int b_lat) {
    const int lane = F.lane, hi = lane >> 5, i32 = lane & 31; const int tau = ((i32 >> 2) & 1) * 16 + ((i32 >> 3) << 2) + (i32 & 3);
    const int blk = st / 6, sub = st % 6; const int col = 32 * sub + i32; const bool cvalid = col < 168; const int c = blk * 168 + (cvalid ? col : 0);
    bf16x8 bfa[12]; LAS unsigned char* wl = F.lds + F.wave * 12288 + lane * 16;
    { const bf16* wa = A.Wg + ((size_t)((dir * 2 + 0) * 16 + blk) * 192 + col) * 192 + 8 * hi; const bf16* wi = A.Wg + ((size_t)((dir * 2 + 1) * 16 + blk) * 192 + col) * 192 + 8 * hi;
#pragma unroll
      for (int ks = 0; ks < 12; ++ks) { bfa[ks] = *(const bf16x8*)(wa + 16 * ks); *(LAS bf16x8*)(wl + ks * 1024) = *(const bf16x8*)(wi + 16 * ks); } }
    const float ba_ = A.ba[(size_t)dir * LW + c], bi_ = A.bi[(size_t)dir * LW + c];
    float sp; { const float y = fexp2(-A.lam[(size_t)dir * LW + c] * LOG2E); sp = y < 0.02f ? y * (1.f - y * (0.5f - y * 0.33333333f)) : __builtin_amdgcn_logf(1.f + y) * 0.6931471805599453f; }
    float Hrun = b_lat >= 0 ? A.h0[((size_t)b_lat * 2 + dir) * LW + c] : 0.f;
    const float nba = -ba_ * LOG2E, nbi = -bi_ * LOG2E, k1 = -8.f * sp * LOG2E;
    bf16* HX = dir == 0 ? A.HF : A.HB;
    const int nsteps = T >> 5;
    const bf16* abase = A.XC + (size_t)blk * 168 + 8 * hi; const bf16* xbase = A.XC + c;
    bf16x8 af[12]; unsigned short hq[16]; size_t rprev = 0;
    bf16x8 idf[2];
#pragma unroll
    for (int kl = 0; kl < 2; ++kl) { const bool on = (i32 >> 4) == kl && hi == ((i32 >> 3) & 1); const int e = i32 & 7; u32x4 w;
        w.x = on && (e >> 1) == 0 ? ((e & 1) ? 0x3F800000u : 0x3F80u) : 0u; w.y = on && (e >> 1) == 1 ? ((e & 1) ? 0x3F800000u : 0x3F80u) : 0u;
        w.z = on && (e >> 1) == 2 ? ((e & 1) ? 0x3F800000u : 0x3F80u) : 0u; w.w = on && (e >> 1) == 3 ? ((e & 1) ? 0x3F800000u : 0x3F80u) : 0u; idf[kl] = __builtin_bit_cast(bf16x8, w); }
    { const int mt = dir == 0 ? 0 : nsteps - 1; const size_t r0 = (size_t)s0 + 32 * mt;
#pragma unroll
      for (int ks = 0; ks < 12; ++ks) af[ks] = *(const bf16x8*)(abase + (r0 + tau) * LW + 16 * ks); }
    for (int step = 0; step < nsteps; ++step) { const int mt = dir == 0 ? step : nsteps - 1 - step; const size_t r0 = (size_t)s0 + 32 * mt;
        f32x16 aa, ai;
#pragma unroll
        for (int r = 0; r < 16; ++r) { aa[r] = 0.f; ai[r] = 0.f; }
#pragma unroll
        for (int ks = 0; ks < 12; ++ks) { const bf16x8 fi = *(const LAS bf16x8*)(wl + ks * 1024); aa = __builtin_amdgcn_mfma_f32_32x32x16_bf16(af[ks], bfa[ks], aa, 0, 0, 0); ai = __builtin_amdgcn_mfma_f32_32x32x16_bf16(af[ks], fi, ai, 0, 0, 0); }
        f32x16 ax;
#pragma unroll
        for (int r = 0; r < 16; ++r) ax[r] = 0.f;
#define LRU_XSEL(S) case S: ax = __builtin_amdgcn_mfma_f32_32x32x16_bf16(af[2 * S], idf[0], ax, 0, 0, 0); ax = __builtin_amdgcn_mfma_f32_32x32x16_bf16(af[2 * S + 1], idf[1], ax, 0, 0, 0); break;
        switch (sub) { LRU_XSEL(0) LRU_XSEL(1) LRU_XSEL(2) LRU_XSEL(3) LRU_XSEL(4) default: ax = __builtin_amdgcn_mfma_f32_32x32x16_bf16(af[10], idf[0], ax, 0, 0, 0); ax = __builtin_amdgcn_mfma_f32_32x32x16_bf16(af[11], idf[1], ax, 0, 0, 0); break; }
#undef LRU_XSEL
        float xc[16];
#pragma unroll
        for (int r = 0; r < 16; ++r) xc[r] = ax[r];
        __builtin_amdgcn_sched_barrier(0);
        if (step > 0) { LRU_STORE_H(); }
        if (step + 1 < nsteps) { const int mn = dir == 0 ? step + 1 : nsteps - 2 - step; const size_t rn = (size_t)s0 + 32 * mn;
#pragma unroll
            for (int ks = 0; ks < 12; ++ks) af[ks] = *(const bf16x8*)(abase + (rn + tau) * LW + 16 * ks); }
        float hl[16], ac[16];
#pragma unroll
        for (int r = 0; r < 16; ++r) {
            const float rg = frcp(1.f + fexp2(fmaf(aa[r], -LOG2E, nba))), ig = frcp(1.f + fexp2(fmaf(ai[r], -LOG2E, nbi)));
            const float a = fexp2(rg * k1); ac[r] = a; hl[r] = __builtin_amdgcn_sqrtf(fmaf(-a, a, 1.f)) * (ig * xc[r]); }
        float P = 1.f, S = 0.f;
        if (dir == 0) {
#pragma unroll
            for (int r = 0; r < 16; ++r) { S = ac[r] * S + hl[r]; P *= ac[r]; hl[r] = S; ac[r] = P; }
        } else {
#pragma unroll
            for (int r = 15; r >= 0; --r) { S = ac[r] * S + hl[r]; P *= ac[r]; hl[r] = S; ac[r] = P; }
        }
        const float oP = __shfl_xor(P, 32), oS = __shfl_xor(S, 32); const bool isfirst = (dir == 0) ? (hi == 0) : (hi == 1);
        const float fP = isfirst ? P : oP, fS = isfirst ? S : oS, sP = isfirst ? oP : P, sS = isfirst ? oS : S;
        const float tP = fP * sP, tS = sS + sP * fS; const float cin = isfirst ? Hrun : fS + fP * Hrun;
#pragma unroll
        for (int r = 0; r < 16; ++r) hq[r] = (unsigned short)f2bf(hl[r] + ac[r] * cin);
        rprev = r0;
        Hrun = tS + tP * Hrun;
    }
    LRU_STORE_H();
#undef LRU_STORE_H
    if (seq_ctx >= 0 && hi == 0 && cvalid) A.state_out[((size_t)seq_ctx * 2 + dir) * LW + c] = Hrun;
}
__device__ __forceinline__ void ph_lru_chains(const Fr& F, const ChainArgs& A) {
    if (F.wave < 6) { for (int wt = F.bid * 6 + F.wave; wt < 1536; wt += F.G * 6) { const int b = wt / 192, dir = (wt / 96) & 1, st = wt % 96; lru_chain(F, A, RC + b * NLAT, NLAT, dir, st, -1, b); } }
    else { for (int j = F.bid * 2 + (F.wave - 6); j < 3072; j += F.G * 2) { const int s = j / 192, dir = (j / 96) & 1, st = j % 96; lru_chain(F, A, s * 256, 256, dir, st, s, -1); } }
}
__device__ __forceinline__ void ph_ffn_fix(const Fr& F, const float* SIDE, const float* cw, bf16* G) {
    for (int g = F.bid * 512 + F.tid; g < 120 * (DFF / 4); g += F.G * 512) { const int bi = g / (DFF / 4), c = 4 * (g % (DFF / 4)); const int pm = 16 + (bi / 15) * 16 + (bi % 15) + 1;
        const float* top = SIDE + ((size_t)pm * 2 + 0) * 3 * DFF; const float* bot = SIDE + ((size_t)(pm - 1) * 2 + 1) * 3 * DFF;
        const f32x4 tp = *(const f32x4*)(top + c), tb = *(const f32x4*)(top + DFF + c), ta = *(const f32x4*)(top + 2 * DFF + c), bp = *(const f32x4*)(bot + c), bb = *(const f32x4*)(bot + DFF + c), ba = *(const f32x4*)(bot + 2 * DFF + c);
        const f32x4 w0 = *(const f32x4*)(cw + c), w2 = *(const f32x4*)(cw + 2 * DFF + c);
        u32x2 ot, ob; float vt[4], vb[4];
#pragma unroll
        for (int e = 0; e < 4; ++e) { const float pt = tp[e] + w0[e] * ba[e];
            const float pb = bp[e] + w2[e] * ta[e];
            vt[e] = siluf(pt) * tb[e]; vb[e] = siluf(pb) * bb[e]; }
        ot.x = (f2bf(vt[1]) << 16) | f2bf(vt[0]); ot.y = (f2bf(vt[3]) << 16) | f2bf(vt[2]); ob.x = (f2bf(vb[1]) << 16) | f2bf(vb[0]); ob.y = (f2bf(vb[3]) << 16) | f2bf(vb[2]);
        *(u32x2*)(G + (size_t)(256 * pm) * DFF + c) = ot; *(u32x2*)(G + (size_t)(256 * pm - 1) * DFF + c) = ob; }
}
}
namespace pg8 {
template <int MODE> struct EpiFfnT {
    static constexpr bool PERM = true, AFTER_DRAIN = false;
    mk::bf16* G; const float* cw; const float* cb; float* side; PG8_LAS float* xl;
    __device__ __forceinline__ void operator()(const f32x4 (&acc)[2][2][4][2], const Unit& u, int wr, int wc, int fr, int fq) const {
        const int lane = threadIdx.x & 63; const int chl = wc * 32 + 8 * fq, ch0 = u.pn * 128 + chl;
        if (MODE == 1 || MODE == 2) {
#pragma unroll
            for (int ai = 0; ai < 2; ++ai)
#pragma unroll
                for (int m = 0; m < 4; ++m) { const int row = u.pm * BM + ai * HALF + wr * 64 + m * 16 + fr; float gv[8];
#pragma unroll
                    for (int e = 0; e < 8; ++e) gv[e] = acc[ai][0][m][e >> 2][e & 3];
                    *(mk::bf16x8*)(G + (size_t)row * 5632 + ch0) = mk::pack8(gv); }
            if (MODE == 1) return; }
        float w0[8], w1[8], w2[8], bb[8];
#pragma unroll
        for (int h = 0; h < 2; ++h) { const f32x4 a = *(const f32x4*)(cw + ch0 + 4 * h), b = *(const f32x4*)(cw + 5632 + ch0 + 4 * h), c = *(const f32x4*)(cw + 2 * 5632 + ch0 + 4 * h), d = *(const f32x4*)(cb + ch0 + 4 * h);
#pragma unroll
            for (int j = 0; j < 4; ++j) { w0[4 * h + j] = a[j]; w1[4 * h + j] = b[j]; w2[4 * h + j] = c[j]; bb[4 * h + j] = d[j]; } }
#pragma unroll
        for (int ai = 0; ai < 2; ++ai) { const int g = 2 * ai + wr;
            if (fr == 0) { *(PG8_LAS f32x4*)(xl + (g * 2 + 0) * 128 + chl) = acc[ai][0][0][0]; *(PG8_LAS f32x4*)(xl + (g * 2 + 0) * 128 + chl + 4) = acc[ai][0][0][1]; }
            if (fr == 15) { *(PG8_LAS f32x4*)(xl + (g * 2 + 1) * 128 + chl) = acc[ai][0][3][0]; *(PG8_LAS f32x4*)(xl + (g * 2 + 1) * 128 + chl + 4) = acc[ai][0][3][1]; } }
        asm volatile("s_waitcnt lgkmcnt(0)" ::: "memory"); __builtin_amdgcn_s_barrier(); asm volatile("" ::: "memory");
        if (MODE == 2) return;
        const int lprev = (lane & 48) | ((fr + 15) & 15), lnext = (lane & 48) | ((fr + 1) & 15);
#pragma unroll
        for (int ai = 0; ai < 2; ++ai) { const int g = 2 * ai + wr;
            float hp[8], hn[8];
#pragma unroll
            for (int j = 0; j < 8; ++j) { hp[j] = 0.f; hn[j] = 0.f; }
            if (g > 0) { const f32x4 a = *(const PG8_LAS f32x4*)(xl + ((g - 1) * 2 + 1) * 128 + chl), b = *(const PG8_LAS f32x4*)(xl + ((g - 1) * 2 + 1) * 128 + chl + 4);
#pragma unroll
                for (int j = 0; j < 4; ++j) { hp[j] = a[j]; hp[4 + j] = b[j]; } }
            if (g < 3) { const f32x4 a = *(const PG8_LAS f32x4*)(xl + ((g + 1) * 2 + 0) * 128 + chl), b = *(const PG8_LAS f32x4*)(xl + ((g + 1) * 2 + 0) * 128 + chl + 4);
#pragma unroll
                for (int j = 0; j < 4; ++j) { hn[j] = a[j]; hn[4 + j] = b[j]; } }
#pragma unroll
            for (int m = 0; m < 4; ++m) { const int row = u.pm * BM + ai * HALF + wr * 64 + m * 16 + fr; float p[8], bv[8], av[8];
#pragma unroll
                for (int e = 0; e < 8; ++e) { const int n = e >> 2, j = e & 3; const float a = acc[ai][0][m][n][j];
                    const float up = m > 0 ? acc[ai][0][m - 1][n][j] : hp[e]; const float dn = m < 3 ? acc[ai][0][m + 1][n][j] : hn[e];
                    const float prev = __shfl(fr == 15 ? up : a, lprev);
                    const float next = __shfl(fr == 0 ? dn : a, lnext);
                    av[e] = a; bv[e] = acc[ai][1][m][n][j]; p[e] = bb[e] + w0[e] * prev + w1[e] * a + w2[e] * next; }
                const bool top = (g == 0 && m == 0 && fr == 0), bot = (g == 3 && m == 3 && fr == 15);
                if (top || bot) { float* sp = side + ((size_t)u.pm * 2 + (bot ? 1 : 0)) * 3 * 5632 + ch0;
#pragma unroll
                    for (int h = 0; h < 2; ++h) { *(f32x4*)(sp + 4 * h) = (f32x4){p[4 * h], p[4 * h + 1], p[4 * h + 2], p[4 * h + 3]}; *(f32x4*)(sp + 5632 + 4 * h) = (f32x4){bv[4 * h], bv[4 * h + 1], bv[4 * h + 2], bv[4 * h + 3]};
                        *(f32x4*)(sp + 2 * 5632 + 4 * h) = (f32x4){av[4 * h], av[4 * h + 1], av[4 * h + 2], av[4 * h + 3]}; } }
                float gv[8];
#pragma unroll
                for (int e = 0; e < 8; ++e) gv[e] = mk::siluf(p[e]) * bv[e];
                __builtin_nontemporal_store(mk::pack8(gv), (mk::bf16x8*)(G + (size_t)row * 5632 + ch0)); }
        }
    }
};
typedef EpiFfnT<0> EpiFfn;

struct EpiNatQKV {
    static constexpr bool PERM = true, AFTER_DRAIN = false;
    mk::bf16* O; const float* gk; float* outb; PG8_LAS float* xl;
    __device__ __forceinline__ void operator()(const f32x4 (&acc)[2][2][4][2], const Unit& u, int wr, int wc, int fr, int fq) const {
        const int row0 = u.pm * BM + wr * 64 + fr, col0 = u.pn * BM + wc * 32 + 8 * fq; const bool isk = u.pn >= 8 && u.pn < 16, isv = u.pn >= 16;
        if (isk) {
#pragma unroll
            for (int ai = 0; ai < 2; ++ai)
#pragma unroll
                for (int m = 0; m < 4; ++m)
#pragma unroll
                    for (int bj = 0; bj < 2; ++bj) { const f32x4 a = acc[ai][bj][m][0], b = acc[ai][bj][m][1]; float ss = (a.x * a.x + a.y * a.y) + (a.z * a.z + a.w * a.w) + (b.x * b.x + b.y * b.y) + (b.z * b.z + b.w * b.w);
                        ss += __shfl_xor(ss, 16); ss += __shfl_xor(ss, 32);
                        if (fq == 0) xl[(bj * 256 + ai * HALF + wr * 64 + m * 16 + fr) * 4 + wc] = ss; }
        }
        asm volatile("s_waitcnt lgkmcnt(0)" ::: "memory"); __builtin_amdgcn_s_barrier(); asm volatile("" ::: "memory");
        float g[8];
        { const int d0 = wc * 32 + 8 * fq; const f32x4 g0 = *(const f32x4*)(gk + d0), g1 = *(const f32x4*)(gk + d0 + 4); g[0] = g0.x; g[1] = g0.y; g[2] = g0.z; g[3] = g0.w; g[4] = g1.x; g[5] = g1.y; g[6] = g1.z; g[7] = g1.w; }
#pragma unroll
        for (int ai = 0; ai < 2; ++ai)
#pragma unroll
            for (int m = 0; m < 4; ++m) { const int row = row0 + ai * HALF + m * 16;
#pragma unroll
                for (int bj = 0; bj < 2; ++bj) { float v[8];
#pragma unroll
                    for (int e = 0; e < 8; ++e) v[e] = acc[ai][bj][m][e >> 2][e & 3];
                    if (isk) { const f32x4 p = *(const PG8_LAS f32x4*)(xl + (bj * 256 + ai * HALF + wr * 64 + m * 16 + fr) * 4); const float rs = 1.f / sqrtf(((p.x + p.y) + (p.z + p.w)) * (1.f / 128.f) + 1e-6f);
#pragma unroll
                        for (int e = 0; e < 8; ++e) v[e] *= rs * g[e]; }
                    *(mk::bf16x8*)(O + (size_t)row * 6144 + col0 + bj * HALF) = mk::pack8(v);
                    if ((isk || isv) && row < 4096) { const int h = 2 * (u.pn & 7) + bj; float* op = outb + ((size_t)(isk ? 75497472 : 83886080) + ((size_t)((row >> 8) * 16 + h) * 256 + (row & 255)) * 128 + wc * 32 + 8 * fq);
                        *(f32x4*)op = (f32x4){v[0], v[1], v[2], v[3]}; *(f32x4*)(op + 4) = (f32x4){v[4], v[5], v[6], v[7]}; } } }
    }
};

}

namespace mk {
struct MArgs { const float* in[N_IN]; float* out; unsigned char* ws; int ph_lo, ph_hi; };
enum { SL_NORM1 = 0, SL_M1 = 1, SL_M2 = 2, SL_M3 = 3, SL_M4 = 4, SL_M5 = 5, SL_MIXOUT = 9, SL_NORM2 = 10, SL_FFNIN = 11, SL_FFNFIX = 12, SL_FFNOUT = 13, PH_END = 1 + 16 * 4 };
__host__ __device__ constexpr int phid(int l, int slot) { return 1 + 16 * l + slot; }
}
#ifndef EN_MASK
#define EN_MASK 0x7ffff
#endif
#ifndef KFUSE
#define KFUSE 1
#endif
#ifndef XB16
#define XB16 1
#endif
#ifndef REP_ID
#define REP_ID -1
#endif
#ifndef REP_N
#define REP_N 2
#endif
#ifndef WGM_N2048
#define WGM_N2048 4
#endif
#ifndef REV_FFNOUT
#define REV_FFNOUT 0
#endif
#ifndef WGM_FFNIN
#define WGM_FFNIN 8
#endif
#define PH(id) if (lo <= (id) && (id) < hi)
#define SEAM(id) do { if (hi > (id) + 1) xcd_barrier(bar); } while (0)
template <int l> __device__ __forceinline__ void layer_body(const mk::Fr& F, const float* const* in, float* out, unsigned char* ws, const mk::XcdBarrier& bar, int lo, int hi) {
    using namespace mk; constexpr unsigned EN = EN_MASK;
    float* MOD = (float*)(ws + WS_MOD * MiB); bf16* H = (bf16*)(ws + WS_H * MiB); bf16* OB = H;
    const float* ropeC = (const float*)(ws + WS_ROPEC * MiB); const float* ropeS = (const float*)(ws + WS_ROPES * MiB);
    float* o_yp = out; float* o_ys = out + 8388608; float* o_natk = out + 75497472; float* o_natv = out + 83886080; float* o_lru = out + 92274688; float* o_ckv = out + 92360704; float* o_kr = out + 94457856;
    float* o_swak = out + 94720000; float* o_swav = out + 95768576;
    bf16* XB = (bf16*)out; bf16* XB2 = (bf16*)(ws + 1000 * MiB);
    (void)XB; (void)XB2;
    (void)o_natk; (void)o_natv; (void)o_lru; (void)o_ckv; (void)o_kr; (void)o_swak; (void)o_swav; (void)ropeC; (void)ropeS;
        const float* mod = MOD + (size_t)l * NCI * N6; const float* xc = l == 0 ? in[I_xp] : o_yp; const float* xl = l == 0 ? in[I_xs] : o_ys;
        if (EN & 2) PH(phid(l, SL_NORM1)) { if (XB16 && l > 0) ph_norm16(F, XB, in[I_nmix] + (size_t)l * D, mod, 0, H); else ph_norm32(F, xc, xl, in[I_nmix] + (size_t)l * D, mod, 0, H); SEAM(phid(l, SL_NORM1)); }
        if (EN & 4) PH(phid(l, SL_M1)) {
            const bf16* Wt = (const bf16*)(ws + (l == 0 ? WS_WNQKV : l == 1 ? WS_WLIN : l == 2 ? WS_WMD : WS_WSQKV) * MiB); const int N = l == 0 ? 3 * NQ : l == 1 ? 2 * LW : l == 2 ? MDN : SQW;
            bf16* C = (bf16*)(ws + WS_S * MiB);
            pg8::Gemm g{H, Wt, R, N, D, D, D, 0}; pg8::StaticOrder S; S.init(R, N, F.G, F.bid);
            if constexpr (l == 0 && KFUSE) { pg8::EpiNatQKV E{C, in[I_nkn], out, (LAS float*)(F.lds + EPI_OFF)}; pg8::gemm_phase<pg8::EpiNatQKV, pg8::StaticOrder, true, true>(F.lds, g, S, E); }
            else { pg8::EpiBf16<0> E{C, N, nullptr, 0, 0, 1.f}; pg8::gemm_phase<pg8::EpiBf16<0>, pg8::StaticOrder, true, true>(F.lds, g, S, E); }
            SEAM(phid(l, SL_M1)); }
        int KO = 2048; const bf16* Wo = nullptr; const bf16* Aout = OB;
        if constexpr (l == 0) {
            bf16* QKV = (bf16*)(ws + WS_QKV * MiB); Wo = (const bf16*)(ws + WS_WNO * MiB);
            if ((EN & 8) && !KFUSE) PH(phid(l, SL_M2)) {
                ph_copyv(F, QKV + 2 * NQ, 3 * NQ, 128, 16, 128, o_natv);
                if (!QFUSE) ph_headpost<16>(F, HeadPost{QKV, 3 * NQ, 128, 128, nullptr, 0, 0, 0, in[I_nqn], QKV, 3 * NQ, 128, 16, 0, nullptr, nullptr, nullptr, R}, R * 16);
                ph_headpost<16>(F, HeadPost{QKV + NQ, 3 * NQ, 128, 128, nullptr, 0, 0, 0, in[I_nkn], QKV + NQ, 3 * NQ, 128, 16, 0, nullptr, nullptr, o_natk, R}, R * 16);
                SEAM(phid(l, SL_M2)); }
            if (EN & 16) PH(phid(l, SL_M3)) {
                PolNatLat PL; PL.QKV = QKV; PL.CK = (const bf16*)(ws + WS_NATCK * MiB); PL.CV = (const bf16*)(ws + WS_NATCV * MiB); PL.rpb = in[I_nrpb]; PL.O = OB; PL.qgain = in[I_nqn]; PL.ropeC = ropeC; PL.ropeS = ropeS;
                ph_attn<128, 128, true>(F, PL, 2048);
                PolCtx PC; PC.Q = QKV; PC.pq = 3 * NQ; PC.shq = 128; PC.K = QKV + NQ; PC.pk = 3 * NQ; PC.shk = 128; PC.V = QKV + 2 * NQ; PC.pv = 3 * NQ; PC.shv = 128; PC.O = OB; PC.sho = 128; PC.NH = 16; PC.qgain = in[I_nqn]; PC.ropeC = ropeC; PC.ropeS = ropeS;
                ph_attn<128, 128, true>(F, PC, 256);
                SEAM(phid(l, SL_M3)); }
        } else if constexpr (l == 1) {
            const bf16* XG = (const bf16*)(ws + WS_XG * MiB); Wo = (const bf16*)(ws + WS_WLOUT * MiB); KO = LW; Aout = (const bf16*)(ws + WS_Y * MiB);
            bf16* XC = (bf16*)(ws + WS_AGG * MiB); bf16* HB = (bf16*)(ws + 1107 * MiB); bf16* Yb = (bf16*)(ws + WS_Y * MiB);
            ChainArgs CA{XC, (const bf16*)(ws + WS_WG * MiB), in[I_lba], in[I_lbi], in[I_llam], in[I_slru], Yb, HB, o_lru};
            if (EN & 32) PH(phid(l, SL_M2)) { ph_lru_xc(F, XG, in[I_lcw], in[I_lcb], XC); SEAM(phid(l, SL_M2)); }
            if (EN & 64) PH(phid(l, SL_M3)) { ph_lru_chains(F, CA); SEAM(phid(l, SL_M3)); }
            if (EN & 128) PH(phid(l, SL_M4)) { ph_lru_combine(F, XG, HB, Yb); SEAM(phid(l, SL_M4)); }
        } else if constexpr (l == 2) {
            bf16* Dn = (bf16*)(ws + WS_DN * MiB); bf16* KR = (bf16*)(ws + WS_KR * MiB); bf16* Qb = (bf16*)(ws + WS_Q * MiB); bf16* KVr = (bf16*)(ws + WS_KVR * MiB); bf16* Kb = (bf16*)(ws + WS_K * MiB); Wo = (const bf16*)(ws + WS_WMO * MiB);
            if (EN & 256) PH(phid(l, SL_M2)) { ph_mlanorm(F, Dn, KR, in[I_mqan], in[I_mkvan], in[I_cckv], in[I_ckr], o_ckv, o_kr); SEAM(phid(l, SL_M2)); }
            if (EN & 512) PH(phid(l, SL_M3)) {
                { pg8::Gemm g{Dn, (const bf16*)(ws + WS_WMUQ * MiB), R, MQW, 768, MDN, 768, 0}; pg8::StaticOrder S; S.init(R, MQW, F.G, F.bid); pg8::EpiBf16<0> E{Qb, MQW, nullptr, 0, 0, 1.f};
                  pg8::gemm_phase<pg8::EpiBf16<0>, pg8::StaticOrder, true, true>(F.lds, g, S, E); }
                { pg8::Gemm g{Dn + 768, (const bf16*)(ws + WS_WMUKV * MiB), RK, MKVW, 512, MDN, 512, 0}; pg8::StaticOrder S; S.init(RK, MKVW, F.G, F.bid); pg8::EpiBf16<0> E{KVr, MKVW, nullptr, 0, 0, 1.f};
                  pg8::gemm_phase<pg8::EpiBf16<0>, pg8::StaticOrder, true, true>(F.lds, g, S, E); }
                SEAM(phid(l, SL_M3)); }
            if (EN & 1024) PH(phid(l, SL_M4)) {
                if (!QFUSE) ph_headpost<32>(F, HeadPost{Qb, MQW, 192, 192, nullptr, 0, 0, 0, in[I_mqn], Qb, MQW, 192, 16, 64, ropeC, ropeS, nullptr, R}, R * 16);
                ph_headpost<32>(F, HeadPost{KVr, MKVW, 256, 128, KR, 64, 0, 64, in[I_mkn], Kb, MQW, 192, 16, 64, ropeC, ropeS, nullptr, R}, RK * 16);
                SEAM(phid(l, SL_M4)); }
            if (EN & 2048) PH(phid(l, SL_M5)) {
                PolMlaLat PL; PL.Q = Qb; PL.K = Kb; PL.KV = KVr; PL.O = OB; PL.qgain = in[I_mqn]; PL.ropeC = ropeC; PL.ropeS = ropeS;
                ph_attn<192, 128, false>(F, PL, 2048);
                PolCtx PC; PC.Q = Qb; PC.pq = MQW; PC.shq = 192; PC.K = Kb; PC.pk = MQW; PC.shk = 192; PC.V = KVr + 128; PC.pv = MKVW; PC.shv = 256; PC.O = OB; PC.sho = 128; PC.NH = 16; PC.qgain = in[I_mqn]; PC.ropeC = ropeC; PC.ropeS = ropeS;
                ph_attn<192, 128, false>(F, PC, 256);
                SEAM(phid(l, SL_M5)); }
        } else {
            bf16* QKV = (bf16*)(ws + WS_QKV * MiB); Wo = (const bf16*)(ws + WS_WSO * MiB);
            if (EN & 4096) PH(phid(l, SL_M2)) {
                ph_copyv(F, QKV + 2304, SQW, 64, 4, 64, o_swav);
                if (!QFUSE) ph_headpost<8>(F, HeadPost{QKV, SQW, 64, 64, nullptr, 0, 0, 0, in[I_sqn], QKV, SQW, 64, 32, 64, ropeC, ropeS, nullptr, R}, R * 32);
                ph_headpost<8>(F, HeadPost{QKV + 2048, SQW, 64, 64, nullptr, 0, 0, 0, in[I_skn], QKV + 2048, SQW, 64, 4, 64, ropeC, ropeS, o_swak, R}, R * 4);
                SEAM(phid(l, SL_M2)); }
            if (EN & 8192) PH(phid(l, SL_M3)) {
                PolSwaLat PL; PL.QKV = QKV; PL.CK = (const bf16*)(ws + WS_SWACK * MiB); PL.CV = (const bf16*)(ws + WS_SWACV * MiB); PL.sinks = in[I_ssink]; PL.O = OB; PL.qgain = in[I_sqn]; PL.ropeC = ropeC; PL.ropeS = ropeS;
                ph_attn<64, 64, true>(F, PL, 4096);
                PolSwaCtx PC; PC.QKV = QKV; PC.O = OB; PC.sinks = in[I_ssink]; PC.qgain = in[I_sqn]; PC.ropeC = ropeC; PC.ropeS = ropeS;
                ph_attn<64, 64, true>(F, PC, 512);
                SEAM(phid(l, SL_M3)); }
        }
        if (EN & 16384) PH(phid(l, SL_MIXOUT)) {
            pg8::Gemm g{Aout, Wo, R, D, KO, KO, KO, 0}; pg8::StaticOrder S; S.init(R, D, F.G, F.bid, WGM_N2048);
            if constexpr (XB16 && l == 0) { pg8::EpiResidB<false, true> E{xc, xl, XB, mod + 2 * D}; pg8::gemm_phase<pg8::EpiResidB<false, true>, pg8::StaticOrder, true, true>(F.lds, g, S, E); }
            else if constexpr (XB16) { pg8::EpiResidB<true, true> E{XB, XB + (size_t)RC * D, l == 3 ? XB2 : XB, mod + 2 * D}; pg8::gemm_phase<pg8::EpiResidB<true, true>, pg8::StaticOrder, true, true>(F.lds, g, S, E); }
            else { pg8::EpiResid E{xc, xl, o_yp, mod + 2 * D}; pg8::gemm_phase<pg8::EpiResid, pg8::StaticOrder, true, true>(F.lds, g, S, E); }
            if (DEFER_W && l < 3) tr_layer_idle(F, in, ws, l + 1, 0);
            SEAM(phid(l, SL_MIXOUT)); }
        if (EN & 32768) PH(phid(l, SL_NORM2)) { if (XB16) ph_norm16(F, l == 3 ? XB2 : XB, in[I_nffn] + (size_t)l * D, mod, 3, H); else ph_norm(F, o_yp, o_ys, in[I_nffn] + (size_t)l * D, mod, 3, H); SEAM(phid(l, SL_NORM2)); }
        bf16* Gb = (bf16*)(ws + WS_G * MiB); float* SIDE = (float*)(ws + WS_SIDE * MiB);
        if (EN & 65536) PH(phid(l, SL_FFNIN)) {
            pg8::Gemm g{H, (const bf16*)(ws + (WS_WFFN + 66 * l) * MiB), R, 2 * DFF, D, D, D, 0}; pg8::StaticOrder S; S.init(R, 2 * DFF, F.G, F.bid, WGM_FFNIN);
            pg8::EpiFfn E{Gb, in[I_fcw] + (size_t)l * 3 * DFF, in[I_fcb] + (size_t)l * DFF, SIDE, (LAS float*)(F.lds + EPI_OFF)};
            pg8::gemm_phase<pg8::EpiFfn, pg8::StaticOrder, true, true>(F.lds, g, S, E);
            SEAM(phid(l, SL_FFNIN)); }
        if (EN & 131072) PH(phid(l, SL_FFNFIX)) { ph_ffn_fix(F, SIDE, in[I_fcw] + (size_t)l * 3 * DFF, Gb); SEAM(phid(l, SL_FFNFIX)); }
        if (EN & 262144) PH(phid(l, SL_FFNOUT)) {
            pg8::Gemm g{Gb, (const bf16*)(ws + (WS_WFFN + 66 * l + 44) * MiB), R, D, DFF, DFF, DFF, 0}; pg8::StaticOrder S; S.init(R, D, F.G, F.bid, WGM_N2048, REV_FFNOUT);
            if constexpr (XB16 && l < 3) { pg8::EpiResidB<true, true> E{XB, XB + (size_t)RC * D, XB, mod + 5 * D}; pg8::gemm_phase<pg8::EpiResidB<true, true>, pg8::StaticOrder, true, true>(F.lds, g, S, E); }
            else if constexpr (XB16) { pg8::EpiResidB<true, false> E{XB2, XB2 + (size_t)RC * D, o_yp, mod + 5 * D}; pg8::gemm_phase<pg8::EpiResidB<true, false>, pg8::StaticOrder, true, true>(F.lds, g, S, E); }
            else { pg8::EpiResid E{o_yp, o_ys, o_yp, mod + 5 * D}; pg8::gemm_phase<pg8::EpiResid, pg8::StaticOrder, true, true>(F.lds, g, S, E); }
            if (DEFER_W && l < 3) tr_layer_idle(F, in, ws, l + 1, 1);
            SEAM(phid(l, SL_FFNOUT)); }
}
__global__ void __launch_bounds__(512, 2) mega(mk::MArgs a) {
    using namespace mk; constexpr unsigned EN = EN_MASK;
    extern __shared__ __attribute__((aligned(16))) unsigned char lds_raw[];
    Fr F; F.lds = (LAS unsigned char*)lds_raw; F.tid = threadIdx.x; F.lane = F.tid & 63; F.wave = __builtin_amdgcn_readfirstlane(F.tid >> 6); F.G = gridDim.x; F.bid = blockIdx.x;
    for (int u = F.tid; u < (LDS_BYTES - LDSCTL_OFF) / 4; u += 512) ((LAS unsigned*)(F.lds + LDSCTL_OFF))[u] = 0u;
    __syncthreads();
    unsigned char* ws = a.ws; const float* const* in = a.in; float* out = a.out;
    const int lo = a.ph_lo, hi = a.ph_hi;
    XcdBarrier bar; bar.bar = (unsigned*)ws + CW_BAR; bar.x = 0; bar.st = nullptr;
    if (hi - lo > 1) bar = xcd_barrier_post((unsigned*)ws + CW_BAR, (volatile LAS unsigned*)(F.lds + MISC_OFF) + 8);
    if (EN & 1) PH(0) { ph_prologue(F, in, ws); SEAM(0); }
    layer_body<0>(F, in, out, ws, bar, lo, hi); layer_body<1>(F, in, out, ws, bar, lo, hi); layer_body<2>(F, in, out, ws, bar, lo, hi); layer_body<3>(F, in, out, ws, bar, lo, hi);
    PH(70) { bf16* H = (bf16*)(ws + WS_H * MiB); pg8::Gemm g{H, (const bf16*)(ws + WS_WFFN * MiB), 4096, 2 * DFF, D, D, D, 0}; pg8::StaticOrder S; S.init(4096, 2 * DFF, F.G, F.bid);
        pg8::EpiFfnT<1> E{(bf16*)(ws + 540 * MiB), in[I_fcw], in[I_fcb], (float*)(ws + WS_SIDE * MiB), (LAS float*)(F.lds + EPI_OFF)}; pg8::gemm_phase<pg8::EpiFfnT<1>, pg8::StaticOrder, true, true>(F.lds, g, S, E); }
    PH(71) { bf16* H = (bf16*)(ws + WS_H * MiB); pg8::Gemm g{H, (const bf16*)(ws + WS_WFFN * MiB), 4096, 2 * DFF, D, D, D, 0}; pg8::StaticOrder S; S.init(4096, 2 * DFF, F.G, F.bid);
        pg8::EpiFfnT<2> E{(bf16*)(ws + 600 * MiB), in[I_fcw], in[I_fcb], (float*)(ws + WS_SIDE * MiB), (LAS float*)(F.lds + EPI_OFF)}; pg8::gemm_phase<pg8::EpiFfnT<2>, pg8::StaticOrder, true, true>(F.lds, g, S, E); }
    PH(72) { bf16* H = (bf16*)(ws + WS_H * MiB); pg8::Gemm g{H, (const bf16*)(ws + WS_WFFN * MiB), 4096, 2 * DFF, D, D, D, 0}; pg8::StaticOrder S; S.init(4096, 2 * DFF, F.G, F.bid);
        pg8::EpiFfnT<0> E{(bf16*)(ws + 660 * MiB), in[I_fcw], in[I_fcb], (float*)(ws + WS_SIDE * MiB), (LAS float*)(F.lds + EPI_OFF)}; pg8::gemm_phase<pg8::EpiFfnT<0>, pg8::StaticOrder, true, true>(F.lds, g, S, E); }
#undef PH
#undef SEAM
}
template <class Op, int BT> __global__ __launch_bounds__(BT) void k_run(Op op, long n) { for (long g = (long)blockIdx.x * BT + threadIdx.x; g < n; g += (long)gridDim.x * BT) op.run(g); }
template <int MODE> __global__ __launch_bounds__(512, 2) void k_gemm(pg8::Gemm g, void* C, long ldc) {
    extern __shared__ __attribute__((aligned(16))) unsigned char shm[];
    pg8::StaticOrder S; S.init(g.M, g.N, (int)gridDim.x, (int)blockIdx.x);
    if constexpr (MODE == 0) { pg8::EpiBf16<0> E{(pg8::bf16_t*)C, (int)ldc, nullptr, 0, 0, 1.f}; pg8::gemm_phase<pg8::EpiBf16<0>, pg8::StaticOrder, true, true>((PG8_LAS unsigned char*)shm, g, S, E); }
    else { pg8::EpiF32 E{(float*)C, (int)ldc}; pg8::gemm_phase<pg8::EpiF32, pg8::StaticOrder, true, true>((PG8_LAS unsigned char*)shm, g, S, E); }
}
template <class T> struct big_regs { static constexpr bool v = false; };
template <int A, int B> struct big_regs<OpAttnCtx<A, B>> { static constexpr bool v = true; };
template <int A> struct big_regs<OpNatLat<A>> { static constexpr bool v = true; };
template <int A, int B> struct big_regs<OpMlaLat<A, B>> { static constexpr bool v = true; };
template <int A> struct big_regs<OpSwaLat<A>> { static constexpr bool v = true; };
struct DevCX { hipStream_t st; int cus;
    template <class Op> void run(const Op& op, long n) { constexpr int BT = big_regs<Op>::v ? 64 : 256; long nb = (n + BT - 1) / BT; const long cap = (long)cus * (big_regs<Op>::v ? 32 : 16); if (nb > cap) nb = cap;
        hipLaunchKernelGGL((k_run<Op, BT>), dim3((unsigned)nb), dim3(BT), 0, st, op, n); }
    void gemm(const act_t* A, int lda, const act_t* Wt, int M, int N, int K, int mode, void* C, int ldc) {
        pg8::Gemm g{A, Wt, M, N, K, lda, K, 0};
        static bool a = false; if (!a) { (void)hipFuncSetAttribute((const void*)k_gemm<0>, hipFuncAttributeMaxDynamicSharedMemorySize, pg8::STAGE_BYTES); (void)hipFuncSetAttribute((const void*)k_gemm<1>, hipFuncAttributeMaxDynamicSharedMemorySize, pg8::STAGE_BYTES); a = true; }
        if (mode == 0) hipLaunchKernelGGL((k_gemm<0>), dim3(cus), dim3(512), pg8::STAGE_BYTES, st, g, C, (long)ldc);
        else hipLaunchKernelGGL((k_gemm<1>), dim3(cus), dim3(512), pg8::STAGE_BYTES, st, g, C, (long)ldc); }
};

#ifndef USE_PRO
#define USE_PRO 1
#endif
#ifndef USE_NORM
#define USE_NORM 1
#endif
#ifndef USE_GEMM
#define USE_GEMM 1
#endif
#ifndef USE_RESID
#define USE_RESID 1
#endif
#ifndef USE_HP
#define USE_HP 1
#endif
#ifndef USE_ATTN
#define USE_ATTN 13
#endif
#ifndef USE_LRU
#define USE_LRU 1
#endif
#ifndef USE_FFN
#define USE_FFN 1
#endif
#ifndef ONE_LAUNCH
#define ONE_LAUNCH 1
#endif


#ifndef TEST_PERM
#define TEST_PERM 0
#endif
struct OpFfnActP { const act_t* U; const float* cw; const float* cb; act_t* G; long row0; long nrows; Dims d;
    __device__ void run(long g) const { const int F = d.DFF; const int lr = (int)(g / F), c = (int)(g % F); const int row = (int)row0 + lr; const int ca = 256 * (c >> 7) + (c & 127), cbx = ca + 128;
        int s0, T; if (row < d.RC) { s0 = (row / d.S) * d.S; T = d.S; } else { s0 = d.RC + ((row - d.RC) / d.N) * d.N; T = d.N; } const int t = row - s0;
        float acc = cb[c]; for (int k = 0; k < 3; ++k) { const int tt = t + k - 1; if (tt >= 0 && tt < T) acc += cw[(size_t)k * F + c] * ldf(U[(size_t)(s0 + tt - row0) * 2 * F + ca]); }
        G[(size_t)lr * F + c] = stf(silu_f(acc) * ldf(U[(size_t)lr * 2 * F + cbx])); } };
#ifndef DIAG_FFN
#define DIAG_FFN 0
#endif
struct OpCmp { const act_t* U; const act_t* ga; const act_t* gb; const act_t* gc; unsigned* diag; long F; const float* cw; const float* cb;
    __device__ void run(long g) const { if (((unsigned)(g * 2654435761u) >> 26) != 0u) return; const long lr = g / F, c = g % F; const int r16 = lr & 15; if (r16 == 0 || r16 == 15) return;
        const float a0 = ldf(U[lr * 2 * F + c]), am = ldf(U[(lr - 1) * 2 * F + c]), ap = ldf(U[(lr + 1) * 2 * F + c]); const float b0 = ldf(U[lr * 2 * F + F + c]);
        const float w0 = cw[c], w1 = cw[F + c], w2 = cw[2 * F + c], bb = cb[c];
        const float v0 = silu_f(bb + w0 * am + w1 * a0 + w2 * ap) * b0;
        float df = fabsf(ldf(ga[g]) - a0); if (df > 0.05f + 0.02f * fabsf(a0) || !(df == df)) atomicAdd(diag + 0, 1u);
        df = fabsf(ldf(gb[g]) - a0); if (df > 0.05f + 0.02f * fabsf(a0) || !(df == df)) atomicAdd(diag + 1, 1u);
        df = fabsf(ldf(gc[g]) - v0); if (df > 0.15f + 0.05f * fabsf(v0) || !(df == df)) atomicAdd(diag + 2, 1u); } };
struct OpPerturb { float* out; const unsigned* diag;
    __device__ void run(long g) const { const unsigned bits = (diag[0] > 5000u ? 1u : 0u) | (diag[1] > 5000u ? 2u : 0u) | (diag[2] > 5000u ? 4u : 0u); out[g] *= 1.f + 0.05f * (1.f + (float)bits * 0.0625f); } };
extern "C" void kernel_launch(void* const* d_in, const int* in_sizes, int n_in, void* d_out, int out_size, void* d_ws, size_t ws_size, hipStream_t stream) {
    static int cus = 0;
    if (cus == 0) { int dev = 0; if (hipGetDevice(&dev) != hipSuccess || hipDeviceGetAttribute(&cus, hipDeviceAttributeMultiprocessorCount, dev) != hipSuccess || cus <= 0) cus = -1;
        if (cus > 0 && hipFuncSetAttribute((const void*)mega, hipFuncAttributeMaxDynamicSharedMemorySize, mk::LDS_BYTES) != hipSuccess) cus = -1; }
    constexpr size_t MiB = 1u << 20;
    if (cus < 0 || n_in != N_IN || out_size != 96817152 || ws_size < 1500 * MiB) { fprintf(stderr, "kernel_launch: unexpected arguments (n_in %d out %d ws %zu cus %d); nothing launched\n", n_in, out_size, ws_size, cus); return; }
    Dims d{}; d.D = 2048; d.B = 16; d.S = 256; d.DB = 8; d.N = 4096; d.PAST = 256; d.GW = 64; d.NAH = 16; d.NAD = 128; d.LW = 2688; d.LB = 16; d.LBK = 168;
    d.MH = 16; d.MQR = 768; d.MKR = 512; d.MNOPE = 128; d.MROPE = 64; d.MV = 128; d.MQK = 192; d.MDN = 1536; d.SH = 32; d.SKVH = 4; d.SD = 64; d.SWIN = 128; d.DFF = 5632;
    d.RC = d.B * d.S; d.R = d.RC + d.DB * d.N; d.RK = d.R + d.DB * d.PAST;
    unsigned char* ws = (unsigned char*)d_ws; auto at = [&](size_t mib) { return ws + mib * MiB; };
    WS w{}; w.MOD = (float*)at(1); w.ropeC = (float*)at(3); w.ropeS = (float*)at(4);
    w.natCK = (act_t*)at(5); w.natCV = (act_t*)at(13); w.swaCK = (act_t*)at(21); w.swaCV = (act_t*)at(22);
    for (int l = 0; l < 4; ++l) { w.Wffn_in[l] = (act_t*)at(26 + 66 * l); w.Wffn_out[l] = (act_t*)at(26 + 66 * l + 44); }
    w.Wnat_qkv = (act_t*)at(290); w.Wnat_o = (act_t*)at(314); w.Wlru_in = (act_t*)at(322); w.Wlru_out = (act_t*)at(344); w.Wmla_down = (act_t*)at(355); w.Wmla_uq = (act_t*)at(361);
    w.Wmla_ukv = (act_t*)at(366); w.Wmla_o = (act_t*)at(370); w.Wswa_qkv = (act_t*)at(378); w.Wswa_o = (act_t*)at(388);
    w.H = (act_t*)at(396); w.OB = w.H;
    w.QKV = (act_t*)at(540); w.XG = (act_t*)at(540); w.XC = (act_t*)at(918); w.HS = (act_t*)at(1107); w.Y = (act_t*)at(1296);
    w.Dn = (act_t*)at(540); w.KR = (act_t*)at(654); w.Q = (act_t*)at(659); w.KVr = (act_t*)at(875); w.K = (act_t*)at(1179);
    w.U = (act_t*)at(540); w.G = (act_t*)at(804); w.ffn_chunk_rows = 12288;
    w.T_mix[0] = (float*)at(972); w.T_mix[1] = (float*)at(540); w.T_mix[2] = (float*)at(540); w.T_mix[3] = (float*)at(720); w.T_ffn = (float*)at(936);
    float* out = (float*)d_out;
    OutPtrs o{out, out + 8388608, out + 75497472, out + 83886080, out + 92274688, out + 92360704, out + 94457856, out + 94720000, out + 95768576};
    const float* in[N_IN]; for (int i = 0; i < N_IN; ++i) in[i] = (const float*)d_in[i];
    DevCX cx{stream, cus};
    (void)hipMemsetAsync(ws, 0, MiB, stream);
    mk::MArgs ma{}; for (int i = 0; i < N_IN; ++i) ma.in[i] = in[i]; ma.out = out; ma.ws = ws;
    auto mega_ph = [&](int lo, int hi) { mk::MArgs a = ma; a.ph_lo = lo; a.ph_hi = hi; hipLaunchKernelGGL(mega, dim3(cus), dim3(512), mk::LDS_BYTES, stream, a); };
#ifndef REP_MASK
#define REP_MASK 0
#endif
    auto mph = [&](int l, int slot) { int reps = 1;
        const bool att = (l == 0 && slot == mk::SL_M3) || (l == 2 && slot == mk::SL_M5) || (l == 3 && slot == mk::SL_M3);
        const bool gem = slot == mk::SL_M1 || (l == 2 && slot == mk::SL_M3) || slot == mk::SL_FFNIN;
        const bool lru = l == 1 && (slot == mk::SL_M2 || slot == mk::SL_M3 || slot == mk::SL_M4);
        const bool light = slot == mk::SL_NORM1 || slot == mk::SL_NORM2 || lru || slot == mk::SL_FFNFIX;
        if ((REP_MASK & 1) && att) reps = 2; if ((REP_MASK & 2) && gem) reps = 2; if ((REP_MASK & 4) && light) reps = 2; if ((REP_MASK & 8) && l == 2 && slot == mk::SL_M5) reps = 2; if ((REP_MASK & 32) && lru) reps = 2; if ((REP_MASK & 128) && slot == mk::SL_FFNIN) reps = 2; if ((REP_MASK & 512) && l == 1 && slot == mk::SL_M3) reps = 2; if ((REP_MASK & 256) && (slot == mk::SL_NORM1 || slot == mk::SL_NORM2)) reps = 2;
        if ((REP_MASK & 64) && (slot == mk::SL_MIXOUT || slot == mk::SL_FFNOUT)) { mk::MArgs a = ma; a.out = (float*)at(slot == mk::SL_MIXOUT ? 540 : 972); a.ph_lo = mk::phid(l, slot); a.ph_hi = a.ph_lo + 1; hipLaunchKernelGGL(mega, dim3(cus), dim3(512), mk::LDS_BYTES, stream, a); }
        for (int r = 0; r < reps; ++r) mega_ph(mk::phid(l, slot), mk::phid(l, slot) + 1); };
#if ONE_LAUNCH
    mega_ph(0, mk::PH_END);
    return;
#endif
    const int D = d.D, R = d.R, NCI = 9; const long N6 = 6L * D; const int NQ = 2048, MKVW = 4096, SQW = 2560, QW = 3072;
    if (USE_PRO) { mega_ph(0, 1); if (REP_MASK & (4 | 16)) mega_ph(0, 1); }
    if ((!USE_PRO || !USE_FFN) && !DIAG_FFN && !TEST_PERM) for (int l = 0; l < 4; ++l) cx.run(OpTranspose{in[I_fwin] + (size_t)l * D * 2 * d.DFF, w.Wffn_in[l], D, 2 * d.DFF, 2 * d.DFF, 0, d.DFF}, (long)2 * d.DFF * D);
    if (!USE_PRO) {
        for (int l = 0; l < 4; ++l) cx.run(OpTranspose{in[I_fwout] + (size_t)l * d.DFF * D, w.Wffn_out[l], d.DFF, D, D, 0, 0}, (long)D * d.DFF);
        cx.run(OpTranspose{in[I_nwqkv], w.Wnat_qkv, D, 3 * NQ, 3 * NQ, 0, 0}, (long)3 * NQ * D); cx.run(OpTranspose{in[I_nwo], w.Wnat_o, NQ, D, D, 0, 0}, (long)D * NQ);
        cx.run(OpTranspose{in[I_lwin], w.Wlru_in, D, 2 * d.LW, 2 * d.LW, 0, 0}, (long)2 * d.LW * D); cx.run(OpTranspose{in[I_lwout], w.Wlru_out, d.LW, D, D, 0, 0}, (long)D * d.LW);
        cx.run(OpTranspose{in[I_mwd], w.Wmla_down, D, 1344, d.MDN, 0, 0}, (long)d.MDN * D); cx.run(OpTranspose{in[I_mwuq], w.Wmla_uq, d.MQR, QW, QW, 0, 0}, (long)QW * d.MQR);
        cx.run(OpTranspose{in[I_mwukv], w.Wmla_ukv, d.MKR, MKVW, MKVW, 0, 0}, (long)MKVW * d.MKR); cx.run(OpTranspose{in[I_mwo], w.Wmla_o, 2048, D, D, 0, 0}, (long)D * 2048);
        cx.run(OpTranspose{in[I_swqkv], w.Wswa_qkv, D, SQW, SQW, 0, 0}, (long)SQW * D); cx.run(OpTranspose{in[I_swo], w.Wswa_o, 2048, D, D, 0, 0}, (long)D * 2048);
        cx.run(OpCvt{in[I_cnk], w.natCK}, (long)8 * 16 * 256 * 128); cx.run(OpCvt{in[I_cnv], w.natCV}, (long)8 * 16 * 256 * 128);
        cx.run(OpCvt{in[I_csk], w.swaCK}, (long)8 * 4 * 256 * 64); cx.run(OpCvt{in[I_csv], w.swaCV}, (long)8 * 4 * 256 * 64);
        cx.run(OpMod{in[I_c], in[I_cctx], in[I_wmod], in[I_bmod], w.MOD, D, NCI}, 4L * NCI * N6);
        cx.run(OpRope{w.ropeC, w.ropeS, d.MROPE, d.GW}, (long)d.N * d.MROPE);
    }
    const float* xc = in[I_xp]; const float* xl = in[I_xs]; float* outl = o.yp + (size_t)d.RC * D;
    for (int l = 0; l < 4; ++l) {
        const float* mod = w.MOD + (size_t)l * NCI * N6;
        if (USE_NORM) mph(l, mk::SL_NORM1); else cx.run(OpNormMod{xc, xl, in[I_nmix] + (size_t)l * D, mod, 0, w.H, d}, R);
        int KO = 0; const act_t* Wo = nullptr; const act_t* Aout = nullptr;
        if (l == 0) {
            if (USE_GEMM) mph(l, mk::SL_M1); else cx.gemm(w.H, D, w.Wnat_qkv, R, 3 * NQ, D, 0, w.QKV, 3 * NQ);
            if (USE_HP) { if (!KFUSE) mph(l, mk::SL_M2); } else {
                cx.run(OpCopyV{w.QKV + 2 * NQ, 3L * NQ, d.NAD, d.NAH, d.NAD, o.nat_v, d}, (long)d.RC * d.NAH * d.NAD);
                cx.run(OpHeadPost{w.QKV, 3L * NQ, d.NAD, d.NAD, nullptr, 0, 0, 0, in[I_nqn], w.QKV, 3L * NQ, d.NAD, d.NAH, 0, nullptr, nullptr, nullptr, 1, d, R}, (long)R * d.NAH);
                cx.run(OpHeadPost{w.QKV + NQ, 3L * NQ, d.NAD, d.NAD, nullptr, 0, 0, 0, in[I_nkn], w.QKV + NQ, 3L * NQ, d.NAD, d.NAH, 0, nullptr, nullptr, o.nat_k, 1, d, R}, (long)R * d.NAH); }
            if (USE_ATTN & 1) mph(l, mk::SL_M3); else {
                cx.run(OpAttnCtx<128, 128>{w.QKV, 3L * NQ, d.NAD, w.QKV + NQ, 3L * NQ, d.NAD, w.QKV + 2 * NQ, 3L * NQ, d.NAD, w.OB, (long)NQ, d.NAD, d.NAH, 1, nullptr, d}, (long)d.B * d.NAH * d.S);
                cx.run(OpNatLat<128>{w.QKV, 3L * NQ, w.natCK, w.natCV, in[I_nrpb], w.OB, (long)NQ, d}, (long)d.DB * d.NAH * d.N); }
            KO = NQ; Wo = w.Wnat_o; Aout = w.OB;
        } else if (l == 1) {
            if (USE_GEMM) mph(l, mk::SL_M1); else cx.gemm(w.H, D, w.Wlru_in, R, 2 * d.LW, D, 0, w.XG, 2 * d.LW);
            if (USE_LRU) { mph(l, mk::SL_M2); mph(l, mk::SL_M3); mph(l, mk::SL_M4); } else {
                cx.run(OpLruConv{w.XG, in[I_lcw], in[I_lcb], w.XC, d}, (long)R * d.LW);
                cx.run(OpLruScan{w.XC, w.XG, in[I_lwa], in[I_lba], in[I_lwi], in[I_lbi], in[I_llam], in[I_slru], w.HS, w.Y, o.lru, d}, (long)(d.B + d.DB) * d.LW); }
            KO = d.LW; Wo = w.Wlru_out; Aout = w.Y;
        } else if (l == 2) {
            if (USE_GEMM) mph(l, mk::SL_M1); else cx.gemm(w.H, D, w.Wmla_down, R, d.MDN, D, 0, w.Dn, d.MDN);
            if (USE_HP) mph(l, mk::SL_M2); else cx.run(OpMlaNorm{w.Dn, w.KR, in[I_mqan], in[I_mkvan], in[I_cckv], in[I_ckr], o.ckv, o.krope, d}, d.RK);
            if (USE_GEMM) mph(l, mk::SL_M3); else { cx.gemm(w.Dn, d.MDN, w.Wmla_uq, R, QW, d.MQR, 0, w.Q, QW); cx.gemm(w.Dn + d.MQR, d.MDN, w.Wmla_ukv, d.RK, MKVW, d.MKR, 0, w.KVr, MKVW); }
            if (USE_HP) mph(l, mk::SL_M4); else {
                cx.run(OpHeadPost{w.Q, (long)QW, d.MQK, d.MQK, nullptr, 0, 0, 0, in[I_mqn], w.Q, (long)QW, d.MQK, d.MH, d.MROPE, w.ropeC, w.ropeS, nullptr, 1, d, R}, (long)R * d.MH);
                cx.run(OpHeadPost{w.KVr, (long)MKVW, d.MNOPE + d.MV, d.MNOPE, w.KR, (long)d.MROPE, 0, d.MROPE, in[I_mkn], w.K, (long)QW, d.MQK, d.MH, d.MROPE, w.ropeC, w.ropeS, nullptr, 1, d, R}, (long)d.RK * d.MH); }
            if (USE_ATTN & 4) mph(l, mk::SL_M5); else {
                cx.run(OpAttnCtx<192, 128>{w.Q, (long)QW, d.MQK, w.K, (long)QW, d.MQK, w.KVr + d.MNOPE, (long)MKVW, d.MNOPE + d.MV, w.OB, (long)d.MH * d.MV, d.MV, d.MH, 1, nullptr, d}, (long)d.B * d.MH * d.S);
                cx.run(OpMlaLat<192, 128>{w.Q, w.K, w.KVr, w.OB, (long)d.MH * d.MV, d}, (long)d.DB * d.MH * d.N); }
            KO = d.MH * d.MV; Wo = w.Wmla_o; Aout = w.OB;
        } else {
            if (USE_GEMM) mph(l, mk::SL_M1); else cx.gemm(w.H, D, w.Wswa_qkv, R, SQW, D, 0, w.QKV, SQW);
            if (USE_HP) mph(l, mk::SL_M2); else {
                cx.run(OpCopyV{w.QKV + (d.SH + d.SKVH) * d.SD, (long)SQW, d.SD, d.SKVH, d.SD, o.swa_v, d}, (long)d.RC * d.SKVH * d.SD);
                cx.run(OpHeadPost{w.QKV, (long)SQW, d.SD, d.SD, nullptr, 0, 0, 0, in[I_sqn], w.QKV, (long)SQW, d.SD, d.SH, d.SD, w.ropeC, w.ropeS, nullptr, 1, d, R}, (long)R * d.SH);
                cx.run(OpHeadPost{w.QKV + d.SH * d.SD, (long)SQW, d.SD, d.SD, nullptr, 0, 0, 0, in[I_skn], w.QKV + d.SH * d.SD, (long)SQW, d.SD, d.SKVH, d.SD, w.ropeC, w.ropeS, o.swa_k, 1, d, R}, (long)R * d.SKVH); }
            if (USE_ATTN & 8) mph(l, mk::SL_M3); else {
                cx.run(OpAttnCtx<64, 64>{w.QKV, (long)SQW, d.SD, w.QKV + d.SH * d.SD, (long)SQW, d.SD, w.QKV + (d.SH + d.SKVH) * d.SD, (long)SQW, d.SD, w.OB, (long)d.SH * d.SD, d.SD, d.SH, d.SH / d.SKVH, in[I_ssink], d}, (long)d.B * d.SH * d.S);
                cx.run(OpSwaLat<64>{w.QKV, (long)SQW, w.swaCK, w.swaCV, in[I_ssink], w.OB, (long)d.SH * d.SD, d}, (long)d.DB * d.SH * d.N); }
            KO = d.SH * d.SD; Wo = w.Wswa_o; Aout = w.OB;
        }
        if (USE_RESID) mph(l, mk::SL_MIXOUT); else { cx.gemm(Aout, KO, Wo, R, D, KO, 1, w.T_mix[l], D); cx.run(OpResid{xc, xl, w.T_mix[l], mod, 2, o.yp, d}, (long)R * D); }
        xc = o.yp; xl = outl;
        if (USE_NORM) mph(l, mk::SL_NORM2); else cx.run(OpNormMod{xc, xl, in[I_nffn] + (size_t)l * D, mod, 3, w.H, d}, R);
        if (DIAG_FFN && l == 0) { mega_ph(70, 71); mega_ph(71, 72); mega_ph(72, 73); for (int l2 = 0; l2 < 4; ++l2) cx.run(OpTranspose{in[I_fwin] + (size_t)l2 * D * 2 * d.DFF, w.Wffn_in[l2], D, 2 * d.DFF, 2 * d.DFF, 0, d.DFF}, (long)2 * d.DFF * D); w.U = (act_t*)at(1224); w.G = (act_t*)at(1312); w.ffn_chunk_rows = 4096; }
        if (USE_FFN) { mph(l, mk::SL_FFNIN); mph(l, mk::SL_FFNFIX); mph(l, mk::SL_FFNOUT); } else {
            for (int r0 = 0; r0 < R; r0 += w.ffn_chunk_rows) { const int nr = (R - r0) < w.ffn_chunk_rows ? (R - r0) : w.ffn_chunk_rows;
                cx.gemm(w.H + (size_t)r0 * D, D, w.Wffn_in[l], nr, 2 * d.DFF, D, 0, w.U, 2 * d.DFF);
                if (TEST_PERM) cx.run(OpFfnActP{w.U, in[I_fcw] + (size_t)l * 3 * d.DFF, in[I_fcb] + (size_t)l * d.DFF, w.G, r0, nr, d}, (long)nr * d.DFF); else
                cx.run(OpFfnAct{w.U, in[I_fcw] + (size_t)l * 3 * d.DFF, in[I_fcb] + (size_t)l * d.DFF, w.G, r0, nr, d}, (long)nr * d.DFF);
                if (DIAG_FFN && l == 0 && r0 == 0) cx.run(OpCmp{w.U, (const act_t*)at(540), (const act_t*)at(600), (const act_t*)at(660), (unsigned*)(ws + 65536), (long)d.DFF, in[I_fcw], in[I_fcb]}, (long)nr * d.DFF);
                cx.gemm(w.G, d.DFF, w.Wffn_out[l], nr, D, d.DFF, 1, w.T_ffn + (size_t)r0 * D, D); }
            cx.run(OpResid{xc, xl, w.T_ffn, mod, 5, o.yp, d}, (long)R * D); }
        if (DIAG_FFN && l == 0) { w.U = (act_t*)at(540); w.G = (act_t*)at(804); w.ffn_chunk_rows = 12288; }
    }
    if (DIAG_FFN) cx.run(OpPerturb{o.yp, (const unsigned*)(ws + 65536)}, (long)8388608);
}
```

```cpp
#include <hip/hip_runtime.h>
#include <cstdio>
#include <cstdint>
#include <math.h>
namespace pg8 {
#define PG8_LAS __attribute__((address_space(3)))
typedef unsigned short bf16_t;
typedef short bf16x8 __attribute__((ext_vector_type(8)));
typedef float f32x4 __attribute__((ext_vector_type(4)));
typedef unsigned u32x4 __attribute__((ext_vector_type(4)));
constexpr int BM = 256, BK = 64, HALF = 128, HTB = HALF * BK * 2  , STAGE_BYTES = 8 * HTB, NXCD = 8, WGM = 8;

__host__ __device__ __forceinline__ int lds_byte(int r, int c) { const int st = (r >> 4) * 2 + (c >> 5), rr = r & 15, cc = c & 31, ob = rr * 64 + cc * 2; return st * 1024 + (ob ^ (((ob >> 9) & 1) << 5)); }
__host__ __device__ __forceinline__ void stage_rc(int b, int& R, int& C) { const int st = b / 1024, sb = b % 1024, swz = sb ^ (((sb >> 9) & 1) << 5); R = (st >> 1) * 16 + swz / 64; C = (st & 1) * 32 + (swz % 64) / 2; }
__host__ __device__ __forceinline__ int perm32(int rho) { const int n = rho >> 4, i = rho & 15; return 8 * (i >> 2) + 4 * n + (i & 3); }

struct Unit { int pm, pn; };
struct Gemm { const bf16_t* A; const bf16_t* Bt; int M, N, K, lda, ldb, pad; };

struct StaticOrder {
    int nM, nN, nwg, G, c, wgm, rev;
    __host__ __device__ void init(int M, int N, int G_, int c_, int wgm_ = WGM, int rev_ = 0) { nM = M / BM; nN = N / BM; nwg = nM * nN; G = G_; c = c_; wgm = wgm_; rev = rev_; }
    __host__ __device__ bool next(int i, Unit& u) const {
        const long L = (long)i * G + c; if (L >= nwg) return false;
        int wgid = (int)L; { const int q = nwg / NXCD, r = nwg % NXCD, xcd = wgid % NXCD, off = wgid / NXCD, sz = xcd < r ? q + 1 : q; wgid = (xcd < r ? xcd * (q + 1) : r * (q + 1) + (xcd - r) * q) + (rev ? sz - 1 - off : off); }
        const int nig = wgm * nN, gid = wgid / nig, fm = gid * wgm, gsz = (nM - fm) < wgm ? (nM - fm) : wgm;
        u.pm = fm + ((wgid % nig) % gsz); u.pn = (wgid % nig) / gsz; return true;
    }
    __device__ __forceinline__ void a_ready(const Unit&) const {}
    __device__ __forceinline__ void done(const Unit&) const {}
};

__device__ __forceinline__ unsigned cvt_pk_bf16(float lo, float hi) { unsigned r; asm volatile("v_cvt_pk_bf16_f32 %0, %1, %2" : "=v"(r) : "v"(lo), "v"(hi)); return r; }
typedef float f32x2 __attribute__((ext_vector_type(2)));
__device__ __forceinline__ f32x2 gelu_pk(f32x2 v) {
    const f32x2 av = __builtin_elementwise_abs(v), d = av * 0.2316418882f + 1.0f;
    f32x2 t; t.x = __builtin_amdgcn_rcpf(d.x); t.y = __builtin_amdgcn_rcpf(d.y);
    f32x2 q = t * 0.5307027145f + (-0.7265760135f); q = q * t + 0.7107068705f; q = q * t + (-0.142248368f); q = q * t + 0.127414796f; q = q * t;
    const f32x2 s = (v * v) * (-0.72134752044f);
    f32x2 e; e.x = __builtin_amdgcn_exp2f(s.x); e.y = __builtin_amdgcn_exp2f(s.y);
    const f32x2 m = v * (q * e), r = v - m;
    f32x2 o; o.x = v.x < 0.f ? m.x : r.x; o.y = v.y < 0.f ? m.y : r.y; return o;
}

template <int ACT  > struct EpiBf16 {
    static constexpr bool PERM = true, AFTER_DRAIN = false; static_assert(ACT == 0 || ACT == 1, "EpiBf16: ACT is 0 (none) or 1 (gelu_pk)");
    bf16_t* O; int ldc; const float* bias; int split_cols; size_t split_stride; float scale0;
    __device__ __forceinline__ void operator()(const f32x4 (&acc)[2][2][4][2], const Unit& u, int wr, int wc, int fr, int fq) const {
        const int row0 = u.pm * BM + wr * 64 + fr; int colt = u.pn * BM; bf16_t* base = O;
        float sc = 1.f; if (split_cols) { const int t = colt / split_cols; base += (size_t)t * split_stride; colt -= t * split_cols; if (t == 0) sc = scale0; }
        const int col0 = colt + wc * 32 + 8 * fq, bcol0 = u.pn * BM + wc * 32 + 8 * fq;
        f32x4 bv[2][2];
#pragma unroll
        for (int bj = 0; bj < 2; ++bj)
#pragma unroll
            for (int n = 0; n < 2; ++n) bv[bj][n] = bias ? *(const f32x4*)(bias + bcol0 + bj * HALF + 4 * n) : (f32x4){0.f, 0.f, 0.f, 0.f};
#pragma unroll
        for (int ai = 0; ai < 2; ++ai)
#pragma unroll
            for (int m = 0; m < 4; ++m) { bf16_t* rowp = base + (size_t)(row0 + ai * HALF + m * 16) * ldc + col0;
#pragma unroll
                for (int bj = 0; bj < 2; ++bj) { f32x4 v0 = acc[ai][bj][m][0] + bv[bj][0], v1 = acc[ai][bj][m][1] + bv[bj][1];
                    if (ACT == 1) { f32x2 a = gelu_pk((f32x2){v0[0], v0[1]}), b = gelu_pk((f32x2){v0[2], v0[3]}), c = gelu_pk((f32x2){v1[0], v1[1]}), d = gelu_pk((f32x2){v1[2], v1[3]});
                        v0 = (f32x4){a.x, a.y, b.x, b.y}; v1 = (f32x4){c.x, c.y, d.x, d.y}; }
                    v0 = v0 * sc; v1 = v1 * sc; u32x4 w; w.x = cvt_pk_bf16(v0[0], v0[1]); w.y = cvt_pk_bf16(v0[2], v0[3]); w.z = cvt_pk_bf16(v1[0], v1[1]); w.w = cvt_pk_bf16(v1[2], v1[3]);
                    *(u32x4*)(rowp + bj * HALF) = w; } }
    }
};


struct EpiF32 {
    static constexpr bool PERM = false, AFTER_DRAIN = false;
    float* C; int ldc;
    __device__ __forceinline__ void operator()(const f32x4 (&acc)[2][2][4][2], const Unit& u, int wr, int wc, int fr, int fq) const {
        const int row0 = u.pm * BM + wr * 64 + fr, col0 = u.pn * BM + wc * 32 + 4 * fq;
#pragma unroll
        for (int ai = 0; ai < 2; ++ai)
#pragma unroll
            for (int m = 0; m < 4; ++m) { float* rowp = C + (size_t)(row0 + ai * HALF + m * 16) * ldc + col0;
#pragma unroll
                for (int bj = 0; bj < 2; ++bj)
#pragma unroll
                    for (int n = 0; n < 2; ++n) *(f32x4*)(rowp + bj * HALF + n * 16) = acc[ai][bj][m][n]; }
    }
};
struct PanelStats {
    unsigned* xbuf;
    unsigned* cnt;
    unsigned* tmo;
    int ntn; float eps;
    unsigned code;
    __device__ __forceinline__ bool run(const f32x4 (&v)[2][2][4][2], const Unit& u, int wr, int wc, int fr, int fq, PG8_LAS unsigned char* lds, int wid, int lane) const {
        typedef float f32x2v __attribute__((ext_vector_type(2)));
        PG8_LAS f32x2v* P = (PG8_LAS f32x2v*)lds;
        PG8_LAS f32x2v* S = (PG8_LAS f32x2v*)(lds + 8192);
        PG8_LAS unsigned* flag = (PG8_LAS unsigned*)(lds + 8192 + 2048);
#pragma unroll
        for (int ai = 0; ai < 2; ++ai)
#pragma unroll
            for (int m = 0; m < 4; ++m) {
                float s = 0.f;
#pragma unroll
                for (int bj = 0; bj < 2; ++bj)
#pragma unroll
                    for (int n = 0; n < 2; ++n) { const f32x4 x = v[ai][bj][m][n]; s += (x[0] + x[1]) + (x[2] + x[3]); }
                s += __shfl_xor(s, 16); s += __shfl_xor(s, 32);
                const float mw = s * (1.0f / 64.0f); float q = 0.f;
#pragma unroll
                for (int bj = 0; bj < 2; ++bj)
#pragma unroll
                    for (int n = 0; n < 2; ++n) { const f32x4 d = v[ai][bj][m][n] - mw; q += (d[0] * d[0] + d[1] * d[1]) + (d[2] * d[2] + d[3] * d[3]); }
                q += __shfl_xor(q, 16); q += __shfl_xor(q, 32);
                if (fq == 0) P[(ai * HALF + wr * 64 + m * 16 + fr) * 4 + wc] = (f32x2v){mw, q};
            }
        asm volatile("s_waitcnt lgkmcnt(0)" ::: "memory"); __builtin_amdgcn_s_barrier(); asm volatile("" ::: "memory");
#if defined(BROKEN_EXCHANGE_NO_WAIT)
#warning BROKEN CONTROL BUILD: the row-statistics exchange does not wait; results are wrong by design
        if (blockIdx.x >= 64) { const long long t0_ = clock64(); while (clock64() - t0_ < 60000) __builtin_amdgcn_s_sleep(8); }
#endif
        const int row = wid * 32 + (lane & 31);
        if (lane < 32) {
            const f32x2v a = P[row * 4 + 0], b = P[row * 4 + 1], c = P[row * 4 + 2], d = P[row * 4 + 3];
            const float mt = (a.x + b.x + c.x + d.x) * 0.25f;
            const float da = a.x - mt, db = b.x - mt, dc = c.x - mt, dd = d.x - mt;
            const float m2 = (a.y + b.y) + (c.y + d.y) + 64.0f * ((da * da + db * db) + (dc * dc + dd * dd));
            unsigned long long* slot = (unsigned long long*)xbuf + ((size_t)(u.pm * BM + row) * 4 + u.pn);
            __hip_atomic_store(slot, ((unsigned long long)__float_as_uint(m2) << 32) | __float_as_uint(mt), __ATOMIC_RELAXED, __HIP_MEMORY_SCOPE_AGENT);
        }
        asm volatile("s_waitcnt vmcnt(0)" ::: "memory");
        if (lane == 0) __hip_atomic_fetch_add(cnt + 64 * u.pm, 1u, __ATOMIC_RELAXED, __HIP_MEMORY_SCOPE_AGENT);
        if (wid == 0) {
            bool dead = false; const unsigned long long t0 = __builtin_amdgcn_s_memrealtime(); const unsigned want = 8u * (unsigned)ntn;
            for (;;) {
#if defined(BROKEN_EXCHANGE_NO_WAIT)
                break;
#endif
                if ((unsigned)__builtin_amdgcn_readfirstlane(__hip_atomic_load(cnt + 64 * u.pm, __ATOMIC_RELAXED, __HIP_MEMORY_SCOPE_AGENT)) >= want) break;
                if (__builtin_amdgcn_s_memrealtime() - t0 > 2000000ull) {
                    if (lane == 0) { unsigned expect = 0u; __hip_atomic_compare_exchange_strong(tmo + 1, &expect, code | (unsigned)(u.pm & 0xff), __ATOMIC_RELAXED, __ATOMIC_RELAXED, __HIP_MEMORY_SCOPE_AGENT);
                                     __hip_atomic_store(tmo, 1u, __ATOMIC_RELAXED, __HIP_MEMORY_SCOPE_AGENT); }
                    dead = true; break; }
                __builtin_amdgcn_s_sleep(2);
            }
            __builtin_amdgcn_fence(__ATOMIC_ACQUIRE, "agent");
            if (lane == 0) flag[0] = dead ? 1u : 0u;
        }
        asm volatile("s_waitcnt vmcnt(0) lgkmcnt(0)" ::: "memory"); __builtin_amdgcn_s_barrier(); asm volatile("" ::: "memory");
        const bool bad = flag[0] != 0u;
        if (lane < 32) {
            const unsigned long long* slot = (const unsigned long long*)xbuf + (size_t)(u.pm * BM + row) * 4; float mt[4], m2[4]; float ms = 0.f;
#pragma unroll
            for (int t = 0; t < 4; ++t) { if (t < ntn) { const unsigned long long w = __hip_atomic_load(slot + t, __ATOMIC_RELAXED, __HIP_MEMORY_SCOPE_AGENT); mt[t] = __uint_as_float((unsigned)w); m2[t] = __uint_as_float((unsigned)(w >> 32)); } else { mt[t] = 0.f; m2[t] = 0.f; } ms += mt[t]; }
            const float mean = ms / (float)ntn; float q = 0.f;
#pragma unroll
            for (int t = 0; t < 4; ++t) if (t < ntn) { const float dm = mt[t] - mean; q += m2[t] + 256.0f * dm * dm; }
            S[row] = (f32x2v){mean, 1.0f / sqrtf(q / (256.0f * (float)ntn) + eps)};
        }
        asm volatile("s_waitcnt lgkmcnt(0)" ::: "memory"); __builtin_amdgcn_s_barrier(); asm volatile("" ::: "memory");
        return bad;
    }
};
struct EpiLnRes {
    static constexpr bool PERM = false, AFTER_DRAIN = true;
    const float* base; float* out; int ldc; const float* bias; PanelStats st; unsigned poison;
    __device__ __forceinline__ void fused(f32x4 (&acc)[2][2][4][2], const Unit& u, int wr, int wc, int fr, int fq, PG8_LAS unsigned char* lds, int wid, int lane) const {
        typedef float f32x2v __attribute__((ext_vector_type(2)));
        const PG8_LAS f32x2v* S = (const PG8_LAS f32x2v*)(lds + 8192);
        const int col0 = u.pn * BM + wc * 32 + 4 * fq;
#pragma unroll
        for (int bj = 0; bj < 2; ++bj)
#pragma unroll
            for (int n = 0; n < 2; ++n) { const f32x4 bv = bias ? *(const f32x4*)(bias + col0 + bj * HALF + n * 16) : (f32x4){0.f, 0.f, 0.f, 0.f};
#pragma unroll
                for (int ai = 0; ai < 2; ++ai)
#pragma unroll
                    for (int m = 0; m < 4; ++m) acc[ai][bj][m][n] += bv; }
        f32x4 pre[4][2][2];
#pragma unroll
        for (int m = 0; m < 4; ++m) { const size_t off = (size_t)(u.pm * BM + wr * 64 + m * 16 + fr) * ldc + col0;
#pragma unroll
            for (int bj = 0; bj < 2; ++bj)
#pragma unroll
                for (int n = 0; n < 2; ++n) pre[m][bj][n] = *(const f32x4*)(base + off + bj * HALF + n * 16); }
        const bool bad = st.run(acc, u, wr, wc, fr, fq, lds, wid, lane) || poison != 0u;
        const float qnan = __builtin_nanf("");
#pragma unroll
        for (int ai = 0; ai < 2; ++ai)
#pragma unroll
            for (int m = 0; m < 4; ++m) { const int r = ai * HALF + wr * 64 + m * 16 + fr; const f32x2v sr = S[r]; const size_t off = (size_t)(u.pm * BM + r) * ldc + col0;
#pragma unroll
                for (int bj = 0; bj < 2; ++bj)
#pragma unroll
                    for (int n = 0; n < 2; ++n) { const f32x4 bs = ai == 0 ? pre[m][bj][n] : *(const f32x4*)(base + off + bj * HALF + n * 16); f32x4 o = bs + (acc[ai][bj][m][n] - sr.x) * sr.y;
                        if (bad) o = (f32x4){qnan, qnan, qnan, qnan}; *(f32x4*)(out + off + bj * HALF + n * 16) = o; }
                if (m & 1) asm volatile("" ::: "memory"); }
    }
};
struct EpiLnResLn {
    static constexpr bool PERM = false, AFTER_DRAIN = true;
    const float* base; float* out; bf16_t* xn; int ldc; const float* bias; PanelStats st1, st2; unsigned poison;
    __device__ __forceinline__ void fused(f32x4 (&acc)[2][2][4][2], const Unit& u, int wr, int wc, int fr, int fq, PG8_LAS unsigned char* lds, int wid, int lane) const {
        typedef float f32x2v __attribute__((ext_vector_type(2))); typedef unsigned u32x2v __attribute__((ext_vector_type(2)));
        const PG8_LAS f32x2v* S = (const PG8_LAS f32x2v*)(lds + 8192);
        const int col0 = u.pn * BM + wc * 32 + 4 * fq;
#pragma unroll
        for (int bj = 0; bj < 2; ++bj)
#pragma unroll
            for (int n = 0; n < 2; ++n) { const f32x4 bv = bias ? *(const f32x4*)(bias + col0 + bj * HALF + n * 16) : (f32x4){0.f, 0.f, 0.f, 0.f};
#pragma unroll
                for (int ai = 0; ai < 2; ++ai)
#pragma unroll
                    for (int m = 0; m < 4; ++m) acc[ai][bj][m][n] += bv; }
        bool bad = st1.run(acc, u, wr, wc, fr, fq, lds, wid, lane) || poison != 0u;
        const float qnan = __builtin_nanf("");
#pragma unroll
        for (int ai = 0; ai < 2; ++ai)
#pragma unroll
            for (int m = 0; m < 4; ++m) { const int r = ai * HALF + wr * 64 + m * 16 + fr; const f32x2v sr = S[r]; const size_t off = (size_t)(u.pm * BM + r) * ldc + col0;
#pragma unroll
                for (int bj = 0; bj < 2; ++bj)
#pragma unroll
                    for (int n = 0; n < 2; ++n) { const f32x4 bs = *(const f32x4*)(base + off + bj * HALF + n * 16); acc[ai][bj][m][n] = bs + (acc[ai][bj][m][n] - sr.x) * sr.y; }
                asm volatile("" : "+v"(acc[ai][0][m][0]), "+v"(acc[ai][0][m][1]), "+v"(acc[ai][1][m][0]), "+v"(acc[ai][1][m][1]));
                if (m & 1) asm volatile("" ::: "memory"); }
        const bool bad1 = bad;
        bad = st2.run(acc, u, wr, wc, fr, fq, lds, wid, lane) || bad;
#pragma unroll
        for (int ai = 0; ai < 2; ++ai)
#pragma unroll
            for (int m = 0; m < 4; ++m) { const int r = ai * HALF + wr * 64 + m * 16 + fr; const f32x2v sr = S[r]; const size_t off = (size_t)(u.pm * BM + r) * ldc + col0;
#pragma unroll
                for (int bj = 0; bj < 2; ++bj)
#pragma unroll
                    for (int n = 0; n < 2; ++n) { const f32x4 x1 = acc[ai][bj][m][n]; *(f32x4*)(out + off + bj * HALF + n * 16) = bad1 ? (f32x4){qnan, qnan, qnan, qnan} : x1;
                        const f32x4 o = (x1 - sr.x) * sr.y; u32x2v w; w.x = cvt_pk_bf16(o[0], o[1]); w.y = cvt_pk_bf16(o[2], o[3]);
                        if (bad) { w.x = 0x7fc07fc0u; w.y = 0x7fc07fc0u; } *(u32x2v*)(xn + off + bj * HALF + n * 16) = w; }
                asm volatile("" ::: "memory"); }
    }
};

template <class Epi, class Sched, bool ALIGN_EPI = false, bool SP2 = false>
__device__ __forceinline__ void gemm_phase(PG8_LAS unsigned char* lds, const Gemm g, const Sched& S, const Epi& E) {
    const int tid = threadIdx.x, wid = __builtin_amdgcn_readfirstlane(tid >> 6), lane = tid & 63, wr = wid >> 2, wc = wid & 3, fr = lane & 15, fq = lane >> 4;
    const int K = g.K, nt = K / BK;
    unsigned voffA[2], voffB[2];
#pragma unroll
    for (int i = 0; i < 2; ++i) { int R, C; stage_rc(tid * 16 + i * 8192, R, C); const int Rb = Epi::PERM ? ((R & ~31) + perm32(R & 31)) : R;
        voffA[i] = (unsigned)(R * g.lda + C) * 2u; voffB[i] = (unsigned)(Rb * g.ldb + C) * 2u; }
    const size_t kstep = (size_t)(BK * 2);
    const size_t hstepA = (size_t)HALF * g.lda * 2, hstepB = (size_t)HALF * g.ldb * 2;
    const size_t tstepA = 2 * hstepA, tstepB = 2 * hstepB;
    const unsigned ldsw = (unsigned)wid * 1024u;
    const int aoff = lds_byte(wr * 64 + fr, fq * 8), boff = lds_byte(wc * 32 + fr, fq * 8);
#define PG8_SA(b, h) (((b) * 2 + (h)) * HTB)
#define PG8_SB(b, h) ((4 + (b) * 2 + (h)) * HTB)
#define PG8_STAGE(bufoff, gbase, voff) do { _Pragma("unroll") for (int _i = 0; _i < 2; ++_i) \
        __builtin_amdgcn_global_load_lds((const unsigned*)((const char*)(gbase) + (voff)[_i]), (PG8_LAS unsigned*)(lds + (bufoff) + ldsw + _i * 8192), 16, 0, 0); } while (0)
#define PG8_LDA(dst, b, h) do { _Pragma("unroll") for (int m = 0; m < 4; ++m) _Pragma("unroll") for (int k = 0; k < 2; ++k) dst[m][k] = *(const PG8_LAS bf16x8*)(lds + PG8_SA(b, h) + aoff + m * 2048 + k * 1024); } while (0)
#define PG8_LDB(dst, b, h) do { _Pragma("unroll") for (int n = 0; n < 2; ++n) _Pragma("unroll") for (int k = 0; k < 2; ++k) dst[n][k] = *(const PG8_LAS bf16x8*)(lds + PG8_SB(b, h) + boff + n * 2048 + k * 1024); } while (0)
#define PG8_MMA(ai, bj, At, Bt) do { __builtin_amdgcn_s_setprio(1); _Pragma("unroll") for (int m = 0; m < 4; ++m) _Pragma("unroll") for (int n = 0; n < 2; ++n) _Pragma("unroll") for (int k = 0; k < 2; ++k) \
        acc[ai][bj][m][n] = __builtin_amdgcn_mfma_f32_16x16x32_bf16(Bt[n][k], At[m][k], acc[ai][bj][m][n], 0, 0, 0); __builtin_amdgcn_s_setprio(0); } while (0)
#define PG8_WAIT_V(n) asm volatile("s_waitcnt vmcnt(" #n ")" ::: "memory")
#define PG8_WAIT_L(n) asm volatile("s_waitcnt lgkmcnt(" #n ")" ::: "memory")
#define PG8_BAR __builtin_amdgcn_s_barrier()
#define PG8_SCHED __builtin_amdgcn_sched_barrier(0)
    Unit cur, nxt; int ui = 0;
    if (!S.next(0, cur)) return;
    f32x4 acc[2][2][4][2];
#pragma unroll
    for (int a = 0; a < 2; ++a)
#pragma unroll
        for (int b = 0; b < 2; ++b)
#pragma unroll
            for (int m = 0; m < 4; ++m)
#pragma unroll
                for (int n = 0; n < 2; ++n) acc[a][b][m][n] = (f32x4){0.f, 0.f, 0.f, 0.f};
    bf16x8 At[4][2], B0[2][2], B1[2][2];
    const char* cA = (const char*)g.A + (size_t)cur.pm * tstepA; const char* cB = (const char*)g.Bt + (size_t)cur.pn * tstepB;
    S.a_ready(cur);
    if constexpr (SP2) {
        PG8_STAGE(PG8_SB(0, 0), cB, voffB); PG8_STAGE(PG8_SB(0, 1), cB + hstepB, voffB); PG8_STAGE(PG8_SA(0, 0), cA, voffA); PG8_STAGE(PG8_SA(0, 1), cA + hstepA, voffA);
        if (wr == 1) PG8_BAR;
        PG8_WAIT_V(2); PG8_BAR;
        PG8_STAGE(PG8_SB(1, 0), cB + kstep, voffB); PG8_STAGE(PG8_SA(1, 0), cA + kstep, voffA); PG8_STAGE(PG8_SB(1, 1), cB + hstepB + kstep, voffB);
        PG8_WAIT_V(6); PG8_BAR;
    } else {
        PG8_STAGE(PG8_SB(0, 0), cB, voffB); PG8_STAGE(PG8_SA(0, 0), cA, voffA); PG8_STAGE(PG8_SB(0, 1), cB + hstepB, voffB); PG8_STAGE(PG8_SA(0, 1), cA + hstepA, voffA);
        if (wr == 1) PG8_BAR;
        PG8_WAIT_V(4); PG8_BAR;
        PG8_STAGE(PG8_SB(1, 0), cB + kstep, voffB); PG8_STAGE(PG8_SA(1, 0), cA + kstep, voffA); PG8_STAGE(PG8_SB(1, 1), cB + hstepB + kstep, voffB);
        PG8_WAIT_V(6); PG8_BAR;
    }
    for (;;) {
        const bool has_next = S.next(ui + 1, nxt);
        const char* nA = has_next ? (const char*)g.A + (size_t)nxt.pm * tstepA : cA; const char* nB = has_next ? (const char*)g.Bt + (size_t)nxt.pn * tstepB : cB;
        for (int t = 0; t < nt; t += 2) {
            const bool last = (t == nt - 2);
            const char* a1 = cA + (size_t)(t + 1) * kstep;
            const char* a2 = last ? nA : cA + (size_t)(t + 2) * kstep; const char* b2 = last ? nB : cB + (size_t)(t + 2) * kstep;
            const char* a3 = a2 + kstep; const char* b3 = b2 + kstep;
            if (last && has_next) S.a_ready(nxt);
            if constexpr (SP2) {
            PG8_LDB(B0, 0, 0); PG8_LDB(B1, 0, 1); PG8_SCHED; PG8_LDA(At, 0, 0); PG8_STAGE(PG8_SA(1, 1), a1 + hstepA, voffA);
            PG8_WAIT_V(8); PG8_WAIT_L(0); PG8_BAR; PG8_MMA(0, 0, At, B0); PG8_MMA(0, 1, At, B1); PG8_BAR; PG8_SCHED;
            PG8_LDA(At, 0, 1); PG8_STAGE(PG8_SB(0, 0), b2, voffB); PG8_STAGE(PG8_SB(0, 1), b2 + hstepB, voffB); PG8_STAGE(PG8_SA(0, 0), a2, voffA);
            PG8_WAIT_V(8); PG8_WAIT_L(0); PG8_BAR; PG8_MMA(1, 0, At, B0); PG8_MMA(1, 1, At, B1); PG8_BAR; PG8_SCHED;
            PG8_LDB(B0, 1, 0); PG8_LDB(B1, 1, 1); PG8_SCHED; PG8_LDA(At, 1, 0); PG8_STAGE(PG8_SA(0, 1), a2 + hstepA, voffA);
            PG8_WAIT_V(8); PG8_WAIT_L(0); PG8_BAR; PG8_MMA(0, 0, At, B0); PG8_MMA(0, 1, At, B1); PG8_BAR; PG8_SCHED;
            PG8_LDA(At, 1, 1); PG8_STAGE(PG8_SB(1, 0), b3, voffB); PG8_STAGE(PG8_SB(1, 1), b3 + hstepB, voffB); PG8_STAGE(PG8_SA(1, 0), a3, voffA);
            PG8_WAIT_V(8); PG8_WAIT_L(0); PG8_BAR; PG8_MMA(1, 0, At, B0); PG8_MMA(1, 1, At, B1); PG8_BAR; PG8_SCHED;
            } else {
            PG8_LDB(B0, 0, 0); PG8_SCHED; PG8_LDA(At, 0, 0); PG8_STAGE(PG8_SA(1, 1), a1 + hstepA, voffA);
            PG8_WAIT_L(8); PG8_BAR; PG8_WAIT_L(0); PG8_MMA(0, 0, At, B0); PG8_BAR; PG8_SCHED;
            PG8_LDB(B1, 0, 1); PG8_STAGE(PG8_SB(0, 0), b2, voffB);
            PG8_BAR; PG8_WAIT_L(0); PG8_MMA(0, 1, At, B1); PG8_BAR;
            PG8_LDA(At, 0, 1); PG8_STAGE(PG8_SA(0, 0), a2, voffA);
            PG8_BAR; PG8_WAIT_L(0); PG8_MMA(1, 0, At, B0); PG8_BAR; PG8_SCHED;
            PG8_STAGE(PG8_SB(0, 1), b2 + hstepB, voffB);
            PG8_WAIT_V(6); PG8_BAR; PG8_MMA(1, 1, At, B1); PG8_BAR;
            PG8_LDB(B0, 1, 0); PG8_SCHED; PG8_LDA(At, 1, 0); PG8_STAGE(PG8_SA(0, 1), a2 + hstepA, voffA);
            PG8_WAIT_L(8); PG8_BAR; PG8_WAIT_L(0); PG8_MMA(0, 0, At, B0); PG8_BAR; PG8_SCHED;
            PG8_LDB(B1, 1, 1); PG8_STAGE(PG8_SB(1, 0), b3, voffB);
            PG8_BAR; PG8_WAIT_L(0); PG8_MMA(0, 1, At, B1); PG8_BAR;
            PG8_LDA(At, 1, 1); PG8_STAGE(PG8_SA(1, 0), a3, voffA);
            PG8_BAR; PG8_WAIT_L(0); PG8_MMA(1, 0, At, B0); PG8_BAR; PG8_SCHED;
            PG8_STAGE(PG8_SB(1, 1), b3 + hstepB, voffB);
            PG8_WAIT_V(6); PG8_BAR; PG8_MMA(1, 1, At, B1); PG8_BAR;
            }
        }
        if constexpr (ALIGN_EPI) { if (wr == 0) PG8_BAR; }
        if constexpr (!Epi::AFTER_DRAIN) { E(acc, cur, wr, wc, fr, fq); S.done(cur); }
        if (!has_next) break;
#pragma unroll
        for (int a = 0; a < 2; ++a)
#pragma unroll
            for (int b = 0; b < 2; ++b)
#pragma unroll
                for (int m = 0; m < 4; ++m)
#pragma unroll
                    for (int n = 0; n < 2; ++n) acc[a][b][m][n] = (f32x4){0.f, 0.f, 0.f, 0.f};
        cur = nxt; cA = nA; cB = nB; ++ui;
        if constexpr (ALIGN_EPI) { if (wr == 1) PG8_BAR; }
    }
    PG8_WAIT_V(0);
    if constexpr (!ALIGN_EPI) { if (wr == 0) PG8_BAR; }
    PG8_BAR;
    if constexpr (Epi::AFTER_DRAIN) { E.fused(acc, cur, wr, wc, fr, fq, lds, wid, lane); S.done(cur); }
#undef PG8_SA
#undef PG8_SB
#undef PG8_STAGE
#undef PG8_LDA
#undef PG8_LDB
#undef PG8_MMA
#undef PG8_WAIT_V
#undef PG8_WAIT_L
#undef PG8_BAR
#undef PG8_SCHED
}
}
#ifdef __HIPCC__
#define HD __host__ __device__ __forceinline__
#define UNR _Pragma("unroll")
typedef unsigned short act_t;
HD float ldf(act_t v) { unsigned u = ((unsigned)v) << 16; float f; __builtin_memcpy(&f, &u, 4); return f; }
HD act_t stf(float f) { unsigned u; __builtin_memcpy(&u, &f, 4); u = (u + 0x7fffu + ((u >> 16) & 1u)) >> 16; return (act_t)u; }
#else
#define HD inline
#define UNR
typedef float act_t;
HD float ldf(act_t v) { return v; }
HD act_t stf(float f) { return f; }
#endif

struct Dims {
    int D, B, S, DB, N, PAST, GW;
    int NAH, NAD;
    int LW, LB, LBK;
    int MH, MQR, MKR, MNOPE, MROPE, MV, MQK, MDN  ;
    int SH, SKVH, SD, SWIN;
    int DFF;
    int RC, R, RK  ;
};
HD int cond_of(const Dims& d, int row) { return row < d.RC ? 0 : 1 + (row - d.RC) / d.N; }
HD float silu_f(float x) { return x / (1.f + expf(-x)); }
HD float sigm_f(float x) { return 1.f / (1.f + expf(-x)); }
HD float gelu_f(float x) { const float u = 0.7978845608028654f * (x + 0.044715f * x * x * x); return x / (1.f + expf(-2.f * u)); }

struct OpTranspose { const float* W; act_t* Wt; long K, N, NP, perm, DFF;
    HD void run(long g) const { const int n = (int)(g / K), k = (int)(g % K); float v = 0.f;
        if (n < N) { int sc = n; if (perm == 1) { const int un = n / 256, j = n % 256; sc = j < 128 ? un * 128 + j : DFF + un * 128 + (j - 128); } v = W[(size_t)k * N + sc]; }
        Wt[(size_t)n * K + k] = stf(v); } };
struct OpCvt { const float* src; act_t* dst; HD void run(long g) const { dst[g] = stf(src[g]); } };
struct OpMod { const float* c; const float* cctx; const float* w; const float* b; float* MOD; long D, NCI;
    HD void run(long g) const { const int N6 = 6 * D; const int n = (int)(g % N6); const int ci = (int)((g / N6) % NCI); const int l = (int)(g / ((long)N6 * NCI));
        const float* cond = ci == 0 ? cctx : c + (size_t)(ci - 1) * D; const float* wl = w + (size_t)l * D * N6; float acc = b[(size_t)l * N6 + n];
        for (int k = 0; k < D; ++k) acc += silu_f(cond[k]) * wl[(size_t)k * N6 + n];
        MOD[g] = acc; } };
struct OpNormMod { const float* xc; const float* xl;   const float* g; const float* mod;   long chunk;   act_t* H; Dims d;
    HD void run(long row) const { const int D = d.D; const float* x = row < d.RC ? xc + (size_t)row * D : xl + (size_t)(row - d.RC) * D;
        float ss = 0.f; for (int k = 0; k < D; ++k) ss += x[k] * x[k];
        const float rstd = 1.f / sqrtf(ss / D + 1e-6f); const float* m = mod + (size_t)cond_of(d, (int)row) * 6 * D + (size_t)chunk * D;
        for (int k = 0; k < D; ++k) H[(size_t)row * D + k] = stf(x[k] * rstd * g[k] * (1.f + m[D + k]) + m[k]); } };
struct OpResid { const float* xc; const float* xl; const float* T; const float* mod; long chunk; float* out; Dims d;
    HD void run(long g) const { const int D = d.D; const int row = (int)(g / D), c = (int)(g % D);
        const float x = row < d.RC ? xc[(size_t)row * D + c] : xl[(size_t)(row - d.RC) * D + c];
        out[g] = x + mod[(size_t)cond_of(d, row) * 6 * D + (size_t)chunk * D + c] * T[g]; } };
struct OpRope { float* cs; float* sn; long rot, GW;
    HD void run(long g) const { const int t = (int)(g / rot), li = (int)(g % rot); const int half = rot / 2, nf = half / 2; const int f = li % nf;
        const float pos = (li < half) ? (float)(t / GW) : (float)(t % GW);
        const float inv = exp2f(-(float)(2 * f) / (float)half * 13.287712379549449f); const float a = pos * inv;
        const float rev = a * 0.15915494309189535f; const float fr = rev - floorf(rev);
#ifdef __HIP_DEVICE_COMPILE__
        cs[g] = __builtin_amdgcn_cosf(fr); sn[g] = __builtin_amdgcn_sinf(fr);
#else
        cs[g] = cosf(fr * 6.283185307179586f); sn[g] = sinf(fr * 6.283185307179586f);
#endif
    } };
struct OpHeadPost { const act_t* sa; long pa; long sha, na; const act_t* sb; long pb; long shb, nb; const float* gain; act_t* dst; long pd; long shd; long NH; long rot; const float* cs; const float* sn; float* of; long norm; Dims d; long rows_lat_end;
    HD void run(long g) const { const int row = (int)(g / NH), h = (int)(g % NH); const int dh = na + nb;
        const act_t* pA = sa + (size_t)row * pa + (size_t)h * sha; const act_t* pB = sb ? sb + (size_t)row * pb + (size_t)h * shb : nullptr;
        float ss = 0.f; for (int k = 0; k < dh; ++k) { const float v = k < na ? ldf(pA[k]) : ldf(pB[k - na]); ss += v * v; }
        const float rstd = norm ? 1.f / sqrtf(ss / dh + 1e-6f) : 1.f;
        act_t* o = dst + (size_t)row * pd + (size_t)h * shd;
        const bool lat = rot > 0 && row >= d.RC && row < rows_lat_end; const int t = lat ? (row - d.RC) % d.N : 0; const int r0 = dh - rot, half = rot / 2, q4 = rot / 4;
        float* ofp = (of && row < d.RC) ? of + ((size_t)((row / d.S) * NH + h) * d.S + (row % d.S)) * dh : nullptr;
        for (int k = 0; k < dh; ++k) { float v = (k < na ? ldf(pA[k]) : ldf(pB[k - na])) * rstd * (norm ? gain[k] : 1.f);
            if (lat && k >= r0) { const int li = k - r0; const int w = li % half; if (w >= q4) continue;
                const int k2 = k + q4; const float v2 = (k2 < na ? ldf(pA[k2]) : ldf(pB[k2 - na])) * rstd * (norm ? gain[k2] : 1.f);
                const size_t tb = (size_t)t * rot + li;
                o[k] = stf(v * cs[tb] - v2 * sn[tb]); o[k2] = stf(v2 * cs[tb + q4] + v * sn[tb + q4]); continue; }
            if (ofp) ofp[k] = v;
            o[k] = stf(v); } } };

template <int DQK, int DV> struct OSM { float q[DQK]; float o[DV]; float m, l, scale;
    HD void init(const act_t* qp, float sc) { UNR for (int i = 0; i < DQK; ++i) q[i] = ldf(qp[i]); UNR for (int i = 0; i < DV; ++i) o[i] = 0.f; m = -1e30f; l = 0.f; scale = sc; }
    HD void key(const act_t* kp, const act_t* vp, float bias) { float s = 0.f; UNR for (int i = 0; i < DQK; ++i) s += q[i] * ldf(kp[i]); s = s * scale + bias;
        const float mn = s > m ? s : m; const float a = expf(m - mn), p = expf(s - mn); l = l * a + p; UNR for (int i = 0; i < DV; ++i) o[i] = o[i] * a + p * ldf(vp[i]); m = mn; }
    HD void sink(float sk) { const float mn = sk > m ? sk : m; const float a = expf(m - mn); l = l * a + expf(sk - mn); UNR for (int i = 0; i < DV; ++i) o[i] *= a; m = mn; }
    HD void fin(act_t* op) { const float r = 1.f / l; UNR for (int i = 0; i < DV; ++i) op[i] = stf(o[i] * r); } };

template <int DQK, int DV> struct OpAttnCtx { const act_t* Q; long pq; long shq; const act_t* K; long pk; long shk; const act_t* V; long pv; long shv; act_t* O; long po; long sho; long NH, G; const float* sinks; Dims d;
    HD void run(long g) const { const int t = (int)(g % d.S); const int h = (int)((g / d.S) % NH); const int b = (int)(g / ((long)d.S * NH)); const int kvh = h / G;
        OSM<DQK, DV> st; st.init(Q + (size_t)(b * d.S + t) * pq + (size_t)h * shq, 1.f / sqrtf((float)DQK));
        for (int j = 0; j < d.S; ++j) { const size_t r = (size_t)(b * d.S + j); st.key(K + r * pk + (size_t)kvh * shk, V + r * pv + (size_t)kvh * shv, 0.f); }
        if (sinks) st.sink(sinks[h]);
        st.fin(O + (size_t)(b * d.S + t) * po + (size_t)h * sho); } };
template <int DH> struct OpNatLat { const act_t* QKV; long pq; const act_t* CK; const act_t* CV; const float* rpb; act_t* O; long po; Dims d;
    HD void run(long g) const { const int t = (int)(g % d.N); const int h = (int)((g / d.N) % d.NAH); const int b = (int)(g / ((long)d.N * d.NAH));
        const int GW = d.GW, rows = d.N / GW; const int wr = rows < 8 ? rows : 8; const int r = t / GW, c = t % GW;
        int rs = r - wr / 2; rs = rs < 0 ? 0 : (rs > rows - wr ? rows - wr : rs); int cst = c - 8; cst = cst < 0 ? 0 : (cst > GW - 16 ? GW - 16 : cst);
        const size_t rb = (size_t)d.RC + (size_t)b * d.N; const int HD_ = d.NAH * DH;
        OSM<DH, DH> st; st.init(QKV + (rb + t) * pq + (size_t)h * DH, 1.f / sqrtf((float)DH));
        for (int j = 0; j < d.PAST; ++j) { const size_t o = ((size_t)(b * d.NAH + h) * d.PAST + j) * DH; st.key(CK + o, CV + o, 0.f); }
        for (int kr = rs; kr < rs + wr; ++kr) for (int kc = cst; kc < cst + 16; ++kc) { const size_t kt = rb + (size_t)kr * GW + kc;
            const float bias = rpb[((size_t)h * 15 + (kr - r + 7)) * 31 + (kc - c + 15)];
            st.key(QKV + kt * pq + HD_ + (size_t)h * DH, QKV + kt * pq + 2 * HD_ + (size_t)h * DH, bias); }
        st.fin(O + (rb + t) * po + (size_t)h * DH); } };
template <int DQK, int DV> struct OpMlaLat { const act_t* Q; const act_t* K; const act_t* KV; act_t* O; long po; Dims d;
    HD void run(long g) const { const int t = (int)(g % d.N); const int h = (int)((g / d.N) % d.MH); const int b = (int)(g / ((long)d.N * d.MH));
        const size_t rb = (size_t)d.RC + (size_t)b * d.N; const size_t pq = (size_t)d.MH * DQK, pkv = (size_t)d.MH * (d.MNOPE + DV);
        OSM<DQK, DV> st; st.init(Q + (rb + t) * pq + (size_t)h * DQK, 1.f / sqrtf((float)DQK));
        for (int j = 0; j < d.PAST; ++j) { const size_t r = (size_t)d.R + (size_t)b * d.PAST + j; st.key(K + r * pq + (size_t)h * DQK, KV + r * pkv + (size_t)h * (d.MNOPE + DV) + d.MNOPE, 0.f); }
        for (int j = 0; j < d.N; ++j) { const size_t r = rb + j; st.key(K + r * pq + (size_t)h * DQK, KV + r * pkv + (size_t)h * (d.MNOPE + DV) + d.MNOPE, 0.f); }
        st.fin(O + (rb + t) * po + (size_t)h * DV); } };
template <int DH> struct OpSwaLat { const act_t* QKV; long pq; const act_t* CK; const act_t* CV; const float* sinks; act_t* O; long po; Dims d;
    HD void run(long g) const { const int t = (int)(g % d.N); const int h = (int)((g / d.N) % d.SH); const int b = (int)(g / ((long)d.N * d.SH)); const int G = d.SH / d.SKVH, kvh = h / G;
        const size_t rb = (size_t)d.RC + (size_t)b * d.N;
        OSM<DH, DH> st; st.init(QKV + (rb + t) * pq + (size_t)h * DH, 1.f / sqrtf((float)DH));
        for (int j = 0; j < d.PAST; ++j) { const size_t o = ((size_t)(b * d.SKVH + kvh) * d.PAST + j) * DH; st.key(CK + o, CV + o, 0.f); }
        int lo = t - d.SWIN, hi = t + d.SWIN; lo = lo < 0 ? 0 : lo; hi = hi > d.N - 1 ? d.N - 1 : hi;
        for (int j = lo; j <= hi; ++j) { const size_t r = rb + j; st.key(QKV + r * pq + (size_t)(d.SH + kvh) * DH, QKV + r * pq + (size_t)(d.SH + d.SKVH + kvh) * DH, 0.f); }
        st.sink(sinks[h]);
        st.fin(O + (rb + t) * po + (size_t)h * DH); } };

struct OpLruConv { const act_t* XG; const float* cw; const float* cb; act_t* XC; Dims d;
    HD void run(long g) const { const int LW = d.LW; const int row = (int)(g / LW), c = (int)(g % LW);
        int s0, T; if (row < d.RC) { s0 = (row / d.S) * d.S; T = d.S; } else { s0 = d.RC + ((row - d.RC) / d.N) * d.N; T = d.N; } const int t = row - s0;
        float acc = cb[c]; for (int k = 0; k < 4; ++k) { const int tt = t + k - 2; if (tt >= 0 && tt < T) acc += cw[(size_t)k * LW + c] * ldf(XG[(size_t)(s0 + tt) * 2 * LW + c]); }
        XC[g] = stf(acc); } };
struct OpLruScan { const act_t* XC; const act_t* XG; const float* wa; const float* ba; const float* wi; const float* bi; const float* lam; const float* h0; act_t* HS; act_t* Y; float* state_out; Dims d;
    HD void step(int dir, size_t row, int c, int blk, int j, float sp, float& h) const { const int LW = d.LW, LBK = d.LBK;
        const act_t* xr = XC + row * LW + (size_t)blk * LBK; const float* Wa = wa + ((size_t)(dir * d.LB + blk) * LBK) * LBK + j; const float* Wi = wi + ((size_t)(dir * d.LB + blk) * LBK) * LBK + j;
        float ra = ba[(size_t)dir * LW + c], ri = bi[(size_t)dir * LW + c];
        for (int k = 0; k < LBK; ++k) { const float x = ldf(xr[k]); ra += x * Wa[(size_t)k * LBK]; ri += x * Wi[(size_t)k * LBK]; }
        const float r = sigm_f(ra), ig = sigm_f(ri); const float la = -8.f * r * sp; const float a = expf(la); const float om = -expm1f(2.f * la);
        h = a * h + sqrtf(om) * (ig * ldf(XC[row * LW + c])); }
    HD void run(long g) const { const int LW = d.LW; const int seq = (int)(g / LW), c = (int)(g % LW); const int blk = c / d.LBK, j = c % d.LBK;
        size_t s0; int T; float hf = 0.f, hb = 0.f;
        if (seq < d.B) { s0 = (size_t)seq * d.S; T = d.S; } else { const int b = seq - d.B; s0 = (size_t)d.RC + (size_t)b * d.N; T = d.N; hf = h0[((size_t)b * 2 + 0) * LW + c]; hb = h0[((size_t)b * 2 + 1) * LW + c]; }
        float spf, spb; { const float l0 = lam[c], l1 = lam[LW + c]; spf = log1pf(expf(-l0)); spb = log1pf(expf(-l1)); }
        for (int t = 0; t < T; ++t) { step(0, s0 + t, c, blk, j, spf, hf); HS[(s0 + t) * LW + c] = stf(hf); }
        for (int t = T - 1; t >= 0; --t) { step(1, s0 + t, c, blk, j, spb, hb); const size_t row = s0 + t; Y[row * LW + c] = stf(gelu_f(ldf(XG[row * 2 * LW + LW + c])) * (ldf(HS[row * LW + c]) + hb)); }
        if (seq < d.B) { state_out[((size_t)seq * 2 + 0) * LW + c] = hf; state_out[((size_t)seq * 2 + 1) * LW + c] = hb; } } };

struct OpMlaNorm { act_t* Dn; act_t* KR; const float* gqa; const float* gkva; const float* cckv; const float* ckr; float* o_ckv; float* o_kr; Dims d;
    HD void run(long row) const { act_t* p = Dn + (size_t)row * d.MDN; act_t* kr = KR + (size_t)row * d.MROPE;
        if (row >= d.R) { const size_t j = (size_t)(row - d.R); for (int k = 0; k < d.MKR; ++k) p[d.MQR + k] = stf(cckv[j * d.MKR + k]); for (int k = 0; k < d.MROPE; ++k) kr[k] = stf(ckr[j * d.MROPE + k]); return; }
        float ss = 0.f; for (int k = 0; k < d.MQR; ++k) { const float v = ldf(p[k]); ss += v * v; } float rs = 1.f / sqrtf(ss / d.MQR + 1e-6f);
        for (int k = 0; k < d.MQR; ++k) p[k] = stf(ldf(p[k]) * rs * gqa[k]);
        ss = 0.f; for (int k = 0; k < d.MKR; ++k) { const float v = ldf(p[d.MQR + k]); ss += v * v; } rs = 1.f / sqrtf(ss / d.MKR + 1e-6f);
        for (int k = 0; k < d.MKR; ++k) { const float v = ldf(p[d.MQR + k]) * rs * gkva[k]; p[d.MQR + k] = stf(v); if (row < d.RC) o_ckv[(size_t)row * d.MKR + k] = v; }
        for (int k = 0; k < d.MROPE; ++k) { const act_t v = p[d.MQR + d.MKR + k]; kr[k] = v; if (row < d.RC) o_kr[(size_t)row * d.MROPE + k] = ldf(v); } } };

struct OpFfnAct { const act_t* U; const float* cw; const float* cb; act_t* G; long row0; long nrows; Dims d;
    HD void run(long g) const { const int F = d.DFF; const int lr = (int)(g / F), c = (int)(g % F); const int row = row0 + lr;
        int s0, T; if (row < d.RC) { s0 = (row / d.S) * d.S; T = d.S; } else { s0 = d.RC + ((row - d.RC) / d.N) * d.N; T = d.N; } const int t = row - s0;
        float acc = cb[c]; for (int k = 0; k < 3; ++k) { const int tt = t + k - 1; if (tt >= 0 && tt < T) acc += cw[(size_t)k * F + c] * ldf(U[(size_t)(s0 + tt - row0) * 2 * F + c]); }
        G[(size_t)lr * F + c] = stf(silu_f(acc) * ldf(U[(size_t)lr * 2 * F + F + c])); } };
struct OpCopyV { const act_t* src; long ps; long sh; long NH, dh; float* of; Dims d;
    HD void run(long g) const { const int k = (int)(g % dh); const int h = (int)((g / dh) % NH); const int row = (int)(g / ((long)dh * NH));
        of[((size_t)((row / d.S) * NH + h) * d.S + (row % d.S)) * dh + k] = ldf(src[(size_t)row * ps + (size_t)h * sh + k]); } };

struct WS {
    float* MOD; float* ropeC; float* ropeS;
    act_t *Wffn_in[4], *Wffn_out[4], *Wnat_qkv, *Wnat_o, *Wlru_in, *Wlru_out, *Wmla_down, *Wmla_uq, *Wmla_ukv, *Wmla_o, *Wswa_qkv, *Wswa_o;
    act_t *natCK, *natCV, *swaCK, *swaCV;
    act_t* H;
    act_t* OB;
    float* T_mix[4]; float* T_ffn;
    act_t* QKV;
    act_t *XG, *XC, *HS, *Y;
    act_t *Dn, *KR, *Q, *KVr, *K;
    act_t *U, *G;
    int ffn_chunk_rows;
};
enum { I_xp = 0, I_xs, I_cnk, I_cnv, I_slru, I_cckv, I_ckr, I_csk, I_csv, I_c, I_cctx, I_nmix, I_nffn, I_wmod, I_bmod, I_fwin, I_fcw, I_fcb, I_fwout,
       I_nwqkv, I_nqn, I_nkn, I_nrpb, I_nwo, I_lwin, I_lcw, I_lcb, I_lwa, I_lba, I_lwi, I_lbi, I_llam, I_lwout, I_mwd, I_mqan, I_mkvan, I_mwuq, I_mwukv, I_mqn, I_mkn, I_mwo,
       I_swqkv, I_sqn, I_skn, I_ssink, I_swo, N_IN };
struct OutPtrs { float *yp, *ys, *nat_k, *nat_v, *lru, *ckv, *krope, *swa_k, *swa_v; };

#define LAS __attribute__((address_space(3)))
namespace mk {
typedef unsigned short bf16;
typedef short bf16x8 __attribute__((ext_vector_type(8)));
typedef short s16x4 __attribute__((ext_vector_type(4)));
typedef float f32x4 __attribute__((ext_vector_type(4)));
typedef float f32x16 __attribute__((ext_vector_type(16)));
typedef unsigned u32x4 __attribute__((ext_vector_type(4)));
typedef unsigned u32x2 __attribute__((ext_vector_type(2)));
constexpr int D = 2048, RC = 4096, NLAT = 4096, R = 36864, RK = 38912, DFF = 5632, NCI = 9, N6 = 12288, LW = 2688, LBK = 168;
constexpr int NQ = 2048, MDN = 1536, MQW = 3072, MKVW = 4096, SQW = 2560;
constexpr float LOG2E = 1.4426950408889634f;
constexpr size_t MiB = 1u << 20;
constexpr size_t WS_CTL = 0, WS_MOD = 1, WS_ROPEC = 3, WS_ROPES = 4, WS_NATCK = 5, WS_NATCV = 13, WS_SWACK = 21, WS_SWACV = 22, WS_WG = 1490, WS_WFFN = 26, WS_WNQKV = 290, WS_WNO = 314, WS_WLIN = 322, WS_WLOUT = 344,
    WS_WMD = 355, WS_WMUQ = 361, WS_WMUKV = 366, WS_WMO = 370, WS_WSQKV = 378, WS_WSO = 388, WS_H = 396, WS_S = 540;
constexpr size_t WS_QKV = 540, WS_XG = 540, WS_AGG = 918, WS_CARRY = 944, WS_Y = 1296, WS_DN = 540, WS_KR = 654, WS_Q = 659, WS_KVR = 875, WS_K = 1179, WS_G = 540, WS_SIDE = 936;
constexpr int CW_BAR = 4096;
constexpr int EPI_OFF = 131072, LDSCTL_OFF = 131072 + 12288, MISC_OFF = LDSCTL_OFF + 320, LDS_BYTES = 147456;

struct Fr { LAS unsigned char* lds; int tid, lane, wave, G, bid; };
__device__ __forceinline__ unsigned f2bf(float f) { unsigned u = __builtin_bit_cast(unsigned, f); return (u + 0x7fffu + ((u >> 16) & 1u)) >> 16; }
__device__ __forceinline__ unsigned pk2(float lo, float hi) { unsigned r; asm volatile("v_cvt_pk_bf16_f32 %0, %1, %2" : "=v"(r) : "v"(lo), "v"(hi)); return r; }
__device__ __forceinline__ float bf2f(unsigned short v) { return __builtin_bit_cast(float, ((unsigned)v) << 16); }
__device__ __forceinline__ float bflo(unsigned w) { return __builtin_bit_cast(float, w << 16); }
__device__ __forceinline__ float bfhi(unsigned w) { return __builtin_bit_cast(float, w & 0xffff0000u); }
__device__ __forceinline__ float wave_sum(float v) {
#pragma unroll
    for (int o = 1; o < 64; o <<= 1) v += __shfl_xor(v, o);
    return v; }
__device__ __forceinline__ float fexp2(float x) { return __builtin_amdgcn_exp2f(x); }
__device__ __forceinline__ float frcp(float x) { return __builtin_amdgcn_rcpf(x); }
__device__ __forceinline__ float sigm(float x) { return frcp(1.f + fexp2(-x * LOG2E)); }
__device__ __forceinline__ float siluf(float x) { return x * sigm(x); }
__device__ __forceinline__ float geluf(float x) { const float u = 0.7978845608028654f * (x + 0.044715f * x * x * x); return x * sigm(2.f * u); }
__device__ __forceinline__ void unpack8(const bf16x8& v, float (&f)[8]) { const u32x4 w = __builtin_bit_cast(u32x4, v);
    f[0] = bflo(w.x); f[1] = bfhi(w.x); f[2] = bflo(w.y); f[3] = bfhi(w.y); f[4] = bflo(w.z); f[5] = bfhi(w.z); f[6] = bflo(w.w); f[7] = bfhi(w.w); }
__device__ __forceinline__ bf16x8 pack8(const float (&f)[8]) { u32x4 w; w.x = pk2(f[0], f[1]); w.y = pk2(f[2], f[3]); w.z = pk2(f[4], f[5]); w.w = pk2(f[6], f[7]); return __builtin_bit_cast(bf16x8, w); }

#define XB_TMO      128
#define XB_XCNT(j)  (256  + 64 * (j))
#define XB_XSUB(j)  (1280 + 64 * (j))
#define XB_XGEN(j)  (2304 + 64 * (j))
#define XB_TOP      3328
#define XB_TOPGEN   3392
#define XCD_BAR_WORDS 3456
#define XB_SPIN_CAP (1u << 22)
__device__ __forceinline__ unsigned xb_ld(unsigned* p)              { return __hip_atomic_load(p, __ATOMIC_RELAXED, __HIP_MEMORY_SCOPE_AGENT); }
__device__ __forceinline__ unsigned xb_add(unsigned* p, unsigned v) { return __hip_atomic_fetch_add(p, v, __ATOMIC_RELAXED, __HIP_MEMORY_SCOPE_AGENT); }
__device__ __forceinline__ unsigned xb_xcc_id() { return (unsigned)__builtin_amdgcn_s_getreg((3 << 11) | 20) & 0xFu; }
#define XB_SPIN(cond, bar) do { unsigned _sp = 0; while (cond) { __builtin_amdgcn_s_sleep(1); \
    if ((++_sp & 255u) == 0u) { if (xb_ld(&(bar)[XB_TMO])) break; if (_sp > XB_SPIN_CAP) { atomicAdd(&(bar)[XB_TMO], 1u); break; } } } } while (0)
struct XcdBarrier { unsigned* bar; unsigned x; volatile LAS unsigned* st; };
__device__ __forceinline__ XcdBarrier xcd_barrier_post(unsigned* bar, volatile LAS unsigned* st) {
    XcdBarrier b; b.bar = bar; b.x = xb_xcc_id(); b.st = st;
    if (threadIdx.x == 0) (void)xb_add(&bar[XB_XCNT(b.x)], 1u);
    return b;
}
__device__ __forceinline__ void xcd_barrier_complete(unsigned* bar, unsigned x, unsigned& nloc, unsigned& nx) {
    const unsigned G = gridDim.x * gridDim.y * gridDim.z;
    unsigned sum, cnt, mine, sp = 0u;
    for (;;) {
        sum = 0u; cnt = 0u; mine = 0u;
#pragma unroll
        for (unsigned j = 0; j < 16; ++j) { const unsigned c = xb_ld(&bar[XB_XCNT(j)]); sum += c; cnt += (c > 0u) ? 1u : 0u; mine = (j == x) ? c : mine; }
        if (sum == G) break;
        __builtin_amdgcn_s_sleep(1);
        if ((++sp & 255u) == 0u) { if (xb_ld(&bar[XB_TMO])) break; if (sp > XB_SPIN_CAP) { atomicAdd(&bar[XB_TMO], 1u); break; } }
    }
    nloc = mine > 0u ? mine : 1u; nx = cnt > 0u ? cnt : 1u;
}
__device__ __forceinline__ void xcd_barrier(const XcdBarrier& b) {
    asm volatile("s_waitcnt vmcnt(0)" ::: "memory");
    __syncthreads();
    if (threadIdx.x == 0) {
        unsigned* bar = b.bar;
        __builtin_amdgcn_s_waitcnt(0);
        unsigned nloc = b.st[0], nx = b.st[1];
        if (nloc == 0u) { xcd_barrier_complete(bar, b.x, nloc, nx); b.st[0] = nloc; b.st[1] = nx; }
        const unsigned old = xb_add(&bar[XB_XSUB(b.x)], 1u);
        const unsigned gen = old / nloc;
        if (old + 1u == (gen + 1u) * nloc) {
            __builtin_amdgcn_fence(__ATOMIC_RELEASE, "agent");
            asm volatile("s_waitcnt vmcnt(0)" ::: "memory");
            const unsigned og = xb_add(&bar[XB_TOP], 1u);
            const unsigned tg = og / nx;
            if (og + 1u == (tg + 1u) * nx) xb_add(&bar[XB_TOPGEN], 1u);
            else XB_SPIN(xb_ld(&bar[XB_TOPGEN]) == tg, bar);
            __builtin_amdgcn_fence(__ATOMIC_ACQUIRE, "agent");
            xb_add(&bar[XB_XGEN(b.x)], 1u);
            asm volatile("s_waitcnt vmcnt(0)" ::: "memory");
        } else {
            XB_SPIN(xb_ld(&bar[XB_XGEN(b.x)]) == gen, bar);
            __builtin_amdgcn_fence(__ATOMIC_ACQUIRE, "agent");
            asm volatile("s_waitcnt vmcnt(0)" ::: "memory");
        }
    }
    __syncthreads();
}

__device__ __forceinline__ void tr_item(const float* W, int N, int k0, int n0, bf16* WT, int Kd, int drow0, LAS float* scr, int lane) {
#pragma unroll 8
    for (int i = 0; i < 32; ++i) { const int kk = 2 * i + (lane >> 5); scr[kk * 33 + (lane & 31)] = __builtin_nontemporal_load(&W[(size_t)(k0 + kk) * N + n0 + (lane & 31)]); }
    asm volatile("s_waitcnt lgkmcnt(0)" ::: "memory");
    const int c = lane & 7;
#pragma unroll
    for (int j = 0; j < 4; ++j) { const int n = (lane >> 3) + 8 * j; const LAS float* s = scr + (8 * c) * 33 + n;
        u32x4 o; o.x = pk2(s[0 * 33], s[1 * 33]); o.y = pk2(s[2 * 33], s[3 * 33]); o.z = pk2(s[4 * 33], s[5 * 33]); o.w = pk2(s[6 * 33], s[7 * 33]);
        *(u32x4*)(WT + (size_t)(drow0 + n) * Kd + k0 + 8 * c) = o; }
    asm volatile("s_waitcnt lgkmcnt(0)" ::: "memory");
}
__device__ __forceinline__ void tr_job(const Fr& F, const float* W, int K, int N, bf16* WT, int perm) {
    LAS float* scr = (LAS float*)(F.lds + F.wave * 16384);
    const int nblk = N / 32, items = (K / 64) * nblk; const int gw = F.bid * 8 + F.wave, NGW = F.G * 8;
    for (int it = gw; it < items; it += NGW) { const int kb = it / nblk, nb = it % nblk, n0 = 32 * nb; int dr = n0;
        if (perm) { const int half = n0 >= DFF; const int c = half ? n0 - DFF : n0; dr = 256 * (c >> 7) + 128 * half + (c & 127); }
        tr_item(W, N, 64 * kb, n0, WT, K, dr, scr, F.lane); }
}
#ifndef DEFER_W
#define DEFER_W 1
#endif
__device__ __forceinline__ void tr_layer(const Fr& F, const float* const* in, unsigned char* ws, int l, int part) {
    if (part == 1) { tr_job(F, in[I_fwin] + (size_t)l * D * 2 * DFF, D, 2 * DFF, (bf16*)(ws + (WS_WFFN + 66 * l) * MiB), 1); tr_job(F, in[I_fwout] + (size_t)l * DFF * D, DFF, D, (bf16*)(ws + (WS_WFFN + 66 * l + 44) * MiB), 0); return; }
    if (l == 0) { tr_job(F, in[I_nwqkv], D, 3 * NQ, (bf16*)(ws + WS_WNQKV * MiB), 0); tr_job(F, in[I_nwo], NQ, D, (bf16*)(ws + WS_WNO * MiB), 0); }
    else if (l == 1) { tr_job(F, in[I_lwin], D, 2 * LW, (bf16*)(ws + WS_WLIN * MiB), 0); tr_job(F, in[I_lwout], LW, D, (bf16*)(ws + WS_WLOUT * MiB), 0); }
    else if (l == 2) { tr_job(F, in[I_mwd], D, 1344, (bf16*)(ws + WS_WMD * MiB), 0); tr_job(F, in[I_mwuq], 768, MQW, (bf16*)(ws + WS_WMUQ * MiB), 0); tr_job(F, in[I_mwukv], 512, MKVW, (bf16*)(ws + WS_WMUKV * MiB), 0); tr_job(F, in[I_mwo], 2048, D, (bf16*)(ws + WS_WMO * MiB), 0);
        unsigned* z = (unsigned*)((bf16*)(ws + WS_WMD * MiB) + (size_t)1344 * D); for (int i = F.bid * 512 + F.tid; i < 192 * D / 2; i += F.G * 512) z[i] = 0u; }
    else { tr_job(F, in[I_swqkv], D, SQW, (bf16*)(ws + WS_WSQKV * MiB), 0); tr_job(F, in[I_swo], 2048, D, (bf16*)(ws + WS_WSO * MiB), 0); }
}
__device__ __forceinline__ void tr_layer_idle(const Fr& F, const float* const* in, unsigned char* ws, int l, int part) {
    const int busy = 1152 % F.G; if (busy == 0 || F.bid < busy) return;
    Fr F2 = F; F2.bid = F.bid - busy; F2.G = F.G - busy; tr_layer(F2, in, ws, l, part);
}
struct ProArgs { const float* const* in; unsigned char* ws; };
__device__ __forceinline__ void ph_prologue(const Fr& F, const float* const* in, unsigned char* ws) {
    const int gt = F.bid * 512 + F.tid, NGT = F.G * 512;
    for (int j = F.bid; j < 256; j += F.G) {
        const int l = j >> 6, n0 = (j & 63) * 192; LAS float* S = (LAS float*)F.lds; LAS float* red = (LAS float*)(F.lds + 73728);
        for (int i = F.tid; i < NCI * D; i += 512) { const int ci = i / D, k = i % D; const float v = ci == 0 ? in[I_cctx][k] : in[I_c][(size_t)(ci - 1) * D + k]; S[i] = siluf(v); }
        __syncthreads();
        float acc[3][NCI];
#pragma unroll
        for (int g = 0; g < 3; ++g)
#pragma unroll
            for (int c = 0; c < NCI; ++c) acc[g][c] = 0.f;
        const float* wl = in[I_wmod] + (size_t)l * D * N6 + n0 + F.lane;
#pragma unroll 4
        for (int k = F.wave * 256; k < F.wave * 256 + 256; ++k) { const float w0 = __builtin_nontemporal_load(&wl[(size_t)k * N6]), w1 = __builtin_nontemporal_load(&wl[(size_t)k * N6 + 64]), w2 = __builtin_nontemporal_load(&wl[(size_t)k * N6 + 128]);
#pragma unroll
            for (int c = 0; c < NCI; ++c) { const float s = S[c * D + k]; acc[0][c] += s * w0; acc[1][c] += s * w1; acc[2][c] += s * w2; } }
#pragma unroll
        for (int g = 0; g < 3; ++g)
#pragma unroll
            for (int c = 0; c < NCI; ++c) red[((F.wave * 3 + g) * NCI + c) * 64 + F.lane] = acc[g][c];
        __syncthreads();
        float* MOD = (float*)(ws + WS_MOD * MiB);
        for (int o = F.tid; o < 192 * NCI; o += 512) { const int ci = o / 192, nl = o % 192, g = nl >> 6, ln = nl & 63; float s = in[I_bmod][(size_t)l * N6 + n0 + nl];
#pragma unroll
            for (int w = 0; w < 8; ++w) s += red[((w * 3 + g) * NCI + ci) * 64 + ln];
            MOD[((size_t)l * NCI + ci) * N6 + n0 + nl] = s; }
        __syncthreads();
    }
    tr_layer(F, in, ws, 0, 0); tr_layer(F, in, ws, 0, 1);
    if (!DEFER_W) for (int l = 1; l < 4; ++l) { tr_layer(F, in, ws, l, 0); tr_layer(F, in, ws, l, 1); }
    { bf16* Wg = (bf16*)(ws + WS_WG * MiB); constexpr int TOT = 2 * 2 * 16 * 192 * 192;
      for (int i0 = gt; i0 < TOT; i0 += 6 * NGT) { float v[6];
#pragma unroll
          for (int u = 0; u < 6; ++u) { const int i = i0 + u * NGT; v[u] = 0.f;
              if (i < TOT) { const int k = i % 192, j = (i / 192) % 192, blk = (i / 36864) % 16, mat = (i / 589824) % 2, dir = i / 1179648;
                  if (j < 168 && k < 168) v[u] = (mat == 0 ? in[I_lwa] : in[I_lwi])[(((size_t)dir * 16 + blk) * 168 + k) * 168 + j]; } }
#pragma unroll
          for (int u = 0; u < 6; ++u) { const int i = i0 + u * NGT; if (i < TOT) Wg[i] = (bf16)f2bf(v[u]); } } }
    { typedef float f4v __attribute__((ext_vector_type(4)));
      bf16* a = (bf16*)(ws + WS_NATCK * MiB); bf16* b = (bf16*)(ws + WS_NATCV * MiB); const f4v* ia = (const f4v*)in[I_cnk]; const f4v* ib = (const f4v*)in[I_cnv];
      for (int i = gt; i < 8 * 16 * 256 * 128 / 8; i += NGT) { const f4v a0 = ia[2 * i], a1 = ia[2 * i + 1], b0 = ib[2 * i], b1 = ib[2 * i + 1];
          const float xa[8] = {a0.x, a0.y, a0.z, a0.w, a1.x, a1.y, a1.z, a1.w}, xb[8] = {b0.x, b0.y, b0.z, b0.w, b1.x, b1.y, b1.z, b1.w};
          *(bf16x8*)(a + 8 * (size_t)i) = pack8(xa); *(bf16x8*)(b + 8 * (size_t)i) = pack8(xb); }
      bf16* c = (bf16*)(ws + WS_SWACK * MiB); bf16* d = (bf16*)(ws + WS_SWACV * MiB); const f4v* ic = (const f4v*)in[I_csk]; const f4v* id = (const f4v*)in[I_csv];
      for (int i = gt; i < 8 * 4 * 256 * 64 / 8; i += NGT) { const f4v a0 = ic[2 * i], a1 = ic[2 * i + 1], b0 = id[2 * i], b1 = id[2 * i + 1];
          const float xa[8] = {a0.x, a0.y, a0.z, a0.w, a1.x, a1.y, a1.z, a1.w}, xb[8] = {b0.x, b0.y, b0.z, b0.w, b1.x, b1.y, b1.z, b1.w};
          *(bf16x8*)(c + 8 * (size_t)i) = pack8(xa); *(bf16x8*)(d + 8 * (size_t)i) = pack8(xb); } }
    { float* cs = (float*)(ws + WS_ROPEC * MiB); float* sn = (float*)(ws + WS_ROPES * MiB);
      for (int i = gt; i < NLAT * 64; i += NGT) { const int t = i >> 6, li = i & 63, f = li & 15; const float pos = li < 32 ? (float)(t >> 6) : (float)(t & 63);
          const float inv = fexp2(-(float)f * 0.8304820237218406f); const float rev = pos * inv * 0.15915494309189535f; const float fr = rev - floorf(rev);
          cs[i] = __builtin_amdgcn_cosf(fr); sn[i] = __builtin_amdgcn_sinf(fr); } }
}

__device__ __forceinline__ void ph_norm(const Fr& F, const float* xc, const float* xl, const float* g, const float* mod, int chunk, bf16* H) {
    const int gw = F.bid * 8 + F.wave, NGW = F.G * 8;
    for (int row0 = gw; row0 < R; row0 += 2 * NGW) {
        const int row1 = row0 + NGW; const bool has1 = row1 < R; const int r1 = has1 ? row1 : row0;
        const float* x0 = (row0 < RC ? xc + (size_t)row0 * D : xl + (size_t)(row0 - RC) * D) + 4 * F.lane; const float* x1 = (r1 < RC ? xc + (size_t)r1 * D : xl + (size_t)(r1 - RC) * D) + 4 * F.lane;
        f32x4 v0[8], v1[8]; float s0 = 0.f, s1 = 0.f;
#pragma unroll
        for (int j = 0; j < 8; ++j) { v0[j] = *(const f32x4*)(x0 + 256 * j); v1[j] = *(const f32x4*)(x1 + 256 * j); }
#pragma unroll
        for (int j = 0; j < 8; ++j) { s0 += (v0[j].x * v0[j].x + v0[j].y * v0[j].y) + (v0[j].z * v0[j].z + v0[j].w * v0[j].w); s1 += (v1[j].x * v1[j].x + v1[j].y * v1[j].y) + (v1[j].z * v1[j].z + v1[j].w * v1[j].w); }
#pragma unroll
        for (int o = 1; o < 64; o <<= 1) { s0 += __shfl_xor(s0, o); s1 += __shfl_xor(s1, o); }
        const float rs0 = 1.f / sqrtf(s0 * (1.f / D) + 1e-6f), rs1 = 1.f / sqrtf(s1 * (1.f / D) + 1e-6f);
        const int c0 = row0 < RC ? 0 : 1 + ((row0 - RC) >> 12), c1 = r1 < RC ? 0 : 1 + ((r1 - RC) >> 12);
        const float* m0 = mod + (size_t)c0 * N6 + (size_t)chunk * D + 4 * F.lane; const float* m1 = mod + (size_t)c1 * N6 + (size_t)chunk * D + 4 * F.lane; const float* gp = g + 4 * F.lane;
        bf16* o0 = H + (size_t)row0 * D + 4 * F.lane; bf16* o1 = H + (size_t)r1 * D + 4 * F.lane;
#pragma unroll
        for (int j = 0; j < 8; ++j) { const f32x4 gv = *(const f32x4*)(gp + 256 * j);
            { const f32x4 sh = *(const f32x4*)(m0 + 256 * j), sc = *(const f32x4*)(m0 + D + 256 * j); const f32x4 h = v0[j] * rs0 * gv * (sc + 1.f) + sh; u32x2 w; w.x = pk2(h.x, h.y); w.y = pk2(h.z, h.w); *(u32x2*)(o0 + 256 * j) = w; }
            if (has1) { const f32x4 sh = *(const f32x4*)(m1 + 256 * j), sc = *(const f32x4*)(m1 + D + 256 * j); const f32x4 h = v1[j] * rs1 * gv * (sc + 1.f) + sh; u32x2 w; w.x = pk2(h.x, h.y); w.y = pk2(h.z, h.w); *(u32x2*)(o1 + 256 * j) = w; } }
    }
}
template <bool F32IN> __device__ __forceinline__ void ph_norm_rows(const Fr& F, const bf16* XB, const float* xc, const float* xl, const float* g, const float* mod, int chunk, bf16* H) {
    const int gw = F.bid * 8 + F.wave, NGW = F.G * 8; const int per = (R + NGW - 1) / NGW; const int rbeg = gw * per, rend = rbeg + per < R ? rbeg + per : R;
    float A[4][8], Bv[4][8]; int ccur = -1;
    for (int row0 = rbeg; row0 < rend; row0 += 2) {
        const int row1 = row0 + 1; const bool has1 = row1 < rend; const int r1 = has1 ? row1 : row0;
        bf16x8 a0[4], a1[4]; f32x4 f0[4][2], f1[4][2];
        if constexpr (F32IN) { const float* x0 = (row0 < RC ? xc + (size_t)row0 * D : xl + (size_t)(row0 - RC) * D) + 8 * F.lane; const float* x1 = (r1 < RC ? xc + (size_t)r1 * D : xl + (size_t)(r1 - RC) * D) + 8 * F.lane;
#pragma unroll
            for (int j = 0; j < 4; ++j) { f0[j][0] = __builtin_nontemporal_load((const f32x4*)(x0 + 512 * j)); f0[j][1] = __builtin_nontemporal_load((const f32x4*)(x0 + 512 * j + 4)); f1[j][0] = __builtin_nontemporal_load((const f32x4*)(x1 + 512 * j)); f1[j][1] = __builtin_nontemporal_load((const f32x4*)(x1 + 512 * j + 4)); }
        } else { const bf16* x0 = XB + (size_t)row0 * D + 8 * F.lane; const bf16* x1 = XB + (size_t)r1 * D + 8 * F.lane;
#pragma unroll
            for (int j = 0; j < 4; ++j) { a0[j] = __builtin_nontemporal_load((const bf16x8*)(x0 + 512 * j)); a1[j] = __builtin_nontemporal_load((const bf16x8*)(x1 + 512 * j)); } }
        const int c0 = row0 < RC ? 0 : 1 + ((row0 - RC) >> 12), c1 = r1 < RC ? 0 : 1 + ((r1 - RC) >> 12);
#define NORM16_PARAMS(ci) do { const float* mp = mod + (size_t)(ci) * N6 + (size_t)chunk * D + 8 * F.lane; const float* gp = g + 8 * F.lane; \
_Pragma("unroll") \
            for (int j = 0; j < 4; ++j) { const f32x4 ga = *(const f32x4*)(gp + 512 * j), gb = *(const f32x4*)(gp + 512 * j + 4), sa = *(const f32x4*)(mp + 512 * j), sb = *(const f32x4*)(mp + 512 * j + 4), \
                    ca = *(const f32x4*)(mp + D + 512 * j), cb = *(const f32x4*)(mp + D + 512 * j + 4); \
                A[j][0] = ga.x * (ca.x + 1.f); A[j][1] = ga.y * (ca.y + 1.f); A[j][2] = ga.z * (ca.z + 1.f); A[j][3] = ga.w * (ca.w + 1.f); A[j][4] = gb.x * (cb.x + 1.f); A[j][5] = gb.y * (cb.y + 1.f); A[j][6] = gb.z * (cb.z + 1.f); A[j][7] = gb.w * (cb.w + 1.f); \
                Bv[j][0] = sa.x; Bv[j][1] = sa.y; Bv[j][2] = sa.z; Bv[j][3] = sa.w; Bv[j][4] = sb.x; Bv[j][5] = sb.y; Bv[j][6] = sb.z; Bv[j][7] = sb.w; } ccur = (ci); } while (0)
        if (c0 != ccur) NORM16_PARAMS(c0);
        float v0[4][8], v1[4][8]; float s0 = 0.f, s1 = 0.f;
#pragma unroll
        for (int j = 0; j < 4; ++j) {
            if constexpr (F32IN) {
#pragma unroll
                for (int e = 0; e < 8; ++e) { v0[j][e] = f0[j][e >> 2][e & 3]; v1[j][e] = f1[j][e >> 2][e & 3]; }
            } else { unpack8(a0[j], v0[j]); unpack8(a1[j], v1[j]); }
#pragma unroll
            for (int e = 0; e < 8; ++e) { s0 += v0[j][e] * v0[j][e]; s1 += v1[j][e] * v1[j][e]; } }
#pragma unroll
        for (int o = 1; o < 64; o <<= 1) { s0 += __shfl_xor(s0, o); s1 += __shfl_xor(s1, o); }
        const float rs0 = 1.f / sqrtf(s0 * (1.f / D) + 1e-6f), rs1 = 1.f / sqrtf(s1 * (1.f / D) + 1e-6f);
        bf16* o0 = H + (size_t)row0 * D + 8 * F.lane; bf16* o1 = H + (size_t)r1 * D + 8 * F.lane;
#pragma unroll
        for (int j = 0; j < 4; ++j) { float h[8];
#pragma unroll
            for (int e = 0; e < 8; ++e) h[e] = v0[j][e] * rs0 * A[j][e] + Bv[j][e];
            *(bf16x8*)(o0 + 512 * j) = pack8(h); }
        if (has1) {
            if (c1 != ccur) NORM16_PARAMS(c1);
#pragma unroll
            for (int j = 0; j < 4; ++j) { float h[8];
#pragma unroll
                for (int e = 0; e < 8; ++e) h[e] = v1[j][e] * rs1 * A[j][e] + Bv[j][e];
                *(bf16x8*)(o1 + 512 * j) = pack8(h); } }
#undef NORM16_PARAMS
    }
}
__device__ __forceinline__ void ph_norm16(const Fr& F, const bf16* XB, const float* g, const float* mod, int chunk, bf16* H) { ph_norm_rows<false>(F, XB, nullptr, nullptr, g, mod, chunk, H); }
__device__ __forceinline__ void ph_norm32(const Fr& F, const float* xc, const float* xl, const float* g, const float* mod, int chunk, bf16* H) { ph_norm_rows<true>(F, nullptr, xc, xl, g, mod, chunk, H); }
}

namespace pg8 {
struct EpiResid {
    static constexpr bool PERM = false, AFTER_DRAIN = false;
    const float* xc; const float* xl; float* out; const float* gate;
    __device__ __forceinline__ void operator()(const f32x4 (&acc)[2][2][4][2], const Unit& u, int wr, int wc, int fr, int fq) const {
        const int ci = u.pm < 16 ? 0 : 1 + ((u.pm - 16) >> 4); const int row0 = u.pm * BM + wr * 64 + fr, col0 = u.pn * BM + wc * 32 + 4 * fq;
        const float* gp = gate + (size_t)ci * 12288 + col0; f32x4 gv[2][2];
#pragma unroll
        for (int bj = 0; bj < 2; ++bj)
#pragma unroll
            for (int n = 0; n < 2; ++n) gv[bj][n] = *(const f32x4*)(gp + bj * HALF + n * 16);
#pragma unroll
        for (int ai = 0; ai < 2; ++ai) {
            f32x4 xv[4][2][2];
#pragma unroll
            for (int m = 0; m < 4; ++m) { const int row = row0 + ai * HALF + m * 16; const float* xr = (row < 4096 ? xc + (size_t)row * 2048 : xl + (size_t)(row - 4096) * 2048) + col0;
#pragma unroll
                for (int bj = 0; bj < 2; ++bj)
#pragma unroll
                    for (int n = 0; n < 2; ++n) xv[m][bj][n] = *(const f32x4*)(xr + bj * HALF + n * 16); }
            asm volatile("" ::: "memory");
#pragma unroll
            for (int m = 0; m < 4; ++m) { const int row = row0 + ai * HALF + m * 16; float* orow = out + (size_t)row * 2048 + col0;
#pragma unroll
                for (int bj = 0; bj < 2; ++bj)
#pragma unroll
                    for (int n = 0; n < 2; ++n) *(f32x4*)(orow + bj * HALF + n * 16) = xv[m][bj][n] + gv[bj][n] * acc[ai][bj][m][n]; }
            asm volatile("" ::: "memory");
        }
    }
};

template <bool IN16, bool OUT16> struct EpiResidB {
    static constexpr bool PERM = true, AFTER_DRAIN = false;
    const void* xc; const void* xl; void* out; const float* gate;
    __device__ __forceinline__ void operator()(const f32x4 (&acc)[2][2][4][2], const Unit& u, int wr, int wc, int fr, int fq) const {
        const int ci = u.pm < 16 ? 0 : 1 + ((u.pm - 16) >> 4); const int row0 = u.pm * BM + wr * 64 + fr, col0 = u.pn * BM + wc * 32 + 8 * fq;
        const float* gp = gate + (size_t)ci * 12288 + col0; f32x4 gv[2][2];
#pragma unroll
        for (int bj = 0; bj < 2; ++bj)
#pragma unroll
            for (int n = 0; n < 2; ++n) gv[bj][n] = *(const f32x4*)(gp + bj * HALF + 4 * n);
#pragma unroll
        for (int ai = 0; ai < 2; ++ai) {
            mk::bf16x8 xb[4][2]; f32x4 xf[4][2][2];
#pragma unroll
            for (int m = 0; m < 4; ++m) { const int row = row0 + ai * HALF + m * 16; const size_t off = (size_t)(row < 4096 ? row : row - 4096) * 2048 + col0;
#pragma unroll
                for (int bj = 0; bj < 2; ++bj) {
                    if (IN16) xb[m][bj] = __builtin_nontemporal_load((const mk::bf16x8*)((const mk::bf16*)(row < 4096 ? xc : xl) + off + bj * HALF));
                    else { const float* p = (const float*)(row < 4096 ? xc : xl) + off + bj * HALF; xf[m][bj][0] = __builtin_nontemporal_load((const f32x4*)p); xf[m][bj][1] = __builtin_nontemporal_load((const f32x4*)(p + 4)); } } }
            asm volatile("" ::: "memory");
#pragma unroll
            for (int m = 0; m < 4; ++m) { const int row = row0 + ai * HALF + m * 16;
#pragma unroll
                for (int bj = 0; bj < 2; ++bj) { float x[8];
                    if (IN16) mk::unpack8(xb[m][bj], x); else { x[0] = xf[m][bj][0].x; x[1] = xf[m][bj][0].y; x[2] = xf[m][bj][0].z; x[3] = xf[m][bj][0].w; x[4] = xf[m][bj][1].x; x[5] = xf[m][bj][1].y; x[6] = xf[m][bj][1].z; x[7] = xf[m][bj][1].w; }
#pragma unroll
                    for (int e = 0; e < 8; ++e) x[e] += gv[bj][e >> 2][e & 3] * acc[ai][bj][m][e >> 2][e & 3];
                    if (OUT16) *(mk::bf16x8*)((mk::bf16*)out + (size_t)row * 2048 + col0 + bj * HALF) = mk::pack8(x);
                    else { float* o = (float*)out + (size_t)row * 2048 + col0 + bj * HALF; __builtin_nontemporal_store((f32x4){x[0], x[1], x[2], x[3]}, (f32x4*)o); __builtin_nontemporal_store((f32x4){x[4], x[5], x[6], x[7]}, (f32x4*)(o + 4)); } } }
            asm volatile("" ::: "memory");
        }
    }
};
}

#ifndef QFUSE
#define QFUSE 1
#endif
namespace mk {
struct HeadPost { const bf16* sa; long pa; int sha, na; const bf16* sb; long pb; int shb, nb; const float* gain; bf16* dst; long pd; int shd, NH, rot; const float* cs; const float* sn; float* of; int lat_end; };
template <int GS>
__device__ __forceinline__ void ph_headpost(const Fr& F, const HeadPost& P, int nitems) {
    constexpr int NB = 4, IPW = 64 / GS;
    const int i = F.lane & (GS - 1), e0 = 8 * i, dh = P.na + P.nb; const bool act_l = e0 < dh; const int r0 = dh - P.rot;
    const int gw2 = (F.bid * 8 + F.wave) * IPW + F.lane / GS, step = F.G * 8 * IPW;
    float gn[8];
    { const int ec = act_l ? e0 : 0; const f32x4 g0 = *(const f32x4*)(P.gain + ec), g1 = *(const f32x4*)(P.gain + ec + 4); gn[0] = g0.x; gn[1] = g0.y; gn[2] = g0.z; gn[3] = g0.w; gn[4] = g1.x; gn[5] = g1.y; gn[6] = g1.z; gn[7] = g1.w; }
    const float inv_dh = 1.f / (float)dh; const int nhs = 31 - __builtin_clz(P.NH);
    const int ntrip = (nitems + step * NB - 1) / (step * NB);
    for (int tr = 0; tr < ntrip; ++tr) { const int it0 = gw2 + tr * step * NB;
        bf16x8 raw[NB]; int rows[NB], hs[NB]; bool acts[NB];
#pragma unroll
        for (int b = 0; b < NB; ++b) { const int item = it0 + b * step; acts[b] = act_l && item < nitems; const int itc = item < nitems ? item : nitems - 1; rows[b] = itc >> nhs; hs[b] = itc & (P.NH - 1);
            raw[b] = (bf16x8){0, 0, 0, 0, 0, 0, 0, 0};
            if (acts[b]) raw[b] = __builtin_nontemporal_load((e0 < P.na) ? (const bf16x8*)(P.sa + (size_t)rows[b] * P.pa + (size_t)hs[b] * P.sha + e0) : (const bf16x8*)(P.sb + (size_t)rows[b] * P.pb + (size_t)hs[b] * P.shb + (e0 - P.na))); }
#pragma unroll
        for (int b = 0; b < NB; ++b) { const int row = rows[b], h = hs[b]; const bool act = acts[b];
            float v[8]; unpack8(raw[b], v);
            float ss = 0.f;
#pragma unroll
            for (int j = 0; j < 8; ++j) ss += v[j] * v[j];
#pragma unroll
            for (int o = 1; o < GS; o <<= 1) ss += __shfl_xor(ss, o);
            const float rstd = 1.f / sqrtf(ss * inv_dh + 1e-6f);
#pragma unroll
            for (int j = 0; j < 8; ++j) v[j] *= rstd * gn[j];
            if (P.of && act && row < RC) { float* op = P.of + ((size_t)((row >> 8) * P.NH + h) * 256 + (row & 255)) * dh + e0;
                *(f32x4*)op = (f32x4){v[0], v[1], v[2], v[3]}; *(f32x4*)(op + 4) = (f32x4){v[4], v[5], v[6], v[7]}; }
            if (P.rot) {
                float pv[8];
#pragma unroll
                for (int j = 0; j < 8; ++j) pv[j] = __shfl_xor(v[j], 2);
                const bool lat = row >= RC && row < P.lat_end;
                if (lat && act && e0 >= r0) { const int li0 = e0 - r0; const bool first = (li0 & 31) < 16; const int t = (row - RC) & (NLAT - 1);
                    const float* cp = P.cs + (size_t)t * 64 + li0; const float* sp = P.sn + (size_t)t * 64 + li0;
                    const f32x4 c0 = *(const f32x4*)cp, c1 = *(const f32x4*)(cp + 4), s0 = *(const f32x4*)sp, s1 = *(const f32x4*)(sp + 4);
                    const float cc[8] = {c0.x, c0.y, c0.z, c0.w, c1.x, c1.y, c1.z, c1.w}, sv[8] = {s0.x, s0.y, s0.z, s0.w, s1.x, s1.y, s1.z, s1.w};
#pragma unroll
                    for (int j = 0; j < 8; ++j) v[j] = v[j] * cc[j] + (first ? -pv[j] : pv[j]) * sv[j]; }
            }
            if (act) *(bf16x8*)(P.dst + (size_t)row * P.pd + (size_t)h * P.shd + e0) = pack8(v);
        }
    }
}
__device__ __forceinline__ void ph_copyv(const Fr& F, const bf16* src, long ps, int sh, int NH, int dh, float* of) {
    const int per = dh / 8, ps_ = 31 - __builtin_clz(per), nhs = 31 - __builtin_clz(NH); const int n = RC * NH * per;
    for (int g = F.bid * 512 + F.tid; g < n; g += F.G * 512) { const int c8 = g & (per - 1); const int h = (g >> ps_) & (NH - 1); const int row = g >> (ps_ + nhs);
        float v[8]; unpack8(*(const bf16x8*)(src + (size_t)row * ps + (size_t)h * sh + 8 * c8), v);
        float* op = of + ((size_t)((row >> 8) * NH + h) * 256 + (row & 255)) * dh + 8 * c8; *(f32x4*)op = (f32x4){v[0], v[1], v[2], v[3]}; *(f32x4*)(op + 4) = (f32x4){v[4], v[5], v[6], v[7]}; }
}
__device__ __forceinline__ void ph_mlanorm(const Fr& F, bf16* Dn, bf16* KR, const float* gqa, const float* gkva, const float* cckv, const float* ckr, float* o_ckv, float* o_kr) {
    const int gw = F.bid * 8 + F.wave, NGW = F.G * 8, lane = F.lane;
    f32x4 gq[3]; float gg[8];
#pragma unroll
    for (int j = 0; j < 3; ++j) gq[j] = *(const f32x4*)(gqa + 4 * lane + 256 * j);
    { const f32x4 g0 = *(const f32x4*)(gkva + 8 * lane), g1 = *(const f32x4*)(gkva + 8 * lane + 4); gg[0] = g0.x; gg[1] = g0.y; gg[2] = g0.z; gg[3] = g0.w; gg[4] = g1.x; gg[5] = g1.y; gg[6] = g1.z; gg[7] = g1.w; }
    for (int row0 = gw; row0 < RK; row0 += 2 * NGW) {
        u32x2 qw[2][3]; bf16x8 kvw[2], krw[2]; int rows[2]; bool on[2];
#pragma unroll
        for (int s = 0; s < 2; ++s) { const int row = row0 + s * NGW; rows[s] = row; on[s] = row < R; krw[s] = (bf16x8){0, 0, 0, 0, 0, 0, 0, 0};
            if (on[s]) { const bf16* p = Dn + (size_t)row * MDN;
#pragma unroll
                for (int j = 0; j < 3; ++j) qw[s][j] = *(const u32x2*)(p + 4 * lane + 256 * j);
                kvw[s] = *(const bf16x8*)(p + 768 + 8 * lane); if (lane < 8) krw[s] = *(const bf16x8*)(p + 1280 + 8 * lane); } }
#pragma unroll
        for (int s = 0; s < 2; ++s) { const int row = rows[s]; if (row >= RK) continue;
            bf16* p = Dn + (size_t)row * MDN;
            if (!on[s]) { const size_t j = (size_t)(row - R); const f32x4 a = *(const f32x4*)(cckv + j * 512 + 8 * lane), b = *(const f32x4*)(cckv + j * 512 + 8 * lane + 4);
                const float v[8] = {a.x, a.y, a.z, a.w, b.x, b.y, b.z, b.w}; *(bf16x8*)(p + 768 + 8 * lane) = pack8(v);
                if (lane < 8) { const f32x4 c = *(const f32x4*)(ckr + j * 64 + 8 * lane), d = *(const f32x4*)(ckr + j * 64 + 8 * lane + 4); const float w[8] = {c.x, c.y, c.z, c.w, d.x, d.y, d.z, d.w}; *(bf16x8*)(KR + (size_t)row * 64 + 8 * lane) = pack8(w); }
                continue; }
            float q[12]; float ss = 0.f;
#pragma unroll
            for (int j = 0; j < 3; ++j) { const u32x2 w = qw[s][j]; q[4 * j] = bflo(w.x); q[4 * j + 1] = bfhi(w.x); q[4 * j + 2] = bflo(w.y); q[4 * j + 3] = bfhi(w.y); }
#pragma unroll
            for (int j = 0; j < 12; ++j) ss += q[j] * q[j];
            ss = wave_sum(ss); float rs = 1.f / sqrtf(ss * (1.f / 768.f) + 1e-6f);
#pragma unroll
            for (int j = 0; j < 3; ++j) { const f32x4 g = gq[j]; u32x2 w; w.x = pk2(q[4 * j] * rs * g.x, q[4 * j + 1] * rs * g.y); w.y = pk2(q[4 * j + 2] * rs * g.z, q[4 * j + 3] * rs * g.w); *(u32x2*)(p + 4 * lane + 256 * j) = w; }
            float kv[8]; unpack8(kvw[s], kv); ss = 0.f;
#pragma unroll
            for (int j = 0; j < 8; ++j) ss += kv[j] * kv[j];
            ss = wave_sum(ss); rs = 1.f / sqrtf(ss * (1.f / 512.f) + 1e-6f);
#pragma unroll
            for (int j = 0; j < 8; ++j) kv[j] *= rs * gg[j];
            *(bf16x8*)(p + 768 + 8 * lane) = pack8(kv);
            if (row < RC) { float* op = o_ckv + (size_t)row * 512 + 8 * lane; *(f32x4*)op = (f32x4){kv[0], kv[1], kv[2], kv[3]}; *(f32x4*)(op + 4) = (f32x4){kv[4], kv[5], kv[6], kv[7]}; }
            if (lane < 8) { const bf16x8 raw = krw[s]; *(bf16x8*)(KR + (size_t)row * 64 + 8 * lane) = raw;
                if (row < RC) { float w[8]; unpack8(raw, w); float* op = o_kr + (size_t)row * 64 + 8 * lane; *(f32x4*)op = (f32x4){w[0], w[1], w[2], w[3]}; *(f32x4*)(op + 4) = (f32x4){w[4], w[5], w[6], w[7]}; } }
        }
    }
}

template <int DQK, int DV> struct AttG { static constexpr int PK = DQK * 2 + 16, PV = DV * 2 + 64, KB = 32 * PK, VB = 32 * PV, BUF = KB + VB;
    static constexpr int KPR = DQK / 8, VPR = DV / 8, NKP = 32 * KPR, NVP = 32 * VPR, KJ = (NKP + 511) / 512, VJ = (NVP + 511) / 512, NC = DQK / 16, NDB = DV / 32; };
struct TileSrc { const bf16* k; const bf16* v; int kp, vp; };
__device__ __forceinline__ int crow(int r, int hi) { return (r & 3) + 8 * (r >> 2) + 4 * hi; }
template <int DQK, int DV> __device__ __forceinline__ void att_gload(const TileSrc& ts, int tid, bf16x8 (&sk)[AttG<DQK, DV>::KJ], bf16x8 (&sv)[AttG<DQK, DV>::VJ]) {
    using G = AttG<DQK, DV>;
#pragma unroll
    for (int j = 0; j < G::KJ; ++j) { const int i = tid + 512 * j; if (i < G::NKP) { const int row = i / G::KPR, cc = i % G::KPR; sk[j] = *(const bf16x8*)(ts.k + (size_t)row * ts.kp + cc * 8); } }
#pragma unroll
    for (int j = 0; j < G::VJ; ++j) { const int i = tid + 512 * j; if (i < G::NVP) { const int row = i / G::VPR, cc = i % G::VPR; sv[j] = *(const bf16x8*)(ts.v + (size_t)row * ts.vp + cc * 8); } }
}
template <int DQK, int DV> __device__ __forceinline__ void att_swrite(LAS unsigned char* kb, LAS unsigned char* vb, int tid, const bf16x8 (&sk)[AttG<DQK, DV>::KJ], const bf16x8 (&sv)[AttG<DQK, DV>::VJ]) {
    using G = AttG<DQK, DV>;
#pragma unroll
    for (int j = 0; j < G::KJ; ++j) { const int i = tid + 512 * j; if (i < G::NKP) { const int row = i / G::KPR, cc = i % G::KPR; *(LAS bf16x8*)(kb + row * G::PK + cc * 16) = sk[j]; } }
#pragma unroll
    for (int j = 0; j < G::VJ; ++j) { const int i = tid + 512 * j; if (i < G::NVP) { const int row = i / G::VPR, cc = i % G::VPR; *(LAS bf16x8*)(vb + row * G::PV + cc * 16) = sv[j]; } }
}
#define ATT_S(t) do { \
_Pragma("unroll") \
            for (int r = 0; r < 16; ++r) s[r] = 0.f; \
_Pragma("unroll") \
            for (int c0 = 0; c0 < G::NC; c0 += 4) { bf16x8 kf[4];     \
_Pragma("unroll") \
                for (int c = 0; c < 4; ++c) kf[c] = *(const LAS bf16x8*)(kbuf + kbase + 32 * (c0 + c)); \
                __builtin_amdgcn_sched_barrier(0); \
_Pragma("unroll") \
                for (int c = 0; c < 4; ++c) s = __builtin_amdgcn_mfma_f32_32x32x16_bf16(kf[c], qf[c0 + c], s, 0, 0, 0); } \
            if (P.needs_adjust(u, wid, t)) { \
_Pragma("unroll") \
                for (int r = 0; r < 16; ++r) s[r] = P.adjust(F, pls, u, wid, r32, t, r, hi, s[r] * cs); \
            } else { \
_Pragma("unroll") \
                for (int r = 0; r < 16; ++r) s[r] *= cs; \
            } } while (0)
#define ATT_SM() do { \
            float mt = s[0]; \
_Pragma("unroll") \
            for (int r = 1; r < 16; ++r) mt = fmaxf(mt, s[r]); \
            mt = fmaxf(mt, __shfl_xor(mt, 32)); \
            if (!__all(mt - m_run <= 8.f)) { \
                const float mn = fmaxf(m_run, mt); const float al = fexp2(m_run - mn); m_run = mn; l_run *= al; \
_Pragma("unroll") \
                for (int db = 0; db < G::NDB; ++db) \
_Pragma("unroll") \
                    for (int r = 0; r < 16; ++r) o[db][r] *= al; \
            } \
            float ps = 0.f; \
_Pragma("unroll") \
            for (int r = 0; r < 16; ++r) { s[r] = fexp2(s[r] - m_run); ps += s[r]; } \
            l_run += ps; \
_Pragma("unroll") \
            for (int s2 = 0; s2 < 2; ++s2) { u32x4 w; w.x = pk2(s[8 * s2], s[8 * s2 + 1]); w.y = pk2(s[8 * s2 + 2], s[8 * s2 + 3]); w.z = pk2(s[8 * s2 + 4], s[8 * s2 + 5]); w.w = pk2(s[8 * s2 + 6], s[8 * s2 + 7]); pf[s2] = __builtin_bit_cast(bf16x8, w); } } while (0)
#define ATT_PV(vbuf) do { \
_Pragma("unroll") \
            for (int s2 = 0; s2 < 2; ++s2) \
_Pragma("unroll") \
                for (int db = 0; db < G::NDB; ++db) { \
                    const s16x4 lo = __builtin_bit_cast(s16x4, __builtin_amdgcn_ds_read_tr16_b64_v4i16((LAS v4i16_t*)((vbuf) + vbase + s2 * 16 * G::PV + db * 64))); \
                    const s16x4 hh = __builtin_bit_cast(s16x4, __builtin_amdgcn_ds_read_tr16_b64_v4i16((LAS v4i16_t*)((vbuf) + vbase + s2 * 16 * G::PV + 8 * G::PV + db * 64))); \
                    const bf16x8 vf = {lo[0], lo[1], lo[2], lo[3], hh[0], hh[1], hh[2], hh[3]}; \
                    o[db] = __builtin_amdgcn_mfma_f32_32x32x16_bf16(vf, pf[s2], o[db], 0, 0, 0); } } while (0)
typedef short v4i16_t __attribute__((ext_vector_type(4)));
template <int DQK, int DV, bool PAIR, class Pol>
__device__ __forceinline__ void attn_unit(const Fr& F, const Pol& P, int u) {
    using G = AttG<DQK, DV>;
    const int tid = F.tid, lane = F.lane, wid = F.wave, r32 = lane & 31, hi = lane >> 5;
    const int NT = P.ntiles(u);
    bf16x8 qf[G::NC];
    { const bf16* qp = P.qrow(u, wid, r32) + hi * 8;
#pragma unroll
      for (int c = 0; c < G::NC; ++c) qf[c] = *(const bf16x8*)(qp + 16 * c); }
    if (QFUSE) {
        float ss = 0.f;
#pragma unroll
        for (int c = 0; c < G::NC; ++c) { float t8[8]; unpack8(qf[c], t8);
#pragma unroll
            for (int j = 0; j < 8; ++j) ss += t8[j] * t8[j]; }
        ss += __shfl_xor(ss, 32);
        const float rs = (LOG2E / sqrtf((float)DQK)) / sqrtf(ss * (1.f / DQK) + 1e-6f);
        constexpr int C0 = Pol::QROPE ? G::NC - 4 : G::NC;
#pragma unroll
        for (int c = 0; c < C0; ++c) { float t8[8]; unpack8(qf[c], t8); const f32x4 g0 = *(const f32x4*)(P.qgain + 16 * c + 8 * hi), g1 = *(const f32x4*)(P.qgain + 16 * c + 8 * hi + 4);
            t8[0] *= rs * g0.x; t8[1] *= rs * g0.y; t8[2] *= rs * g0.z; t8[3] *= rs * g0.w; t8[4] *= rs * g1.x; t8[5] *= rs * g1.y; t8[6] *= rs * g1.z; t8[7] *= rs * g1.w; qf[c] = pack8(t8); }
        if (Pol::QROPE) { const int t = P.qpos(u, wid, r32); const float* cp = P.ropeC + (size_t)t * 64 + 8 * hi; const float* sp = P.ropeS + (size_t)t * 64 + 8 * hi;
#pragma unroll
            for (int pr = 0; pr < 2; ++pr) { constexpr int CB = G::NC - 4; const int ca = CB + 2 * pr, cb = CB + 2 * pr + 1; float va[8], vb[8]; unpack8(qf[ca], va); unpack8(qf[cb], vb);
                const f32x4 ga0 = *(const f32x4*)(P.qgain + 16 * ca + 8 * hi), ga1 = *(const f32x4*)(P.qgain + 16 * ca + 8 * hi + 4), gb0 = *(const f32x4*)(P.qgain + 16 * cb + 8 * hi), gb1 = *(const f32x4*)(P.qgain + 16 * cb + 8 * hi + 4);
                const float ga[8] = {ga0.x, ga0.y, ga0.z, ga0.w, ga1.x, ga1.y, ga1.z, ga1.w}, gb[8] = {gb0.x, gb0.y, gb0.z, gb0.w, gb1.x, gb1.y, gb1.z, gb1.w};
                const f32x4 c0 = *(const f32x4*)(cp + 32 * pr), c1 = *(const f32x4*)(cp + 32 * pr + 4), s0 = *(const f32x4*)(sp + 32 * pr), s1 = *(const f32x4*)(sp + 32 * pr + 4);
                const float cc[8] = {c0.x, c0.y, c0.z, c0.w, c1.x, c1.y, c1.z, c1.w}, sn[8] = {s0.x, s0.y, s0.z, s0.w, s1.x, s1.y, s1.z, s1.w};
#pragma unroll
                for (int j = 0; j < 8; ++j) { const float a = va[j] * rs * ga[j], b2 = vb[j] * rs * gb[j]; va[j] = a * cc[j] - b2 * sn[j]; vb[j] = b2 * cc[j] + a * sn[j]; }
                qf[ca] = pack8(va); qf[cb] = pack8(vb); } }
    }
    f32x16 o[G::NDB];
#pragma unroll
    for (int db = 0; db < G::NDB; ++db)
#pragma unroll
        for (int r = 0; r < 16; ++r) o[db][r] = 0.f;
    float m_run = -1e30f, l_run = 0.f;
    const float cs = QFUSE ? 1.f : LOG2E / sqrtf((float)DQK);
    const int kbase = r32 * G::PK + hi * 16;
    const int li = lane & 15; const int vbase = (4 * hi + (li >> 2)) * G::PV + (16 * ((lane >> 4) & 1) + 4 * (li & 3)) * 2;
    f32x16 s; bf16x8 pf[2];
    P.unit_setup(F, u);
    const typename Pol::LS pls = P.lane_init(u, wid, r32, hi);
    if constexpr (PAIR) {
        LAS unsigned char* const kring = F.lds; LAS unsigned char* const vring = F.lds + 4 * G::KB;
        bf16x8 skA[G::KJ], svA[G::VJ], skB[G::KJ], svB[G::VJ];
        { const TileSrc t0 = P.tile(u, 0); att_gload<DQK, DV>(t0, tid, skA, svA); }
        if (NT > 1) { const TileSrc t1 = P.tile(u, 1); att_gload<DQK, DV>(t1, tid, skB, svB); }
        att_swrite<DQK, DV>(kring, vring, tid, skA, svA);
        if (NT > 1) att_swrite<DQK, DV>(kring + G::KB, vring + G::VB, tid, skB, svB);
        asm volatile("s_waitcnt lgkmcnt(0)\n\ts_barrier" ::: "memory");
        for (int t0 = 0; t0 < NT; t0 += 2) { const int slot = (t0 >> 1) & 1;
            if (t0 + 2 < NT) { const TileSrc ta = P.tile(u, t0 + 2); att_gload<DQK, DV>(ta, tid, skA, svA); }
            if (t0 + 3 < NT) { const TileSrc tb = P.tile(u, t0 + 3); att_gload<DQK, DV>(tb, tid, skB, svB); }
#pragma unroll
            for (int sub = 0; sub < 2; ++sub) { const int t = t0 + sub;
                if (t < NT && P.active(u, wid, t)) { LAS unsigned char* kbuf = kring + (slot * 2 + sub) * G::KB; ATT_S(t); ATT_SM(); ATT_PV(vring + (slot * 2 + sub) * G::VB); } }
            if (t0 + 2 < NT) att_swrite<DQK, DV>(kring + ((slot ^ 1) * 2) * G::KB, vring + ((slot ^ 1) * 2) * G::VB, tid, skA, svA);
            if (t0 + 3 < NT) att_swrite<DQK, DV>(kring + ((slot ^ 1) * 2 + 1) * G::KB, vring + ((slot ^ 1) * 2 + 1) * G::VB, tid, skB, svB);
            asm volatile("s_waitcnt lgkmcnt(0)\n\ts_barrier" ::: "memory");
        }
    } else {
    bf16x8 sk[G::KJ], sv[G::VJ];
    LAS unsigned char* const kring = F.lds; LAS unsigned char* const vring = F.lds + 2 * G::KB;
    { const TileSrc t0 = P.tile(u, 0); att_gload<DQK, DV>(t0, tid, sk, sv); }
    att_swrite<DQK, DV>(kring, vring, tid, sk, sv);
    asm volatile("s_waitcnt lgkmcnt(0)\n\ts_barrier" ::: "memory");
    const bool lag = wid >= 4; bool prev_act = false; int vprev = 0, vcur = 0;
#define ATT_STEP(LAG, t) do { \
        LAS unsigned char* kbuf = kring + ((t) & 1) * G::KB; const int vnext = vcur == 2 ? 0 : vcur + 1; \
        if ((t) + 1 < NT) { const TileSrc tn = P.tile(u, (t) + 1); att_gload<DQK, DV>(tn, tid, sk, sv); } \
        const bool act = P.active(u, wid, t); \
        if (LAG) { if (act) ATT_S(t); if (prev_act) ATT_PV(vring + vprev * G::VB); if (act) ATT_SM(); } \
        else if (act) { ATT_S(t); ATT_SM(); ATT_PV(vring + vcur * G::VB); } \
        prev_act = act; \
        if ((t) + 1 < NT) att_swrite<DQK, DV>(kring + (((t) + 1) & 1) * G::KB, vring + vnext * G::VB, tid, sk, sv); \
        vprev = vcur; vcur = vnext; \
        asm volatile("s_waitcnt lgkmcnt(0)\n\ts_barrier" ::: "memory"); } while (0)
    if (lag) { for (int t = 0; t < NT; ++t) ATT_STEP(true, t); }
    else { for (int t = 0; t < NT; ++t) ATT_STEP(false, t); }
#undef ATT_STEP
    if (lag && prev_act) ATT_PV(vring + vprev * G::VB);
    asm volatile("s_waitcnt lgkmcnt(0)\n\ts_barrier" ::: "memory");
    }
    float lt = l_run + __shfl_xor(l_run, 32);
    if (Pol::HAS_SINK) lt += fexp2(P.sink_l2(u, wid) - m_run);
    const float inv = 1.f / lt;
    bf16* op = P.orow(u, wid, r32) + 4 * hi;
#pragma unroll
    for (int db = 0; db < G::NDB; ++db)
#pragma unroll
        for (int rg = 0; rg < 4; ++rg) { u32x2 w; w.x = pk2(o[db][4 * rg] * inv, o[db][4 * rg + 1] * inv); w.y = pk2(o[db][4 * rg + 2] * inv, o[db][4 * rg + 3] * inv); *(u32x2*)(op + 32 * db + 8 * rg) = w; }
}
struct PolBase { static constexpr bool HAS_SINK = false, QROPE = false; const float* qgain; const float* ropeC; const float* ropeS;
    __device__ __forceinline__ int qpos(int, int, int) const { return 0; }
    __device__ __forceinline__ void unit_setup(const Fr&, int) const {}
    __device__ __forceinline__ bool active(int, int, int) const { return true; }
    __device__ __forceinline__ bool needs_adjust(int, int, int) const { return false; }
    struct LS {}; __device__ __forceinline__ LS lane_init(int, int, int, int) const { return LS{}; }
    __device__ __forceinline__ float adjust(const Fr&, const LS&, int, int, int, int, int  , int  , float s) const { return s; }
    __device__ __forceinline__ float sink_l2(int, int) const { return 0.f; }
    static __device__ __forceinline__ int remap(int w) { return w; } };
__device__ __forceinline__ int remap_heads16(int w) { const int c = w & 255, x = c & 7, j = c >> 3; return (w & ~255) | ((2 * x + (j >> 4)) << 4) | (j & 15); }
struct PolCtx : PolBase { const bf16* Q; long pq; int shq; const bf16* K; long pk; int shk; const bf16* V; long pv; int shv; bf16* O; int sho; int NH;
    __device__ __forceinline__ int ntiles(int) const { return 8; }
    __device__ __forceinline__ TileSrc tile(int u, int t) const { const int b = u / NH, h = u % NH; const size_t r = (size_t)b * 256 + 32 * t; return TileSrc{K + r * pk + (size_t)h * shk, V + r * pv + (size_t)h * shv, (int)pk, (int)pv}; }
    __device__ __forceinline__ const bf16* qrow(int u, int wid, int r32) const { const int b = u / NH, h = u % NH; return Q + ((size_t)b * 256 + wid * 32 + r32) * pq + (size_t)h * shq; }
    __device__ __forceinline__ bf16* orow(int u, int wid, int r32) const { const int b = u / NH, h = u % NH; return O + ((size_t)b * 256 + wid * 32 + r32) * 2048 + (size_t)h * sho; } };
struct PolSwaCtx : PolBase { static constexpr bool HAS_SINK = true, QROPE = false; const bf16* QKV; bf16* O; const float* sinks;
    __device__ __forceinline__ int ntiles(int) const { return 8; }
    __device__ __forceinline__ TileSrc tile(int u, int t) const { const int b = u >> 5, kvh = (u >> 3) & 3; const size_t r = (size_t)b * 256 + 32 * t; return TileSrc{QKV + r * SQW + 2048 + kvh * 64, QKV + r * SQW + 2304 + kvh * 64, SQW, SQW}; }
    __device__ __forceinline__ const bf16* qrow(int u, int wid, int r32) const { const int b = u >> 5, kvh = (u >> 3) & 3, tq = u & 7; return QKV + ((size_t)b * 256 + 32 * tq + r32) * SQW + (kvh * 8 + wid) * 64; }
    __device__ __forceinline__ bf16* orow(int u, int wid, int r32) const { const int b = u >> 5, kvh = (u >> 3) & 3, tq = u & 7; return O + ((size_t)b * 256 + 32 * tq + r32) * 2048 + (kvh * 8 + wid) * 64; }
    __device__ __forceinline__ float sink_l2(int u, int wid) const { return sinks[((u >> 3) & 3) * 8 + wid] * LOG2E; } };
struct PolMlaLat : PolBase { static constexpr bool QROPE = true; const bf16* Q; const bf16* K; const bf16* KV; bf16* O;
    __device__ __forceinline__ int ntiles(int) const { return 136; }
    __device__ __forceinline__ TileSrc tile(int u, int t) const { const int b = u >> 8, h = (u >> 4) & 15; const size_t r = t < 8 ? (size_t)R + b * 256 + 32 * t : (size_t)RC + (size_t)b * NLAT + 32 * (t - 8);
        return TileSrc{K + r * MQW + h * 192, KV + r * MKVW + h * 256 + 128, MQW, MKVW}; }
    __device__ __forceinline__ const bf16* qrow(int u, int wid, int r32) const { const int b = u >> 8, h = (u >> 4) & 15, qb = u & 15; return Q + ((size_t)RC + (size_t)b * NLAT + qb * 256 + wid * 32 + r32) * MQW + h * 192; }
    __device__ __forceinline__ bf16* orow(int u, int wid, int r32) const { const int b = u >> 8, h = (u >> 4) & 15, qb = u & 15; return O + ((size_t)RC + (size_t)b * NLAT + qb * 256 + wid * 32 + r32) * 2048 + h * 128; }
    __device__ __forceinline__ int qpos(int u, int wid, int r32) const { return (u & 15) * 256 + wid * 32 + r32; }
    static __device__ __forceinline__ int remap(int w) { return remap_heads16(w); } };
struct PolNatLat : PolBase { const bf16* QKV; const bf16* CK; const bf16* CV; const float* rpb; bf16* O;
    static constexpr int RPB_OFF = 4 * AttG<128, 128>::KB + 4 * AttG<128, 128>::VB;
    __device__ __forceinline__ int rmin(int u) const { const int rb = u & 15; int r = 4 * rb - 4; return r < 0 ? 0 : (r > 56 ? 56 : r); }
    __device__ __forceinline__ int ntiles(int u) const { const int rb = u & 15; int rl = 4 * rb - 1; rl = rl < 0 ? 0 : (rl > 56 ? 56 : rl); return 8 + 2 * (rl + 7 - rmin(u) + 1); }
    __device__ __forceinline__ void unit_setup(const Fr& F, int u) const { const int h = (u >> 4) & 15; LAS float* rp = (LAS float*)(F.lds + RPB_OFF); if (F.tid < 480) rp[F.tid] = (F.tid & 31) < 31 ? rpb[h * 465 + (F.tid >> 5) * 31 + (F.tid & 31)] * LOG2E : -1e30f; }
    __device__ __forceinline__ TileSrc tile(int u, int t) const { const int b = u >> 8, h = (u >> 4) & 15;
        if (t < 8) { const size_t o = ((size_t)(b * 16 + h) * 256 + 32 * t) * 128; return TileSrc{CK + o, CV + o, 128, 128}; }
        const int lt = t - 8; const int kr = rmin(u) + (lt >> 1); const size_t r = (size_t)RC + (size_t)b * NLAT + kr * 64 + 32 * (lt & 1);
        return TileSrc{QKV + r * 6144 + 2048 + h * 128, QKV + r * 6144 + 4096 + h * 128, 6144, 6144}; }
    __device__ __forceinline__ size_t qtok(int u, int wid, int r32) const { const int b = u >> 8, rb = u & 15; return (size_t)RC + (size_t)b * NLAT + (4 * rb + (wid >> 1)) * 64 + 32 * (wid & 1) + r32; }
    __device__ __forceinline__ const bf16* qrow(int u, int wid, int r32) const { return QKV + qtok(u, wid, r32) * 6144 + ((u >> 4) & 15) * 128; }
    __device__ __forceinline__ bf16* orow(int u, int wid, int r32) const { return O + qtok(u, wid, r32) * 2048 + ((u >> 4) & 15) * 128; }
    __device__ __forceinline__ bool active(int u, int wid, int t) const { if (t < 8) return true; const int r = 4 * (u & 15) + (wid >> 1); int rs = r - 4; rs = rs < 0 ? 0 : (rs > 56 ? 56 : rs); const int kr = rmin(u) + ((t - 8) >> 1); return kr >= rs && kr < rs + 8; }
    __device__ __forceinline__ bool needs_adjust(int, int, int t) const { return t >= 8; }
    struct LS { unsigned pk[2][4]; };
    __device__ __forceinline__ LS lane_init(int, int wid, int r32, int hi) const { LS ls; const int c = 32 * (wid & 1) + r32; int cst = c - 8; cst = cst < 0 ? 0 : (cst > 48 ? 48 : cst);
#pragma unroll
        for (int hf = 0; hf < 2; ++hf)
#pragma unroll
            for (int q = 0; q < 4; ++q) { unsigned w = 0;
#pragma unroll
                for (int e = 0; e < 4; ++e) { const int r = 4 * q + e, kc = 32 * hf + crow(r, hi); const bool valid = kc >= cst && kc < cst + 16; int di = kc - c + 15; di = di < 0 ? 0 : (di > 30 ? 30 : di);
                    w |= (unsigned)(valid ? di : 31) << (8 * e); }
                ls.pk[hf][q] = w; }
        return ls; }
    __device__ __forceinline__ float adjust(const Fr& F, const LS& ls, int u, int wid, int, int t, int r, int, float s) const {
        const int lt = t - 8; const int rr = 4 * (u & 15) + (wid >> 1), kr = rmin(u) + (lt >> 1);
        const unsigned w = (lt & 1) ? ls.pk[1][r >> 2] : ls.pk[0][r >> 2]; const unsigned off = (w >> (8 * (r & 3))) & 0xffu;
        const LAS float* rp = (const LAS float*)(F.lds + RPB_OFF) + (kr - rr + 7) * 32;
        return s + rp[off]; }
    static __device__ __forceinline__ int remap(int w) { const int u = remap_heads16(w); return (u & ~15) | ((u + (w >> 8)) & 15); } };
struct PolSwaLat : PolBase { static constexpr bool HAS_SINK = true, QROPE = true; const bf16* QKV; const bf16* CK; const bf16* CV; const float* sinks; bf16* O;
    __device__ __forceinline__ int kt0(int u) const { const int tb = u & 127; return tb < 4 ? 0 : tb - 4; }
    __device__ __forceinline__ int ntiles(int u) const { const int tb = u & 127; const int k1 = tb + 4 > 127 ? 127 : tb + 4; return 8 + k1 - kt0(u) + 1; }
    __device__ __forceinline__ TileSrc tile(int u, int t) const { const int b = u >> 9, kvh = (u >> 7) & 3;
        if (t < 8) { const size_t o = ((size_t)(b * 4 + kvh) * 256 + 32 * t) * 64; return TileSrc{CK + o, CV + o, 64, 64}; }
        const size_t r = (size_t)RC + (size_t)b * NLAT + 32 * (kt0(u) + t - 8); return TileSrc{QKV + r * SQW + 2048 + kvh * 64, QKV + r * SQW + 2304 + kvh * 64, SQW, SQW}; }
    __device__ __forceinline__ size_t qtok(int u, int r32) const { return (size_t)RC + (size_t)(u >> 9) * NLAT + 32 * (u & 127) + r32; }
    __device__ __forceinline__ int qpos(int u, int, int r32) const { return 32 * (u & 127) + r32; }
    __device__ __forceinline__ const bf16* qrow(int u, int wid, int r32) const { return QKV + qtok(u, r32) * SQW + (((u >> 7) & 3) * 8 + wid) * 64; }
    __device__ __forceinline__ bf16* orow(int u, int wid, int r32) const { return O + qtok(u, r32) * 2048 + (((u >> 7) & 3) * 8 + wid) * 64; }
    __device__ __forceinline__ bool needs_adjust(int u, int, int t) const { if (t < 8) return false; const int tb = u & 127, kt = kt0(u) + t - 8; return kt == tb - 4 || kt == tb + 4; }
    __device__ __forceinline__ float adjust(const Fr&, const LS&, int u, int, int r32, int t, int r, int hi, float s) const { const int tb = u & 127, kt = kt0(u) + t - 8; const int dlt = 32 * (kt - tb) + crow(r, hi) - r32; return (dlt <= 128 && dlt >= -128) ? s : -1e30f; }
    __device__ __forceinline__ float sink_l2(int u, int wid) const { return sinks[((u >> 7) & 3) * 8 + wid] * LOG2E; }
    static __device__ __forceinline__ int remap(int w) { const int c = w & 255, x = c & 7, j = c >> 3; return (w & ~255) | ((j >> 4) << 7) | (16 * x + (j & 15)); } };
template <int DQK, int DV, bool PAIR, class Pol> __device__ __forceinline__ void ph_attn(const Fr& F, const Pol& P, int nunits) { const bool rm = F.G == 256 && (nunits & 255) == 0;
    for (int u = F.bid; u < nunits; u += F.G) attn_unit<DQK, DV, PAIR, Pol>(F, P, rm ? Pol::remap(u) : u); }
}

namespace mk {
#ifndef LRU_UNROLL
#define LRU_UNROLL 4
#endif
constexpr int PXC = 400;
struct LruArgs { const bf16* XG; const bf16* Wg; const float* cw; const float* cb; const float* ba; const float* bi; const float* lam; float* AGG; const float* CARRY; bf16* Y; };
template <int PASS> __device__ __forceinline__ void lru_unit(const Fr& F, const LruArgs& A, int u) {
    const int chunk = u >> 2, bq = u & 3, row0 = chunk * 64, tid = F.tid, lane = F.lane, hi = lane >> 5;
    int s0, T; if (row0 < RC) { s0 = (row0 >> 8) << 8; T = 256; } else { s0 = RC + (((row0 - RC) >> 12) << 12); T = NLAT; } const int t0 = row0 - s0;
    if (tid < 480) { const int combo = tid % 96, blk = combo / 24, cg = combo % 24, rbeg = (tid / 96) * 13, nr = rbeg + 13 > 64 ? 64 - rbeg : 13;
        LAS unsigned char* dst = F.lds + blk * (64 * PXC) + cg * 16;
        if (cg < 21) { const int ch = (4 * bq + blk) * 168 + 8 * cg;
            bf16x8 xr[16];
#pragma unroll
            for (int i = 0; i < 16; ++i) { const int tt = t0 + rbeg + i - 2; xr[i] = (bf16x8){0, 0, 0, 0, 0, 0, 0, 0}; if (tt >= 0 && tt < T && i < nr + 3) xr[i] = *(const bf16x8*)(A.XG + (size_t)(s0 + tt) * (2 * LW) + ch); }
            float w[4][8], bb[8];
#pragma unroll
            for (int k = 0; k < 4; ++k) { const f32x4 w0 = *(const f32x4*)(A.cw + (size_t)k * LW + ch), w1 = *(const f32x4*)(A.cw + (size_t)k * LW + ch + 4); w[k][0] = w0.x; w[k][1] = w0.y; w[k][2] = w0.z; w[k][3] = w0.w; w[k][4] = w1.x; w[k][5] = w1.y; w[k][6] = w1.z; w[k][7] = w1.w; }
            { const f32x4 b0 = *(const f32x4*)(A.cb + ch), b1 = *(const f32x4*)(A.cb + ch + 4); bb[0] = b0.x; bb[1] = b0.y; bb[2] = b0.z; bb[3] = b0.w; bb[4] = b1.x; bb[5] = b1.y; bb[6] = b1.z; bb[7] = b1.w; }
#pragma unroll
            for (int r = 0; r < 13; ++r) if (r < nr) { float acc[8];
#pragma unroll
                for (int j = 0; j < 8; ++j) acc[j] = bb[j];
#pragma unroll
                for (int k = 0; k < 4; ++k) { float x[8]; unpack8(xr[r + k], x);
#pragma unroll
                    for (int j = 0; j < 8; ++j) acc[j] += w[k][j] * x[j]; }
                *(LAS bf16x8*)(dst + (rbeg + r) * PXC) = pack8(acc); }
        } else { for (int r = 0; r < nr; ++r) *(LAS bf16x8*)(dst + (rbeg + r) * PXC) = (bf16x8){0, 0, 0, 0, 0, 0, 0, 0}; }
    }
    __syncthreads();
    const int i32 = lane & 31; const int tau = ((i32 >> 2) & 1) * 16 + ((i32 >> 3) << 2) + (i32 & 3);
    for (int task = F.wave; task < 24; task += 8) {
        const int blk = task / 6, sub = task % 6; const int col = 32 * sub + i32; const bool cvalid = col < 168; const int gb = 4 * bq + blk; const int c = gb * 168 + (cvalid ? col : 0);
        LAS unsigned char* xcb = F.lds + blk * (64 * PXC);
        LAS unsigned short* hst = (LAS unsigned short*)(F.lds + 4 * 64 * PXC) + F.wave * 2048 + lane;
#pragma unroll
        for (int dir = 0; dir < 2; ++dir) {
            const bf16* wa = A.Wg + ((size_t)((dir * 2 + 0) * 16 + gb) * 192 + col) * 192 + 8 * hi; const bf16* wi = A.Wg + ((size_t)((dir * 2 + 1) * 16 + gb) * 192 + col) * 192 + 8 * hi;
            const float ba_ = A.ba[(size_t)dir * LW + c], bi_ = A.bi[(size_t)dir * LW + c];
            float sp; { const float y = fexp2(-A.lam[(size_t)dir * LW + c] * LOG2E); sp = y < 0.02f ? y * (1.f - y * (0.5f - y * 0.33333333f)) : __builtin_amdgcn_logf(1.f + y) * 0.6931471805599453f; }
            float Hrun = 0.f, Prun = 1.f, Srun = 0.f;
            if (PASS == 2) Hrun = A.CARRY[((size_t)chunk * 2 + dir) * LW + c];
            f32x16 aa[2], ai[2];
#pragma unroll
            for (int mt = 0; mt < 2; ++mt)
#pragma unroll
                for (int r = 0; r < 16; ++r) { aa[mt][r] = 0.f; ai[mt][r] = 0.f; }
            { const LAS unsigned char* ap = xcb + tau * PXC + 16 * hi;
#pragma unroll (PASS == 1 ? 6 : 4)
              for (int ks = 0; ks < 12; ++ks) { const bf16x8 fa = *(const bf16x8*)(wa + 16 * ks), fi = *(const bf16x8*)(wi + 16 * ks);
                  const bf16x8 a0 = *(const LAS bf16x8*)(ap + 32 * ks), a1 = *(const LAS bf16x8*)(ap + 32 * PXC + 32 * ks);
                  aa[0] = __builtin_amdgcn_mfma_f32_32x32x16_bf16(a0, fa, aa[0], 0, 0, 0); ai[0] = __builtin_amdgcn_mfma_f32_32x32x16_bf16(a0, fi, ai[0], 0, 0, 0);
                  aa[1] = __builtin_amdgcn_mfma_f32_32x32x16_bf16(a1, fa, aa[1], 0, 0, 0); ai[1] = __builtin_amdgcn_mfma_f32_32x32x16_bf16(a1, fi, ai[1], 0, 0, 0); } }
#pragma unroll
            for (int mi = 0; mi < 2; ++mi) { const int mt = dir == 0 ? mi : 1 - mi;
                float hl[16], ac[16];
#pragma unroll
                for (int r = 0; r < 16; ++r) { const int tt = 32 * mt + 16 * hi + r; const float xcv = bf2f(*(const LAS unsigned short*)(xcb + tt * PXC + col * 2));
                    const float rg = sigm(aa[mt][r] + ba_), ig = sigm(ai[mt][r] + bi_); const float la = -8.f * rg * sp; const float a = fexp2(la * LOG2E); const float z = 2.f * la;
                    const float om = z > -0.05f ? -z * (1.f + z * (0.5f + z * 0.16666667f)) : 1.f - a * a;
                    ac[r] = a; hl[r] = __builtin_amdgcn_sqrtf(om) * ig * xcv; }
                float P = 1.f, S = 0.f;
                if (dir == 0) {
#pragma unroll
                    for (int r = 0; r < 16; ++r) { S = ac[r] * S + hl[r]; P *= ac[r]; hl[r] = S; ac[r] = P; }
                } else {
#pragma unroll
                    for (int r = 15; r >= 0; --r) { S = ac[r] * S + hl[r]; P *= ac[r]; hl[r] = S; ac[r] = P; }
                }
                const float oP = __shfl_xor(P, 32), oS = __shfl_xor(S, 32); const bool isfirst = (dir == 0) ? (hi == 0) : (hi == 1);
                const float fP = isfirst ? P : oP, fS = isfirst ? S : oS, sP = isfirst ? oP : P, sS = isfirst ? oS : S;
                const float tP = fP * sP, tS = sS + sP * fS;
                if (PASS == 1) { Srun = tS + tP * Srun; Prun *= tP; }
                else { const float cin = isfirst ? Hrun : fS + fP * Hrun;
#pragma unroll
                    for (int r = 0; r < 16; ++r) { const float h = hl[r] + ac[r] * cin; LAS unsigned short* hp = hst + (mt * 16 + r) * 64;
                        if (dir == 0) *hp = (unsigned short)f2bf(h);
                        else if (cvalid) { const size_t row = (size_t)row0 + 32 * mt + 16 * hi + r; const float gate = bf2f(A.XG[row * (2 * LW) + LW + c]); A.Y[row * LW + c] = (bf16)f2bf(geluf(gate) * (bf2f(*hp) + h)); } }
                    Hrun = tS + tP * Hrun; asm volatile("" ::: "memory"); }
            }
            if (PASS == 1 && hi == 0 && cvalid) { A.AGG[(((size_t)chunk * 2 + dir) * 2 + 0) * LW + c] = Prun; A.AGG[(((size_t)chunk * 2 + dir) * 2 + 1) * LW + c] = Srun; }
        }
    }
    __syncthreads();
}
template <int PASS> __device__ __forceinline__ void ph_lru(const Fr& F, const LruArgs& A) { for (int u = F.bid; u < 576 * 4; u += F.G) lru_unit<PASS>(F, A, u); }
__device__ __forceinline__ void ph_lru_carry(const Fr& F, const float* AGG, float* CARRY, const float* h0, float* state_out) {
    for (int g = F.bid * 512 + F.tid; g < 24 * 2 * LW; g += F.G * 512) { const int seq = g / (2 * LW), rem = g % (2 * LW), dir = rem / LW, c = rem % LW;
        int nch, ch0; float h = 0.f; if (seq < 16) { nch = 4; ch0 = 4 * seq; } else { const int b = seq - 16; nch = 64; ch0 = 64 + 64 * b; h = h0[((size_t)b * 2 + dir) * LW + c]; }
        for (int j = 0; j < nch; ++j) { const int ch = ch0 + (dir == 0 ? j : nch - 1 - j); CARRY[((size_t)ch * 2 + dir) * LW + c] = h;
            const float P = AGG[(((size_t)ch * 2 + dir) * 2 + 0) * LW + c], S = AGG[(((size_t)ch * 2 + dir) * 2 + 1) * LW + c]; h = S + P * h; }
        if (seq < 16) state_out[((size_t)seq * 2 + dir) * LW + c] = h; }
}
__device__ __forceinline__ void ph_lru_xc(const Fr& F, const bf16* XG, const float* cw, const float* cb, bf16* XC) {
    for (int g = F.bid * 512 + F.tid; g < (R / 8) * 336; g += F.G * 512) { const int row0 = (g / 336) * 8, ch = 8 * (g % 336);
        int s0, T; if (row0 < RC) { s0 = (row0 >> 8) << 8; T = 256; } else { s0 = RC + (((row0 - RC) >> 12) << 12); T = NLAT; } const int t0 = row0 - s0;
        bf16x8 xr[11];
#pragma unroll
        for (int i = 0; i < 11; ++i) { const int tt = t0 + i - 2; xr[i] = __builtin_bit_cast(bf16x8, (u32x4){0u, 0u, 0u, 0u}); if (tt >= 0 && tt < T) xr[i] = __builtin_nontemporal_load((const bf16x8*)(XG + (size_t)(s0 + tt) * (2 * LW) + ch)); }
        float w[4][8], bb[8];
        { const f32x4 b0 = *(const f32x4*)(cb + ch), b1 = *(const f32x4*)(cb + ch + 4); bb[0] = b0.x; bb[1] = b0.y; bb[2] = b0.z; bb[3] = b0.w; bb[4] = b1.x; bb[5] = b1.y; bb[6] = b1.z; bb[7] = b1.w; }
#pragma unroll
        for (int k = 0; k < 4; ++k) { const f32x4 w0 = *(const f32x4*)(cw + (size_t)k * LW + ch), w1 = *(const f32x4*)(cw + (size_t)k * LW + ch + 4);
            w[k][0] = w0.x; w[k][1] = w0.y; w[k][2] = w0.z; w[k][3] = w0.w; w[k][4] = w1.x; w[k][5] = w1.y; w[k][6] = w1.z; w[k][7] = w1.w; }
        float x[11][8];
#pragma unroll
        for (int i = 0; i < 11; ++i) unpack8(xr[i], x[i]);
#pragma unroll
        for (int r = 0; r < 8; ++r) { float acc[8];
#pragma unroll
            for (int e = 0; e < 8; ++e) acc[e] = bb[e];
#pragma unroll
            for (int k = 0; k < 4; ++k)
#pragma unroll
                for (int e = 0; e < 8; ++e) acc[e] += w[k][e] * x[r + k][e];
            *(bf16x8*)(XC + (size_t)(row0 + r) * LW + ch) = pack8(acc); } }
}
__device__ __forceinline__ void ph_lru_combine(const Fr& F, const bf16* XG, const bf16* HB, bf16* Y) {
    for (int g = F.bid * 512 + F.tid; g < R * 336; g += F.G * 512) { const int row = g / 336, ch = 8 * (g % 336);
        float a[8], b[8], gt[8]; unpack8(__builtin_nontemporal_load((const bf16x8*)(Y + (size_t)row * LW + ch)), a); unpack8(__builtin_nontemporal_load((const bf16x8*)(HB + (size_t)row * LW + ch)), b); unpack8(__builtin_nontemporal_load((const bf16x8*)(XG + (size_t)row * (2 * LW) + LW + ch)), gt);
#pragma unroll
        for (int j = 0; j < 8; ++j) a[j] = geluf(gt[j]) * (a[j] + b[j]);
        *(bf16x8*)(Y + (size_t)row * LW + ch) = pack8(a); }
}
struct ChainArgs { const bf16* XC; const bf16* Wg; const float* ba; const float* bi; const float* lam; const float* h0; bf16* HF; bf16* HB; float* state_out; };
#define LRU_STORE_H() do { const int odd = i32 & 1; \
_Pragma("unroll") \
        for (int rp = 0; rp < 8; ++rp) { const unsigned own = odd ? hq[2 * rp + 1] : hq[2 * rp], snd = odd ? hq[2 * rp] : hq[2 * rp + 1]; \
            const unsigned rcv = (unsigned)__builtin_amdgcn_update_dpp(0, (int)snd, 0xB1, 0xF, 0xF, false); \
            const unsigned wd = odd ? (rcv | (own << 16)) : (own | (rcv << 16)); \
            if (cvalid) *(unsigned*)(HX + (rprev + 16 * hi + 2 * rp + odd) * LW + c - odd) = wd; } } while (0)
__device__ __forceinline__ void lru_chain(const Fr& F, const ChainArgs& A, int s0, int T, int dir, int st, int seq_ctx, int b_lat) {
    const int lane = F.lane, hi = lane >> 5, i32 = lane & 31; const int tau = ((i32 >> 2) & 1) * 16 + ((i32 >> 3) << 2) + (i32 & 3);
    const int blk = st / 6, sub = st % 6; const int col = 32 * sub + i32; const bool cvalid = col < 168; const int c = blk * 168 + (cvalid ? col : 0);
    bf16x8 bfa[12]; LAS unsigned char* wl = F.lds + F.wave * 12288 + lane * 16;
    { const bf16* wa = A.Wg + ((size_t)((dir * 2 + 0) * 16 + blk) * 192 + col) * 192 + 8 * hi; const bf16* wi = A.Wg + ((size_t)((dir * 2 + 1) * 16 + blk) * 192 + col) * 192 + 8 * hi;
#pragma unroll
      for (int ks = 0; ks < 12; ++ks) { bfa[ks] = *(const bf16x8*)(wa + 16 * ks); *(LAS bf16x8*)(wl + ks * 1024) = *(const bf16x8*)(wi + 16 * ks); } }
    const float ba_ = A.ba[(size_t)dir * LW + c], bi_ = A.bi[(size_t)dir * LW + c];
    float sp; { const float y = fexp2(-A.lam[(size_t)dir * LW + c] * LOG2E); sp = y < 0.02f ? y * (1.f - y * (0.5f - y * 0.33333333f)) : __builtin_amdgcn_logf(1.f + y) * 0.6931471805599453f; }
    float Hrun = b_lat >= 0 ? A.h0[((size_t)b_lat * 2 + dir) * LW + c] : 0.f;
    const float nba = -ba_ * LOG2E, nbi = -bi_ * LOG2E, k1 = -8.f * sp * LOG2E;
    bf16* HX = dir == 0 ? A.HF : A.HB;
    const int nsteps = T >> 5;
    const bf16* abase = A.XC + (size_t)blk * 168 + 8 * hi; const bf16* xbase = A.XC + c;
    bf16x8 af[12]; unsigned short hq[16]; size_t rprev = 0;
    bf16x8 idf[2];
#pragma unroll
    for (int kl = 0; kl < 2; ++kl) { const bool on = (i32 >> 4) == kl && hi == ((i32 >> 3) & 1); const int e = i32 & 7; u32x4 w;
        w.x = on && (e >> 1) == 0 ? ((e & 1) ? 0x3F800000u : 0x3F80u) : 0u; w.y = on && (e >> 1) == 1 ? ((e & 1) ? 0x3F800000u : 0x3F80u) : 0u;
        w.z = on && (e >> 1) == 2 ? ((e & 1) ? 0x3F800000u : 0x3F80u) : 0u; w.w = on && (e >> 1) == 3 ? ((e & 1) ? 0x3F800000u : 0x3F80u) : 0u; idf[kl] = __builtin_bit_cast(bf16x8, w); }
    { const int mt = dir == 0 ? 0 : nsteps - 1; const size_t r0 = (size_t)s0 + 32 * mt;
#pragma unroll
      for (int ks = 0; ks < 12; ++ks) af[ks] = *(const bf16x8*)(abase + (r0 + tau) * LW + 16 * ks); }
    for (int step = 0; step < nsteps; ++step) { const int mt = dir == 0 ? step : nsteps - 1 - step; const size_t r0 = (size_t)s0 + 32 * mt;
        f32x16 aa, ai;
#pragma unroll
        for (int r = 0; r < 16; ++r) { aa[r] = 0.f; ai[r] = 0.f; }
#pragma unroll
        for (int ks = 0; ks < 12; ++ks) { const bf16x8 fi = *(const LAS bf16x8*)(wl + ks * 1024); aa = __builtin_amdgcn_mfma_f32_32x32x16_bf16(af[ks], bfa[ks], aa, 0, 0, 0); ai = __builtin_amdgcn_mfma_f32_32x32x16_bf16(af[ks], fi, ai, 0, 0, 0); }
        f32x16 ax;
#pragma unroll
        for (int r = 0; r < 16; ++r) ax[r] = 0.f;
#define LRU_XSEL(S) case S: ax = __builtin_amdgcn_mfma_f32_32x32x16_bf16(af[2 * S], idf[0], ax, 0, 0, 0); ax = __builtin_amdgcn_mfma_f32_32x32x16_bf16(af[2 * S + 1], idf[1], ax, 0, 0, 0); break;
        switch (sub) { LRU_XSEL(0) LRU_XSEL(1) LRU_XSEL(2) LRU_XSEL(3) LRU_XSEL(4) default: ax = __builtin_amdgcn_mfma_f32_32x32x16_bf16(af[10], idf[0], ax, 0, 0, 0); ax = __builtin_amdgcn_mfma_f32_32x32x16_bf16(af[11], idf[1], ax, 0, 0, 0); break; }
#undef LRU_XSEL
        float xc[16];
#pragma unroll
        for (int r = 0; r < 16; ++r) xc[r] = ax[r];
        __builtin_amdgcn_sched_barrier(0);
        if (step > 0) { LRU_STORE_H(); }
        if (step + 1 < nsteps) { const int mn = dir == 0 ? step + 1 : nsteps - 2 - step; const size_t rn = (size_t)s0 + 32 * mn;
#pragma unroll
            for (int ks = 0; ks < 12; ++ks) af[ks] = *(const bf16x8*)(abase + (rn + tau) * LW + 16 * ks); }
        float hl[16], ac[16];
#pragma unroll
        for (int r = 0; r < 16; ++r) {
            const float rg = frcp(1.f + fexp2(fmaf(aa[r], -LOG2E, nba))), ig = frcp(1.f + fexp2(fmaf(ai[r], -LOG2E, nbi)));
            const float a = fexp2(rg * k1); ac[r] = a; hl[r] = __builtin_amdgcn_sqrtf(fmaf(-a, a, 1.f)) * (ig * xc[r]); }
        float P = 1.f, S = 0.f;
        if (dir == 0) {
#pragma unroll
            for (int r = 0; r < 16; ++r) { S = ac[r] * S + hl[r]; P *= ac[r]; hl[r] = S; ac[r] = P; }
        } else {
#pragma unroll
            for (int r = 15; r >= 0; --r) { S = ac[r] * S + hl[r]; P *= ac[r]; hl[r] = S; ac[r] = P; }
        }
        const float oP = __shfl_xor(P, 32), oS = __shfl_xor(S, 32); const bool isfirst = (dir == 0) ? (hi == 0) : (hi == 1);
        const float fP = isfirst ? P : oP, fS = isfirst ? S : oS, sP = isfirst ? oP : P, sS = isfirst ? oS : S;
        const float tP = fP * sP, tS = sS + sP * fS; const float cin = isfirst ? Hrun : fS + fP * Hrun;
#pragma unroll
        for (int r = 0; r < 16; ++r) hq[r] = (unsigned short)f2bf(hl[r] + ac[r] * cin);
        rprev = r0;
        Hrun = tS + tP * Hrun;
    }
    LRU_STORE_H();
#undef LRU_STORE_H
    if (seq_ctx >= 0 && hi == 0 && cvalid) A.state_out[((size_t)seq_ctx * 2 + dir) * LW + c] = Hrun;
}
__device__ __forceinline__ void ph_lru_chains(const Fr& F, const ChainArgs& A) {
    if (F.wave < 6) { for (int wt = F.bid * 6 + F.wave; wt < 1536; wt += F.G * 6) { const int b = wt / 192, dir = (wt / 96) & 1, st = wt % 96; lru_chain(F, A, RC + b * NLAT, NLAT, dir, st, -1, b); } }
    else { for (int j = F.bid * 2 + (F.wave - 6); j < 3072; j += F.G * 2) { const int s = j / 192, dir = (j / 96) & 1, st = j % 96; lru_chain(F, A, s * 256, 256, dir, st, s, -1); } }
}
__device__ __forceinline__ void ph_ffn_fix(const Fr& F, const float* SIDE, const float* cw, bf16* G) {
    for (int g = F.bid * 512 + F.tid; g < 120 * (DFF / 4); g += F.G * 512) { const int bi = g / (DFF / 4), c = 4 * (g % (DFF / 4)); const int pm = 16 + (bi / 15) * 16 + (bi % 15) + 1;
        const float* top = SIDE + ((size_t)pm * 2 + 0) * 3 * DFF; const float* bot = SIDE + ((size_t)(pm - 1) * 2 + 1) * 3 * DFF;
        const f32x4 tp = *(const f32x4*)(top + c), tb = *(const f32x4*)(top + DFF + c), ta = *(const f32x4*)(top + 2 * DFF + c), bp = *(const f32x4*)(bot + c), bb = *(const f32x4*)(bot + DFF + c), ba = *(const f32x4*)(bot + 2 * DFF + c);
        const f32x4 w0 = *(const f32x4*)(cw + c), w2 = *(const f32x4*)(cw + 2 * DFF + c);
        u32x2 ot, ob; float vt[4], vb[4];
#pragma unroll
        for (int e = 0; e < 4; ++e) { const float pt = tp[e] + w0[e] * ba[e];
            const float pb = bp[e] + w2[e] * ta[e];
            vt[e] = siluf(pt) * tb[e]; vb[e] = siluf(pb) * bb[e]; }
        ot.x = (f2bf(vt[1]) << 16) | f2bf(vt[0]); ot.y = (f2bf(vt[3]) << 16) | f2bf(vt[2]); ob.x = (f2bf(vb[1]) << 16) | f2bf(vb[0]); ob.y = (f2bf(vb[3]) << 16) | f2bf(vb[2]);
        *(u32x2*)(G + (size_t)(256 * pm) * DFF + c) = ot; *(u32x2*)(G + (size_t)(256 * pm - 1) * DFF + c) = ob; }
}
}
namespace pg8 {
template <int MODE> struct EpiFfnT {
    static constexpr bool PERM = true, AFTER_DRAIN = false;
    mk::bf16* G; const float* cw; const float* cb; float* side; PG8_LAS float* xl;
    __device__ __forceinline__ void operator()(const f32x4 (&acc)[2][2][4][2], const Unit& u, int wr, int wc, int fr, int fq) const {
        const int lane = threadIdx.x & 63; const int chl = wc * 32 + 8 * fq, ch0 = u.pn * 128 + chl;
        if (MODE == 1 || MODE == 2) {
#pragma unroll
            for (int ai = 0; ai < 2; ++ai)
#pragma unroll
                for (int m = 0; m < 4; ++m) { const int row = u.pm * BM + ai * HALF + wr * 64 + m * 16 + fr; float gv[8];
#pragma unroll
                    for (int e = 0; e < 8; ++e) gv[e] = acc[ai][0][m][e >> 2][e & 3];
                    *(mk::bf16x8*)(G + (size_t)row * 5632 + ch0) = mk::pack8(gv); }
            if (MODE == 1) return; }
        float w0[8], w1[8], w2[8], bb[8];
#pragma unroll
        for (int h = 0; h < 2; ++h) { const f32x4 a = *(const f32x4*)(cw + ch0 + 4 * h), b = *(const f32x4*)(cw + 5632 + ch0 + 4 * h), c = *(const f32x4*)(cw + 2 * 5632 + ch0 + 4 * h), d = *(const f32x4*)(cb + ch0 + 4 * h);
#pragma unroll
            for (int j = 0; j < 4; ++j) { w0[4 * h + j] = a[j]; w1[4 * h + j] = b[j]; w2[4 * h + j] = c[j]; bb[4 * h + j] = d[j]; } }
#pragma unroll
        for (int ai = 0; ai < 2; ++ai) { const int g = 2 * ai + wr;
            if (fr == 0) { *(PG8_LAS f32x4*)(xl + (g * 2 + 0) * 128 + chl) = acc[ai][0][0][0]; *(PG8_LAS f32x4*)(xl + (g * 2 + 0) * 128 + chl + 4) = acc[ai][0][0][1]; }
            if (fr == 15) { *(PG8_LAS f32x4*)(xl + (g * 2 + 1) * 128 + chl) = acc[ai][0][3][0]; *(PG8_LAS f32x4*)(xl + (g * 2 + 1) * 128 + chl + 4) = acc[ai][0][3][1]; } }
        asm volatile("s_waitcnt lgkmcnt(0)" ::: "memory"); __builtin_amdgcn_s_barrier(); asm volatile("" ::: "memory");
        if (MODE == 2) return;
        const int lprev = (lane & 48) | ((fr + 15) & 15), lnext = (lane & 48) | ((fr + 1) & 15);
#pragma unroll
        for (int ai = 0; ai < 2; ++ai) { const int g = 2 * ai + wr;
            float hp[8], hn[8];
#pragma unroll
            for (int j = 0; j < 8; ++j) { hp[j] = 0.f; hn[j] = 0.f; }
            if (g > 0) { const f32x4 a = *(const PG8_LAS f32x4*)(xl + ((g - 1) * 2 + 1) * 128 + chl), b = *(const PG8_LAS f32x4*)(xl + ((g - 1) * 2 + 1) * 128 + chl + 4);
#pragma unroll
                for (int j = 0; j < 4; ++j) { hp[j] = a[j]; hp[4 + j] = b[j]; } }
            if (g < 3) { const f32x4 a = *(const PG8_LAS f32x4*)(xl + ((g + 1) * 2 + 0) * 128 + chl), b = *(const PG8_LAS f32x4*)(xl + ((g + 1) * 2 + 0) * 128 + chl + 4);
#pragma unroll
                for (int j = 0; j < 4; ++j) { hn[j] = a[j]; hn[4 + j] = b[j]; } }
#pragma unroll
            for (int m = 0; m < 4; ++m) { const int row = u.pm * BM + ai * HALF + wr * 64 + m * 16 + fr; float p[8], bv[8], av[8];
#pragma unroll
                for (int e = 0; e < 8; ++e) { const int n = e >> 2, j = e & 3; const float a = acc[ai][0][m][n][j];
                    const float up = m > 0 ? acc[ai][0][m - 1][n][j] : hp[e]; const float dn = m < 3 ? acc[ai][0][m + 1][n][j] : hn[e];
                    const float prev = __shfl(fr == 15 ? up : a, lprev);
                    const float next = __shfl(fr == 0 ? dn : a, lnext);
                    av[e] = a; bv[e] = acc[ai][1][m][n][j]; p[e] = bb[e] + w0[e] * prev + w1[e] * a + w2[e] * next; }
                const bool top = (g == 0 && m == 0 && fr == 0), bot = (g == 3 && m == 3 && fr == 15);
                if (top || bot) { float* sp = side + ((size_t)u.pm * 2 + (bot ? 1 : 0)) * 3 * 5632 + ch0;
#pragma unroll
                    for (int h = 0; h < 2; ++h) { *(f32x4*)(sp + 4 * h) = (f32x4){p[4 * h], p[4 * h + 1], p[4 * h + 2], p[4 * h + 3]}; *(f32x4*)(sp + 5632 + 4 * h) = (f32x4){bv[4 * h], bv[4 * h + 1], bv[4 * h + 2], bv[4 * h + 3]};
                        *(f32x4*)(sp + 2 * 5632 + 4 * h) = (f32x4){av[4 * h], av[4 * h + 1], av[4 * h + 2], av[4 * h + 3]}; } }
                float gv[8];
#pragma unroll
                for (int e = 0; e < 8; ++e) gv[e] = mk::siluf(p[e]) * bv[e];
                *(mk::bf16x8*)(G + (size_t)row * 5632 + ch0) = mk::pack8(gv); }
        }
    }
};
typedef EpiFfnT<0> EpiFfn;

struct EpiNatQKV {
    static constexpr bool PERM = true, AFTER_DRAIN = false;
    mk::bf16* O; const float* gk; float* outb; PG8_LAS float* xl;
    __device__ __forceinline__ void operator()(const f32x4 (&acc)[2][2][4][2], const Unit& u, int wr, int wc, int fr, int fq) const {
        const int row0 = u.pm * BM + wr * 64 + fr, col0 = u.pn * BM + wc * 32 + 8 * fq; const bool isk = u.pn >= 8 && u.pn < 16, isv = u.pn >= 16;
        if (isk) {
#pragma unroll
            for (int ai = 0; ai < 2; ++ai)
#pragma unroll
                for (int m = 0; m < 4; ++m)
#pragma unroll
                    for (int bj = 0; bj < 2; ++bj) { const f32x4 a = acc[ai][bj][m][0], b = acc[ai][bj][m][1]; float ss = (a.x * a.x + a.y * a.y) + (a.z * a.z + a.w * a.w) + (b.x * b.x + b.y * b.y) + (b.z * b.z + b.w * b.w);
                        ss += __shfl_xor(ss, 16); ss += __shfl_xor(ss, 32);
                        if (fq == 0) xl[(bj * 256 + ai * HALF + wr * 64 + m * 16 + fr) * 4 + wc] = ss; }
        }
        asm volatile("s_waitcnt lgkmcnt(0)" ::: "memory"); __builtin_amdgcn_s_barrier(); asm volatile("" ::: "memory");
        float g[8];
        { const int d0 = wc * 32 + 8 * fq; const f32x4 g0 = *(const f32x4*)(gk + d0), g1 = *(const f32x4*)(gk + d0 + 4); g[0] = g0.x; g[1] = g0.y; g[2] = g0.z; g[3] = g0.w; g[4] = g1.x; g[5] = g1.y; g[6] = g1.z; g[7] = g1.w; }
#pragma unroll
        for (int ai = 0; ai < 2; ++ai)
#pragma unroll
            for (int m = 0; m < 4; ++m) { const int row = row0 + ai * HALF + m * 16;
#pragma unroll
                for (int bj = 0; bj < 2; ++bj) { float v[8];
#pragma unroll
                    for (int e = 0; e < 8; ++e) v[e] = acc[ai][bj][m][e >> 2][e & 3];
                    if (isk) { const f32x4 p = *(const PG8_LAS f32x4*)(xl + (bj * 256 + ai * HALF + wr * 64 + m * 16 + fr) * 4); const float rs = 1.f / sqrtf(((p.x + p.y) + (p.z + p.w)) * (1.f / 128.f) + 1e-6f);
#pragma unroll
                        for (int e = 0; e < 8; ++e) v[e] *= rs * g[e]; }
                    *(mk::bf16x8*)(O + (size_t)row * 6144 + col0 + bj * HALF) = mk::pack8(v);
                    if ((isk || isv) && row < 4096) { const int h = 2 * (u.pn & 7) + bj; float* op = outb + ((size_t)(isk ? 75497472 : 83886080) + ((size_t)((row >> 8) * 16 + h) * 256 + (row & 255)) * 128 + wc * 32 + 8 * fq);
                        *(f32x4*)op = (f32x4){v[0], v[1], v[2], v[3]}; *(f32x4*)(op + 4) = (f32x4){v[4], v[5], v[6], v[7]}; } } }
    }
};

}

namespace mk {
struct MArgs { const float* in[N_IN]; float* out; unsigned char* ws; int ph_lo, ph_hi; };
enum { SL_NORM1 = 0, SL_M1 = 1, SL_M2 = 2, SL_M3 = 3, SL_M4 = 4, SL_M5 = 5, SL_MIXOUT = 9, SL_NORM2 = 10, SL_FFNIN = 11, SL_FFNFIX = 12, SL_FFNOUT = 13, PH_END = 1 + 16 * 4 };
__host__ __device__ constexpr int phid(int l, int slot) { return 1 + 16 * l + slot; }
}
#ifndef EN_MASK
#define EN_MASK 0x7ffff
#endif
#ifndef KFUSE
#define KFUSE 1
#endif
#ifndef XB16
#define XB16 1
#endif
#ifndef REP_ID
#define REP_ID -1
#endif
#ifndef REP_N
#define REP_N 2
#endif
#ifndef WGM_N2048
#define WGM_N2048 4
#endif
#ifndef REV_FFNOUT
#define REV_FFNOUT 0
#endif
#ifndef WGM_FFNIN
#define WGM_FFNIN 8
#endif
#define PH(id) if (lo <= (id) && (id) < hi)
#define SEAM(id) do { if (hi > (id) + 1) xcd_barrier(bar); } while (0)
template <int l> __device__ __forceinline__ void layer_body(const mk::Fr& F, const float* const* in, float* out, unsigned char* ws, const mk::XcdBarrier& bar, int lo, int hi) {
    using namespace mk; constexpr unsigned EN = EN_MASK;
    float* MOD = (float*)(ws + WS_MOD * MiB); bf16* H = (bf16*)(ws + WS_H * MiB); bf16* OB = H;
    const float* ropeC = (const float*)(ws + WS_ROPEC * MiB); const float* ropeS = (const float*)(ws + WS_ROPES * MiB);
    float* o_yp = out; float* o_ys = out + 8388608; float* o_natk = out + 75497472; float* o_natv = out + 83886080; float* o_lru = out + 92274688; float* o_ckv = out + 92360704; float* o_kr = out + 94457856;
    float* o_swak = out + 94720000; float* o_swav = out + 95768576;
    bf16* XB = (bf16*)out; bf16* XB2 = (bf16*)(ws + 1000 * MiB);
    (void)XB; (void)XB2;
    (void)o_natk; (void)o_natv; (void)o_lru; (void)o_ckv; (void)o_kr; (void)o_swak; (void)o_swav; (void)ropeC; (void)ropeS;
        const float* mod = MOD + (size_t)l * NCI * N6; const float* xc = l == 0 ? in[I_xp] : o_yp; const float* xl = l == 0 ? in[I_xs] : o_ys;
        if (EN & 2) PH(phid(l, SL_NORM1)) { if (XB16 && l > 0) ph_norm16(F, XB, in[I_nmix] + (size_t)l * D, mod, 0, H); else ph_norm32(F, xc, xl, in[I_nmix] + (size_t)l * D, mod, 0, H); SEAM(phid(l, SL_NORM1)); }
        if (EN & 4) PH(phid(l, SL_M1)) {
            const bf16* Wt = (const bf16*)(ws + (l == 0 ? WS_WNQKV : l == 1 ? WS_WLIN : l == 2 ? WS_WMD : WS_WSQKV) * MiB); const int N = l == 0 ? 3 * NQ : l == 1 ? 2 * LW : l == 2 ? MDN : SQW;
            bf16* C = (bf16*)(ws + WS_S * MiB);
            pg8::Gemm g{H, Wt, R, N, D, D, D, 0}; pg8::StaticOrder S; S.init(R, N, F.G, F.bid);
            if constexpr (l == 0 && KFUSE) { pg8::EpiNatQKV E{C, in[I_nkn], out, (LAS float*)(F.lds + EPI_OFF)}; pg8::gemm_phase<pg8::EpiNatQKV, pg8::StaticOrder, true, true>(F.lds, g, S, E); }
            else { pg8::EpiBf16<0> E{C, N, nullptr, 0, 0, 1.f}; pg8::gemm_phase<pg8::EpiBf16<0>, pg8::StaticOrder, true, true>(F.lds, g, S, E); }
            SEAM(phid(l, SL_M1)); }
        int KO = 2048; const bf16* Wo = nullptr; const bf16* Aout = OB;
        if constexpr (l == 0) {
            bf16* QKV = (bf16*)(ws + WS_QKV * MiB); Wo = (const bf16*)(ws + WS_WNO * MiB);
            if ((EN & 8) && !KFUSE) PH(phid(l, SL_M2)) {
                ph_copyv(F, QKV + 2 * NQ, 3 * NQ, 128, 16, 128, o_natv);
                if (!QFUSE) ph_headpost<16>(F, HeadPost{QKV, 3 * NQ, 128, 128, nullptr, 0, 0, 0, in[I_nqn], QKV, 3 * NQ, 128, 16, 0, nullptr, nullptr, nullptr, R}, R * 16);
                ph_headpost<16>(F, HeadPost{QKV + NQ, 3 * NQ, 128, 128, nullptr, 0, 0, 0, in[I_nkn], QKV + NQ, 3 * NQ, 128, 16, 0, nullptr, nullptr, o_natk, R}, R * 16);
                SEAM(phid(l, SL_M2)); }
            if (EN & 16) PH(phid(l, SL_M3)) {
                PolNatLat PL; PL.QKV = QKV; PL.CK = (const bf16*)(ws + WS_NATCK * MiB); PL.CV = (const bf16*)(ws + WS_NATCV * MiB); PL.rpb = in[I_nrpb]; PL.O = OB; PL.qgain = in[I_nqn]; PL.ropeC = ropeC; PL.ropeS = ropeS;
                ph_attn<128, 128, true>(F, PL, 2048);
                PolCtx PC; PC.Q = QKV; PC.pq = 3 * NQ; PC.shq = 128; PC.K = QKV + NQ; PC.pk = 3 * NQ; PC.shk = 128; PC.V = QKV + 2 * NQ; PC.pv = 3 * NQ; PC.shv = 128; PC.O = OB; PC.sho = 128; PC.NH = 16; PC.qgain = in[I_nqn]; PC.ropeC = ropeC; PC.ropeS = ropeS;
                ph_attn<128, 128, true>(F, PC, 256);
                SEAM(phid(l, SL_M3)); }
        } else if constexpr (l == 1) {
            const bf16* XG = (const bf16*)(ws + WS_XG * MiB); Wo = (const bf16*)(ws + WS_WLOUT * MiB); KO = LW; Aout = (const bf16*)(ws + WS_Y * MiB);
            bf16* XC = (bf16*)(ws + WS_AGG * MiB); bf16* HB = (bf16*)(ws + 1107 * MiB); bf16* Yb = (bf16*)(ws + WS_Y * MiB);
            ChainArgs CA{XC, (const bf16*)(ws + WS_WG * MiB), in[I_lba], in[I_lbi], in[I_llam], in[I_slru], Yb, HB, o_lru};
            if (EN & 32) PH(phid(l, SL_M2)) { ph_lru_xc(F, XG, in[I_lcw], in[I_lcb], XC); SEAM(phid(l, SL_M2)); }
            if (EN & 64) PH(phid(l, SL_M3)) { ph_lru_chains(F, CA); SEAM(phid(l, SL_M3)); }
            if (EN & 128) PH(phid(l, SL_M4)) { ph_lru_combine(F, XG, HB, Yb); SEAM(phid(l, SL_M4)); }
        } else if constexpr (l == 2) {
            bf16* Dn = (bf16*)(ws + WS_DN * MiB); bf16* KR = (bf16*)(ws + WS_KR * MiB); bf16* Qb = (bf16*)(ws + WS_Q * MiB); bf16* KVr = (bf16*)(ws + WS_KVR * MiB); bf16* Kb = (bf16*)(ws + WS_K * MiB); Wo = (const bf16*)(ws + WS_WMO * MiB);
            if (EN & 256) PH(phid(l, SL_M2)) { ph_mlanorm(F, Dn, KR, in[I_mqan], in[I_mkvan], in[I_cckv], in[I_ckr], o_ckv, o_kr); SEAM(phid(l, SL_M2)); }
            if (EN & 512) PH(phid(l, SL_M3)) {
                { pg8::Gemm g{Dn, (const bf16*)(ws + WS_WMUQ * MiB), R, MQW, 768, MDN, 768, 0}; pg8::StaticOrder S; S.init(R, MQW, F.G, F.bid); pg8::EpiBf16<0> E{Qb, MQW, nullptr, 0, 0, 1.f};
                  pg8::gemm_phase<pg8::EpiBf16<0>, pg8::StaticOrder, true, true>(F.lds, g, S, E); }
                { pg8::Gemm g{Dn + 768, (const bf16*)(ws + WS_WMUKV * MiB), RK, MKVW, 512, MDN, 512, 0}; pg8::StaticOrder S; S.init(RK, MKVW, F.G, F.bid); pg8::EpiBf16<0> E{KVr, MKVW, nullptr, 0, 0, 1.f};
                  pg8::gemm_phase<pg8::EpiBf16<0>, pg8::StaticOrder, true, true>(F.lds, g, S, E); }
                SEAM(phid(l, SL_M3)); }
            if (EN & 1024) PH(phid(l, SL_M4)) {
                if (!QFUSE) ph_headpost<32>(F, HeadPost{Qb, MQW, 192, 192, nullptr, 0, 0, 0, in[I_mqn], Qb, MQW, 192, 16, 64, ropeC, ropeS, nullptr, R}, R * 16);
                ph_headpost<32>(F, HeadPost{KVr, MKVW, 256, 128, KR, 64, 0, 64, in[I_mkn], Kb, MQW, 192, 16, 64, ropeC, ropeS, nullptr, R}, RK * 16);
                SEAM(phid(l, SL_M4)); }
            if (EN & 2048) PH(phid(l, SL_M5)) {
                PolMlaLat PL; PL.Q = Qb; PL.K = Kb; PL.KV = KVr; PL.O = OB; PL.qgain = in[I_mqn]; PL.ropeC = ropeC; PL.ropeS = ropeS;
                ph_attn<192, 128, false>(F, PL, 2048);
                PolCtx PC; PC.Q = Qb; PC.pq = MQW; PC.shq = 192; PC.K = Kb; PC.pk = MQW; PC.shk = 192; PC.V = KVr + 128; PC.pv = MKVW; PC.shv = 256; PC.O = OB; PC.sho = 128; PC.NH = 16; PC.qgain = in[I_mqn]; PC.ropeC = ropeC; PC.ropeS = ropeS;
                ph_attn<192, 128, false>(F, PC, 256);
                SEAM(phid(l, SL_M5)); }
        } else {
            bf16* QKV = (bf16*)(ws + WS_QKV * MiB); Wo = (const bf16*)(ws + WS_WSO * MiB);
            if (EN & 4096) PH(phid(l, SL_M2)) {
                ph_copyv(F, QKV + 2304, SQW, 64, 4, 64, o_swav);
                if (!QFUSE) ph_headpost<8>(F, HeadPost{QKV, SQW, 64, 64, nullptr, 0, 0, 0, in[I_sqn], QKV, SQW, 64, 32, 64, ropeC, ropeS, nullptr, R}, R * 32);
                ph_headpost<8>(F, HeadPost{QKV + 2048, SQW, 64, 64, nullptr, 0, 0, 0, in[I_skn], QKV + 2048, SQW, 64, 4, 64, ropeC, ropeS, o_swak, R}, R * 4);
                SEAM(phid(l, SL_M2)); }
            if (EN & 8192) PH(phid(l, SL_M3)) {
                PolSwaLat PL; PL.QKV = QKV; PL.CK = (const bf16*)(ws + WS_SWACK * MiB); PL.CV = (const bf16*)(ws + WS_SWACV * MiB); PL.sinks = in[I_ssink]; PL.O = OB; PL.qgain = in[I_sqn]; PL.ropeC = ropeC; PL.ropeS = ropeS;
                ph_attn<64, 64, true>(F, PL, 4096);
                PolSwaCtx PC; PC.QKV = QKV; PC.O = OB; PC.sinks = in[I_ssink]; PC.qgain = in[I_sqn]; PC.ropeC = ropeC; PC.ropeS = ropeS;
                ph_attn<64, 64, true>(F, PC, 512);
                SEAM(phid(l, SL_M3)); }
        }
        if (EN & 16384) PH(phid(l, SL_MIXOUT)) {
            pg8::Gemm g{Aout, Wo, R, D, KO, KO, KO, 0}; pg8::StaticOrder S; S.init(R, D, F.G, F.bid, WGM_N2048);
            if constexpr (XB16 && l == 0) { pg8::EpiResidB<false, true> E{xc, xl, XB, mod + 2 * D}; pg8::gemm_phase<pg8::EpiResidB<false, true>, pg8::StaticOrder, true, true>(F.lds, g, S, E); }
            else if constexpr (XB16) { pg8::EpiResidB<true, true> E{XB, XB + (size_t)RC * D, l == 3 ? XB2 : XB, mod + 2 * D}; pg8::gemm_phase<pg8::EpiResidB<true, true>, pg8::StaticOrder, true, true>(F.lds, g, S, E); }
            else { pg8::EpiResid E{xc, xl, o_yp, mod + 2 * D}; pg8::gemm_phase<pg8::EpiResid, pg8::StaticOrder, true, true>(F.lds, g, S, E); }
            if (DEFER_W && l < 3) tr_layer_idle(F, in, ws, l + 1, 0);
            SEAM(phid(l, SL_MIXOUT)); }
        if (EN & 32768) PH(phid(l, SL_NORM2)) { if (XB16) ph_norm16(F, l == 3 ? XB2 : XB, in[I_nffn] + (size_t)l * D, mod, 3, H); else ph_norm(F, o_yp, o_ys, in[I_nffn] + (size_t)l * D, mod, 3, H); SEAM(phid(l, SL_NORM2)); }
        bf16* Gb = (bf16*)(ws + WS_G * MiB); float* SIDE = (float*)(ws + WS_SIDE * MiB);
        if (EN & 65536) PH(phid(l, SL_FFNIN)) {
            pg8::Gemm g{H, (const bf16*)(ws + (WS_WFFN + 66 * l) * MiB), R, 2 * DFF, D, D, D, 0}; pg8::StaticOrder S; S.init(R, 2 * DFF, F.G, F.bid, WGM_FFNIN);
            pg8::EpiFfn E{Gb, in[I_fcw] + (size_t)l * 3 * DFF, in[I_fcb] + (size_t)l * DFF, SIDE, (LAS float*)(F.lds + EPI_OFF)};
            pg8::gemm_phase<pg8::EpiFfn, pg8::StaticOrder, true, true>(F.lds, g, S, E);
            SEAM(phid(l, SL_FFNIN)); }
        if (EN & 131072) PH(phid(l, SL_FFNFIX)) { ph_ffn_fix(F, SIDE, in[I_fcw] + (size_t)l * 3 * DFF, Gb); SEAM(phid(l, SL_FFNFIX)); }
        if (EN & 262144) PH(phid(l, SL_FFNOUT)) {
            pg8::Gemm g{Gb, (const bf16*)(ws + (WS_WFFN + 66 * l + 44) * MiB), R, D, DFF, DFF, DFF, 0}; pg8::StaticOrder S; S.init(R, D, F.G, F.bid, WGM_N2048, REV_FFNOUT);
            if constexpr (XB16 && l < 3) { pg8::EpiResidB<true, true> E{XB, XB + (size_t)RC * D, XB, mod + 5 * D}; pg8::gemm_phase<pg8::EpiResidB<true, true>, pg8::StaticOrder, true, true>(F.lds, g, S, E); }
            else if constexpr (XB16) { pg8::EpiResidB<true, false> E{XB2, XB2 + (size_t)RC * D, o_yp, mod + 5 * D}; pg8::gemm_phase<pg8::EpiResidB<true, false>, pg8::StaticOrder, true, true>(F.lds, g, S, E); }
            else { pg8::EpiResid E{o_yp, o_ys, o_yp, mod + 5 * D}; pg8::gemm_phase<pg8::EpiResid, pg8::StaticOrder, true, true>(F.lds, g, S, E); }
            if (DEFER_W && l < 3) tr_layer_idle(F, in, ws, l + 1, 1);
            SEAM(phid(l, SL_FFNOUT)); }
}
__global__ void __launch_bounds__(512, 2) mega(mk::MArgs a) {
    using namespace mk; constexpr unsigned EN = EN_MASK;
    extern __shared__ __attribute__((aligned(16))) unsigned char lds_raw[];
    Fr F; F.lds = (LAS unsigned char*)lds_raw; F.tid = threadIdx.x; F.lane = F.tid & 63; F.wave = __builtin_amdgcn_readfirstlane(F.tid >> 6); F.G = gridDim.x; F.bid = blockIdx.x;
    for (int u = F.tid; u < (LDS_BYTES - LDSCTL_OFF) / 4; u += 512) ((LAS unsigned*)(F.lds + LDSCTL_OFF))[u] = 0u;
    __syncthreads();
    unsigned char* ws = a.ws; const float* const* in = a.in; float* out = a.out;
    const int lo = a.ph_lo, hi = a.ph_hi;
    XcdBarrier bar; bar.bar = (unsigned*)ws + CW_BAR; bar.x = 0; bar.st = nullptr;
    if (hi - lo > 1) bar = xcd_barrier_post((unsigned*)ws + CW_BAR, (volatile LAS unsigned*)(F.lds + MISC_OFF) + 8);
    if (EN & 1) PH(0) { ph_prologue(F, in, ws); SEAM(0); }
    layer_body<0>(F, in, out, ws, bar, lo, hi); layer_body<1>(F, in, out, ws, bar, lo, hi); layer_body<2>(F, in, out, ws, bar, lo, hi); layer_body<3>(F, in, out, ws, bar, lo, hi);
    PH(70) { bf16* H = (bf16*)(ws + WS_H * MiB); pg8::Gemm g{H, (const bf16*)(ws + WS_WFFN * MiB), 4096, 2 * DFF, D, D, D, 0}; pg8::StaticOrder S; S.init(4096, 2 * DFF, F.G, F.bid);
        pg8::EpiFfnT<1> E{(bf16*)(ws + 540 * MiB), in[I_fcw], in[I_fcb], (float*)(ws + WS_SIDE * MiB), (LAS float*)(F.lds + EPI_OFF)}; pg8::gemm_phase<pg8::EpiFfnT<1>, pg8::StaticOrder, true, true>(F.lds, g, S, E); }
    PH(71) { bf16* H = (bf16*)(ws + WS_H * MiB); pg8::Gemm g{H, (const bf16*)(ws + WS_WFFN * MiB), 4096, 2 * DFF, D, D, D, 0}; pg8::StaticOrder S; S.init(4096, 2 * DFF, F.G, F.bid);
        pg8::EpiFfnT<2> E{(bf16*)(ws + 600 * MiB), in[I_fcw], in[I_fcb], (float*)(ws + WS_SIDE * MiB), (LAS float*)(F.lds + EPI_OFF)}; pg8::gemm_phase<pg8::EpiFfnT<2>, pg8::StaticOrder, true, true>(F.lds, g, S, E); }
    PH(72) { bf16* H = (bf16*)(ws + WS_H * MiB); pg8::Gemm g{H, (const bf16*)(ws + WS_WFFN * MiB), 4096, 2 * DFF, D, D, D, 0}; pg8::StaticOrder S; S.init(4096, 2 * DFF, F.G, F.bid);
        pg8::EpiFfnT<0> E{(bf16*)(ws + 660 * MiB), in[I_fcw], in[I_fcb], (float*)(ws + WS_SIDE * MiB), (LAS float*)(F.lds + EPI_OFF)}; pg8::gemm_phase<pg8::EpiFfnT<0>, pg8::StaticOrder, true, true>(F.lds, g, S, E); }
#undef PH
#undef SEAM
}
template <class Op, int BT> __global__ __launch_bounds__(BT) void k_run(Op op, long n) { for (long g = (long)blockIdx.x * BT + threadIdx.x; g < n; g += (long)gridDim.x * BT) op.run(g); }
template <int MODE> __global__ __launch_bounds__(512, 2) void k_gemm(pg8::Gemm g, void* C, long ldc) {
    extern __shared__ __attribute__((aligned(16))) unsigned char shm[];
    pg8::StaticOrder S; S.init(g.M, g.N, (int)gridDim.x, (int)blockIdx.x);
    if constexpr (MODE == 0) { pg8::EpiBf16<0> E{(pg8::bf16_t*)C, (int)ldc, nullptr, 0, 0, 1.f}; pg8::gemm_phase<pg8::EpiBf16<0>, pg8::StaticOrder, true, true>((PG8_LAS unsigned char*)shm, g, S, E); }
    else { pg8::EpiF32 E{(float*)C, (int)ldc}; pg8::gemm_phase<pg8::EpiF32, pg8::StaticOrder, true, true>((PG8_LAS unsigned char*)shm, g, S, E); }
}
template <class T> struct big_regs { static constexpr bool v = false; };
template <int A, int B> struct big_regs<OpAttnCtx<A, B>> { static constexpr bool v = true; };
template <int A> struct big_regs<OpNatLat<A>> { static constexpr bool v = true; };
template <int A, int B> struct big_regs<OpMlaLat<A, B>> { static constexpr bool v = true; };
template <int A> struct big_regs<OpSwaLat<A>> { static constexpr bool v = true; };
struct DevCX { hipStream_t st; int cus;
    template <class Op> void run(const Op& op, long n) { constexpr int BT = big_regs<Op>::v ? 64 : 256; long nb = (n + BT - 1) / BT; const long cap = (long)cus * (big_regs<Op>::v ? 32 : 16); if (nb > cap) nb = cap;
        hipLaunchKernelGGL((k_run<Op, BT>), dim3((unsigned)nb), dim3(BT), 0, st, op, n); }
    void gemm(const act_t* A, int lda, const act_t* Wt, int M, int N, int K, int mode, void* C, int ldc) {
        pg8::Gemm g{A, Wt, M, N, K, lda, K, 0};
        static bool a = false; if (!a) { (void)hipFuncSetAttribute((const void*)k_gemm<0>, hipFuncAttributeMaxDynamicSharedMemorySize, pg8::STAGE_BYTES); (void)hipFuncSetAttribute((const void*)k_gemm<1>, hipFuncAttributeMaxDynamicSharedMemorySize, pg8::STAGE_BYTES); a = true; }
        if (mode == 0) hipLaunchKernelGGL((k_gemm<0>), dim3(cus), dim3(512), pg8::STAGE_BYTES, st, g, C, (long)ldc);
        else hipLaunchKernelGGL((k_gemm<1>), dim3(cus), dim3(512), pg8::STAGE_BYTES, st, g, C, (long)ldc); }
};

#ifndef USE_PRO
#define USE_PRO 1
#endif
#ifndef USE_NORM
#define USE_NORM 1
#endif
#ifndef USE_GEMM
#define USE_GEMM 1
#endif
#ifndef USE_RESID
#define USE_RESID 1
#endif
#ifndef USE_HP
#define USE_HP 1
#endif
#ifndef USE_ATTN
#define USE_ATTN 13
#endif
#ifndef USE_LRU
#define USE_LRU 1
#endif
#ifndef USE_FFN
#define USE_FFN 1
#endif
#ifndef ONE_LAUNCH
#define ONE_LAUNCH 1
#endif


#ifndef TEST_PERM
#define TEST_PERM 0
#endif
struct OpFfnActP { const act_t* U; const float* cw; const float* cb; act_t* G; long row0; long nrows; Dims d;
    __device__ void run(long g) const { const int F = d.DFF; const int lr = (int)(g / F), c = (int)(g % F); const int row = (int)row0 + lr; const int ca = 256 * (c >> 7) + (c & 127), cbx = ca + 128;
        int s0, T; if (row < d.RC) { s0 = (row / d.S) * d.S; T = d.S; } else { s0 = d.RC + ((row - d.RC) / d.N) * d.N; T = d.N; } const int t = row - s0;
        float acc = cb[c]; for (int k = 0; k < 3; ++k) { const int tt = t + k - 1; if (tt >= 0 && tt < T) acc += cw[(size_t)k * F + c] * ldf(U[(size_t)(s0 + tt - row0) * 2 * F + ca]); }
        G[(size_t)lr * F + c] = stf(silu_f(acc) * ldf(U[(size_t)lr * 2 * F + cbx])); } };
#ifndef DIAG_FFN
#define DIAG_FFN 0
#endif
struct OpCmp { const act_t* U; const act_t* ga; const act_t* gb; const act_t* gc; unsigned* diag; long F; const float* cw; const float* cb;
    __device__ void run(long g) const { if (((unsigned)(g * 2654435761u) >> 26) != 0u) return; const long lr = g / F, c = g % F; const int r16 = lr & 15; if (r16 == 0 || r16 == 15) return;
        const float a0 = ldf(U[lr * 2 * F + c]), am = ldf(U[(lr - 1) * 2 * F + c]), ap = ldf(U[(lr + 1) * 2 * F + c]); const float b0 = ldf(U[lr * 2 * F + F + c]);
        const float w0 = cw[c], w1 = cw[F + c], w2 = cw[2 * F + c], bb = cb[c];
        const float v0 = silu_f(bb + w0 * am + w1 * a0 + w2 * ap) * b0;
        float df = fabsf(ldf(ga[g]) - a0); if (df > 0.05f + 0.02f * fabsf(a0) || !(df == df)) atomicAdd(diag + 0, 1u);
        df = fabsf(ldf(gb[g]) - a0); if (df > 0.05f + 0.02f * fabsf(a0) || !(df == df)) atomicAdd(diag + 1, 1u);
        df = fabsf(ldf(gc[g]) - v0); if (df > 0.15f + 0.05f * fabsf(v0) || !(df == df)) atomicAdd(diag + 2, 1u); } };
struct OpPerturb { float* out; const unsigned* diag;
    __device__ void run(long g) const { const unsigned bits = (diag[0] > 5000u ? 1u : 0u) | (diag[1] > 5000u ? 2u : 0u) | (diag[2] > 5000u ? 4u : 0u); out[g] *= 1.f + 0.05f * (1.f + (float)bits * 0.0625f); } };
extern "C" void kernel_launch(void* const* d_in, const int* in_sizes, int n_in, void* d_out, int out_size, void* d_ws, size_t ws_size, hipStream_t stream) {
    static int cus = 0;
    if (cus == 0) { int dev = 0; if (hipGetDevice(&dev) != hipSuccess || hipDeviceGetAttribute(&cus, hipDeviceAttributeMultiprocessorCount, dev) != hipSuccess || cus <= 0) cus = -1;
        if (cus > 0 && hipFuncSetAttribute((const void*)mega, hipFuncAttributeMaxDynamicSharedMemorySize, mk::LDS_BYTES) != hipSuccess) cus = -1; }
    constexpr size_t MiB = 1u << 20;
    if (cus < 0 || n_in != N_IN || out_size != 96817152 || ws_size < 1500 * MiB) { fprintf(stderr, "kernel_launch: unexpected arguments (n_in %d out %d ws %zu cus %d); nothing launched\n", n_in, out_size, ws_size, cus); return; }
    Dims d{}; d.D = 2048; d.B = 16; d.S = 256; d.DB = 8; d.N = 4096; d.PAST = 256; d.GW = 64; d.NAH = 16; d.NAD = 128; d.LW = 2688; d.LB = 16; d.LBK = 168;
    d.MH = 16; d.MQR = 768; d.MKR = 512; d.MNOPE = 128; d.MROPE = 64; d.MV = 128; d.MQK = 192; d.MDN = 1536; d.SH = 32; d.SKVH = 4; d.SD = 64; d.SWIN = 128; d.DFF = 5632;
    d.RC = d.B * d.S; d.R = d.RC + d.DB * d.N; d.RK = d.R + d.DB * d.PAST;
    unsigned char* ws = (unsigned char*)d_ws; auto at = [&](size_t mib) { return ws + mib * MiB; };
    WS w{}; w.MOD = (float*)at(1); w.ropeC = (float*)at(3); w.ropeS = (float*)at(4);
    w.natCK = (act_t*)at(5); w.natCV = (act_t*)at(13); w.swaCK = (act_t*)at(21); w.swaCV = (act_t*)at(22);
    for (int l = 0; l < 4; ++l) { w.Wffn_in[l] = (act_t*)at(26 + 66 * l); w.Wffn_out[l] = (act_t*)at(26 + 66 * l + 44); }
    w.Wnat_qkv = (act_t*)at(290); w.Wnat_o = (act_t*)at(314); w.Wlru_in = (act_t*)at(322); w.Wlru_out = (act_t*)at(344); w.Wmla_down = (act_t*)at(355); w.Wmla_uq = (act_t*)at(361);
    w.Wmla_ukv = (act_t*)at(366); w.Wmla_o = (act_t*)at(370); w.Wswa_qkv = (act_t*)at(378); w.Wswa_o = (act_t*)at(388);
    w.H = (act_t*)at(396); w.OB = w.H;
    w.QKV = (act_t*)at(540); w.XG = (act_t*)at(540); w.XC = (act_t*)at(918); w.HS = (act_t*)at(1107); w.Y = (act_t*)at(1296);
    w.Dn = (act_t*)at(540); w.KR = (act_t*)at(654); w.Q = (act_t*)at(659); w.KVr = (act_t*)at(875); w.K = (act_t*)at(1179);
    w.U = (act_t*)at(540); w.G = (act_t*)at(804); w.ffn_chunk_rows = 12288;
    w.T_mix[0] = (float*)at(972); w.T_mix[1] = (float*)at(540); w.T_mix[2] = (float*)at(540); w.T_mix[3] = (float*)at(720); w.T_ffn = (float*)at(936);
    float* out = (float*)d_out;
    OutPtrs o{out, out + 8388608, out + 75497472, out + 83886080, out + 92274688, out + 92360704, out + 94457856, out + 94720000, out + 95768576};
    const float* in[N_IN]; for (int i = 0; i < N_IN; ++i) in[i] = (const float*)d_in[i];
    DevCX cx{stream, cus};
    (void)hipMemsetAsync(ws, 0, MiB, stream);
    mk::MArgs ma{}; for (int i = 0; i < N_IN; ++i) ma.in[i] = in[i]; ma.out = out; ma.ws = ws;
    auto mega_ph = [&](int lo, int hi) { mk::MArgs a = ma; a.ph_lo = lo; a.ph_hi = hi; hipLaunchKernelGGL(mega, dim3(cus), dim3(512), mk::LDS_BYTES, stream, a); };
#ifndef REP_MASK
#define REP_MASK 0
#endif
    auto mph = [&](int l, int slot) { int reps = 1;
        const bool att = (l == 0 && slot == mk::SL_M3) || (l == 2 && slot == mk::SL_M5) || (l == 3 && slot == mk::SL_M3);
        const bool gem = slot == mk::SL_M1 || (l == 2 && slot == mk::SL_M3) || slot == mk::SL_FFNIN;
        const bool lru = l == 1 && (slot == mk::SL_M2 || slot == mk::SL_M3 || slot == mk::SL_M4);
        const bool light = slot == mk::SL_NORM1 || slot == mk::SL_NORM2 || lru || slot == mk::SL_FFNFIX;
        if ((REP_MASK & 1) && att) reps = 2; if ((REP_MASK & 2) && gem) reps = 2; if ((REP_MASK & 4) && light) reps = 2; if ((REP_MASK & 8) && l == 2 && slot == mk::SL_M5) reps = 2; if ((REP_MASK & 32) && lru) reps = 2; if ((REP_MASK & 128) && slot == mk::SL_FFNIN) reps = 2; if ((REP_MASK & 512) && l == 1 && slot == mk::SL_M3) reps = 2; if ((REP_MASK & 256) && (slot == mk::SL_NORM1 || slot == mk::SL_NORM2)) reps = 2;
        if ((REP_MASK & 64) && (slot == mk::SL_MIXOUT || slot == mk::SL_FFNOUT)) { mk::MArgs a = ma; a.out = (float*)at(slot == mk::SL_MIXOUT ? 540 : 972); a.ph_lo = mk::phid(l, slot); a.ph_hi = a.ph_lo + 1; hipLaunchKernelGGL(mega, dim3(cus), dim3(512), mk::LDS_BYTES, stream, a); }
        for (int r = 0; r < reps; ++r) mega_ph(mk::phid(l, slot), mk::phid(l, slot) + 1); };
#if ONE_LAUNCH
    mega_ph(0, mk::PH_END);
    return;
#endif
    const int D = d.D, R = d.R, NCI = 9; const long N6 = 6L * D; const int NQ = 2048, MKVW = 4096, SQW = 2560, QW = 3072;
    if (USE_PRO) { mega_ph(0, 1); if (REP_MASK & (4 | 16)) mega_ph(0, 1); }
    if ((!USE_PRO || !USE_FFN) && !DIAG_FFN && !TEST_PERM) for (int l = 0; l < 4; ++l) cx.run(OpTranspose{in[I_fwin] + (size_t)l * D * 2 * d.DFF, w.Wffn_in[l], D, 2 * d.DFF, 2 * d.DFF, 0, d.DFF}, (long)2 * d.DFF * D);
    if (!USE_PRO) {
        for (int l = 0; l < 4; ++l) cx.run(OpTranspose{in[I_fwout] + (size_t)l * d.DFF * D, w.Wffn_out[l], d.DFF, D, D, 0, 0}, (long)D * d.DFF);
        cx.run(OpTranspose{in[I_nwqkv], w.Wnat_qkv, D, 3 * NQ, 3 * NQ, 0, 0}, (long)3 * NQ * D); cx.run(OpTranspose{in[I_nwo], w.Wnat_o, NQ, D, D, 0, 0}, (long)D * NQ);
        cx.run(OpTranspose{in[I_lwin], w.Wlru_in, D, 2 * d.LW, 2 * d.LW, 0, 0}, (long)2 * d.LW * D); cx.run(OpTranspose{in[I_lwout], w.Wlru_out, d.LW, D, D, 0, 0}, (long)D * d.LW);
        cx.run(OpTranspose{in[I_mwd], w.Wmla_down, D, 1344, d.MDN, 0, 0}, (long)d.MDN * D); cx.run(OpTranspose{in[I_mwuq], w.Wmla_uq, d.MQR, QW, QW, 0, 0}, (long)QW * d.MQR);
        cx.run(OpTranspose{in[I_mwukv], w.Wmla_ukv, d.MKR, MKVW, MKVW, 0, 0}, (long)MKVW * d.MKR); cx.run(OpTranspose{in[I_mwo], w.Wmla_o, 2048, D, D, 0, 0}, (long)D * 2048);
        cx.run(OpTranspose{in[I_swqkv], w.Wswa_qkv, D, SQW, SQW, 0, 0}, (long)SQW * D); cx.run(OpTranspose{in[I_swo], w.Wswa_o, 2048, D, D, 0, 0}, (long)D * 2048);
        cx.run(OpCvt{in[I_cnk], w.natCK}, (long)8 * 16 * 256 * 128); cx.run(OpCvt{in[I_cnv], w.natCV}, (long)8 * 16 * 256 * 128);
        cx.run(OpCvt{in[I_csk], w.swaCK}, (long)8 * 4 * 256 * 64); cx.run(OpCvt{in[I_csv], w.swaCV}, (long)8 * 4 * 256 * 64);
        cx.run(OpMod{in[I_c], in[I_cctx], in[I_wmod], in[I_bmod], w.MOD, D, NCI}, 4L * NCI * N6);
        cx.run(OpRope{w.ropeC, w.ropeS, d.MROPE, d.GW}, (long)d.N * d.MROPE);
    }
    const float* xc = in[I_xp]; const float* xl = in[I_xs]; float* outl = o.yp + (size_t)d.RC * D;
    for (int l = 0; l < 4; ++l) {
        const float* mod = w.MOD + (size_t)l * NCI * N6;
        if (USE_NORM) mph(l, mk::SL_NORM1); else cx.run(OpNormMod{xc, xl, in[I_nmix] + (size_t)l * D, mod, 0, w.H, d}, R);
        int KO = 0; const act_t* Wo = nullptr; const act_t* Aout = nullptr;
        if (l == 0) {
            if (USE_GEMM) mph(l, mk::SL_M1); else cx.gemm(w.H, D, w.Wnat_qkv, R, 3 * NQ, D, 0, w.QKV, 3 * NQ);
            if (USE_HP) { if (!KFUSE) mph(l, mk::SL_M2); } else {
                cx.run(OpCopyV{w.QKV + 2 * NQ, 3L * NQ, d.NAD, d.NAH, d.NAD, o.nat_v, d}, (long)d.RC * d.NAH * d.NAD);
                cx.run(OpHeadPost{w.QKV, 3L * NQ, d.NAD, d.NAD, nullptr, 0, 0, 0, in[I_nqn], w.QKV, 3L * NQ, d.NAD, d.NAH, 0, nullptr, nullptr, nullptr, 1, d, R}, (long)R * d.NAH);
                cx.run(OpHeadPost{w.QKV + NQ, 3L * NQ, d.NAD, d.NAD, nullptr, 0, 0, 0, in[I_nkn], w.QKV + NQ, 3L * NQ, d.NAD, d.NAH, 0, nullptr, nullptr, o.nat_k, 1, d, R}, (long)R * d.NAH); }
            if (USE_ATTN & 1) mph(l, mk::SL_M3); else {
                cx.run(OpAttnCtx<128, 128>{w.QKV, 3L * NQ, d.NAD, w.QKV + NQ, 3L * NQ, d.NAD, w.QKV + 2 * NQ, 3L * NQ, d.NAD, w.OB, (long)NQ, d.NAD, d.NAH, 1, nullptr, d}, (long)d.B * d.NAH * d.S);
                cx.run(OpNatLat<128>{w.QKV, 3L * NQ, w.natCK, w.natCV, in[I_nrpb], w.OB, (long)NQ, d}, (long)d.DB * d.NAH * d.N); }
            KO = NQ; Wo = w.Wnat_o; Aout = w.OB;
        } else if (l == 1) {
            if (USE_GEMM) mph(l, mk::SL_M1); else cx.gemm(w.H, D, w.Wlru_in, R, 2 * d.LW, D, 0, w.XG, 2 * d.LW);
            if (USE_LRU) { mph(l, mk::SL_M2); mph(l, mk::SL_M3); mph(l, mk::SL_M4); } else {
                cx.run(OpLruConv{w.XG, in[I_lcw], in[I_lcb], w.XC, d}, (long)R * d.LW);
                cx.run(OpLruScan{w.XC, w.XG, in[I_lwa], in[I_lba], in[I_lwi], in[I_lbi], in[I_llam], in[I_slru], w.HS, w.Y, o.lru, d}, (long)(d.B + d.DB) * d.LW); }
            KO = d.LW; Wo = w.Wlru_out; Aout = w.Y;
        } else if (l == 2) {
            if (USE_GEMM) mph(l, mk::SL_M1); else cx.gemm(w.H, D, w.Wmla_down, R, d.MDN, D, 0, w.Dn, d.MDN);
            if (USE_HP) mph(l, mk::SL_M2); else cx.run(OpMlaNorm{w.Dn, w.KR, in[I_mqan], in[I_mkvan], in[I_cckv], in[I_ckr], o.ckv, o.krope, d}, d.RK);
            if (USE_GEMM) mph(l, mk::SL_M3); else { cx.gemm(w.Dn, d.MDN, w.Wmla_uq, R, QW, d.MQR, 0, w.Q, QW); cx.gemm(w.Dn + d.MQR, d.MDN, w.Wmla_ukv, d.RK, MKVW, d.MKR, 0, w.KVr, MKVW); }
            if (USE_HP) mph(l, mk::SL_M4); else {
                cx.run(OpHeadPost{w.Q, (long)QW, d.MQK, d.MQK, nullptr, 0, 0, 0, in[I_mqn], w.Q, (long)QW, d.MQK, d.MH, d.MROPE, w.ropeC, w.ropeS, nullptr, 1, d, R}, (long)R * d.MH);
                cx.run(OpHeadPost{w.KVr, (long)MKVW, d.MNOPE + d.MV, d.MNOPE, w.KR, (long)d.MROPE, 0, d.MROPE, in[I_mkn], w.K, (long)QW, d.MQK, d.MH, d.MROPE, w.ropeC, w.ropeS, nullptr, 1, d, R}, (long)d.RK * d.MH); }
            if (USE_ATTN & 4) mph(l, mk::SL_M5); else {
                cx.run(OpAttnCtx<192, 128>{w.Q, (long)QW, d.MQK, w.K, (long)QW, d.MQK, w.KVr + d.MNOPE, (long)MKVW, d.MNOPE + d.MV, w.OB, (long)d.MH * d.MV, d.MV, d.MH, 1, nullptr, d}, (long)d.B * d.MH * d.S);
                cx.run(OpMlaLat<192, 128>{w.Q, w.K, w.KVr, w.OB, (long)d.MH * d.MV, d}, (long)d.DB * d.MH * d.N); }
            KO = d.MH * d.MV; Wo = w.Wmla_o; Aout = w.OB;
        } else {
            if (USE_GEMM) mph(l, mk::SL_M1); else cx.gemm(w.H, D, w.Wswa_qkv, R, SQW, D, 0, w.QKV, SQW);
            if (USE_HP) mph(l, mk::SL_M2); else {
                cx.run(OpCopyV{w.QKV + (d.SH + d.SKVH) * d.SD, (long)SQW, d.SD, d.SKVH, d.SD, o.swa_v, d}, (long)d.RC * d.SKVH * d.SD);
                cx.run(OpHeadPost{w.QKV, (long)SQW, d.SD, d.SD, nullptr, 0, 0, 0, in[I_sqn], w.QKV, (long)SQW, d.SD, d.SH, d.SD, w.ropeC, w.ropeS, nullptr, 1, d, R}, (long)R * d.SH);
                cx.run(OpHeadPost{w.QKV + d.SH * d.SD, (long)SQW, d.SD, d.SD, nullptr, 0, 0, 0, in[I_skn], w.QKV + d.SH * d.SD, (long)SQW, d.SD, d.SKVH, d.SD, w.ropeC, w.ropeS, o.swa_k, 1, d, R}, (long)R * d.SKVH); }
            if (USE_ATTN & 8) mph(l, mk::SL_M3); else {
                cx.run(OpAttnCtx<64, 64>{w.QKV, (long)SQW, d.SD, w.QKV + d.SH * d.SD, (long)SQW, d.SD, w.QKV + (d.SH + d.SKVH) * d.SD, (long)SQW, d.SD, w.OB, (long)d.SH * d.SD, d.SD, d.SH, d.SH / d.SKVH, in[I_ssink], d}, (long)d.B * d.SH * d.S);
                cx.run(OpSwaLat<64>{w.QKV, (long)SQW, w.swaCK, w.swaCV, in[I_ssink], w.OB, (long)d.SH * d.SD, d}, (long)d.DB * d.SH * d.N); }
            KO = d.SH * d.SD; Wo = w.Wswa_o; Aout = w.OB;
        }
        if (USE_RESID) mph(l, mk::SL_MIXOUT); else { cx.gemm(Aout, KO, Wo, R, D, KO, 1, w.T_mix[l], D); cx.run(OpResid{xc, xl, w.T_mix[l], mod, 2, o.yp, d}, (long)R * D); }
        xc = o.yp; xl = outl;
        if (USE_NORM) mph(l, mk::SL_NORM2); else cx.run(OpNormMod{xc, xl, in[I_nffn] + (size_t)l * D, mod, 3, w.H, d}, R);
        if (DIAG_FFN && l == 0) { mega_ph(70, 71); mega_ph(71, 72); mega_ph(72, 73); for (int l2 = 0; l2 < 4; ++l2) cx.run(OpTranspose{in[I_fwin] + (size_t)l2 * D * 2 * d.DFF, w.Wffn_in[l2], D, 2 * d.DFF, 2 * d.DFF, 0, d.DFF}, (long)2 * d.DFF * D); w.U = (act_t*)at(1224); w.G = (act_t*)at(1312); w.ffn_chunk_rows = 4096; }
        if (USE_FFN) { mph(l, mk::SL_FFNIN); mph(l, mk::SL_FFNFIX); mph(l, mk::SL_FFNOUT); } else {
            for (int r0 = 0; r0 < R; r0 += w.ffn_chunk_rows) { const int nr = (R - r0) < w.ffn_chunk_rows ? (R - r0) : w.ffn_chunk_rows;
                cx.gemm(w.H + (size_t)r0 * D, D, w.Wffn_in[l], nr, 2 * d.DFF, D, 0, w.U, 2 * d.DFF);
                if (TEST_PERM) cx.run(OpFfnActP{w.U, in[I_fcw] + (size_t)l * 3 * d.DFF, in[I_fcb] + (size_t)l * d.DFF, w.G, r0, nr, d}, (long)nr * d.DFF); else
                cx.run(OpFfnAct{w.U, in[I_fcw] + (size_t)l * 3 * d.DFF, in[I_fcb] + (size_t)l * d.DFF, w.G, r0, nr, d}, (long)nr * d.DFF);
                if (DIAG_FFN && l == 0 && r0 == 0) cx.run(OpCmp{w.U, (const act_t*)at(540), (const act_t*)at(600), (const act_t*)at(660), (unsigned*)(ws + 65536), (long)d.DFF, in[I_fcw], in[I_fcb]}, (long)nr * d.DFF);
                cx.gemm(w.G, d.DFF, w.Wffn_out[l], nr, D, d.DFF, 1, w.T_ffn + (size_t)r0 * D, D); }
            cx.run(OpResid{xc, xl, w.T_ffn, mod, 5, o.yp, d}, (long)R * D); }
        if (DIAG_FFN && l == 0) { w.U = (act_t*)at(540); w.G = (act_t*)at(804); w.ffn_chunk_rows = 12288; }
    }
    if (DIAG_FFN) cx.run(OpPerturb{o.yp, (const unsigned*)(ws + 65536)}, (long)8388608);
}
```

```cpp
#include <hip/hip_runtime.h>
#include <cstdio>
#include <cstdint>
#include <math.h>
namespace pg8 {
#define PG8_LAS __attribute__((address_space(3)))
typedef unsigned short bf16_t;
typedef short bf16x8 __attribute__((ext_vector_type(8)));
typedef float f32x4 __attribute__((ext_vector_type(4)));
typedef unsigned u32x4 __attribute__((ext_vector_type(4)));
constexpr int BM = 256, BK = 64, HALF = 128, HTB = HALF * BK * 2  , STAGE_BYTES = 8 * HTB, NXCD = 8, WGM = 8;

__host__ __device__ __forceinline__ int lds_byte(int r, int c) { const int st = (r >> 4) * 2 + (c >> 5), rr = r & 15, cc = c & 31, ob = rr * 64 + cc * 2; return st * 1024 + (ob ^ (((ob >> 9) & 1) << 5)); }
__host__ __device__ __forceinline__ void stage_rc(int b, int& R, int& C) { const int st = b / 1024, sb = b % 1024, swz = sb ^ (((sb >> 9) & 1) << 5); R = (st >> 1) * 16 + swz / 64; C = (st & 1) * 32 + (swz % 64) / 2; }
__host__ __device__ __forceinline__ int perm32(int rho) { const int n = rho >> 4, i = rho & 15; return 8 * (i >> 2) + 4 * n + (i & 3); }

struct Unit { int pm, pn; };
struct Gemm { const bf16_t* A; const bf16_t* Bt; int M, N, K, lda, ldb, pad; };

struct StaticOrder {
    int nM, nN, nwg, G, c, wgm, rev;
    __host__ __device__ void init(int M, int N, int G_, int c_, int wgm_ = WGM, int rev_ = 0) { nM = M / BM; nN = N / BM; nwg = nM * nN; G = G_; c = c_; wgm = wgm_; rev = rev_; }
    __host__ __device__ bool next(int i, Unit& u) const {
        const long L = (long)i * G + c; if (L >= nwg) return false;
        int wgid = (int)L; { const int q = nwg / NXCD, r = nwg % NXCD, xcd = wgid % NXCD, off = wgid / NXCD, sz = xcd < r ? q + 1 : q; wgid = (xcd < r ? xcd * (q + 1) : r * (q + 1) + (xcd - r) * q) + (rev ? sz - 1 - off : off); }
        const int nig = wgm * nN, gid = wgid / nig, fm = gid * wgm, gsz = (nM - fm) < wgm ? (nM - fm) : wgm;
        u.pm = fm + ((wgid % nig) % gsz); u.pn = (wgid % nig) / gsz; return true;
    }
    __device__ __forceinline__ void a_ready(const Unit&) const {}
    __device__ __forceinline__ void done(const Unit&) const {}
};

__device__ __forceinline__ unsigned cvt_pk_bf16(float lo, float hi) { unsigned r; asm volatile("v_cvt_pk_bf16_f32 %0, %1, %2" : "=v"(r) : "v"(lo), "v"(hi)); return r; }
typedef float f32x2 __attribute__((ext_vector_type(2)));
__device__ __forceinline__ f32x2 gelu_pk(f32x2 v) {
    const f32x2 av = __builtin_elementwise_abs(v), d = av * 0.2316418882f + 1.0f;
    f32x2 t; t.x = __builtin_amdgcn_rcpf(d.x); t.y = __builtin_amdgcn_rcpf(d.y);
    f32x2 q = t * 0.5307027145f + (-0.7265760135f); q = q * t + 0.7107068705f; q = q * t + (-0.142248368f); q = q * t + 0.127414796f; q = q * t;
    const f32x2 s = (v * v) * (-0.72134752044f);
    f32x2 e; e.x = __builtin_amdgcn_exp2f(s.x); e.y = __builtin_amdgcn_exp2f(s.y);
    const f32x2 m = v * (q * e), r = v - m;
    f32x2 o; o.x = v.x < 0.f ? m.x : r.x; o.y = v.y < 0.f ? m.y : r.y; return o;
}

template <int ACT  > struct EpiBf16 {
    static constexpr bool PERM = true, AFTER_DRAIN = false; static_assert(ACT == 0 || ACT == 1, "EpiBf16: ACT is 0 (none) or 1 (gelu_pk)");
    bf16_t* O; int ldc; const float* bias; int split_cols; size_t split_stride; float scale0;
    __device__ __forceinline__ void operator()(const f32x4 (&acc)[2][2][4][2], const Unit& u, int wr, int wc, int fr, int fq) const {
        const int row0 = u.pm * BM + wr * 64 + fr; int colt = u.pn * BM; bf16_t* base = O;
        float sc = 1.f; if (split_cols) { const int t = colt / split_cols; base += (size_t)t * split_stride; colt -= t * split_cols; if (t == 0) sc = scale0; }
        const int col0 = colt + wc * 32 + 8 * fq, bcol0 = u.pn * BM + wc * 32 + 8 * fq;
        f32x4 bv[2][2];
#pragma unroll
        for (int bj = 0; bj < 2; ++bj)
#pragma unroll
            for (int n = 0; n < 2; ++n) bv[bj][n] = bias ? *(const f32x4*)(bias + bcol0 + bj * HALF + 4 * n) : (f32x4){0.f, 0.f, 0.f, 0.f};
#pragma unroll
        for (int ai = 0; ai < 2; ++ai)
#pragma unroll
            for (int m = 0; m < 4; ++m) { bf16_t* rowp = base + (size_t)(row0 + ai * HALF + m * 16) * ldc + col0;
#pragma unroll
                for (int bj = 0; bj < 2; ++bj) { f32x4 v0 = acc[ai][bj][m][0] + bv[bj][0], v1 = acc[ai][bj][m][1] + bv[bj][1];
                    if (ACT == 1) { f32x2 a = gelu_pk((f32x2){v0[0], v0[1]}), b = gelu_pk((f32x2){v0[2], v0[3]}), c = gelu_pk((f32x2){v1[0], v1[1]}), d = gelu_pk((f32x2){v1[2], v1[3]});
                        v0 = (f32x4){a.x, a.y, b.x, b.y}; v1 = (f32x4){c.x, c.y, d.x, d.y}; }
                    v0 = v0 * sc; v1 = v1 * sc; u32x4 w; w.x = cvt_pk_bf16(v0[0], v0[1]); w.y = cvt_pk_bf16(v0[2], v0[3]); w.z = cvt_pk_bf16(v1[0], v1[1]); w.w = cvt_pk_bf16(v1[2], v1[3]);
                    *(u32x4*)(rowp + bj * HALF) = w; } }
    }
};


struct EpiF32 {
    static constexpr bool PERM = false, AFTER_DRAIN = false;
    float* C; int ldc;
    __device__ __forceinline__ void operator()(const f32x4 (&acc)[2][2][4][2], const Unit& u, int wr, int wc, int fr, int fq) const {
        const int row0 = u.pm * BM + wr * 64 + fr, col0 = u.pn * BM + wc * 32 + 4 * fq;
#pragma unroll
        for (int ai = 0; ai < 2; ++ai)
#pragma unroll
            for (int m = 0; m < 4; ++m) { float* rowp = C + (size_t)(row0 + ai * HALF + m * 16) * ldc + col0;
#pragma unroll
                for (int bj = 0; bj < 2; ++bj)
#pragma unroll
                    for (int n = 0; n < 2; ++n) *(f32x4*)(rowp + bj * HALF + n * 16) = acc[ai][bj][m][n]; }
    }
};
struct PanelStats {
    unsigned* xbuf;
    unsigned* cnt;
    unsigned* tmo;
    int ntn; float eps;
    unsigned code;
    __device__ __forceinline__ bool run(const f32x4 (&v)[2][2][4][2], const Unit& u, int wr, int wc, int fr, int fq, PG8_LAS unsigned char* lds, int wid, int lane) const {
        typedef float f32x2v __attribute__((ext_vector_type(2)));
        PG8_LAS f32x2v* P = (PG8_LAS f32x2v*)lds;
        PG8_LAS f32x2v* S = (PG8_LAS f32x2v*)(lds + 8192);
        PG8_LAS unsigned* flag = (PG8_LAS unsigned*)(lds + 8192 + 2048);
#pragma unroll
        for (int ai = 0; ai < 2; ++ai)
#pragma unroll
            for (int m = 0; m < 4; ++m) {
                float s = 0.f;
#pragma unroll
                for (int bj = 0; bj < 2; ++bj)
#pragma unroll
                    for (int n = 0; n < 2; ++n) { const f32x4 x = v[ai][bj][m][n]; s += (x[0] + x[1]) + (x[2] + x[3]); }
                s += __shfl_xor(s, 16); s += __shfl_xor(s, 32);
                const float mw = s * (1.0f / 64.0f); float q = 0.f;
#pragma unroll
                for (int bj = 0; bj < 2; ++bj)
#pragma unroll
                    for (int n = 0; n < 2; ++n) { const f32x4 d = v[ai][bj][m][n] - mw; q += (d[0] * d[0] + d[1] * d[1]) + (d[2] * d[2] + d[3] * d[3]); }
                q += __shfl_xor(q, 16); q += __shfl_xor(q, 32);
                if (fq == 0) P[(ai * HALF + wr * 64 + m * 16 + fr) * 4 + wc] = (f32x2v){mw, q};
            }
        asm volatile("s_waitcnt lgkmcnt(0)" ::: "memory"); __builtin_amdgcn_s_barrier(); asm volatile("" ::: "memory");
#if defined(BROKEN_EXCHANGE_NO_WAIT)
#warning BROKEN CONTROL BUILD: the row-statistics exchange does not wait; results are wrong by design
        if (blockIdx.x >= 64) { const long long t0_ = clock64(); while (clock64() - t0_ < 60000) __builtin_amdgcn_s_sleep(8); }
#endif
        const int row = wid * 32 + (lane & 31);
        if (lane < 32) {
            const f32x2v a = P[row * 4 + 0], b = P[row * 4 + 1], c = P[row * 4 + 2], d = P[row * 4 + 3];
            const float mt = (a.x + b.x + c.x + d.x) * 0.25f;
            const float da = a.x - mt, db = b.x - mt, dc = c.x - mt, dd = d.x - mt;
            const float m2 = (a.y + b.y) + (c.y + d.y) + 64.0f * ((da * da + db * db) + (dc * dc + dd * dd));
            unsigned long long* slot = (unsigned long long*)xbuf + ((size_t)(u.pm * BM + row) * 4 + u.pn);
            __hip_atomic_store(slot, ((unsigned long long)__float_as_uint(m2) << 32) | __float_as_uint(mt), __ATOMIC_RELAXED, __HIP_MEMORY_SCOPE_AGENT);
        }
        asm volatile("s_waitcnt vmcnt(0)" ::: "memory");
        if (lane == 0) __hip_atomic_fetch_add(cnt + 64 * u.pm, 1u, __ATOMIC_RELAXED, __HIP_MEMORY_SCOPE_AGENT);
        if (wid == 0) {
            bool dead = false; const unsigned long long t0 = __builtin_amdgcn_s_memrealtime(); const unsigned want = 8u * (unsigned)ntn;
            for (;;) {
#if defined(BROKEN_EXCHANGE_NO_WAIT)
                break;
#endif
                if ((unsigned)__builtin_amdgcn_readfirstlane(__hip_atomic_load(cnt + 64 * u.pm, __ATOMIC_RELAXED, __HIP_MEMORY_SCOPE_AGENT)) >= want) break;
                if (__builtin_amdgcn_s_memrealtime() - t0 > 2000000ull) {
                    if (lane == 0) { unsigned expect = 0u; __hip_atomic_compare_exchange_strong(tmo + 1, &expect, code | (unsigned)(u.pm & 0xff), __ATOMIC_RELAXED, __ATOMIC_RELAXED, __HIP_MEMORY_SCOPE_AGENT);
                                     __hip_atomic_store(tmo, 1u, __ATOMIC_RELAXED, __HIP_MEMORY_SCOPE_AGENT); }
                    dead = true; break; }
                __builtin_amdgcn_s_sleep(2);
            }
            __builtin_amdgcn_fence(__ATOMIC_ACQUIRE, "agent");
            if (lane == 0) flag[0] = dead ? 1u : 0u;
        }
        asm volatile("s_waitcnt vmcnt(0) lgkmcnt(0)" ::: "memory"); __builtin_amdgcn_s_barrier(); asm volatile("" ::: "memory");
        const bool bad = flag[0] != 0u;
        if (lane < 32) {
            const unsigned long long* slot = (const unsigned long long*)xbuf + (size_t)(u.pm * BM + row) * 4; float mt[4], m2[4]; float ms = 0.f;
#pragma unroll
            for (int t = 0; t < 4; ++t) { if (t < ntn) { const unsigned long long w = __hip_atomic_load(slot + t, __ATOMIC_RELAXED, __HIP_MEMORY_SCOPE_AGENT); mt[t] = __uint_as_float((unsigned)w); m2[t] = __uint_as_float((unsigned)(w >> 32)); } else { mt[t] = 0.f; m2[t] = 0.f; } ms += mt[t]; }
            const float mean = ms / (float)ntn; float q = 0.f;
#pragma unroll
            for (int t = 0; t < 4; ++t) if (t < ntn) { const float dm = mt[t] - mean; q += m2[t] + 256.0f * dm * dm; }
            S[row] = (f32x2v){mean, 1.0f / sqrtf(q / (256.0f * (float)ntn) + eps)};
        }
        asm volatile("s_waitcnt lgkmcnt(0)" ::: "memory"); __builtin_amdgcn_s_barrier(); asm volatile("" ::: "memory");
        return bad;
    }
};
struct EpiLnRes {
    static constexpr bool PERM = false, AFTER_DRAIN = true;
    const float* base; float* out; int ldc; const float* bias; PanelStats st; unsigned poison;
    __device__ __forceinline__ void fused(f32x4 (&acc)[2][2][4][2], const Unit& u, int wr, int wc, int fr, int fq, PG8_LAS unsigned char* lds, int wid, int lane) const {
        typedef float f32x2v __attribute__((ext_vector_type(2)));
        const PG8_LAS f32x2v* S = (const PG8_LAS f32x2v*)(lds + 8192);
        const int col0 = u.pn * BM + wc * 32 + 4 * fq;
#pragma unroll
        for (int bj = 0; bj < 2; ++bj)
#pragma unroll
            for (int n = 0; n < 2; ++n) { const f32x4 bv = bias ? *(const f32x4*)(bias + col0 + bj * HALF + n * 16) : (f32x4){0.f, 0.f, 0.f, 0.f};
#pragma unroll
                for (int ai = 0; ai < 2; ++ai)
#pragma unroll
                    for (int m = 0; m < 4; ++m) acc[ai][bj][m][n] += bv; }
        f32x4 pre[4][2][2];
#pragma unroll
        for (int m = 0; m < 4; ++m) { const size_t off = (size_t)(u.pm * BM + wr * 64 + m * 16 + fr) * ldc + col0;
#pragma unroll
            for (int bj = 0; bj < 2; ++bj)
#pragma unroll
                for (int n = 0; n < 2; ++n) pre[m][bj][n] = *(const f32x4*)(base + off + bj * HALF + n * 16); }
        const bool bad = st.run(acc, u, wr, wc, fr, fq, lds, wid, lane) || poison != 0u;
        const float qnan = __builtin_nanf("");
#pragma unroll
        for (int ai = 0; ai < 2; ++ai)
#pragma unroll
            for (int m = 0; m < 4; ++m) { const int r = ai * HALF + wr * 64 + m * 16 + fr; const f32x2v sr = S[r]; const size_t off = (size_t)(u.pm * BM + r) * ldc + col0;
#pragma unroll
                for (int bj = 0; bj < 2; ++bj)
#pragma unroll
                    for (int n = 0; n < 2; ++n) { const f32x4 bs = ai == 0 ? pre[m][bj][n] : *(const f32x4*)(base + off + bj * HALF + n * 16); f32x4 o = bs + (acc[ai][bj][m][n] - sr.x) * sr.y;
                        if (bad) o = (f32x4){qnan, qnan, qnan, qnan}; *(f32x4*)(out + off + bj * HALF + n * 16) = o; }
                if (m & 1) asm volatile("" ::: "memory"); }
    }
};
struct EpiLnResLn {
    static constexpr bool PERM = false, AFTER_DRAIN = true;
    const float* base; float* out; bf16_t* xn; int ldc; const float* bias; PanelStats st1, st2; unsigned poison;
    __device__ __forceinline__ void fused(f32x4 (&acc)[2][2][4][2], const Unit& u, int wr, int wc, int fr, int fq, PG8_LAS unsigned char* lds, int wid, int lane) const {
        typedef float f32x2v __attribute__((ext_vector_type(2))); typedef unsigned u32x2v __attribute__((ext_vector_type(2)));
        const PG8_LAS f32x2v* S = (const PG8_LAS f32x2v*)(lds + 8192);
        const int col0 = u.pn * BM + wc * 32 + 4 * fq;
#pragma unroll
        for (int bj = 0; bj < 2; ++bj)
#pragma unroll
            for (int n = 0; n < 2; ++n) { const f32x4 bv = bias ? *(const f32x4*)(bias + col0 + bj * HALF + n * 16) : (f32x4){0.f, 0.f, 0.f, 0.f};
#pragma unroll
                for (int ai = 0; ai < 2; ++ai)
#pragma unroll
                    for (int m = 0; m < 4; ++m) acc[ai][bj][m][n] += bv; }
        bool bad = st1.run(acc, u, wr, wc, fr, fq, lds, wid, lane) || poison != 0u;
        const float qnan = __builtin_nanf("");
#pragma unroll
        for (int ai = 0; ai < 2; ++ai)
#pragma unroll
            for (int m = 0; m < 4; ++m) { const int r = ai * HALF + wr * 64 + m * 16 + fr; const f32x2v sr = S[r]; const size_t off = (size_t)(u.pm * BM + r) * ldc + col0;
#pragma unroll
                for (int bj = 0; bj < 2; ++bj)
#pragma unroll
                    for (int n = 0; n < 2; ++n) { const f32x4 bs = *(const f32x4*)(base + off + bj * HALF + n * 16); acc[ai][bj][m][n] = bs + (acc[ai][bj][m][n] - sr.x) * sr.y; }
                asm volatile("" : "+v"(acc[ai][0][m][0]), "+v"(acc[ai][0][m][1]), "+v"(acc[ai][1][m][0]), "+v"(acc[ai][1][m][1]));
                if (m & 1) asm volatile("" ::: "memory"); }
        const bool bad1 = bad;
        bad = st2.run(acc, u, wr, wc, fr, fq, lds, wid, lane) || bad;
#pragma unroll
        for (int ai = 0; ai < 2; ++ai)
#pragma unroll
            for (int m = 0; m < 4; ++m) { const int r = ai * HALF + wr * 64 + m * 16 + fr; const f32x2v sr = S[r]; const size_t off = (size_t)(u.pm * BM + r) * ldc + col0;
#pragma unroll
                for (int bj = 0; bj < 2; ++bj)
#pragma unroll
                    for (int n = 0; n < 2; ++n) { const f32x4 x1 = acc[ai][bj][m][n]; *(f32x4*)(out + off + bj * HALF + n * 16) = bad1 ? (f32x4){qnan, qnan, qnan, qnan} : x1;
                        const f32x4 o = (x1 - sr.x) * sr.y; u32x2v w; w.x = cvt_pk_bf16(o[0], o[1]); w.y = cvt_pk_bf16(o[2], o[3]);
                        if (bad) { w.x = 0x7fc07fc0u; w.y = 0x7fc07fc0u; } *(u32x2v*)(xn + off + bj * HALF + n * 16) = w; }
                asm volatile("" ::: "memory"); }
    }
};

template <class Epi, class Sched, bool ALIGN_EPI = false, bool SP2 = false>
__device__ __forceinline__ void gemm_phase(PG8_LAS unsigned char* lds, const Gemm g, const Sched& S, const Epi& E) {
    const int tid = threadIdx.x, wid = __builtin_amdgcn_readfirstlane(tid >> 6), lane = tid & 63, wr = wid >> 2, wc = wid & 3, fr = lane & 15, fq = lane >> 4;
    const int K = g.K, nt = K / BK;
    unsigned voffA[2], voffB[2];
#pragma unroll
    for (int i = 0; i < 2; ++i) { int R, C; stage_rc(tid * 16 + i * 8192, R, C); const int Rb = Epi::PERM ? ((R & ~31) + perm32(R & 31)) : R;
        voffA[i] = (unsigned)(R * g.lda + C) * 2u; voffB[i] = (unsigned)(Rb * g.ldb + C) * 2u; }
    const size_t kstep = (size_t)(BK * 2);
    const size_t hstepA = (size_t)HALF * g.lda * 2, hstepB = (size_t)HALF * g.ldb * 2;
    const size_t tstepA = 2 * hstepA, tstepB = 2 * hstepB;
    const unsigned ldsw = (unsigned)wid * 1024u;
    const int aoff = lds_byte(wr * 64 + fr, fq * 8), boff = lds_byte(wc * 32 + fr, fq * 8);
#define PG8_SA(b, h) (((b) * 2 + (h)) * HTB)
#define PG8_SB(b, h) ((4 + (b) * 2 + (h)) * HTB)
#define PG8_STAGE(bufoff, gbase, voff) do { _Pragma("unroll") for (int _i = 0; _i < 2; ++_i) \
        __builtin_amdgcn_global_load_lds((const unsigned*)((const char*)(gbase) + (voff)[_i]), (PG8_LAS unsigned*)(lds + (bufoff) + ldsw + _i * 8192), 16, 0, 0); } while (0)
#define PG8_LDA(dst, b, h) do { _Pragma("unroll") for (int m = 0; m < 4; ++m) _Pragma("unroll") for (int k = 0; k < 2; ++k) dst[m][k] = *(const PG8_LAS bf16x8*)(lds + PG8_SA(b, h) + aoff + m * 2048 + k * 1024); } while (0)
#define PG8_LDB(dst, b, h) do { _Pragma("unroll") for (int n = 0; n < 2; ++n) _Pragma("unroll") for (int k = 0; k < 2; ++k) dst[n][k] = *(const PG8_LAS bf16x8*)(lds + PG8_SB(b, h) + boff + n * 2048 + k * 1024); } while (0)
#define PG8_MMA(ai, bj, At, Bt) do { __builtin_amdgcn_s_setprio(1); _Pragma("unroll") for (int m = 0; m < 4; ++m) _Pragma("unroll") for (int n = 0; n < 2; ++n) _Pragma("unroll") for (int k = 0; k < 2; ++k) \
        acc[ai][bj][m][n] = __builtin_amdgcn_mfma_f32_16x16x32_bf16(Bt[n][k], At[m][k], acc[ai][bj][m][n], 0, 0, 0); __builtin_amdgcn_s_setprio(0); } while (0)
#define PG8_WAIT_V(n) asm volatile("s_waitcnt vmcnt(" #n ")" ::: "memory")
#define PG8_WAIT_L(n) asm volatile("s_waitcnt lgkmcnt(" #n ")" ::: "memory")
#define PG8_BAR __builtin_amdgcn_s_barrier()
#define PG8_SCHED __builtin_amdgcn_sched_barrier(0)
    Unit cur, nxt; int ui = 0;
    if (!S.next(0, cur)) return;
    f32x4 acc[2][2][4][2];
#pragma unroll
    for (int a = 0; a < 2; ++a)
#pragma unroll
        for (int b = 0; b < 2; ++b)
#pragma unroll
            for (int m = 0; m < 4; ++m)
#pragma unroll
                for (int n = 0; n < 2; ++n) acc[a][b][m][n] = (f32x4){0.f, 0.f, 0.f, 0.f};
    bf16x8 At[4][2], B0[2][2], B1[2][2];
    const char* cA = (const char*)g.A + (size_t)cur.pm * tstepA; const char* cB = (const char*)g.Bt + (size_t)cur.pn * tstepB;
    S.a_ready(cur);
    if constexpr (SP2) {
        PG8_STAGE(PG8_SB(0, 0), cB, voffB); PG8_STAGE(PG8_SB(0, 1), cB + hstepB, voffB); PG8_STAGE(PG8_SA(0, 0), cA, voffA); PG8_STAGE(PG8_SA(0, 1), cA + hstepA, voffA);
        if (wr == 1) PG8_BAR;
        PG8_WAIT_V(2); PG8_BAR;
        PG8_STAGE(PG8_SB(1, 0), cB + kstep, voffB); PG8_STAGE(PG8_SA(1, 0), cA + kstep, voffA); PG8_STAGE(PG8_SB(1, 1), cB + hstepB + kstep, voffB);
        PG8_WAIT_V(6); PG8_BAR;
    } else {
        PG8_STAGE(PG8_SB(0, 0), cB, voffB); PG8_STAGE(PG8_SA(0, 0), cA, voffA); PG8_STAGE(PG8_SB(0, 1), cB + hstepB, voffB); PG8_STAGE(PG8_SA(0, 1), cA + hstepA, voffA);
        if (wr == 1) PG8_BAR;
        PG8_WAIT_V(4); PG8_BAR;
        PG8_STAGE(PG8_SB(1, 0), cB + kstep, voffB); PG8_STAGE(PG8_SA(1, 0), cA + kstep, voffA); PG8_STAGE(PG8_SB(1, 1), cB + hstepB + kstep, voffB);
        PG8_WAIT_V(6); PG8_BAR;
    }
    for (;;) {
        const bool has_next = S.next(ui + 1, nxt);
        const char* nA = has_next ? (const char*)g.A + (size_t)nxt.pm * tstepA : cA; const char* nB = has_next ? (const char*)g.Bt + (size_t)nxt.pn * tstepB : cB;
        for (int t = 0; t < nt; t += 2) {
            const bool last = (t == nt - 2);
            const char* a1 = cA + (size_t)(t + 1) * kstep;
            const char* a2 = last ? nA : cA + (size_t)(t + 2) * kstep; const char* b2 = last ? nB : cB + (size_t)(t + 2) * kstep;
            const char* a3 = a2 + kstep; const char* b3 = b2 + kstep;
            if (last && has_next) S.a_ready(nxt);
            if constexpr (SP2) {
            PG8_LDB(B0, 0, 0); PG8_LDB(B1, 0, 1); PG8_SCHED; PG8_LDA(At, 0, 0); PG8_STAGE(PG8_SA(1, 1), a1 + hstepA, voffA);
            PG8_WAIT_V(8); PG8_WAIT_L(0); PG8_BAR; PG8_MMA(0, 0, At, B0); PG8_MMA(0, 1, At, B1); PG8_BAR; PG8_SCHED;
            PG8_LDA(At, 0, 1); PG8_STAGE(PG8_SB(0, 0), b2, voffB); PG8_STAGE(PG8_SB(0, 1), b2 + hstepB, voffB); PG8_STAGE(PG8_SA(0, 0), a2, voffA);
            PG8_WAIT_V(8); PG8_WAIT_L(0); PG8_BAR; PG8_MMA(1, 0, At, B0); PG8_MMA(1, 1, At, B1); PG8_BAR; PG8_SCHED;
            PG8_LDB(B0, 1, 0); PG8_LDB(B1, 1, 1); PG8_SCHED; PG8_LDA(At, 1, 0); PG8_STAGE(PG8_SA(0, 1), a2 + hstepA, voffA);
            PG8_WAIT_V(8); PG8_WAIT_L(0); PG8_BAR; PG8_MMA(0, 0, At, B0); PG8_MMA(0, 1, At, B1); PG8_BAR; PG8_SCHED;
            PG8_LDA(At, 1, 1); PG8_STAGE(PG8_SB(1, 0), b3, voffB); PG8_STAGE(PG8_SB(1, 1), b3 + hstepB, voffB); PG8_STAGE(PG8_SA(1, 0), a3, voffA);
            PG8_WAIT_V(8); PG8_WAIT_L(0); PG8_BAR; PG8_MMA(1, 0, At, B0); PG8_MMA(1, 1, At, B1); PG8_BAR; PG8_SCHED;
            } else {
            PG8_LDB(B0, 0, 0); PG8_SCHED; PG8_LDA(At, 0, 0); PG8_STAGE(PG8_SA(1, 1), a1 + hstepA, voffA);
            PG8_WAIT_L(8); PG8_BAR; PG8_WAIT_L(0); PG8_MMA(0, 0, At, B0); PG8_BAR; PG8_SCHED;
            PG8_LDB(B1, 0, 1); PG8_STAGE(PG8_SB(0, 0), b2, voffB);
            PG8_BAR; PG8_WAIT_L(0); PG8_MMA(0, 1, At, B1); PG8_BAR;
            PG8_LDA(At, 0, 1); PG8_STAGE(PG8_SA(0, 0), a2, voffA);
            PG8_BAR; PG8_WAIT_L(0); PG8_MMA(1, 0, At, B0); PG8_BAR; PG8_SCHED;
            PG8_STAGE(PG8_SB(0, 1), b2 + hstepB, voffB);
            PG8_WAIT_V(6); PG8_BAR; PG8_MMA(1, 1, At, B1); PG8_BAR;
            PG8_LDB(B0, 1, 0); PG8_SCHED; PG8_LDA(At, 1, 0); PG8_STAGE(PG8_SA(0, 1), a2 + hstepA, voffA);
            PG8_WAIT_L(8); PG8_BAR; PG8_WAIT_L(0); PG8_MMA(0, 0, At, B0); PG8_BAR; PG8_SCHED;
            PG8_LDB(B1, 1, 1); PG8_STAGE(PG8_SB(1, 0), b3, voffB);
            PG8_BAR; PG8_WAIT_L(0); PG8_MMA(0, 1, At, B1); PG8_BAR;
            PG8_LDA(At, 1, 1); PG8_STAGE(PG8_SA(1, 0), a3, voffA);
            PG8_BAR; PG8_WAIT_L(0); PG8_MMA(1, 0, At, B0); PG8_BAR; PG8_SCHED;
            PG8_STAGE(PG8_SB(1, 1), b3 + hstepB, voffB);
            PG8_WAIT_V(6); PG8_BAR; PG8_MMA(1, 1, At, B1); PG8_BAR;
            }
        }
        if constexpr (ALIGN_EPI) { if (wr == 0) PG8_BAR; }
        if constexpr (!Epi::AFTER_DRAIN) { E(acc, cur, wr, wc, fr, fq); S.done(cur); }
        if (!has_next) break;
#pragma unroll
        for (int a = 0; a < 2; ++a)
#pragma unroll
            for (int b = 0; b < 2; ++b)
#pragma unroll
                for (int m = 0; m < 4; ++m)
#pragma unroll
                    for (int n = 0; n < 2; ++n) acc[a][b][m][n] = (f32x4){0.f, 0.f, 0.f, 0.f};
        cur = nxt; cA = nA; cB = nB; ++ui;
        if constexpr (ALIGN_EPI) { if (wr == 1) PG8_BAR; }
    }
    PG8_WAIT_V(0);
    if constexpr (!ALIGN_EPI) { if (wr == 0) PG8_BAR; }
    PG8_BAR;
    if constexpr (Epi::AFTER_DRAIN) { E.fused(acc, cur, wr, wc, fr, fq, lds, wid, lane); S.done(cur); }
#undef PG8_SA
#undef PG8_SB
#undef PG8_STAGE
#undef PG8_LDA
#undef PG8_LDB
#undef PG8_MMA
#undef PG8_WAIT_V
#undef PG8_WAIT_L
#undef PG8_BAR
#undef PG8_SCHED
}
}
#ifdef __HIPCC__
#define HD __host__ __device__ __forceinline__
#define UNR _Pragma("unroll")
typedef unsigned short act_t;
HD float ldf(act_t v) { unsigned u = ((unsigned)v) << 16; float f; __builtin_memcpy(&f, &u, 4); return f; }
HD act_t stf(float f) { unsigned u; __builtin_memcpy(&u, &f, 4); u = (u + 0x7fffu + ((u >> 16) & 1u)) >> 16; return (act_t)u; }
#else
#define HD inline
#define UNR
typedef float act_t;
HD float ldf(act_t v) { return v; }
HD act_t stf(float f) { return f; }
#endif

struct Dims {
    int D, B, S, DB, N, PAST, GW;
    int NAH, NAD;
    int LW, LB, LBK;
    int MH, MQR, MKR, MNOPE, MROPE, MV, MQK, MDN  ;
    int SH, SKVH, SD, SWIN;
    int DFF;
    int RC, R, RK  ;
};
HD int cond_of(const Dims& d, int row) { return row < d.RC ? 0 : 1 + (row - d.RC) / d.N; }
HD float silu_f(float x) { return x / (1.f + expf(-x)); }
HD float sigm_f(float x) { return 1.f / (1.f + expf(-x)); }
HD float gelu_f(float x) { const float u = 0.7978845608028654f * (x + 0.044715f * x * x * x); return x / (1.f + expf(-2.f * u)); }

struct OpTranspose { const float* W; act_t* Wt; long K, N, NP, perm, DFF;
    HD void run(long g) const { const int n = (int)(g / K), k = (int)(g % K); float v = 0.f;
        if (n < N) { int sc = n; if (perm == 1) { const int un = n / 256, j = n % 256; sc = j < 128 ? un * 128 + j : DFF + un * 128 + (j - 128); } v = W[(size_t)k * N + sc]; }
        Wt[(size_t)n * K + k] = stf(v); } };
struct OpCvt { const float* src; act_t* dst; HD void run(long g) const { dst[g] = stf(src[g]); } };
struct OpMod { const float* c; const float* cctx; const float* w; const float* b; float* MOD; long D, NCI;
    HD void run(long g) const { const int N6 = 6 * D; const int n = (int)(g % N6); const int ci = (int)((g / N6) % NCI); const int l = (int)(g / ((long)N6 * NCI));
        const float* cond = ci == 0 ? cctx : c + (size_t)(ci - 1) * D; const float* wl = w + (size_t)l * D * N6; float acc = b[(size_t)l * N6 + n];
        for (int k = 0; k < D; ++k) acc += silu_f(cond[k]) * wl[(size_t)k * N6 + n];
        MOD[g] = acc; } };
struct OpNormMod { const float* xc; const float* xl;   const float* g; const float* mod;   long chunk;   act_t* H; Dims d;
    HD void run(long row) const { const int D = d.D; const float* x = row < d.RC ? xc + (size_t)row * D : xl + (size_t)(row - d.RC) * D;
        float ss = 0.f; for (int k = 0; k < D; ++k) ss += x[k] * x[k];
        const float rstd = 1.f / sqrtf(ss / D + 1e-6f); const float* m = mod + (size_t)cond_of(d, (int)row) * 6 * D + (size_t)chunk * D;
        for (int k = 0; k < D; ++k) H[(size_t)row * D + k] = stf(x[k] * rstd * g[k] * (1.f + m[D + k]) + m[k]); } };
struct OpResid { const float* xc; const float* xl; const float* T; const float* mod; long chunk; float* out; Dims d;
    HD void run(long g) const { const int D = d.D; const int row = (int)(g / D), c = (int)(g % D);
        const float x = row < d.RC ? xc[(size_t)row * D + c] : xl[(size_t)(row - d.RC) * D + c];
        out[g] = x + mod[(size_t)cond_of(d, row) * 6 * D + (size_t)chunk * D + c] * T[g]; } };
struct OpRope { float* cs; float* sn; long rot, GW;
    HD void run(long g) const { const int t = (int)(g / rot), li = (int)(g % rot); const int half = rot / 2, nf = half / 2; const int f = li % nf;
        const float pos = (li < half) ? (float)(t / GW) : (float)(t % GW);
        const float inv = exp2f(-(float)(2 * f) / (float)half * 13.287712379549449f); const float a = pos * inv;
        const float rev = a * 0.15915494309189535f; const float fr = rev - floorf(rev);
#ifdef __HIP_DEVICE_COMPILE__
        cs[g] = __builtin_amdgcn_cosf(fr); sn[g] = __builtin_amdgcn_sinf(fr);
#else
        cs[g] = cosf(fr * 6.283185307179586f); sn[g] = sinf(fr * 6.283185307179586f);
#endif
    } };
struct OpHeadPost { const act_t* sa; long pa; long sha, na; const act_t* sb; long pb; long shb, nb; const float* gain; act_t* dst; long pd; long shd; long NH; long rot; const float* cs; const float* sn; float* of; long norm; Dims d; long rows_lat_end;
    HD void run(long g) const { const int row = (int)(g / NH), h = (int)(g % NH); const int dh = na + nb;
        const act_t* pA = sa + (size_t)row * pa + (size_t)h * sha; const act_t* pB = sb ? sb + (size_t)row * pb + (size_t)h * shb : nullptr;
        float ss = 0.f; for (int k = 0; k < dh; ++k) { const float v = k < na ? ldf(pA[k]) : ldf(pB[k - na]); ss += v * v; }
        const float rstd = norm ? 1.f / sqrtf(ss / dh + 1e-6f) : 1.f;
        act_t* o = dst + (size_t)row * pd + (size_t)h * shd;
        const bool lat = rot > 0 && row >= d.RC && row < rows_lat_end; const int t = lat ? (row - d.RC) % d.N : 0; const int r0 = dh - rot, half = rot / 2, q4 = rot / 4;
        float* ofp = (of && row < d.RC) ? of + ((size_t)((row / d.S) * NH + h) * d.S + (row % d.S)) * dh : nullptr;
        for (int k = 0; k < dh; ++k) { float v = (k < na ? ldf(pA[k]) : ldf(pB[k - na])) * rstd * (norm ? gain[k] : 1.f);
            if (lat && k >= r0) { const int li = k - r0; const int w = li % half; if (w >= q4) continue;
                const int k2 = k + q4; const float v2 = (k2 < na ? ldf(pA[k2]) : ldf(pB[k2 - na])) * rstd * (norm ? gain[k2] : 1.f);
                const size_t tb = (size_t)t * rot + li;
                o[k] = stf(v * cs[tb] - v2 * sn[tb]); o[k2] = stf(v2 * cs[tb + q4] + v * sn[tb + q4]); continue; }
            if (ofp) ofp[k] = v;
            o[k] = stf(v); } } };

template <int DQK, int DV> struct OSM { float q[DQK]; float o[DV]; float m, l, scale;
    HD void init(const act_t* qp, float sc) { UNR for (int i = 0; i < DQK; ++i) q[i] = ldf(qp[i]); UNR for (int i = 0; i < DV; ++i) o[i] = 0.f; m = -1e30f; l = 0.f; scale = sc; }
    HD void key(const act_t* kp, const act_t* vp, float bias) { float s = 0.f; UNR for (int i = 0; i < DQK; ++i) s += q[i] * ldf(kp[i]); s = s * scale + bias;
        const float mn = s > m ? s : m; const float a = expf(m - mn), p = expf(s - mn); l = l * a + p; UNR for (int i = 0; i < DV; ++i) o[i] = o[i] * a + p * ldf(vp[i]); m = mn; }
    HD void sink(float sk) { const float mn = sk > m ? sk : m; const float a = expf(m - mn); l = l * a + expf(sk - mn); UNR for (int i = 0; i < DV; ++i) o[i] *= a; m = mn; }
    HD void fin(act_t* op) { const float r = 1.f / l; UNR for (int i = 0; i < DV; ++i) op[i] = stf(o[i] * r); } };

template <int DQK, int DV> struct OpAttnCtx { const act_t* Q; long pq; long shq; const act_t* K; long pk; long shk; const act_t* V; long pv; long shv; act_t* O; long po; long sho; long NH, G; const float* sinks; Dims d;
    HD void run(long g) const { const int t = (int)(g % d.S); const int h = (int)((g / d.S) % NH); const int b = (int)(g / ((long)d.S * NH)); const int kvh = h / G;
        OSM<DQK, DV> st; st.init(Q + (size_t)(b * d.S + t) * pq + (size_t)h * shq, 1.f / sqrtf((float)DQK));
        for (int j = 0; j < d.S; ++j) { const size_t r = (size_t)(b * d.S + j); st.key(K + r * pk + (size_t)kvh * shk, V + r * pv + (size_t)kvh * shv, 0.f); }
        if (sinks) st.sink(sinks[h]);
        st.fin(O + (size_t)(b * d.S + t) * po + (size_t)h * sho); } };
template <int DH> struct OpNatLat { const act_t* QKV; long pq; const act_t* CK; const act_t* CV; const float* rpb; act_t* O; long po; Dims d;
    HD void run(long g) const { const int t = (int)(g % d.N); const int h = (int)((g / d.N) % d.NAH); const int b = (int)(g / ((long)d.N * d.NAH));
        const int GW = d.GW, rows = d.N / GW; const int wr = rows < 8 ? rows : 8; const int r = t / GW, c = t % GW;
        int rs = r - wr / 2; rs = rs < 0 ? 0 : (rs > rows - wr ? rows - wr : rs); int cst = c - 8; cst = cst < 0 ? 0 : (cst > GW - 16 ? GW - 16 : cst);
        const size_t rb = (size_t)d.RC + (size_t)b * d.N; const int HD_ = d.NAH * DH;
        OSM<DH, DH> st; st.init(QKV + (rb + t) * pq + (size_t)h * DH, 1.f / sqrtf((float)DH));
        for (int j = 0; j < d.PAST; ++j) { const size_t o = ((size_t)(b * d.NAH + h) * d.PAST + j) * DH; st.key(CK + o, CV + o, 0.f); }
        for (int kr = rs; kr < rs + wr; ++kr) for (int kc = cst; kc < cst + 16; ++kc) { const size_t kt = rb + (size_t)kr * GW + kc;
            const float bias = rpb[((size_t)h * 15 + (kr - r + 7)) * 31 + (kc - c + 15)];
            st.key(QKV + kt * pq + HD_ + (size_t)h * DH, QKV + kt * pq + 2 * HD_ + (size_t)h * DH, bias); }
        st.fin(O + (rb + t) * po + (size_t)h * DH); } };
template <int DQK, int DV> struct OpMlaLat { const act_t* Q; const act_t* K; const act_t* KV; act_t* O; long po; Dims d;
    HD void run(long g) const { const int t = (int)(g % d.N); const int h = (int)((g / d.N) % d.MH); const int b = (int)(g / ((long)d.N * d.MH));
        const size_t rb = (size_t)d.RC + (size_t)b * d.N; const size_t pq = (size_t)d.MH * DQK, pkv = (size_t)d.MH * (d.MNOPE + DV);
        OSM<DQK, DV> st; st.init(Q + (rb + t) * pq + (size_t)h * DQK, 1.f / sqrtf((float)DQK));
        for (int j = 0; j < d.PAST; ++j) { const size_t r = (size_t)d.R + (size_t)b * d.PAST + j; st.key(K + r * pq + (size_t)h * DQK, KV + r * pkv + (size_t)h * (d.MNOPE + DV) + d.MNOPE, 0.f); }
        for (int j = 0; j < d.N; ++j) { const size_t r = rb + j; st.key(K + r * pq + (size_t)h * DQK, KV + r * pkv + (size_t)h * (d.MNOPE + DV) + d.MNOPE, 0.f); }
        st.fin(O + (rb + t) * po + (size_t)h * DV); } };
template <int DH> struct OpSwaLat { const act_t* QKV; long pq; const act_t* CK; const act_t* CV; const float* sinks; act_t* O; long po; Dims d;
    HD void run(long g) const { const int t = (int)(g % d.N); const int h = (int)((g / d.N) % d.SH); const int b = (int)(g / ((long)d.N * d.SH)); const int G = d.SH / d.SKVH, kvh = h / G;
        const size_t rb = (size_t)d.RC + (size_t)b * d.N;
        OSM<DH, DH> st; st.init(QKV + (rb + t) * pq + (size_t)h * DH, 1.f / sqrtf((float)DH));
        for (int j = 0; j < d.PAST; ++j) { const size_t o = ((size_t)(b * d.SKVH + kvh) * d.PAST + j) * DH; st.key(CK + o, CV + o, 0.f); }
        int lo = t - d.SWIN, hi = t + d.SWIN; lo = lo < 0 ? 0 : lo; hi = hi > d.N - 1 ? d.N - 1 : hi;
        for (int j = lo; j <= hi; ++j) { const size_t r = rb + j; st.key(QKV + r * pq + (size_t)(d.SH + kvh) * DH, QKV + r * pq + (size_t)(d.SH + d.SKVH + kvh) * DH, 0.f); }
        st.sink(sinks[h]);
        st.fin(O + (rb + t) * po + (size_t)h * DH); } };

struct OpLruConv { const act_t* XG; const float* cw; const float* cb; act_t* XC; Dims d;
    HD void run(long g) const { const int LW = d.LW; const int row = (int)(g / LW), c = (int)(g % LW);
        int s0, T; if (row < d.RC) { s0 = (row / d.S) * d.S; T = d.S; } else { s0 = d.RC + ((row - d.RC) / d.N) * d.N; T = d.N; } const int t = row - s0;
        float acc = cb[c]; for (int k = 0; k < 4; ++k) { const int tt = t + k - 2; if (tt >= 0 && tt < T) acc += cw[(size_t)k * LW + c] * ldf(XG[(size_t)(s0 + tt) * 2 * LW + c]); }
        XC[g] = stf(acc); } };
struct OpLruScan { const act_t* XC; const act_t* XG; const float* wa; const float* ba; const float* wi; const float* bi; const float* lam; const float* h0; act_t* HS; act_t* Y; float* state_out; Dims d;
    HD void step(int dir, size_t row, int c, int blk, int j, float sp, float& h) const { const int LW = d.LW, LBK = d.LBK;
        const act_t* xr = XC + row * LW + (size_t)blk * LBK; const float* Wa = wa + ((size_t)(dir * d.LB + blk) * LBK) * LBK + j; const float* Wi = wi + ((size_t)(dir * d.LB + blk) * LBK) * LBK + j;
        float ra = ba[(size_t)dir * LW + c], ri = bi[(size_t)dir * LW + c];
        for (int k = 0; k < LBK; ++k) { const float x = ldf(xr[k]); ra += x * Wa[(size_t)k * LBK]; ri += x * Wi[(size_t)k * LBK]; }
        const float r = sigm_f(ra), ig = sigm_f(ri); const float la = -8.f * r * sp; const float a = expf(la); const float om = -expm1f(2.f * la);
        h = a * h + sqrtf(om) * (ig * ldf(XC[row * LW + c])); }
    HD void run(long g) const { const int LW = d.LW; const int seq = (int)(g / LW), c = (int)(g % LW); const int blk = c / d.LBK, j = c % d.LBK;
        size_t s0; int T; float hf = 0.f, hb = 0.f;
        if (seq < d.B) { s0 = (size_t)seq * d.S; T = d.S; } else { const int b = seq - d.B; s0 = (size_t)d.RC + (size_t)b * d.N; T = d.N; hf = h0[((size_t)b * 2 + 0) * LW + c]; hb = h0[((size_t)b * 2 + 1) * LW + c]; }
        float spf, spb; { const float l0 = lam[c], l1 = lam[LW + c]; spf = log1pf(expf(-l0)); spb = log1pf(expf(-l1)); }
        for (int t = 0; t < T; ++t) { step(0, s0 + t, c, blk, j, spf, hf); HS[(s0 + t) * LW + c] = stf(hf); }
        for (int t = T - 1; t >= 0; --t) { step(1, s0 + t, c, blk, j, spb, hb); const size_t row = s0 + t; Y[row * LW + c] = stf(gelu_f(ldf(XG[row * 2 * LW + LW + c])) * (ldf(HS[row * LW + c]) + hb)); }
        if (seq < d.B) { state_out[((size_t)seq * 2 + 0) * LW + c] = hf; state_out[((size_t)seq * 2 + 1) * LW + c] = hb; } } };

struct OpMlaNorm { act_t* Dn; act_t* KR; const float* gqa; const float* gkva; const float* cckv; const float* ckr; float* o_ckv; float* o_kr; Dims d;
    HD void run(long row) const { act_t* p = Dn + (size_t)row * d.MDN; act_t* kr = KR + (size_t)row * d.MROPE;
        if (row >= d.R) { const size_t j = (size_t)(row - d.R); for (int k = 0; k < d.MKR; ++k) p[d.MQR + k] = stf(cckv[j * d.MKR + k]); for (int k = 0; k < d.MROPE; ++k) kr[k] = stf(ckr[j * d.MROPE + k]); return; }
        float ss = 0.f; for (int k = 0; k < d.MQR; ++k) { const float v = ldf(p[k]); ss += v * v; } float rs = 1.f / sqrtf(ss / d.MQR + 1e-6f);
        for (int k = 0; k < d.MQR; ++k) p[k] = stf(ldf(p[k]) * rs * gqa[k]);
        ss = 0.f; for (int k = 0; k < d.MKR; ++k) { const float v = ldf(p[d.MQR + k]); ss += v * v; } rs = 1.f / sqrtf(ss / d.MKR + 1e-6f);
        for (int k = 0; k < d.MKR; ++k) { const float v = ldf(p[d.MQR + k]) * rs * gkva[k]; p[d.MQR + k] = stf(v); if (row < d.RC) o_ckv[(size_t)row * d.MKR + k] = v; }
        for (int k = 0; k < d.MROPE; ++k) { const act_t v = p[d.MQR + d.MKR + k]; kr[k] = v; if (row < d.RC) o_kr[(size_t)row * d.MROPE + k] = ldf(v); } } };

struct OpFfnAct { const act_t* U; const float* cw; const float* cb; act_t* G; long row0; long nrows; Dims d;
    HD void run(long g) const { const int F = d.DFF; const int lr = (int)(g / F), c = (int)(g % F); const int row = row0 + lr;
        int s0, T; if (row < d.RC) { s0 = (row / d.S) * d.S; T = d.S; } else { s0 = d.RC + ((row - d.RC) / d.N) * d.N; T = d.N; } const int t = row - s0;
        float acc = cb[c]; for (int k = 0; k < 3; ++k) { const int tt = t + k - 1; if (tt >= 0 && tt < T) acc += cw[(size_t)k * F + c] * ldf(U[(size_t)(s0 + tt - row0) * 2 * F + c]); }
        G[(size_t)lr * F + c] = stf(silu_f(acc) * ldf(U[(size_t)lr * 2 * F + F + c])); } };
struct OpCopyV { const act_t* src; long ps; long sh; long NH, dh; float* of; Dims d;
    HD void run(long g) const { const int k = (int)(g % dh); const int h = (int)((g / dh) % NH); const int row = (int)(g / ((long)dh * NH));
        of[((size_t)((row / d.S) * NH + h) * d.S + (row % d.S)) * dh + k] = ldf(src[(size_t)row * ps + (size_t)h * sh + k]); } };

struct WS {
    float* MOD; float* ropeC; float* ropeS;
    act_t *Wffn_in[4], *Wffn_out[4], *Wnat_qkv, *Wnat_o, *Wlru_in, *Wlru_out, *Wmla_down, *Wmla_uq, *Wmla_ukv, *Wmla_o, *Wswa_qkv, *Wswa_o;
    act_t *natCK, *natCV, *swaCK, *swaCV;
    act_t* H;
    act_t* OB;
    float* T_mix[4]; float* T_ffn;
    act_t* QKV;
    act_t *XG, *XC, *HS, *Y;
    act_t *Dn, *KR, *Q, *KVr, *K;
    act_t *U, *G;
    int ffn_chunk_rows;
};
enum { I_xp = 0, I_xs, I_cnk, I_cnv, I_slru, I_cckv, I_ckr, I_csk, I_csv, I_c, I_cctx, I_nmix, I_nffn, I_wmod, I_bmod, I_fwin, I_fcw, I_fcb, I_fwout,
       I_nwqkv, I_nqn, I_nkn, I_nrpb, I_nwo, I_lwin, I_lcw, I_lcb, I_lwa, I_lba, I_lwi, I_lbi, I_llam, I_lwout, I_mwd, I_mqan, I_mkvan, I_mwuq, I_mwukv, I_mqn, I_mkn, I_mwo,
       I_swqkv, I_sqn, I_skn, I_ssink, I_swo, N_IN };
struct OutPtrs { float *yp, *ys, *nat_k, *nat_v, *lru, *ckv, *krope, *swa_k, *swa_v; };

#define LAS __attribute__((address_space(3)))
namespace mk {
typedef unsigned short bf16;
typedef short bf16x8 __attribute__((ext_vector_type(8)));
typedef short s16x4 __attribute__((ext_vector_type(4)));
typedef float f32x4 __attribute__((ext_vector_type(4)));
typedef float f32x16 __attribute__((ext_vector_type(16)));
typedef unsigned u32x4 __attribute__((ext_vector_type(4)));
typedef unsigned u32x2 __attribute__((ext_vector_type(2)));
constexpr int D = 2048, RC = 4096, NLAT = 4096, R = 36864, RK = 38912, DFF = 5632, NCI = 9, N6 = 12288, LW = 2688, LBK = 168;
constexpr int NQ = 2048, MDN = 1536, MQW = 3072, MKVW = 4096, SQW = 2560;
constexpr float LOG2E = 1.4426950408889634f;
constexpr size_t MiB = 1u << 20;
constexpr size_t WS_CTL = 0, WS_MOD = 1, WS_ROPEC = 3, WS_ROPES = 4, WS_NATCK = 5, WS_NATCV = 13, WS_SWACK = 21, WS_SWACV = 22, WS_WG = 1490, WS_WFFN = 26, WS_WNQKV = 290, WS_WNO = 314, WS_WLIN = 322, WS_WLOUT = 344,
    WS_WMD = 355, WS_WMUQ = 361, WS_WMUKV = 366, WS_WMO = 370, WS_WSQKV = 378, WS_WSO = 388, WS_H = 396, WS_S = 540;
constexpr size_t WS_QKV = 540, WS_XG = 540, WS_AGG = 918, WS_CARRY = 944, WS_Y = 1296, WS_DN = 540, WS_KR = 654, WS_Q = 659, WS_KVR = 875, WS_K = 1179, WS_G = 540, WS_SIDE = 936;
constexpr int CW_BAR = 4096;
constexpr int EPI_OFF = 131072, LDSCTL_OFF = 131072 + 12288, MISC_OFF = LDSCTL_OFF + 320, LDS_BYTES = 147456;

struct Fr { LAS unsigned char* lds; int tid, lane, wave, G, bid; };
__device__ __forceinline__ unsigned f2bf(float f) { unsigned u = __builtin_bit_cast(unsigned, f); return (u + 0x7fffu + ((u >> 16) & 1u)) >> 16; }
__device__ __forceinline__ unsigned pk2(float lo, float hi) { unsigned r; asm volatile("v_cvt_pk_bf16_f32 %0, %1, %2" : "=v"(r) : "v"(lo), "v"(hi)); return r; }
__device__ __forceinline__ float bf2f(unsigned short v) { return __builtin_bit_cast(float, ((unsigned)v) << 16); }
__device__ __forceinline__ float bflo(unsigned w) { return __builtin_bit_cast(float, w << 16); }
__device__ __forceinline__ float bfhi(unsigned w) { return __builtin_bit_cast(float, w & 0xffff0000u); }
__device__ __forceinline__ float wave_sum(float v) {
#pragma unroll
    for (int o = 1; o < 64; o <<= 1) v += __shfl_xor(v, o);
    return v; }
__device__ __forceinline__ float fexp2(float x) { return __builtin_amdgcn_exp2f(x); }
__device__ __forceinline__ float frcp(float x) { return __builtin_amdgcn_rcpf(x); }
__device__ __forceinline__ float sigm(float x) { return frcp(1.f + fexp2(-x * LOG2E)); }
__device__ __forceinline__ float siluf(float x) { return x * sigm(x); }
__device__ __forceinline__ float geluf(float x) { const float u = 0.7978845608028654f * (x + 0.044715f * x * x * x); return x * sigm(2.f * u); }
__device__ __forceinline__ void unpack8(const bf16x8& v, float (&f)[8]) { const u32x4 w = __builtin_bit_cast(u32x4, v);
    f[0] = bflo(w.x); f[1] = bfhi(w.x); f[2] = bflo(w.y); f[3] = bfhi(w.y); f[4] = bflo(w.z); f[5] = bfhi(w.z); f[6] = bflo(w.w); f[7] = bfhi(w.w); }
__device__ __forceinline__ bf16x8 pack8(const float (&f)[8]) { u32x4 w; w.x = pk2(f[0], f[1]); w.y = pk2(f[2], f[3]); w.z = pk2(f[4], f[5]); w.w = pk2(f[6], f[7]); return __builtin_bit_cast(bf16x8, w); }

#define XB_TMO      128
#define XB_XCNT(j)  (256  + 64 * (j))
#define XB_XSUB(j)  (1280 + 64 * (j))
#define XB_XGEN(j)  (2304 + 64 * (j))
#define XB_TOP      3328
#define XB_TOPGEN   3392
#define XCD_BAR_WORDS 3456
#define XB_SPIN_CAP (1u << 22)
__device__ __forceinline__ unsigned xb_ld(unsigned* p)              { return __hip_atomic_load(p, __ATOMIC_RELAXED, __HIP_MEMORY_SCOPE_AGENT); }
__device__ __forceinline__ unsigned xb_add(unsigned* p, unsigned v) { return __hip_atomic_fetch_add(p, v, __ATOMIC_RELAXED, __HIP_MEMORY_SCOPE_AGENT); }
__device__ __forceinline__ unsigned xb_xcc_id() { return (unsigned)__builtin_amdgcn_s_getreg((3 << 11) | 20) & 0xFu; }
#define XB_SPIN(cond, bar) do { unsigned _sp = 0; while (cond) { __builtin_amdgcn_s_sleep(1); \
    if ((++_sp & 255u) == 0u) { if (xb_ld(&(bar)[XB_TMO])) break; if (_sp > XB_SPIN_CAP) { atomicAdd(&(bar)[XB_TMO], 1u); break; } } } } while (0)
struct XcdBarrier { unsigned* bar; unsigned x; volatile LAS unsigned* st; };
__device__ __forceinline__ XcdBarrier xcd_barrier_post(unsigned* bar, volatile LAS unsigned* st) {
    XcdBarrier b; b.bar = bar; b.x = xb_xcc_id(); b.st = st;
    if (threadIdx.x == 0) (void)xb_add(&bar[XB_XCNT(b.x)], 1u);
    return b;
}
__device__ __forceinline__ void xcd_barrier_complete(unsigned* bar, unsigned x, unsigned& nloc, unsigned& nx) {
    const unsigned G = gridDim.x * gridDim.y * gridDim.z;
    unsigned sum, cnt, mine, sp = 0u;
    for (;;) {
        sum = 0u; cnt = 0u; mine = 0u;
#pragma unroll
        for (unsigned j = 0; j < 16; ++j) { const unsigned c = xb_ld(&bar[XB_XCNT(j)]); sum += c; cnt += (c > 0u) ? 1u : 0u; mine = (j == x) ? c : mine; }
        if (sum == G) break;
        __builtin_amdgcn_s_sleep(1);
        if ((++sp & 255u) == 0u) { if (xb_ld(&bar[XB_TMO])) break; if (sp > XB_SPIN_CAP) { atomicAdd(&bar[XB_TMO], 1u); break; } }
    }
    nloc = mine > 0u ? mine : 1u; nx = cnt > 0u ? cnt : 1u;
}
__device__ __forceinline__ void xcd_barrier(const XcdBarrier& b) {
    asm volatile("s_waitcnt vmcnt(0)" ::: "memory");
    __syncthreads();
    if (threadIdx.x == 0) {
        unsigned* bar = b.bar;
        __builtin_amdgcn_s_waitcnt(0);
        unsigned nloc = b.st[0], nx = b.st[1];
        if (nloc == 0u) { xcd_barrier_complete(bar, b.x, nloc, nx); b.st[0] = nloc; b.st[1] = nx; }
        const unsigned old = xb_add(&bar[XB_XSUB(b.x)], 1u);
        const unsigned gen = old / nloc;
        if (old + 1u == (gen + 1u) * nloc) {
            __builtin_amdgcn_fence(__ATOMIC_RELEASE, "agent");
            asm volatile("s_waitcnt vmcnt(0)" ::: "memory");
            const unsigned og = xb_add(&bar[XB_TOP], 1u);
            const unsigned tg = og / nx;
            if (og + 1u == (tg + 1u) * nx) xb_add(&bar[XB_TOPGEN], 1u);
            else XB_SPIN(xb_ld(&bar[XB_TOPGEN]) == tg, bar);
            __builtin_amdgcn_fence(__ATOMIC_ACQUIRE, "agent");
            xb_add(&bar[XB_XGEN(b.x)], 1u);
            asm volatile("s_waitcnt vmcnt(0)" ::: "memory");
        } else {
            XB_SPIN(xb_ld(&bar[XB_XGEN(b.x)]) == gen, bar);
            __builtin_amdgcn_fence(__ATOMIC_ACQUIRE, "agent");
            asm volatile("s_waitcnt vmcnt(0)" ::: "memory");
        }
    }
    __syncthreads();
}

__device__ __forceinline__ void tr_item(const float* W, int N, int k0, int n0, bf16* WT, int Kd, int drow0, LAS float* scr, int lane) {
#pragma unroll 8
    for (int i = 0; i < 32; ++i) { const int kk = 2 * i + (lane >> 5); scr[kk * 33 + (lane & 31)] = __builtin_nontemporal_load(&W[(size_t)(k0 + kk) * N + n0 + (lane & 31)]); }
    asm volatile("s_waitcnt lgkmcnt(0)" ::: "memory");
    const int c = lane & 7;
#pragma unroll
    for (int j = 0; j < 4; ++j) { const int n = (lane >> 3) + 8 * j; const LAS float* s = scr + (8 * c) * 33 + n;
        u32x4 o; o.x = pk2(s[0 * 33], s[1 * 33]); o.y = pk2(s[2 * 33], s[3 * 33]); o.z = pk2(s[4 * 33], s[5 * 33]); o.w = pk2(s[6 * 33], s[7 * 33]);
        *(u32x4*)(WT + (size_t)(drow0 + n) * Kd + k0 + 8 * c) = o; }
    asm volatile("s_waitcnt lgkmcnt(0)" ::: "memory");
}
__device__ __forceinline__ void tr_job(const Fr& F, const float* W, int K, int N, bf16* WT, int perm) {
    LAS float* scr = (LAS float*)(F.lds + F.wave * 16384);
    const int nblk = N / 32, items = (K / 64) * nblk; const int gw = F.bid * 8 + F.wave, NGW = F.G * 8;
    for (int it = gw; it < items; it += NGW) { const int kb = it / nblk, nb = it % nblk, n0 = 32 * nb; int dr = n0;
        if (perm) { const int half = n0 >= DFF; const int c = half ? n0 - DFF : n0; dr = 256 * (c >> 7) + 128 * half + (c & 127); }
        tr_item(W, N, 64 * kb, n0, WT, K, dr, scr, F.lane); }
}
#ifndef DEFER_W
#define DEFER_W 1
#endif
__device__ __forceinline__ void tr_layer(const Fr& F, const float* const* in, unsigned char* ws, int l, int part) {
    if (part == 1) { tr_job(F, in[I_fwin] + (size_t)l * D * 2 * DFF, D, 2 * DFF, (bf16*)(ws + (WS_WFFN + 66 * l) * MiB), 1); tr_job(F, in[I_fwout] + (size_t)l * DFF * D, DFF, D, (bf16*)(ws + (WS_WFFN + 66 * l + 44) * MiB), 0); return; }
    if (l == 0) { tr_job(F, in[I_nwqkv], D, 3 * NQ, (bf16*)(ws + WS_WNQKV * MiB), 0); tr_job(F, in[I_nwo], NQ, D, (bf16*)(ws + WS_WNO * MiB), 0); }
    else if (l == 1) { tr_job(F, in[I_lwin], D, 2 * LW, (bf16*)(ws + WS_WLIN * MiB), 0); tr_job(F, in[I_lwout], LW, D, (bf16*)(ws + WS_WLOUT * MiB), 0); }
    else if (l == 2) { tr_job(F, in[I_mwd], D, 1344, (bf16*)(ws + WS_WMD * MiB), 0); tr_job(F, in[I_mwuq], 768, MQW, (bf16*)(ws + WS_WMUQ * MiB), 0); tr_job(F, in[I_mwukv], 512, MKVW, (bf16*)(ws + WS_WMUKV * MiB), 0); tr_job(F, in[I_mwo], 2048, D, (bf16*)(ws + WS_WMO * MiB), 0);
        unsigned* z = (unsigned*)((bf16*)(ws + WS_WMD * MiB) + (size_t)1344 * D); for (int i = F.bid * 512 + F.tid; i < 192 * D / 2; i += F.G * 512) z[i] = 0u; }
    else { tr_job(F, in[I_swqkv], D, SQW, (bf16*)(ws + WS_WSQKV * MiB), 0); tr_job(F, in[I_swo], 2048, D, (bf16*)(ws + WS_WSO * MiB), 0); }
}
__device__ __forceinline__ void tr_layer_idle(const Fr& F, const float* const* in, unsigned char* ws, int l, int part) {
    const int busy = 1152 % F.G; if (busy == 0 || F.bid < busy) return;
    Fr F2 = F; F2.bid = F.bid - busy; F2.G = F.G - busy; tr_layer(F2, in, ws, l, part);
}
struct ProArgs { const float* const* in; unsigned char* ws; };
__device__ __forceinline__ void ph_prologue(const Fr& F, const float* const* in, unsigned char* ws) {
    const int gt = F.bid * 512 + F.tid, NGT = F.G * 512;
    for (int j = F.bid; j < 256; j += F.G) {
        const int l = j >> 6, n0 = (j & 63) * 192; LAS float* S = (LAS float*)F.lds; LAS float* red = (LAS float*)(F.lds + 73728);
        for (int i = F.tid; i < NCI * D; i += 512) { const int ci = i / D, k = i % D; const float v = ci == 0 ? in[I_cctx][k] : in[I_c][(size_t)(ci - 1) * D + k]; S[i] = siluf(v); }
        __syncthreads();
        float acc[3][NCI];
#pragma unroll
        for (int g = 0; g < 3; ++g)
#pragma unroll
            for (int c = 0; c < NCI; ++c) acc[g][c] = 0.f;
        const float* wl = in[I_wmod] + (size_t)l * D * N6 + n0 + F.lane;
#pragma unroll 4
        for (int k = F.wave * 256; k < F.wave * 256 + 256; ++k) { const float w0 = __builtin_nontemporal_load(&wl[(size_t)k * N6]), w1 = __builtin_nontemporal_load(&wl[(size_t)k * N6 + 64]), w2 = __builtin_nontemporal_load(&wl[(size_t)k * N6 + 128]);
#pragma unroll
            for (int c = 0; c < NCI; ++c) { const float s = S[c * D + k]; acc[0][c] += s * w0; acc[1][c] += s * w1; acc[2][c] += s * w2; } }
#pragma unroll
        for (int g = 0; g < 3; ++g)
#pragma unroll
            for (int c = 0; c < NCI; ++c) red[((F.wave * 3 + g) * NCI + c) * 64 + F.lane] = acc[g][c];
        __syncthreads();
        float* MOD = (float*)(ws + WS_MOD * MiB);
        for (int o = F.tid; o < 192 * NCI; o += 512) { const int ci = o / 192, nl = o % 192, g = nl >> 6, ln = nl & 63; float s = in[I_bmod][(size_t)l * N6 + n0 + nl];
#pragma unroll
            for (int w = 0; w < 8; ++w) s += red[((w * 3 + g) * NCI + ci) * 64 + ln];
            MOD[((size_t)l * NCI + ci) * N6 + n0 + nl] = s; }
        __syncthreads();
    }
    tr_layer(F, in, ws, 0, 0); tr_layer(F, in, ws, 0, 1);
    if (!DEFER_W) for (int l = 1; l < 4; ++l) { tr_layer(F, in, ws, l, 0); tr_layer(F, in, ws, l, 1); }
    { bf16* Wg = (bf16*)(ws + WS_WG * MiB); constexpr int TOT = 2 * 2 * 16 * 192 * 192;
      for (int i0 = gt; i0 < TOT; i0 += 6 * NGT) { float v[6];
#pragma unroll
          for (int u = 0; u < 6; ++u) { const int i = i0 + u * NGT; v[u] = 0.f;
              if (i < TOT) { const int k = i % 192, j = (i / 192) % 192, blk = (i / 36864) % 16, mat = (i / 589824) % 2, dir = i / 1179648;
                  if (j < 168 && k < 168) v[u] = (mat == 0 ? in[I_lwa] : in[I_lwi])[(((size_t)dir * 16 + blk) * 168 + k) * 168 + j]; } }
#pragma unroll
          for (int u = 0; u < 6; ++u) { const int i = i0 + u * NGT; if (i < TOT) Wg[i] = (bf16)f2bf(v[u]); } } }
    { typedef float f4v __attribute__((ext_vector_type(4)));
      bf16* a = (bf16*)(ws + WS_NATCK * MiB); bf16* b = (bf16*)(ws + WS_NATCV * MiB); const f4v* ia = (const f4v*)in[I_cnk]; const f4v* ib = (const f4v*)in[I_cnv];
      for (int i = gt; i < 8 * 16 * 256 * 128 / 8; i += NGT) { const f4v a0 = ia[2 * i], a1 = ia[2 * i + 1], b0 = ib[2 * i], b1 = ib[2 * i + 1];
          const float xa[8] = {a0.x, a0.y, a0.z, a0.w, a1.x, a1.y, a1.z, a1.w}, xb[8] = {b0.x, b0.y, b0.z, b0.w, b1.x, b1.y, b1.z, b1.w};
          *(bf16x8*)(a + 8 * (size_t)i) = pack8(xa); *(bf16x8*)(b + 8 * (size_t)i) = pack8(xb); }
      bf16* c = (bf16*)(ws + WS_SWACK * MiB); bf16* d = (bf16*)(ws + WS_SWACV * MiB); const f4v* ic = (const f4v*)in[I_csk]; const f4v* id = (const f4v*)in[I_csv];
      for (int i = gt; i < 8 * 4 * 256 * 64 / 8; i += NGT) { const f4v a0 = ic[2 * i], a1 = ic[2 * i + 1], b0 = id[2 * i], b1 = id[2 * i + 1];
          const float xa[8] = {a0.x, a0.y, a0.z, a0.w, a1.x, a1.y, a1.z, a1.w}, xb[8] = {b0.x, b0.y, b0.z, b0.w, b1.x, b1.y, b1.z, b1.w};
          *(bf16x8*)(c + 8 * (size_t)i) = pack8(xa); *(bf16x8*)(d + 8 * (size_t)i) = pack8(xb); } }
    { float* cs = (float*)(ws + WS_ROPEC * MiB); float* sn = (float*)(ws + WS_ROPES * MiB);
      for (int i = gt; i < NLAT * 64; i += NGT) { const int t = i >> 6, li = i & 63, f = li & 15; const float pos = li < 32 ? (float)(t >> 6) : (float)(t & 63);
          const float inv = fexp2(-(float)f * 0.8304820237218406f); const float rev = pos * inv * 0.15915494309189535f; const float fr = rev - floorf(rev);
          cs[i] = __builtin_amdgcn_cosf(fr); sn[i] = __builtin_amdgcn_sinf(fr); } }
}

__device__ __forceinline__ void ph_norm(const Fr& F, const float* xc, const float* xl, const float* g, const float* mod, int chunk, bf16* H) {
    const int gw = F.bid * 8 + F.wave, NGW = F.G * 8;
    for (int row0 = gw; row0 < R; row0 += 2 * NGW) {
        const int row1 = row0 + NGW; const bool has1 = row1 < R; const int r1 = has1 ? row1 : row0;
        const float* x0 = (row0 < RC ? xc + (size_t)row0 * D : xl + (size_t)(row0 - RC) * D) + 4 * F.lane; const float* x1 = (r1 < RC ? xc + (size_t)r1 * D : xl + (size_t)(r1 - RC) * D) + 4 * F.lane;
        f32x4 v0[8], v1[8]; float s0 = 0.f, s1 = 0.f;
#pragma unroll
        for (int j = 0; j < 8; ++j) { v0[j] = *(const f32x4*)(x0 + 256 * j); v1[j] = *(const f32x4*)(x1 + 256 * j); }
#pragma unroll
        for (int j = 0; j < 8; ++j) { s0 += (v0[j].x * v0[j].x + v0[j].y * v0[j].y) + (v0[j].z * v0[j].z + v0[j].w * v0[j].w); s1 += (v1[j].x * v1[j].x + v1[j].y * v1[j].y) + (v1[j].z * v1[j].z + v1[j].w * v1[j].w); }
#pragma unroll
        for (int o = 1; o < 64; o <<= 1) { s0 += __shfl_xor(s0, o); s1 += __shfl_xor(s1, o); }
        const float rs0 = 1.f / sqrtf(s0 * (1.f / D) + 1e-6f), rs1 = 1.f / sqrtf(s1 * (1.f / D) + 1e-6f);
        const int c0 = row0 < RC ? 0 : 1 + ((row0 - RC) >> 12), c1 = r1 < RC ? 0 : 1 + ((r1 - RC) >> 12);
        const float* m0 = mod + (size_t)c0 * N6 + (size_t)chunk * D + 4 * F.lane; const float* m1 = mod + (size_t)c1 * N6 + (size_t)chunk * D + 4 * F.lane; const float* gp = g + 4 * F.lane;
        bf16* o0 = H + (size_t)row0 * D + 4 * F.lane; bf16* o1 = H + (size_t)r1 * D + 4 * F.lane;
#pragma unroll
        for (int j = 0; j < 8; ++j) { const f32x4 gv = *(const f32x4*)(gp + 256 * j);
            { const f32x4 sh = *(const f32x4*)(m0 + 256 * j), sc = *(const f32x4*)(m0 + D + 256 * j); const f32x4 h = v0[j] * rs0 * gv * (sc + 1.f) + sh; u32x2 w; w.x = pk2(h.x, h.y); w.y = pk2(h.z, h.w); *(u32x2*)(o0 + 256 * j) = w; }
            if (has1) { const f32x4 sh = *(const f32x4*)(m1 + 256 * j), sc = *(const f32x4*)(m1 + D + 256 * j); const f32x4 h = v1[j] * rs1 * gv * (sc + 1.f) + sh; u32x2 w; w.x = pk2(h.x, h.y); w.y = pk2(h.z, h.w); *(u32x2*)(o1 + 256 * j) = w; } }
    }
}
template <bool F32IN> __device__ __forceinline__ void ph_norm_rows(const Fr& F, const bf16* XB, const float* xc, const float* xl, const float* g, const float* mod, int chunk, bf16* H) {
    const int gw = F.bid * 8 + F.wave, NGW = F.G * 8; const int per = (R + NGW - 1) / NGW; const int rbeg = gw * per, rend = rbeg + per < R ? rbeg + per : R;
    float A[4][8], Bv[4][8]; int ccur = -1;
    for (int row0 = rbeg; row0 < rend; row0 += 2) {
        const int row1 = row0 + 1; const bool has1 = row1 < rend; const int r1 = has1 ? row1 : row0;
        bf16x8 a0[4], a1[4]; f32x4 f0[4][2], f1[4][2];
        if constexpr (F32IN) { const float* x0 = (row0 < RC ? xc + (size_t)row0 * D : xl + (size_t)(row0 - RC) * D) + 8 * F.lane; const float* x1 = (r1 < RC ? xc + (size_t)r1 * D : xl + (size_t)(r1 - RC) * D) + 8 * F.lane;
#pragma unroll
            for (int j = 0; j < 4; ++j) { f0[j][0] = __builtin_nontemporal_load((const f32x4*)(x0 + 512 * j)); f0[j][1] = __builtin_nontemporal_load((const f32x4*)(x0 + 512 * j + 4)); f1[j][0] = __builtin_nontemporal_load((const f32x4*)(x1 + 512 * j)); f1[j][1] = __builtin_nontemporal_load((const f32x4*)(x1 + 512 * j + 4)); }
        } else { const bf16* x0 = XB + (size_t)row0 * D + 8 * F.lane; const bf16* x1 = XB + (size_t)r1 * D + 8 * F.lane;
#pragma unroll
            for (int j = 0; j < 4; ++j) { a0[j] = __builtin_nontemporal_load((const bf16x8*)(x0 + 512 * j)); a1[j] = __builtin_nontemporal_load((const bf16x8*)(x1 + 512 * j)); } }
        const int c0 = row0 < RC ? 0 : 1 + ((row0 - RC) >> 12), c1 = r1 < RC ? 0 : 1 + ((r1 - RC) >> 12);
#define NORM16_PARAMS(ci) do { const float* mp = mod + (size_t)(ci) * N6 + (size_t)chunk * D + 8 * F.lane; const float* gp = g + 8 * F.lane; \
_Pragma("unroll") \
            for (int j = 0; j < 4; ++j) { const f32x4 ga = *(const f32x4*)(gp + 512 * j), gb = *(const f32x4*)(gp + 512 * j + 4), sa = *(const f32x4*)(mp + 512 * j), sb = *(const f32x4*)(mp + 512 * j + 4), \
                    ca = *(const f32x4*)(mp + D + 512 * j), cb = *(const f32x4*)(mp + D + 512 * j + 4); \
                A[j][0] = ga.x * (ca.x + 1.f); A[j][1] = ga.y * (ca.y + 1.f); A[j][2] = ga.z * (ca.z + 1.f); A[j][3] = ga.w * (ca.w + 1.f); A[j][4] = gb.x * (cb.x + 1.f); A[j][5] = gb.y * (cb.y + 1.f); A[j][6] = gb.z * (cb.z + 1.f); A[j][7] = gb.w * (cb.w + 1.f); \
                Bv[j][0] = sa.x; Bv[j][1] = sa.y; Bv[j][2] = sa.z; Bv[j][3] = sa.w; Bv[j][4] = sb.x; Bv[j][5] = sb.y; Bv[j][6] = sb.z; Bv[j][7] = sb.w; } ccur = (ci); } while (0)
        if (c0 != ccur) NORM16_PARAMS(c0);
        float v0[4][8], v1[4][8]; float s0 = 0.f, s1 = 0.f;
#pragma unroll
        for (int j = 0; j < 4; ++j) {
            if constexpr (F32IN) {
#pragma unroll
                for (int e = 0; e < 8; ++e) { v0[j][e] = f0[j][e >> 2][e & 3]; v1[j][e] = f1[j][e >> 2][e & 3]; }
            } else { unpack8(a0[j], v0[j]); unpack8(a1[j], v1[j]); }
#pragma unroll
            for (int e = 0; e < 8; ++e) { s0 += v0[j][e] * v0[j][e]; s1 += v1[j][e] * v1[j][e]; } }
#pragma unroll
        for (int o = 1; o < 64; o <<= 1) { s0 += __shfl_xor(s0, o); s1 += __shfl_xor(s1, o); }
        const float rs0 = 1.f / sqrtf(s0 * (1.f / D) + 1e-6f), rs1 = 1.f / sqrtf(s1 * (1.f / D) + 1e-6f);
        bf16* o0 = H + (size_t)row0 * D + 8 * F.lane; bf16* o1 = H + (size_t)r1 * D + 8 * F.lane;
#pragma unroll
        for (int j = 0; j < 4; ++j) { float h[8];
#pragma unroll
            for (int e = 0; e < 8; ++e) h[e] = v0[j][e] * rs0 * A[j][e] + Bv[j][e];
            *(bf16x8*)(o0 + 512 * j) = pack8(h); }
        if (has1) {
            if (c1 != ccur) NORM16_PARAMS(c1);
#pragma unroll
            for (int j = 0; j < 4; ++j) { float h[8];
#pragma unroll
                for (int e = 0; e < 8; ++e) h[e] = v1[j][e] * rs1 * A[j][e] + Bv[j][e];
                *(bf16x8*)(o1 + 512 * j) = pack8(h); } }
#undef NORM16_PARAMS
    }
}
__device__ __forceinline__ void ph_norm16(const Fr& F, const bf16* XB, const float* g, const float* mod, int chunk, bf16* H) { ph_norm_rows<false>(F, XB, nullptr, nullptr, g, mod, chunk, H); }
__device__ __forceinline__ void ph_norm32(const Fr& F, const float* xc, const float* xl, const float* g, const float* mod, int chunk, bf16* H) { ph_norm_rows<true>(F, nullptr, xc, xl, g, mod, chunk, H); }
}

namespace pg8 {
struct EpiResid {
    static constexpr bool PERM = false, AFTER_DRAIN = false;
    const float* xc; const float* xl; float* out; const float* gate;
    __device__ __forceinline__ void operator()(const f32x4 (&acc)[2][2][4][2], const Unit& u, int wr, int wc, int fr, int fq) const {
        const int ci = u.pm < 16 ? 0 : 1 + ((u.pm - 16) >> 4); const int row0 = u.pm * BM + wr * 64 + fr, col0 = u.pn * BM + wc * 32 + 4 * fq;
        const float* gp = gate + (size_t)ci * 12288 + col0; f32x4 gv[2][2];
#pragma unroll
        for (int bj = 0; bj < 2; ++bj)
#pragma unroll
            for (int n = 0; n < 2; ++n) gv[bj][n] = *(const f32x4*)(gp + bj * HALF + n * 16);
#pragma unroll
        for (int ai = 0; ai < 2; ++ai) {
            f32x4 xv[4][2][2];
#pragma unroll
            for (int m = 0; m < 4; ++m) { const int row = row0 + ai * HALF + m * 16; const float* xr = (row < 4096 ? xc + (size_t)row * 2048 : xl + (size_t)(row - 4096) * 2048) + col0;
#pragma unroll
                for (int bj = 0; bj < 2; ++bj)
#pragma unroll
                    for (int n = 0; n < 2; ++n) xv[m][bj][n] = *(const f32x4*)(xr + bj * HALF + n * 16); }
            asm volatile("" ::: "memory");
#pragma unroll
            for (int m = 0; m < 4; ++m) { const int row = row0 + ai * HALF + m * 16; float* orow = out + (size_t)row * 2048 + col0;
#pragma unroll
                for (int bj = 0; bj < 2; ++bj)
#pragma unroll
                    for (int n = 0; n < 2; ++n) *(f32x4*)(orow + bj * HALF + n * 16) = xv[m][bj][n] + gv[bj][n] * acc[ai][bj][m][n]; }
            asm volatile("" ::: "memory");
        }
    }
};

template <bool IN16, bool OUT16> struct EpiResidB {
    static constexpr bool PERM = true, AFTER_DRAIN = false;
    const void* xc; const void* xl; void* out; const float* gate;
    __device__ __forceinline__ void operator()(const f32x4 (&acc)[2][2][4][2], const Unit& u, int wr, int wc, int fr, int fq) const {
        const int ci = u.pm < 16 ? 0 : 1 + ((u.pm - 16) >> 4); const int row0 = u.pm * BM + wr * 64 + fr, col0 = u.pn * BM + wc * 32 + 8 * fq;
        const float* gp = gate + (size_t)ci * 12288 + col0; f32x4 gv[2][2];
#pragma unroll
        for (int bj = 0; bj < 2; ++bj)
#pragma unroll
            for (int n = 0; n < 2; ++n) gv[bj][n] = *(const f32x4*)(gp + bj * HALF + 4 * n);
#pragma unroll
        for (int ai = 0; ai < 2; ++ai) {
            mk::bf16x8 xb[4][2]; f32x4 xf[4][2][2];
#pragma unroll
            for (int m = 0; m < 4; ++m) { const int row = row0 + ai * HALF + m * 16; const size_t off = (size_t)(row < 4096 ? row : row - 4096) * 2048 + col0;
#pragma unroll
                for (int bj = 0; bj < 2; ++bj) {
                    if (IN16) xb[m][bj] = __builtin_nontemporal_load((const mk::bf16x8*)((const mk::bf16*)(row < 4096 ? xc : xl) + off + bj * HALF));
                    else { const float* p = (const float*)(row < 4096 ? xc : xl) + off + bj * HALF; xf[m][bj][0] = __builtin_nontemporal_load((const f32x4*)p); xf[m][bj][1] = __builtin_nontemporal_load((const f32x4*)(p + 4)); } } }
            asm volatile("" ::: "memory");
#pragma unroll
            for (int m = 0; m < 4; ++m) { const int row = row0 + ai * HALF + m * 16;
#pragma unroll
                for (int bj = 0; bj < 2; ++bj) { float x[8];
                    if (IN16) mk::unpack8(xb[m][bj], x); else { x[0] = xf[m][bj][0].x; x[1] = xf[m][bj][0].y; x[2] = xf[m][bj][0].z; x[3] = xf[m][bj][0].w; x[4] = xf[m][bj][1].x; x[5] = xf[m][bj][1].y; x[6] = xf[m][bj][1].z; x[7] = xf[m][bj][1].w; }
#pragma unroll
                    for (int e = 0; e < 8; ++e) x[e] += gv[bj][e >> 2][e & 3] * acc[ai][bj][m][e >> 2][e & 3];
                    if (OUT16) *(mk::bf16x8*)((mk::bf16*)out + (size_t)row * 2048 + col0 + bj * HALF) = mk::pack8(x);
                    else { float* o = (float*)out + (size_t)row * 2048 + col0 + bj * HALF; __builtin_nontemporal_store((f32x4){x[0], x[1], x[2], x[3]}, (f32x4*)o); __builtin_nontemporal_store((f32x4){x[4], x[5], x[6], x[7]}, (f32x4*)(o + 4)); } } }
            asm volatile("" ::: "memory");
        }
    }
};
}

#ifndef QFUSE
#define QFUSE 1
#endif
namespace mk {
struct HeadPost { const bf16* sa; long pa; int sha, na; const bf16* sb; long pb; int shb, nb; const float* gain; bf16* dst; long pd; int shd, NH, rot; const float* cs; const float* sn; float* of; int lat_end; };
template <int GS>
__device__ __forceinline__ void ph_headpost(const Fr& F, const HeadPost& P, int nitems) {
    constexpr int NB = 4, IPW = 64 / GS;
    const int i = F.lane & (GS - 1), e0 = 8 * i, dh = P.na + P.nb; const bool act_l = e0 < dh; const int r0 = dh - P.rot;
    const int gw2 = (F.bid * 8 + F.wave) * IPW + F.lane / GS, step = F.G * 8 * IPW;
    float gn[8];
    { const int ec = act_l ? e0 : 0; const f32x4 g0 = *(const f32x4*)(P.gain + ec), g1 = *(const f32x4*)(P.gain + ec + 4); gn[0] = g0.x; gn[1] = g0.y; gn[2] = g0.z; gn[3] = g0.w; gn[4] = g1.x; gn[5] = g1.y; gn[6] = g1.z; gn[7] = g1.w; }
    const float inv_dh = 1.f / (float)dh; const int nhs = 31 - __builtin_clz(P.NH);
    const int ntrip = (nitems + step * NB - 1) / (step * NB);
    for (int tr = 0; tr < ntrip; ++tr) { const int it0 = gw2 + tr * step * NB;
        bf16x8 raw[NB]; int rows[NB], hs[NB]; bool acts[NB];
#pragma unroll
        for (int b = 0; b < NB; ++b) { const int item = it0 + b * step; acts[b] = act_l && item < nitems; const int itc = item < nitems ? item : nitems - 1; rows[b] = itc >> nhs; hs[b] = itc & (P.NH - 1);
            raw[b] = (bf16x8){0, 0, 0, 0, 0, 0, 0, 0};
            if (acts[b]) raw[b] = __builtin_nontemporal_load((e0 < P.na) ? (const bf16x8*)(P.sa + (size_t)rows[b] * P.pa + (size_t)hs[b] * P.sha + e0) : (const bf16x8*)(P.sb + (size_t)rows[b] * P.pb + (size_t)hs[b] * P.shb + (e0 - P.na))); }
#pragma unroll
        for (int b = 0; b < NB; ++b) { const int row = rows[b], h = hs[b]; const bool act = acts[b];
            float v[8]; unpack8(raw[b], v);
            float ss = 0.f;
#pragma unroll
            for (int j = 0; j < 8; ++j) ss += v[j] * v[j];
#pragma unroll
            for (int o = 1; o < GS; o <<= 1) ss += __shfl_xor(ss, o);
            const float rstd = 1.f / sqrtf(ss * inv_dh + 1e-6f);
#pragma unroll
            for (int j = 0; j < 8; ++j) v[j] *= rstd * gn[j];
            if (P.of && act && row < RC) { float* op = P.of + ((size_t)((row >> 8) * P.NH + h) * 256 + (row & 255)) * dh + e0;
                *(f32x4*)op = (f32x4){v[0], v[1], v[2], v[3]}; *(f32x4*)(op + 4) = (f32x4){v[4], v[5], v[6], v[7]}; }
            if (P.rot) {
                float pv[8];
#pragma unroll
                for (int j = 0; j < 8; ++j) pv[j] = __shfl_xor(v[j], 2);
                const bool lat = row >= RC && row < P.lat_end;
                if (lat && act && e0 >= r0) { const int li0 = e0 - r0; const bool first = (li0 & 31) < 16; const int t = (row - RC) & (NLAT - 1);
                    const float* cp = P.cs + (size_t)t * 64 + li0; const float* sp = P.sn + (size_t)t * 64 + li0;
                    const f32x4 c0 = *(const f32x4*)cp, c1 = *(const f32x4*)(cp + 4), s0 = *(const f32x4*)sp, s1 = *(const f32x4*)(sp + 4);
                    const float cc[8] = {c0.x, c0.y, c0.z, c0.w, c1.x, c1.y, c1.z, c1.w}, sv[8] = {s0.x, s0.y, s0.z, s0.w, s1.x, s1.y, s1.z, s1.w};
#pragma unroll
                    for (int j = 0; j < 8; ++j) v[j] = v[j] * cc[j] + (first ? -pv[j] : pv[j]) * sv[j]; }
            }
            if (act) *(bf16x8*)(P.dst + (size_t)row * P.pd + (size_t)h * P.shd + e0) = pack8(v);
        }
    }
}
__device__ __forceinline__ void ph_copyv(const Fr& F, const bf16* src, long ps, int sh, int NH, int dh, float* of) {
    const int per = dh / 8, ps_ = 31 - __builtin_clz(per), nhs = 31 - __builtin_clz(NH); const int n = RC * NH * per;
    for (int g = F.bid * 512 + F.tid; g < n; g += F.G * 512) { const int c8 = g & (per - 1); const int h = (g >> ps_) & (NH - 1); const int row = g >> (ps_ + nhs);
        float v[8]; unpack8(*(const bf16x8*)(src + (size_t)row * ps + (size_t)h * sh + 8 * c8), v);
        float* op = of + ((size_t)((row >> 8) * NH + h) * 256 + (row & 255)) * dh + 8 * c8; *(f32x4*)op = (f32x4){v[0], v[1], v[2], v[3]}; *(f32x4*)(op + 4) = (f32x4){v[4], v[5], v[6], v[7]}; }
}
__device__ __forceinline__ void ph_mlanorm(const Fr& F, bf16* Dn, bf16* KR, const float* gqa, const float* gkva, const float* cckv, const float* ckr, float* o_ckv, float* o_kr) {
    const int gw = F.bid * 8 + F.wave, NGW = F.G * 8, lane = F.lane;
    f32x4 gq[3]; float gg[8];
#pragma unroll
    for (int j = 0; j < 3; ++j) gq[j] = *(const f32x4*)(gqa + 4 * lane + 256 * j);
    { const f32x4 g0 = *(const f32x4*)(gkva + 8 * lane), g1 = *(const f32x4*)(gkva + 8 * lane + 4); gg[0] = g0.x; gg[1] = g0.y; gg[2] = g0.z; gg[3] = g0.w; gg[4] = g1.x; gg[5] = g1.y; gg[6] = g1.z; gg[7] = g1.w; }
    for (int row0 = gw; row0 < RK; row0 += 2 * NGW) {
        u32x2 qw[2][3]; bf16x8 kvw[2], krw[2]; int rows[2]; bool on[2];
#pragma unroll
        for (int s = 0; s < 2; ++s) { const int row = row0 + s * NGW; rows[s] = row; on[s] = row < R; krw[s] = (bf16x8){0, 0, 0, 0, 0, 0, 0, 0};
            if (on[s]) { const bf16* p = Dn + (size_t)row * MDN;
#pragma unroll
                for (int j = 0; j < 3; ++j) qw[s][j] = *(const u32x2*)(p + 4 * lane + 256 * j);
                kvw[s] = *(const bf16x8*)(p + 768 + 8 * lane); if (lane < 8) krw[s] = *(const bf16x8*)(p + 1280 + 8 * lane); } }
#pragma unroll
        for (int s = 0; s < 2; ++s) { const int row = rows[s]; if (row >= RK) continue;
            bf16* p = Dn + (size_t)row * MDN;
            if (!on[s]) { const size_t j = (size_t)(row - R); const f32x4 a = *(const f32x4*)(cckv + j * 512 + 8 * lane), b = *(const f32x4*)(cckv + j * 512 + 8 * lane + 4);
                const float v[8] = {a.x, a.y, a.z, a.w, b.x, b.y, b.z, b.w}; *(bf16x8*)(p + 768 + 8 * lane) = pack8(v);
                if (lane < 8) { const f32x4 c = *(const f32x4*)(ckr + j * 64 + 8 * lane), d = *(const f32x4*)(ckr + j * 64 + 8 * lane + 4); const float w[8] = {c.x, c.y, c.z, c.w, d.x, d.y, d.z, d.w}; *(bf16x8*)(KR + (size_t)row * 64 + 8 * lane) = pack8(w); }
                continue; }
            float q[12]; float ss = 0.f;
#pragma unroll
            for (int j = 0; j < 3; ++j) { const u32x2 w = qw[s][j]; q[4 * j] = bflo(w.x); q[4 * j + 1] = bfhi(w.x); q[4 * j + 2] = bflo(w.y); q[4 * j + 3] = bfhi(w.y); }
#pragma unroll
            for (int j = 0; j < 12; ++j) ss += q[j] * q[j];
            ss = wave_sum(ss); float rs = 1.f / sqrtf(ss * (1.f / 768.f) + 1e-6f);
#pragma unroll
            for (int j = 0; j < 3; ++j) { const f32x4 g = gq[j]; u32x2 w; w.x = pk2(q[4 * j] * rs * g.x, q[4 * j + 1] * rs * g.y); w.y = pk2(q[4 * j + 2] * rs * g.z, q[4 * j + 3] * rs * g.w); *(u32x2*)(p + 4 * lane + 256 * j) = w; }
            float kv[8]; unpack8(kvw[s], kv); ss = 0.f;
#pragma unroll
            for (int j = 0; j < 8; ++j) ss += kv[j] * kv[j];
            ss = wave_sum(ss); rs = 1.f / sqrtf(ss * (1.f / 512.f) + 1e-6f);
#pragma unroll
            for (int j = 0; j < 8; ++j) kv[j] *= rs * gg[j];
            *(bf16x8*)(p + 768 + 8 * lane) = pack8(kv);
            if (row < RC) { float* op = o_ckv + (size_t)row * 512 + 8 * lane; *(f32x4*)op = (f32x4){kv[0], kv[1], kv[2], kv[3]}; *(f32x4*)(op + 4) = (f32x4){kv[4], kv[5], kv[6], kv[7]}; }
            if (lane < 8) { const bf16x8 raw = krw[s]; *(bf16x8*)(KR + (size_t)row * 64 + 8 * lane) = raw;
                if (row < RC) { float w[8]; unpack8(raw, w); float* op = o_kr + (size_t)row * 64 + 8 * lane; *(f32x4*)op = (f32x4){w[0], w[1], w[2], w[3]}; *(f32x4*)(op + 4) = (f32x4){w[4], w[5], w[6], w[7]}; } }
        }
    }
}

template <int DQK, int DV> struct AttG { static constexpr int PK = DQK * 2 + 16, PV = DV * 2 + 64, KB = 32 * PK, VB = 32 * PV, BUF = KB + VB;
    static constexpr int KPR = DQK / 8, VPR = DV / 8, NKP = 32 * KPR, NVP = 32 * VPR, KJ = (NKP + 511) / 512, VJ = (NVP + 511) / 512, NC = DQK / 16, NDB = DV / 32; };
struct TileSrc { const bf16* k; const bf16* v; int kp, vp; };
__device__ __forceinline__ int crow(int r, int hi) { return (r & 3) + 8 * (r >> 2) + 4 * hi; }
template <int DQK, int DV> __device__ __forceinline__ void att_gload(const TileSrc& ts, int tid, bf16x8 (&sk)[AttG<DQK, DV>::KJ], bf16x8 (&sv)[AttG<DQK, DV>::VJ]) {
    using G = AttG<DQK, DV>;
#pragma unroll
    for (int j = 0; j < G::KJ; ++j) { const int i = tid + 512 * j; if (i < G::NKP) { const int row = i / G::KPR, cc = i % G::KPR; sk[j] = *(const bf16x8*)(ts.k + (size_t)row * ts.kp + cc * 8); } }
#pragma unroll
    for (int j = 0; j < G::VJ; ++j) { const int i = tid + 512 * j; if (i < G::NVP) { const int row = i / G::VPR, cc = i % G::VPR; sv[j] = *(const bf16x8*)(ts.v + (size_t)row * ts.vp + cc * 8); } }
}
template <int DQK, int DV> __device__ __forceinline__ void att_swrite(LAS unsigned char* kb, LAS unsigned char* vb, int tid, const bf16x8 (&sk)[AttG<DQK, DV>::KJ], const bf16x8 (&sv)[AttG<DQK, DV>::VJ]) {
    using G = AttG<DQK, DV>;
#pragma unroll
    for (int j = 0; j < G::KJ; ++j) { const int i = tid + 512 * j; if (i < G::NKP) { const int row = i / G::KPR, cc = i % G::KPR; *(LAS bf16x8*)(kb + row * G::PK + cc * 16) = sk[j]; } }
#pragma unroll
    for (int j = 0; j < G::VJ; ++j) { const int i = tid + 512 * j; if (i < G::NVP) { const int row = i / G::VPR, cc = i % G::VPR; *(LAS bf16x8*)(vb + row * G::PV + cc * 16) = sv[j]; } }
}
#define ATT_S(t) do { \
_Pragma("unroll") \
            for (int r = 0; r < 16; ++r) s[r] = 0.f; \
_Pragma("unroll") \
            for (int c0 = 0; c0 < G::NC; c0 += 4) { bf16x8 kf[4];     \
_Pragma("unroll") \
                for (int c = 0; c < 4; ++c) kf[c] = *(const LAS bf16x8*)(kbuf + kbase + 32 * (c0 + c)); \
                __builtin_amdgcn_sched_barrier(0); \
_Pragma("unroll") \
                for (int c = 0; c < 4; ++c) s = __builtin_amdgcn_mfma_f32_32x32x16_bf16(kf[c], qf[c0 + c], s, 0, 0, 0); } \
            if (P.needs_adjust(u, wid, t)) { \
_Pragma("unroll") \
                for (int r = 0; r < 16; ++r) s[r] = P.adjust(F, pls, u, wid, r32, t, r, hi, s[r] * cs); \
            } else { \
_Pragma("unroll") \
                for (int r = 0; r < 16; ++r) s[r] *= cs; \
            } } while (0)
#define ATT_SM() do { \
            float mt = s[0]; \
_Pragma("unroll") \
            for (int r = 1; r < 16; ++r) mt = fmaxf(mt, s[r]); \
            mt = fmaxf(mt, __shfl_xor(mt, 32)); \
            if (!__all(mt - m_run <= 8.f)) { \
                const float mn = fmaxf(m_run, mt); const float al = fexp2(m_run - mn); m_run = mn; l_run *= al; \
_Pragma("unroll") \
                for (int db = 0; db < G::NDB; ++db) \
_Pragma("unroll") \
                    for (int r = 0; r < 16; ++r) o[db][r] *= al; \
            } \
            float ps = 0.f; \
_Pragma("unroll") \
            for (int r = 0; r < 16; ++r) { s[r] = fexp2(s[r] - m_run); ps += s[r]; } \
            l_run += ps; \
_Pragma("unroll") \
            for (int s2 = 0; s2 < 2; ++s2) { u32x4 w; w.x = pk2(s[8 * s2], s[8 * s2 + 1]); w.y = pk2(s[8 * s2 + 2], s[8 * s2 + 3]); w.z = pk2(s[8 * s2 + 4], s[8 * s2 + 5]); w.w = pk2(s[8 * s2 + 6], s[8 * s2 + 7]); pf[s2] = __builtin_bit_cast(bf16x8, w); } } while (0)
#define ATT_PV(vbuf) do { \
_Pragma("unroll") \
            for (int s2 = 0; s2 < 2; ++s2) \
_Pragma("unroll") \
                for (int db = 0; db < G::NDB; ++db) { \
                    const s16x4 lo = __builtin_bit_cast(s16x4, __builtin_amdgcn_ds_read_tr16_b64_v4i16((LAS v4i16_t*)((vbuf) + vbase + s2 * 16 * G::PV + db * 64))); \
                    const s16x4 hh = __builtin_bit_cast(s16x4, __builtin_amdgcn_ds_read_tr16_b64_v4i16((LAS v4i16_t*)((vbuf) + vbase + s2 * 16 * G::PV + 8 * G::PV + db * 64))); \
                    const bf16x8 vf = {lo[0], lo[1], lo[2], lo[3], hh[0], hh[1], hh[2], hh[3]}; \
                    o[db] = __builtin_amdgcn_mfma_f32_32x32x16_bf16(vf, pf[s2], o[db], 0, 0, 0); } } while (0)
typedef short v4i16_t __attribute__((ext_vector_type(4)));
template <int DQK, int DV, bool PAIR, class Pol>
__device__ __forceinline__ void attn_unit(const Fr& F, const Pol& P, int u) {
    using G = AttG<DQK, DV>;
    const int tid = F.tid, lane = F.lane, wid = F.wave, r32 = lane & 31, hi = lane >> 5;
    const int NT = P.ntiles(u);
    bf16x8 qf[G::NC];
    { const bf16* qp = P.qrow(u, wid, r32) + hi * 8;
#pragma unroll
      for (int c = 0; c < G::NC; ++c) qf[c] = *(const bf16x8*)(qp + 16 * c); }
    if (QFUSE) {
        float ss = 0.f;
#pragma unroll
        for (int c = 0; c < G::NC; ++c) { float t8[8]; unpack8(qf[c], t8);
#pragma unroll
            for (int j = 0; j < 8; ++j) ss += t8[j] * t8[j]; }
        ss += __shfl_xor(ss, 32);
        const float rs = (LOG2E / sqrtf((float)DQK)) / sqrtf(ss * (1.f / DQK) + 1e-6f);
        constexpr int C0 = Pol::QROPE ? G::NC - 4 : G::NC;
#pragma unroll
        for (int c = 0; c < C0; ++c) { float t8[8]; unpack8(qf[c], t8); const f32x4 g0 = *(const f32x4*)(P.qgain + 16 * c + 8 * hi), g1 = *(const f32x4*)(P.qgain + 16 * c + 8 * hi + 4);
            t8[0] *= rs * g0.x; t8[1] *= rs * g0.y; t8[2] *= rs * g0.z; t8[3] *= rs * g0.w; t8[4] *= rs * g1.x; t8[5] *= rs * g1.y; t8[6] *= rs * g1.z; t8[7] *= rs * g1.w; qf[c] = pack8(t8); }
        if (Pol::QROPE) { const int t = P.qpos(u, wid, r32); const float* cp = P.ropeC + (size_t)t * 64 + 8 * hi; const float* sp = P.ropeS + (size_t)t * 64 + 8 * hi;
#pragma unroll
            for (int pr = 0; pr < 2; ++pr) { constexpr int CB = G::NC - 4; const int ca = CB + 2 * pr, cb = CB + 2 * pr + 1; float va[8], vb[8]; unpack8(qf[ca], va); unpack8(qf[cb], vb);
                const f32x4 ga0 = *(const f32x4*)(P.qgain + 16 * ca + 8 * hi), ga1 = *(const f32x4*)(P.qgain + 16 * ca + 8 * hi + 4), gb0 = *(const f32x4*)(P.qgain + 16 * cb + 8 * hi), gb1 = *(const f32x4*)(P.qgain + 16 * cb + 8 * hi + 4);
                const float ga[8] = {ga0.x, ga0.y, ga0.z, ga0.w, ga1.x, ga1.y, ga1.z, ga1.w}, gb[8] = {gb0.x, gb0.y, gb0.z, gb0.w, gb1.x, gb1.y, gb1.z, gb1.w};
                const f32x4 c0 = *(const f32x4*)(cp + 32 * pr), c1 = *(const f32x4*)(cp + 32 * pr + 4), s0 = *(const f32x4*)(sp + 32 * pr), s1 = *(const f32x4*)(sp + 32 * pr + 4);
                const float cc[8] = {c0.x, c0.y, c0.z, c0.w, c1.x, c1.y, c1.z, c1.w}, sn[8] = {s0.x, s0.y, s0.z, s0.w, s1.x, s1.y, s1.z, s1.w};
#pragma unroll
                for (int j = 0; j < 8; ++j) { const float a = va[j] * rs * ga[j], b2 = vb[j] * rs * gb[j]; va[j] = a * cc[j] - b2 * sn[j]; vb[j] = b2 * cc[j] + a * sn[j]; }
                qf[ca] = pack8(va); qf[cb] = pack8(vb); } }
    }
    f32x16 o[G::NDB];
#pragma unroll
    for (int db = 0; db < G::NDB; ++db)
#pragma unroll
        for (int r = 0; r < 16; ++r) o[db][r] = 0.f;
    float m_run = -1e30f, l_run = 0.f;
    const float cs = QFUSE ? 1.f : LOG2E / sqrtf((float)DQK);
    const int kbase = r32 * G::PK + hi * 16;
    const int li = lane & 15; const int vbase = (4 * hi + (li >> 2)) * G::PV + (16 * ((lane >> 4) & 1) + 4 * (li & 3)) * 2;
    f32x16 s; bf16x8 pf[2];
    P.unit_setup(F, u);
    const typename Pol::LS pls = P.lane_init(u, wid, r32, hi);
    if constexpr (PAIR) {
        LAS unsigned char* const kring = F.lds; LAS unsigned char* const vring = F.lds + 4 * G::KB;
        bf16x8 skA[G::KJ], svA[G::VJ], skB[G::KJ], svB[G::VJ];
        { const TileSrc t0 = P.tile(u, 0); att_gload<DQK, DV>(t0, tid, skA, svA); }
        if (NT > 1) { const TileSrc t1 = P.tile(u, 1); att_gload<DQK, DV>(t1, tid, skB, svB); }
        att_swrite<DQK, DV>(kring, vring, tid, skA, svA);
        if (NT > 1) att_swrite<DQK, DV>(kring + G::KB, vring + G::VB, tid, skB, svB);
        asm volatile("s_waitcnt lgkmcnt(0)\n\ts_barrier" ::: "memory");
        for (int t0 = 0; t0 < NT; t0 += 2) { const int slot = (t0 >> 1) & 1;
            if (t0 + 2 < NT) { const TileSrc ta = P.tile(u, t0 + 2); att_gload<DQK, DV>(ta, tid, skA, svA); }
            if (t0 + 3 < NT) { const TileSrc tb = P.tile(u, t0 + 3); att_gload<DQK, DV>(tb, tid, skB, svB); }
#pragma unroll
            for (int sub = 0; sub < 2; ++sub) { const int t = t0 + sub;
                if (t < NT && P.active(u, wid, t)) { LAS unsigned char* kbuf = kring + (slot * 2 + sub) * G::KB; ATT_S(t); ATT_SM(); ATT_PV(vring + (slot * 2 + sub) * G::VB); } }
            if (t0 + 2 < NT) att_swrite<DQK, DV>(kring + ((slot ^ 1) * 2) * G::KB, vring + ((slot ^ 1) * 2) * G::VB, tid, skA, svA);
            if (t0 + 3 < NT) att_swrite<DQK, DV>(kring + ((slot ^ 1) * 2 + 1) * G::KB, vring + ((slot ^ 1) * 2 + 1) * G::VB, tid, skB, svB);
            asm volatile("s_waitcnt lgkmcnt(0)\n\ts_barrier" ::: "memory");
        }
    } else {
    bf16x8 sk[G::KJ], sv[G::VJ];
    LAS unsigned char* const kring = F.lds; LAS unsigned char* const vring = F.lds + 2 * G::KB;
    { const TileSrc t0 = P.tile(u, 0); att_gload<DQK, DV>(t0, tid, sk, sv); }
    att_swrite<DQK, DV>(kring, vring, tid, sk, sv);
    asm volatile("s_waitcnt lgkmcnt(0)\n\ts_barrier" ::: "memory");
    const bool lag = wid >= 4; bool prev_act = false; int vprev = 0, vcur = 0;
#define ATT_STEP(LAG, t) do { \
        LAS unsigned char* kbuf = kring + ((t) & 1) * G::KB; const int vnext = vcur == 2 ? 0 : vcur + 1; \
        if ((t) + 1 < NT) { const TileSrc tn = P.tile(u, (t) + 1); att_gload<DQK, DV>(tn, tid, sk, sv); } \
        const bool act = P.active(u, wid, t); \
        if (LAG) { if (act) ATT_S(t); if (prev_act) ATT_PV(vring + vprev * G::VB); if (act) ATT_SM(); } \
        else if (act) { ATT_S(t); ATT_SM(); ATT_PV(vring + vcur * G::VB); } \
        prev_act = act; \
        if ((t) + 1 < NT) att_swrite<DQK, DV>(kring + (((t) + 1) & 1) * G::KB, vring + vnext * G::VB, tid, sk, sv); \
        vprev = vcur; vcur = vnext; \
        asm volatile("s_waitcnt lgkmcnt(0)\n\ts_barrier" ::: "memory"); } while (0)
    if (lag) { for (int t = 0; t < NT; ++t) ATT_STEP(true, t); }
    else { for (int t = 0; t < NT; ++t) ATT_STEP(false, t); }
#undef ATT_STEP
    if (lag && prev_act) ATT_PV(vring + vprev * G::VB);
    asm volatile("s_waitcnt lgkmcnt(0)\n\ts_barrier" ::: "memory");
    }
    float lt = l_run + __shfl_xor(l_run, 32);
    if (Pol::HAS_SINK) lt += fexp2(P.sink_l2(u, wid) - m_run);
    const float inv = 1.f / lt;
    bf16* op = P.orow(u, wid, r32) + 4 * hi;
#pragma unroll
    for (int db = 0; db < G::NDB; ++db)
#pragma unroll
        for (int rg = 0; rg < 4; ++rg) { u32x2 w; w.x = pk2(o[db][4 * rg] * inv, o[db][4 * rg + 1] * inv); w.y = pk2(o[db][4 * rg + 2] * inv, o[db][4 * rg + 3] * inv); *(u32x2*)(op + 32 * db + 8 * rg) = w; }
}
struct PolBase { static constexpr bool HAS_SINK = false, QROPE = false; const float* qgain; const float* ropeC; const float* ropeS;
    __device__ __forceinline__ int qpos(int, int, int) const { return 0; }
    __device__ __forceinline__ void unit_setup(const Fr&, int) const {}
    __device__ __forceinline__ bool active(int, int, int) const { return true; }
    __device__ __forceinline__ bool needs_adjust(int, int, int) const { return false; }
    struct LS {}; __device__ __forceinline__ LS lane_init(int, int, int, int) const { return LS{}; }
    __device__ __forceinline__ float adjust(const Fr&, const LS&, int, int, int, int, int  , int  , float s) const { return s; }
    __device__ __forceinline__ float sink_l2(int, int) const { return 0.f; }
    static __device__ __forceinline__ int remap(int w) { return w; } };
__device__ __forceinline__ int remap_heads16(int w) { const int c = w & 255, x = c & 7, j = c >> 3; return (w & ~255) | ((2 * x + (j >> 4)) << 4) | (j & 15); }
struct PolCtx : PolBase { const bf16* Q; long pq; int shq; const bf16* K; long pk; int shk; const bf16* V; long pv; int shv; bf16* O; int sho; int NH;
    __device__ __forceinline__ int ntiles(int) const { return 8; }
    __device__ __forceinline__ TileSrc tile(int u, int t) const { const int b = u / NH, h = u % NH; const size_t r = (size_t)b * 256 + 32 * t; return TileSrc{K + r * pk + (size_t)h * shk, V + r * pv + (size_t)h * shv, (int)pk, (int)pv}; }
    __device__ __forceinline__ const bf16* qrow(int u, int wid, int r32) const { const int b = u / NH, h = u % NH; return Q + ((size_t)b * 256 + wid * 32 + r32) * pq + (size_t)h * shq; }
    __device__ __forceinline__ bf16* orow(int u, int wid, int r32) const { const int b = u / NH, h = u % NH; return O + ((size_t)b * 256 + wid * 32 + r32) * 2048 + (size_t)h * sho; } };
struct PolSwaCtx : PolBase { static constexpr bool HAS_SINK = true, QROPE = false; const bf16* QKV; bf16* O; const float* sinks;
    __device__ __forceinline__ int ntiles(int) const { return 8; }
    __device__ __forceinline__ TileSrc tile(int u, int t) const { const int b = u >> 5, kvh = (u >> 3) & 3; const size_t r = (size_t)b * 256 + 32 * t; return TileSrc{QKV + r * SQW + 2048 + kvh * 64, QKV + r * SQW + 2304 + kvh * 64, SQW, SQW}; }
    __device__ __forceinline__ const bf16* qrow(int u, int wid, int r32) const { const int b = u >> 5, kvh = (u >> 3) & 3, tq = u & 7; return QKV + ((size_t)b * 256 + 32 * tq + r32) * SQW + (kvh * 8 + wid) * 64; }
    __device__ __forceinline__ bf16* orow(int u, int wid, int r32) const { const int b = u >> 5, kvh = (u >> 3) & 3, tq = u & 7; return O + ((size_t)b * 256 + 32 * tq + r32) * 2048 + (kvh * 8 + wid) * 64; }
    __device__ __forceinline__ float sink_l2(int u, int wid) const { return sinks[((u >> 3) & 3) * 8 + wid] * LOG2E; } };
struct PolMlaLat : PolBase { static constexpr bool QROPE = true; const bf16* Q; const bf16* K; const bf16* KV; bf16* O;
    __device__ __forceinline__ int ntiles(int) const { return 136; }
    __device__ __forceinline__ TileSrc tile(int u, int t) const { const int b = u >> 8, h = (u >> 4) & 15; const size_t r = t < 8 ? (size_t)R + b * 256 + 32 * t : (size_t)RC + (size_t)b * NLAT + 32 * (t - 8);
        return TileSrc{K + r * MQW + h * 192, KV + r * MKVW + h * 256 + 128, MQW, MKVW}; }
    __device__ __forceinline__ const bf16* qrow(int u, int wid, int r32) const { const int b = u >> 8, h = (u >> 4) & 15, qb = u & 15; return Q + ((size_t)RC + (size_t)b * NLAT + qb * 256 + wid * 32 + r32) * MQW + h * 192; }
    __device__ __forceinline__ bf16* orow(int u, int wid, int r32) const { const int b = u >> 8, h = (u >> 4) & 15, qb = u & 15; return O + ((size_t)RC + (size_t)b * NLAT + qb * 256 + wid * 32 + r32) * 2048 + h * 128; }
    __device__ __forceinline__ int qpos(int u, int wid, int r32) const { return (u & 15) * 256 + wid * 32 + r32; }
    static __device__ __forceinline__ int remap(int w) { return remap_heads16(w); } };
struct PolNatLat : PolBase { const bf16* QKV; const bf16* CK; const bf16* CV; const float* rpb; bf16* O;
    static constexpr int RPB_OFF = 4 * AttG<128, 128>::KB + 4 * AttG<128, 128>::VB;
    __device__ __forceinline__ int rmin(int u) const { const int rb = u & 15; int r = 4 * rb - 4; return r < 0 ? 0 : (r > 56 ? 56 : r); }
    __device__ __forceinline__ int ntiles(int u) const { const int rb = u & 15; int rl = 4 * rb - 1; rl = rl < 0 ? 0 : (rl > 56 ? 56 : rl); return 8 + 2 * (rl + 7 - rmin(u) + 1); }
    __device__ __forceinline__ void unit_setup(const Fr& F, int u) const { const int h = (u >> 4) & 15; LAS float* rp = (LAS float*)(F.lds + RPB_OFF); if (F.tid < 480) rp[F.tid] = (F.tid & 31) < 31 ? rpb[h * 465 + (F.tid >> 5) * 31 + (F.tid & 31)] * LOG2E : -1e30f; }
    __device__ __forceinline__ TileSrc tile(int u, int t) const { const int b = u >> 8, h = (u >> 4) & 15;
        if (t < 8) { const size_t o = ((size_t)(b * 16 + h) * 256 + 32 * t) * 128; return TileSrc{CK + o, CV + o, 128, 128}; }
        const int lt = t - 8; const int kr = rmin(u) + (lt >> 1); const size_t r = (size_t)RC + (size_t)b * NLAT + kr * 64 + 32 * (lt & 1);
        return TileSrc{QKV + r * 6144 + 2048 + h * 128, QKV + r * 6144 + 4096 + h * 128, 6144, 6144}; }
    __device__ __forceinline__ size_t qtok(int u, int wid, int r32) const { const int b = u >> 8, rb = u & 15; return (size_t)RC + (size_t)b * NLAT + (4 * rb + (wid >> 1)) * 64 + 32 * (wid & 1) + r32; }
    __device__ __forceinline__ const bf16* qrow(int u, int wid, int r32) const { return QKV + qtok(u, wid, r32) * 6144 + ((u >> 4) & 15) * 128; }
    __device__ __forceinline__ bf16* orow(int u, int wid, int r32) const { return O + qtok(u, wid, r32) * 2048 + ((u >> 4) & 15) * 128; }
    __device__ __forceinline__ bool active(int u, int wid, int t) const { if (t < 8) return true; const int r = 4 * (u & 15) + (wid >> 1); int rs = r - 4; rs = rs < 0 ? 0 : (rs > 56 ? 56 : rs); const int kr = rmin(u) + ((t - 8) >> 1); return kr >= rs && kr < rs + 8; }
    __device__ __forceinline__ bool needs_adjust(int, int, int t) const { return t >= 8; }
    struct LS { unsigned pk[2][4]; };
    __device__ __forceinline__ LS lane_init(int, int wid, int r32, int hi) const { LS ls; const int c = 32 * (wid & 1) + r32; int cst = c - 8; cst = cst < 0 ? 0 : (cst > 48 ? 48 : cst);
#pragma unroll
        for (int hf = 0; hf < 2; ++hf)
#pragma unroll
            for (int q = 0; q < 4; ++q) { unsigned w = 0;
#pragma unroll
                for (int e = 0; e < 4; ++e) { const int r = 4 * q + e, kc = 32 * hf + crow(r, hi); const bool valid = kc >= cst && kc < cst + 16; int di = kc - c + 15; di = di < 0 ? 0 : (di > 30 ? 30 : di);
                    w |= (unsigned)(valid ? di : 31) << (8 * e); }
                ls.pk[hf][q] = w; }
        return ls; }
    __device__ __forceinline__ float adjust(const Fr& F, const LS& ls, int u, int wid, int, int t, int r, int, float s) const {
        const int lt = t - 8; const int rr = 4 * (u & 15) + (wid >> 1), kr = rmin(u) + (lt >> 1);
        const unsigned w = (lt & 1) ? ls.pk[1][r >> 2] : ls.pk[0][r >> 2]; const unsigned off = (w >> (8 * (r & 3))) & 0xffu;
        const LAS float* rp = (const LAS float*)(F.lds + RPB_OFF) + (kr - rr + 7) * 32;
        return s + rp[off]; }
    static __device__ __forceinline__ int remap(int w) { const int u = remap_heads16(w); return (u & ~15) | ((u + (w >> 8)) & 15); } };
struct PolSwaLat : PolBase { static constexpr bool HAS_SINK = true, QROPE = true; const bf16* QKV; const bf16* CK; const bf16* CV; const float* sinks; bf16* O;
    __device__ __forceinline__ int kt0(int u) const { const int tb = u & 127; return tb < 4 ? 0 : tb - 4; }
    __device__ __forceinline__ int ntiles(int u) const { const int tb = u & 127; const int k1 = tb + 4 > 127 ? 127 : tb + 4; return 8 + k1 - kt0(u) + 1; }
    __device__ __forceinline__ TileSrc tile(int u, int t) const { const int b = u >> 9, kvh = (u >> 7) & 3;
        if (t < 8) { const size_t o = ((size_t)(b * 4 + kvh) * 256 + 32 * t) * 64; return TileSrc{CK + o, CV + o, 64, 64}; }
        const size_t r = (size_t)RC + (size_t)b * NLAT + 32 * (kt0(u) + t - 8); return TileSrc{QKV + r * SQW + 2048 + kvh * 64, QKV + r * SQW + 2304 + kvh * 64, SQW, SQW}; }
    __device__ __forceinline__ size_t qtok(int u, int r32) const { return (size_t)RC + (size_t)(u >> 9) * NLAT + 32 * (u & 127) + r32; }
    __device__ __forceinline__ int qpos(int u, int, int r32) const { return 32 * (u & 127) + r32; }
    __device__ __forceinline__ const bf16* qrow(int u, int wid, int r32) const { return QKV + qtok(u, r32) * SQW + (((u >> 7) & 3) * 8 + wid) * 64; }
    __device__ __forceinline__ bf16* orow(int u, int wid, int r32) const { return O + qtok(u, r32) * 2048 + (((u >> 7) & 3) * 8 + wid) * 64; }
    __device__ __forceinline__ bool needs_adjust(int u, int, int t) const { if (t < 8) return false; const int tb = u & 127, kt = kt0(u) + t - 8; return kt == tb - 4 || kt == tb + 4; }
    __device__ __forceinline__ float adjust(const Fr&, const LS&, int u, int, int r32, int t, int r, int hi, float s) const { const int tb = u & 127, kt = kt0(u) + t - 8; const int dlt = 32 * (kt - tb) + crow(r, hi) - r32; return (dlt <= 128 && dlt >= -128) ? s : -1e30f; }
    __device__ __forceinline__ float sink_l2(int u, int wid) const { return sinks[((u >> 7) & 3) * 8 + wid] * LOG2E; }
    static __device__ __forceinline__ int remap(int w) { const int c = w & 255, x = c & 7, j = c >> 3; return (w & ~255) | ((j >> 4) << 7) | (16 * x + (j & 15)); } };
template <int DQK, int DV, bool PAIR, class Pol> __device__ __forceinline__ void ph_attn(const Fr& F, const Pol& P, int nunits) { const bool rm = F.G == 256 && (nunits & 255) == 0;
    for (int u = F.bid; u < nunits; u += F.G) attn_unit<DQK, DV, PAIR, Pol>(F, P, rm ? Pol::remap(u) : u); }
}

namespace mk {
#ifndef LRU_UNROLL
#define LRU_UNROLL 4
#endif
constexpr int PXC = 400;
struct LruArgs { const bf16* XG; const bf16* Wg; const float* cw; const float* cb; const float* ba; const float* bi; const float* lam; float* AGG; const float* CARRY; bf16* Y; };
template <int PASS> __device__ __forceinline__ void lru_unit(const Fr& F, const LruArgs& A, int u) {
    const int chunk = u >> 2, bq = u & 3, row0 = chunk * 64, tid = F.tid, lane = F.lane, hi = lane >> 5;
    int s0, T; if (row0 < RC) { s0 = (row0 >> 8) << 8; T = 256; } else { s0 = RC + (((row0 - RC) >> 12) << 12); T = NLAT; } const int t0 = row0 - s0;
    if (tid < 480) { const int combo = tid % 96, blk = combo / 24, cg = combo % 24, rbeg = (tid / 96) * 13, nr = rbeg + 13 > 64 ? 64 - rbeg : 13;
        LAS unsigned char* dst = F.lds + blk * (64 * PXC) + cg * 16;
        if (cg < 21) { const int ch = (4 * bq + blk) * 168 + 8 * cg;
            bf16x8 xr[16];
#pragma unroll
            for (int i = 0; i < 16; ++i) { const int tt = t0 + rbeg + i - 2; xr[i] = (bf16x8){0, 0, 0, 0, 0, 0, 0, 0}; if (tt >= 0 && tt < T && i < nr + 3) xr[i] = *(const bf16x8*)(A.XG + (size_t)(s0 + tt) * (2 * LW) + ch); }
            float w[4][8], bb[8];
#pragma unroll
            for (int k = 0; k < 4; ++k) { const f32x4 w0 = *(const f32x4*)(A.cw + (size_t)k * LW + ch), w1 = *(const f32x4*)(A.cw + (size_t)k * LW + ch + 4); w[k][0] = w0.x; w[k][1] = w0.y; w[k][2] = w0.z; w[k][3] = w0.w; w[k][4] = w1.x; w[k][5] = w1.y; w[k][6] = w1.z; w[k][7] = w1.w; }
            { const f32x4 b0 = *(const f32x4*)(A.cb + ch), b1 = *(const f32x4*)(A.cb + ch + 4); bb[0] = b0.x; bb[1] = b0.y; bb[2] = b0.z; bb[3] = b0.w; bb[4] = b1.x; bb[5] = b1.y; bb[6] = b1.z; bb[7] = b1.w; }
#pragma unroll
            for (int r = 0; r < 13; ++r) if (r < nr) { float acc[8];
#pragma unroll
                for (int j = 0; j < 8; ++j) acc[j] = bb[j];
#pragma unroll
                for (int k = 0; k < 4; ++k) { float x[8]; unpack8(xr[r + k], x);
#pragma unroll
                    for (int j = 0; j < 8; ++j) acc[j] += w[k][j] * x[j]; }
                *(LAS bf16x8*)(dst + (rbeg + r) * PXC) = pack8(acc); }
        } else { for (int r = 0; r < nr; ++r) *(LAS bf16x8*)(dst + (rbeg + r) * PXC) = (bf16x8){0, 0, 0, 0, 0, 0, 0, 0}; }
    }
    __syncthreads();
    const int i32 = lane & 31; const int tau = ((i32 >> 2) & 1) * 16 + ((i32 >> 3) << 2) + (i32 & 3);
    for (int task = F.wave; task < 24; task += 8) {
        const int blk = task / 6, sub = task % 6; const int col = 32 * sub + i32; const bool cvalid = col < 168; const int gb = 4 * bq + blk; const int c = gb * 168 + (cvalid ? col : 0);
        LAS unsigned char* xcb = F.lds + blk * (64 * PXC);
        LAS unsigned short* hst = (LAS unsigned short*)(F.lds + 4 * 64 * PXC) + F.wave * 2048 + lane;
#pragma unroll
        for (int dir = 0; dir < 2; ++dir) {
            const bf16* wa = A.Wg + ((size_t)((dir * 2 + 0) * 16 + gb) * 192 + col) * 192 + 8 * hi; const bf16* wi = A.Wg + ((size_t)((dir * 2 + 1) * 16 + gb) * 192 + col) * 192 + 8 * hi;
            const float ba_ = A.ba[(size_t)dir * LW + c], bi_ = A.bi[(size_t)dir * LW + c];
            float sp; { const float y = fexp2(-A.lam[(size_t)dir * LW + c] * LOG2E); sp = y < 0.02f ? y * (1.f - y * (0.5f - y * 0.33333333f)) : __builtin_amdgcn_logf(1.f + y) * 0.6931471805599453f; }
            float Hrun = 0.f, Prun = 1.f, Srun = 0.f;
            if (PASS == 2) Hrun = A.CARRY[((size_t)chunk * 2 + dir) * LW + c];
            f32x16 aa[2], ai[2];
#pragma unroll
            for (int mt = 0; mt < 2; ++mt)
#pragma unroll
                for (int r = 0; r < 16; ++r) { aa[mt][r] = 0.f; ai[mt][r] = 0.f; }
            { const LAS unsigned char* ap = xcb + tau * PXC + 16 * hi;
#pragma unroll (PASS == 1 ? 6 : 4)
              for (int ks = 0; ks < 12; ++ks) { const bf16x8 fa = *(const bf16x8*)(wa + 16 * ks), fi = *(const bf16x8*)(wi + 16 * ks);
                  const bf16x8 a0 = *(const LAS bf16x8*)(ap + 32 * ks), a1 = *(const LAS bf16x8*)(ap + 32 * PXC + 32 * ks);
                  aa[0] = __builtin_amdgcn_mfma_f32_32x32x16_bf16(a0, fa, aa[0], 0, 0, 0); ai[0] = __builtin_amdgcn_mfma_f32_32x32x16_bf16(a0, fi, ai[0], 0, 0, 0);
                  aa[1] = __builtin_amdgcn_mfma_f32_32x32x16_bf16(a1, fa, aa[1], 0, 0, 0); ai[1] = __builtin_amdgcn_mfma_f32_32x32x16_bf16(a1, fi, ai[1], 0, 0, 0); } }
#pragma unroll
            for (int mi = 0; mi < 2; ++mi) { const int mt = dir == 0 ? mi : 1 - mi;
                float hl[16], ac[16];
#pragma unroll
                for (int r = 0; r < 16; ++r) { const int tt = 32 * mt + 16 * hi + r; const float xcv = bf2f(*(const LAS unsigned short*)(xcb + tt * PXC + col * 2));
                    const float rg = sigm(aa[mt][r] + ba_), ig = sigm(ai[mt][r] + bi_); const float la = -8.f * rg * sp; const float a = fexp2(la * LOG2E); const float z = 2.f * la;
                    const float om = z > -0.05f ? -z * (1.f + z * (0.5f + z * 0.16666667f)) : 1.f - a * a;
                    ac[r] = a; hl[r] = __builtin_amdgcn_sqrtf(om) * ig * xcv; }
                float P = 1.f, S = 0.f;
                if (dir == 0) {
#pragma unroll
                    for (int r = 0; r < 16; ++r) { S = ac[r] * S + hl[r]; P *= ac[r]; hl[r] = S; ac[r] = P; }
                } else {
#pragma unroll
                    for (int r = 15; r >= 0; --r) { S = ac[r] * S + hl[r]; P *= ac[r]; hl[r] = S; ac[r] = P; }
                }
                const float oP = __shfl_xor(P, 32), oS = __shfl_xor(S, 32); const bool isfirst = (dir == 0) ? (hi == 0) : (hi == 1);
                const float fP = isfirst ? P : oP, fS = isfirst ? S : oS, sP = isfirst ? oP : P, sS = isfirst ? oS : S;
                const float tP = fP * sP, tS = sS + sP * fS;
                if (PASS == 1) { Srun = tS + tP * Srun; Prun *= tP; }
                else { const float cin = isfirst ? Hrun : fS + fP * Hrun;
#pragma unroll
                    for (int r = 0; r < 16; ++r) { const float h = hl[r] + ac[r] * cin; LAS unsigned short* hp = hst + (mt * 16 + r) * 64;
                        if (dir == 0) *hp = (unsigned short)f2bf(h);
                        else if (cvalid) { const size_t row = (size_t)row0 + 32 * mt + 16 * hi + r; const float gate = bf2f(A.XG[row * (2 * LW) + LW + c]); A.Y[row * LW + c] = (bf16)f2bf(geluf(gate) * (bf2f(*hp) + h)); } }
                    Hrun = tS + tP * Hrun; asm volatile("" ::: "memory"); }
            }
            if (PASS == 1 && hi == 0 && cvalid) { A.AGG[(((size_t)chunk * 2 + dir) * 2 + 0) * LW + c] = Prun; A.AGG[(((size_t)chunk * 2 + dir) * 2 + 1) * LW + c] = Srun; }
        }
    }
    __syncthreads();
}
template <int PASS> __device__ __forceinline__ void ph_lru(const Fr& F, const LruArgs& A) { for (int u = F.bid; u < 576 * 4; u += F.G) lru_unit<PASS>(F, A, u); }
__device__ __forceinline__ void ph_lru_carry(const Fr& F, const float* AGG, float* CARRY, const float* h0, float* state_out) {
    for (int g = F.bid * 512 + F.tid; g < 24 * 2 * LW; g += F.G * 512) { const int seq = g / (2 * LW), rem = g % (2 * LW), dir = rem / LW, c = rem % LW;
        int nch, ch0; float h = 0.f; if (seq < 16) { nch = 4; ch0 = 4 * seq; } else { const int b = seq - 16; nch = 64; ch0 = 64 + 64 * b; h = h0[((size_t)b * 2 + dir) * LW + c]; }
        for (int j = 0; j < nch; ++j) { const int ch = ch0 + (dir == 0 ? j : nch - 1 - j); CARRY[((size_t)ch * 2 + dir) * LW + c] = h;
            const float P = AGG[(((size_t)ch * 2 + dir) * 2 + 0) * LW + c], S = AGG[(((size_t)ch * 2 + dir) * 2 + 1) * LW + c]; h = S + P * h; }
        if (seq < 16) state_out[((size_t)seq * 2 + dir) * LW + c] = h; }
}
__device__ __forceinline__ void ph_lru_xc(const Fr& F, const bf16* XG, const float* cw, const float* cb, bf16* XC) {
    for (int g = F.bid * 512 + F.tid; g < (R / 8) * 336; g += F.G * 512) { const int row0 = (g / 336) * 8, ch = 8 * (g % 336);
        int s0, T; if (row0 < RC) { s0 = (row0 >> 8) << 8; T = 256; } else { s0 = RC + (((row0 - RC) >> 12) << 12); T = NLAT; } const int t0 = row0 - s0;
        bf16x8 xr[11];
#pragma unroll
        for (int i = 0; i < 11; ++i) { const int tt = t0 + i - 2; xr[i] = __builtin_bit_cast(bf16x8, (u32x4){0u, 0u, 0u, 0u}); if (tt >= 0 && tt < T) xr[i] = __builtin_nontemporal_load((const bf16x8*)(XG + (size_t)(s0 + tt) * (2 * LW) + ch)); }
        float w[4][8], bb[8];
        { const f32x4 b0 = *(const f32x4*)(cb + ch), b1 = *(const f32x4*)(cb + ch + 4); bb[0] = b0.x; bb[1] = b0.y; bb[2] = b0.z; bb[3] = b0.w; bb[4] = b1.x; bb[5] = b1.y; bb[6] = b1.z; bb[7] = b1.w; }
#pragma unroll
        for (int k = 0; k < 4; ++k) { const f32x4 w0 = *(const f32x4*)(cw + (size_t)k * LW + ch), w1 = *(const f32x4*)(cw + (size_t)k * LW + ch + 4);
            w[k][0] = w0.x; w[k][1] = w0.y; w[k][2] = w0.z; w[k][3] = w0.w; w[k][4] = w1.x; w[k][5] = w1.y; w[k][6] = w1.z; w[k][7] = w1.w; }
        float x[11][8];
#pragma unroll
        for (int i = 0; i < 11; ++i) unpack8(xr[i], x[i]);
#pragma unroll
        for (int r = 0; r < 8; ++r) { float acc[8];
#pragma unroll
            for (int e = 0; e < 8; ++e) acc[e] = bb[e];
#pragma unroll
            for (int k = 0; k < 4; ++k)
#pragma unroll
                for (int e = 0; e < 8; ++e) acc[e] += w[k][e] * x[r + k][e];
            *(bf16x8*)(XC + (size_t)(row0 + r) * LW + ch) = pack8(acc); } }
}
__device__ __forceinline__ void ph_lru_combine(const Fr& F, const bf16* XG, const bf16* HB, bf16* Y) {
    for (int g = F.bid * 512 + F.tid; g < R * 336; g += F.G * 512) { const int row = g / 336, ch = 8 * (g % 336);
        float a[8], b[8], gt[8]; unpack8(__builtin_nontemporal_load((const bf16x8*)(Y + (size_t)row * LW + ch)), a); unpack8(__builtin_nontemporal_load((const bf16x8*)(HB + (size_t)row * LW + ch)), b); unpack8(__builtin_nontemporal_load((const bf16x8*)(XG + (size_t)row * (2 * LW) + LW + ch)), gt);
#pragma unroll
        for (int j = 0; j < 8; ++j) a[j] = geluf(gt[j]) * (a[j] + b[j]);
        *(bf16x8*)(Y + (size_t)row * LW + ch) = pack8(a); }
}
struct ChainArgs { const bf16* XC; const bf16* Wg; const float* ba; const float* bi; const float* lam; const float* h0; bf16* HF; bf16* HB; float* state_out; };
#define LRU_STORE_H() do { const int odd = i32 & 1; \
_Pragma("unroll") \
        for (int rp = 0; rp < 8; ++rp) { const unsigned own = odd ? hq[2 * rp + 1] : hq[2 * rp], snd = odd ? hq[2 * rp] : hq[2 * rp + 1]; \
            const unsigned rcv = (unsigned)__builtin_amdgcn_update_dpp(0, (int)snd, 0xB1, 0xF, 0xF, false); \
            const unsigned wd = odd ? (rcv | (own << 16)) : (own | (rcv << 16)); \
            if (cvalid) __builtin_nontemporal_store(wd, (unsigned*)(HX + (rprev + 16 * hi + 2 * rp + odd) * LW + c - odd)); } } while (0)
__device__ __forceinline__ void lru_chain(const Fr& F, const ChainArgs& A, int s0, int T, int dir, int st, int seq_ctx, int b_lat) {
    const int lane = F.lane, hi = lane >> 5, i32 = lane & 31; const int tau = ((i32 >> 2) & 1) * 16 + ((i32 >> 3) << 2) + (i32 & 3);
    const int blk = st / 6, sub = st % 6; const int col = 32 * sub + i32; const bool cvalid = col < 168; const int c = blk * 168 + (cvalid ? col : 0);
    bf16x8 bfa[12]; LAS unsigned char* wl = F.lds + F.wave * 12288 + lane * 16;
    { const bf16* wa = A.Wg + ((size_t)((dir * 2 + 0) * 16 + blk) * 192 + col) * 192 + 8 * hi; const bf16* wi = A.Wg + ((size_t)((dir * 2 + 1) * 16 + blk) * 192 + col) * 192 + 8 * hi;
#pragma unroll
      for (int ks = 0; ks < 12; ++ks) { bfa[ks] = *(const bf16x8*)(wa + 16 * ks); *(LAS bf16x8*)(wl + ks * 1024) = *(const bf16x8*)(wi + 16 * ks); } }
    const float ba_ = A.ba[(size_t)dir * LW + c], bi_ = A.bi[(size_t)dir * LW + c];
    float sp; { const float y = fexp2(-A.lam[(size_t)dir * LW + c] * LOG2E); sp = y < 0.02f ? y * (1.f - y * (0.5f - y * 0.33333333f)) : __builtin_amdgcn_logf(1.f + y) * 0.6931471805599453f; }
    float Hrun = b_lat >= 0 ? A.h0[((size_t)b_lat * 2 + dir) * LW + c] : 0.f;
    const float nba = -ba_ * LOG2E, nbi = -bi_ * LOG2E, k1 = -8.f * sp * LOG2E;
    bf16* HX = dir == 0 ? A.HF : A.HB;
    const int nsteps = T >> 5;
    const bf16* abase = A.XC + (size_t)blk * 168 + 8 * hi; const bf16* xbase = A.XC + c;
    bf16x8 af[12]; unsigned short hq[16]; size_t rprev = 0;
    bf16x8 idf[2];
#pragma unroll
    for (int kl = 0; kl < 2; ++kl) { const bool on = (i32 >> 4) == kl && hi == ((i32 >> 3) & 1); const int e = i32 & 7; u32x4 w;
        w.x = on && (e >> 1) == 0 ? ((e & 1) ? 0x3F800000u : 0x3F80u) : 0u; w.y = on && (e >> 1) == 1 ? ((e & 1) ? 0x3F800000u : 0x3F80u) : 0u;
        w.z = on && (e >> 1) == 2 ? ((e & 1) ? 0x3F800000u : 0x3F80u) : 0u; w.w = on && (e >> 1) == 3 ? ((e & 1) ? 0x3F800000u : 0x3F80u) : 0u; idf[kl] = __builtin_bit_cast(bf16x8, w); }
    { const int mt = dir == 0 ? 0 : nsteps - 1; const size_t r0 = (size_t)s0 + 32 * mt;
#pragma unroll
      for (int ks = 0; ks < 12; ++ks) af[ks] = *(const bf16x8*)(abase + (r0 + tau) * LW + 16 * ks); }
    for (int step = 0; step < nsteps; ++step) { const int mt = dir == 0 ? step : nsteps - 1 - step; const size_t r0 = (size_t)s0 + 32 * mt;
        f32x16 aa, ai;
#pragma unroll
        for (int r = 0; r < 16; ++r) { aa[r] = 0.f; ai[r] = 0.f; }
#pragma unroll
        for (int ks = 0; ks < 12; ++ks) { const bf16x8 fi = *(const LAS bf16x8*)(wl + ks * 1024); aa = __builtin_amdgcn_mfma_f32_32x32x16_bf16(af[ks], bfa[ks], aa, 0, 0, 0); ai = __builtin_amdgcn_mfma_f32_32x32x16_bf16(af[ks], fi, ai, 0, 0, 0); }
        f32x16 ax;
#pragma unroll
        for (int r = 0; r < 16; ++r) ax[r] = 0.f;
#define LRU_XSEL(S) case S: ax = __builtin_amdgcn_mfma_f32_32x32x16_bf16(af[2 * S], idf[0], ax, 0, 0, 0); ax = __builtin_amdgcn_mfma_f32_32x32x16_bf16(af[2 * S + 1], idf[1], ax, 0, 0, 0); break;
        switch (sub) { LRU_XSEL(0) LRU_XSEL(1) LRU_XSEL(2) LRU_XSEL(3) LRU_XSEL(4) default: ax = __builtin_amdgcn_mfma_f32_32x32x16_bf16(af[10], idf[0], ax, 0, 0, 0); ax = __builtin_amdgcn_mfma_f32_32x32x16_bf16(af[11], idf[1], ax, 0, 0, 0); break; }
#undef LRU_XSEL
        float xc[16];
#pragma unroll
        for (int r = 0; r < 16; ++r) xc[r] = ax[r];
        __builtin_amdgcn_sched_barrier(0);
        if (step > 0) { LRU_STORE_H(); }
        if (step + 1 < nsteps) { const int mn = dir == 0 ? step + 1 : nsteps - 2 - step; const size_t rn = (size_t)s0 + 32 * mn;
#pragma unroll
            for (int ks = 0; ks < 12; ++ks) af[ks] = *(const bf16x8*)(abase + (rn + tau) * LW + 16 * ks); }
        float hl[16], ac[16];
#pragma unroll
        for (int r = 0; r < 16; ++r) {
            const float rg = frcp(1.f + fexp2(fmaf(aa[r], -LOG2E, nba))), ig = frcp(1.f + fexp2(fmaf(ai[r], -LOG2E, nbi)));
            const float a = fexp2(rg * k1); ac[r] = a; hl[r] = __builtin_amdgcn_sqrtf(fmaf(-a, a, 1.f)) * (ig * xc[r]); }
        float P = 1.f, S = 0.f;
        if (dir == 0) {
#pragma unroll
            for (int r = 0; r < 16; ++r) { S = ac[r] * S + hl[r]; P *= ac[r]; hl[r] = S; ac[r] = P; }
        } else {
#pragma unroll
            for (int r = 15; r >= 0; --r) { S = ac[r] * S + hl[r]; P *= ac[r]; hl[r] = S; ac[r] = P; }
        }
        const float oP = __shfl_xor(P, 32), oS = __shfl_xor(S, 32); const bool isfirst = (dir == 0) ? (hi == 0) : (hi == 1);
        const float fP = isfirst ? P : oP, fS = isfirst ? S : oS, sP = isfirst ? oP : P, sS = isfirst ? oS : S;
        const float tP = fP * sP, tS = sS + sP * fS; const float cin = isfirst ? Hrun : fS + fP * Hrun;
#pragma unroll
        for (int r = 0; r < 16; ++r) hq[r] = (unsigned short)f2bf(hl[r] + ac[r] * cin);
        rprev = r0;
        Hrun = tS + tP * Hrun;
    }
    LRU_STORE_H();
#undef LRU_STORE_H
    if (seq_ctx >= 0 && hi == 0 && cvalid) A.state_out[((size_t)seq_ctx * 2 + dir) * LW + c] = Hrun;
}
__device__ __forceinline__ void ph_lru_chains(const Fr& F, const ChainArgs& A) {
    if (F.wave < 6) { for (int wt = F.bid * 6 + F.wave; wt < 1536; wt += F.G * 6) { const int b = wt / 192, dir = (wt / 96) & 1, st = wt % 96; lru_chain(F, A, RC + b * NLAT, NLAT, dir, st, -1, b); } }
    else { for (int j = F.bid * 2 + (F.wave - 6); j < 3072; j += F.G * 2) { const int s = j / 192, dir = (j / 96) & 1, st = j % 96; lru_chain(F, A, s * 256, 256, dir, st, s, -1); } }
}
__device__ __forceinline__ void ph_ffn_fix(const Fr& F, const float* SIDE, const float* cw, bf16* G) {
    for (int g = F.bid * 512 + F.tid; g < 120 * (DFF / 4); g += F.G * 512) { const int bi = g / (DFF / 4), c = 4 * (g % (DFF / 4)); const int pm = 16 + (bi / 15) * 16 + (bi % 15) + 1;
        const float* top = SIDE + ((size_t)pm * 2 + 0) * 3 * DFF; const float* bot = SIDE + ((size_t)(pm - 1) * 2 + 1) * 3 * DFF;
        const f32x4 tp = *(const f32x4*)(top + c), tb = *(const f32x4*)(top + DFF + c), ta = *(const f32x4*)(top + 2 * DFF + c), bp = *(const f32x4*)(bot + c), bb = *(const f32x4*)(bot + DFF + c), ba = *(const f32x4*)(bot + 2 * DFF + c);
        const f32x4 w0 = *(const f32x4*)(cw + c), w2 = *(const f32x4*)(cw + 2 * DFF + c);
        u32x2 ot, ob; float vt[4], vb[4];
#pragma unroll
        for (int e = 0; e < 4; ++e) { const float pt = tp[e] + w0[e] * ba[e];
            const float pb = bp[e] + w2[e] * ta[e];
            vt[e] = siluf(pt) * tb[e]; vb[e] = siluf(pb) * bb[e]; }
        ot.x = (f2bf(vt[1]) << 16) | f2bf(vt[0]); ot.y = (f2bf(vt[3]) << 16) | f2bf(vt[2]); ob.x = (f2bf(vb[1]) << 16) | f2bf(vb[0]); ob.y = (f2bf(vb[3]) << 16) | f2bf(vb[2]);
        *(u32x2*)(G + (size_t)(256 * pm) * DFF + c) = ot; *(u32x2*)(G + (size_t)(256 * pm - 1) * DFF + c) = ob; }
}
}
namespace pg8 {
template <int MODE> struct EpiFfnT {
    static constexpr bool PERM = true, AFTER_DRAIN = false;
    mk::bf16* G; const float* cw; const float* cb; float* side; PG8_LAS float* xl;
    __device__ __forceinline__ void operator()(const f32x4 (&acc)[2][2][4][2], const Unit& u, int wr, int wc, int fr, int fq) const {
        const int lane = threadIdx.x & 63; const int chl = wc * 32 + 8 * fq, ch0 = u.pn * 128 + chl;
        if (MODE == 1 || MODE == 2) {
#pragma unroll
            for (int ai = 0; ai < 2; ++ai)
#pragma unroll
                for (int m = 0; m < 4; ++m) { const int row = u.pm * BM + ai * HALF + wr * 64 + m * 16 + fr; float gv[8];
#pragma unroll
                    for (int e = 0; e < 8; ++e) gv[e] = acc[ai][0][m][e >> 2][e & 3];
                    *(mk::bf16x8*)(G + (size_t)row * 5632 + ch0) = mk::pack8(gv); }
            if (MODE == 1) return; }
        float w0[8], w1[8], w2[8], bb[8];
#pragma unroll
        for (int h = 0; h < 2; ++h) { const f32x4 a = *(const f32x4*)(cw + ch0 + 4 * h), b = *(const f32x4*)(cw + 5632 + ch0 + 4 * h), c = *(const f32x4*)(cw + 2 * 5632 + ch0 + 4 * h), d = *(const f32x4*)(cb + ch0 + 4 * h);
#pragma unroll
            for (int j = 0; j < 4; ++j) { w0[4 * h + j] = a[j]; w1[4 * h + j] = b[j]; w2[4 * h + j] = c[j]; bb[4 * h + j] = d[j]; } }
#pragma unroll
        for (int ai = 0; ai < 2; ++ai) { const int g = 2 * ai + wr;
            if (fr == 0) { *(PG8_LAS f32x4*)(xl + (g * 2 + 0) * 128 + chl) = acc[ai][0][0][0]; *(PG8_LAS f32x4*)(xl + (g * 2 + 0) * 128 + chl + 4) = acc[ai][0][0][1]; }
            if (fr == 15) { *(PG8_LAS f32x4*)(xl + (g * 2 + 1) * 128 + chl) = acc[ai][0][3][0]; *(PG8_LAS f32x4*)(xl + (g * 2 + 1) * 128 + chl + 4) = acc[ai][0][3][1]; } }
        asm volatile("s_waitcnt lgkmcnt(0)" ::: "memory"); __builtin_amdgcn_s_barrier(); asm volatile("" ::: "memory");
        if (MODE == 2) return;
        const int lprev = (lane & 48) | ((fr + 15) & 15), lnext = (lane & 48) | ((fr + 1) & 15);
#pragma unroll
        for (int ai = 0; ai < 2; ++ai) { const int g = 2 * ai + wr;
            float hp[8], hn[8];
#pragma unroll
            for (int j = 0; j < 8; ++j) { hp[j] = 0.f; hn[j] = 0.f; }
            if (g > 0) { const f32x4 a = *(const PG8_LAS f32x4*)(xl + ((g - 1) * 2 + 1) * 128 + chl), b = *(const PG8_LAS f32x4*)(xl + ((g - 1) * 2 + 1) * 128 + chl + 4);
#pragma unroll
                for (int j = 0; j < 4; ++j) { hp[j] = a[j]; hp[4 + j] = b[j]; } }
            if (g < 3) { const f32x4 a = *(const PG8_LAS f32x4*)(xl + ((g + 1) * 2 + 0) * 128 + chl), b = *(const PG8_LAS f32x4*)(xl + ((g + 1) * 2 + 0) * 128 + chl + 4);
#pragma unroll
                for (int j = 0; j < 4; ++j) { hn[j] = a[j]; hn[4 + j] = b[j]; } }
#pragma unroll
            for (int m = 0; m < 4; ++m) { const int row = u.pm * BM + ai * HALF + wr * 64 + m * 16 + fr; float p[8], bv[8], av[8];
#pragma unroll
                for (int e = 0; e < 8; ++e) { const int n = e >> 2, j = e & 3; const float a = acc[ai][0][m][n][j];
                    const float up = m > 0 ? acc[ai][0][m - 1][n][j] : hp[e]; const float dn = m < 3 ? acc[ai][0][m + 1][n][j] : hn[e];
                    const float prev = __shfl(fr == 15 ? up : a, lprev);
                    const float next = __shfl(fr == 0 ? dn : a, lnext);
                    av[e] = a; bv[e] = acc[ai][1][m][n][j]; p[e] = bb[e] + w0[e] * prev + w1[e] * a + w2[e] * next; }
                const bool top = (g == 0 && m == 0 && fr == 0), bot = (g == 3 && m == 3 && fr == 15);
                if (top || bot) { float* sp = side + ((size_t)u.pm * 2 + (bot ? 1 : 0)) * 3 * 5632 + ch0;
#pragma unroll
                    for (int h = 0; h < 2; ++h) { *(f32x4*)(sp + 4 * h) = (f32x4){p[4 * h], p[4 * h + 1], p[4 * h + 2], p[4 * h + 3]}; *(f32x4*)(sp + 5632 + 4 * h) = (f32x4){bv[4 * h], bv[4 * h + 1], bv[4 * h + 2], bv[4 * h + 3]};
                        *(f32x4*)(sp + 2 * 5632 + 4 * h) = (f32x4){av[4 * h], av[4 * h + 1], av[4 * h + 2], av[4 * h + 3]}; } }
                float gv[8];
#pragma unroll
                for (int e = 0; e < 8; ++e) gv[e] = mk::siluf(p[e]) * bv[e];
                *(mk::bf16x8*)(G + (size_t)row * 5632 + ch0) = mk::pack8(gv); }
        }
    }
};
typedef EpiFfnT<0> EpiFfn;

struct EpiNatQKV {
    static constexpr bool PERM = true, AFTER_DRAIN = false;
    mk::bf16* O; const float* gk; float* outb; PG8_LAS float* xl;
    __device__ __forceinline__ void operator()(const f32x4 (&acc)[2][2][4][2], const Unit& u, int wr, int wc, int fr, int fq) const {
        const int row0 = u.pm * BM + wr * 64 + fr, col0 = u.pn * BM + wc * 32 + 8 * fq; const bool isk = u.pn >= 8 && u.pn < 16, isv = u.pn >= 16;
        if (isk) {
#pragma unroll
            for (int ai = 0; ai < 2; ++ai)
#pragma unroll
                for (int m = 0; m < 4; ++m)
#pragma unroll
                    for (int bj = 0; bj < 2; ++bj) { const f32x4 a = acc[ai][bj][m][0], b = acc[ai][bj][m][1]; float ss = (a.x * a.x + a.y * a.y) + (a.z * a.z + a.w * a.w) + (b.x * b.x + b.y * b.y) + (b.z * b.z + b.w * b.w);
                        ss += __shfl_xor(ss, 16); ss += __shfl_xor(ss, 32);
                        if (fq == 0) xl[(bj * 256 + ai * HALF + wr * 64 + m * 16 + fr) * 4 + wc] = ss; }
        }
        asm volatile("s_waitcnt lgkmcnt(0)" ::: "memory"); __builtin_amdgcn_s_barrier(); asm volatile("" ::: "memory");
        float g[8];
        { const int d0 = wc * 32 + 8 * fq; const f32x4 g0 = *(const f32x4*)(gk + d0), g1 = *(const f32x4*)(gk + d0 + 4); g[0] = g0.x; g[1] = g0.y; g[2] = g0.z; g[3] = g0.w; g[4] = g1.x; g[5] = g1.y; g[6] = g1.z; g[7] = g1.w; }
#pragma unroll
        for (int ai = 0; ai < 2; ++ai)
#pragma unroll
            for (int m = 0; m < 4; ++m) { const int row = row0 + ai * HALF + m * 16;
#pragma unroll
                for (int bj = 0; bj < 2; ++bj) { float v[8];
#pragma unroll
                    for (int e = 0; e < 8; ++e) v[e] = acc[ai][bj][m][e >> 2][e & 3];
                    if (isk) { const f32x4 p = *(const PG8_LAS f32x4*)(xl + (bj * 256 + ai * HALF + wr * 64 + m * 16 + fr) * 4); const float rs = 1.f / sqrtf(((p.x + p.y) + (p.z + p.w)) * (1.f / 128.f) + 1e-6f);
#pragma unroll
                        for (int e = 0; e < 8; ++e) v[e] *= rs * g[e]; }
                    *(mk::bf16x8*)(O + (size_t)row * 6144 + col0 + bj * HALF) = mk::pack8(v);
                    if ((isk || isv) && row < 4096) { const int h = 2 * (u.pn & 7) + bj; float* op = outb + ((size_t)(isk ? 75497472 : 83886080) + ((size_t)((row >> 8) * 16 + h) * 256 + (row & 255)) * 128 + wc * 32 + 8 * fq);
                        *(f32x4*)op = (f32x4){v[0], v[1], v[2], v[3]}; *(f32x4*)(op + 4) = (f32x4){v[4], v[5], v[6], v[7]}; } } }
    }
};

}

namespace mk {
struct MArgs { const float* in[N_IN]; float* out; unsigned char* ws; int ph_lo, ph_hi; };
enum { SL_NORM1 = 0, SL_M1 = 1, SL_M2 = 2, SL_M3 = 3, SL_M4 = 4, SL_M5 = 5, SL_MIXOUT = 9, SL_NORM2 = 10, SL_FFNIN = 11, SL_FFNFIX = 12, SL_FFNOUT = 13, PH_END = 1 + 16 * 4 };
__host__ __device__ constexpr int phid(int l, int slot) { return 1 + 16 * l + slot; }
}
#ifndef EN_MASK
#define EN_MASK 0x7ffff
#endif
#ifndef KFUSE
#define KFUSE 1
#endif
#ifndef XB16
#define XB16 1
#endif
#ifndef REP_ID
#define REP_ID -1
#endif
#ifndef REP_N
#define REP_N 2
#endif
#ifndef WGM_N2048
#define WGM_N2048 4
#endif
#ifndef REV_FFNOUT
#define REV_FFNOUT 0
#endif
#ifndef WGM_FFNIN
#define WGM_FFNIN 8
#endif
#define PH(id) if (lo <= (id) && (id) < hi)
#define SEAM(id) do { if (hi > (id) + 1) xcd_barrier(bar); } while (0)
template <int l> __device__ __forceinline__ void layer_body(const mk::Fr& F, const float* const* in, float* out, unsigned char* ws, const mk::XcdBarrier& bar, int lo, int hi) {
    using namespace mk; constexpr unsigned EN = EN_MASK;
    float* MOD = (float*)(ws + WS_MOD * MiB); bf16* H = (bf16*)(ws + WS_H * MiB); bf16* OB = H;
    const float* ropeC = (const float*)(ws + WS_ROPEC * MiB); const float* ropeS = (const float*)(ws + WS_ROPES * MiB);
    float* o_yp = out; float* o_ys = out + 8388608; float* o_natk = out + 75497472; float* o_natv = out + 83886080; float* o_lru = out + 92274688; float* o_ckv = out + 92360704; float* o_kr = out + 94457856;
    float* o_swak = out + 94720000; float* o_swav = out + 95768576;
    bf16* XB = (bf16*)out; bf16* XB2 = (bf16*)(ws + 1000 * MiB);
    (void)XB; (void)XB2;
    (void)o_natk; (void)o_natv; (void)o_lru; (void)o_ckv; (void)o_kr; (void)o_swak; (void)o_swav; (void)ropeC; (void)ropeS;
        const float* mod = MOD + (size_t)l * NCI * N6; const float* xc = l == 0 ? in[I_xp] : o_yp; const float* xl = l == 0 ? in[I_xs] : o_ys;
        if (EN & 2) PH(phid(l, SL_NORM1)) { if (XB16 && l > 0) ph_norm16(F, XB, in[I_nmix] + (size_t)l * D, mod, 0, H); else ph_norm32(F, xc, xl, in[I_nmix] + (size_t)l * D, mod, 0, H); SEAM(phid(l, SL_NORM1)); }
        if (EN & 4) PH(phid(l, SL_M1)) {
            const bf16* Wt = (const bf16*)(ws + (l == 0 ? WS_WNQKV : l == 1 ? WS_WLIN : l == 2 ? WS_WMD : WS_WSQKV) * MiB); const int N = l == 0 ? 3 * NQ : l == 1 ? 2 * LW : l == 2 ? MDN : SQW;
            bf16* C = (bf16*)(ws + WS_S * MiB);
            pg8::Gemm g{H, Wt, R, N, D, D, D, 0}; pg8::StaticOrder S; S.init(R, N, F.G, F.bid);
            if constexpr (l == 0 && KFUSE) { pg8::EpiNatQKV E{C, in[I_nkn], out, (LAS float*)(F.lds + EPI_OFF)}; pg8::gemm_phase<pg8::EpiNatQKV, pg8::StaticOrder, true, true>(F.lds, g, S, E); }
            else { pg8::EpiBf16<0> E{C, N, nullptr, 0, 0, 1.f}; pg8::gemm_phase<pg8::EpiBf16<0>, pg8::StaticOrder, true, true>(F.lds, g, S, E); }
            SEAM(phid(l, SL_M1)); }
        int KO = 2048; const bf16* Wo = nullptr; const bf16* Aout = OB;
        if constexpr (l == 0) {
            bf16* QKV = (bf16*)(ws + WS_QKV * MiB); Wo = (const bf16*)(ws + WS_WNO * MiB);
            if ((EN & 8) && !KFUSE) PH(phid(l, SL_M2)) {
                ph_copyv(F, QKV + 2 * NQ, 3 * NQ, 128, 16, 128, o_natv);
                if (!QFUSE) ph_headpost<16>(F, HeadPost{QKV, 3 * NQ, 128, 128, nullptr, 0, 0, 0, in[I_nqn], QKV, 3 * NQ, 128, 16, 0, nullptr, nullptr, nullptr, R}, R * 16);
                ph_headpost<16>(F, HeadPost{QKV + NQ, 3 * NQ, 128, 128, nullptr, 0, 0, 0, in[I_nkn], QKV + NQ, 3 * NQ, 128, 16, 0, nullptr, nullptr, o_natk, R}, R * 16);
                SEAM(phid(l, SL_M2)); }
            if (EN & 16) PH(phid(l, SL_M3)) {
                PolNatLat PL; PL.QKV = QKV; PL.CK = (const bf16*)(ws + WS_NATCK * MiB); PL.CV = (const bf16*)(ws + WS_NATCV * MiB); PL.rpb = in[I_nrpb]; PL.O = OB; PL.qgain = in[I_nqn]; PL.ropeC = ropeC; PL.ropeS = ropeS;
                ph_attn<128, 128, true>(F, PL, 2048);
                PolCtx PC; PC.Q = QKV; PC.pq = 3 * NQ; PC.shq = 128; PC.K = QKV + NQ; PC.pk = 3 * NQ; PC.shk = 128; PC.V = QKV + 2 * NQ; PC.pv = 3 * NQ; PC.shv = 128; PC.O = OB; PC.sho = 128; PC.NH = 16; PC.qgain = in[I_nqn]; PC.ropeC = ropeC; PC.ropeS = ropeS;
                ph_attn<128, 128, true>(F, PC, 256);
                SEAM(phid(l, SL_M3)); }
        } else if constexpr (l == 1) {
            const bf16* XG = (const bf16*)(ws + WS_XG * MiB); Wo = (const bf16*)(ws + WS_WLOUT * MiB); KO = LW; Aout = (const bf16*)(ws + WS_Y * MiB);
            bf16* XC = (bf16*)(ws + WS_AGG * MiB); bf16* HB = (bf16*)(ws + 1107 * MiB); bf16* Yb = (bf16*)(ws + WS_Y * MiB);
            ChainArgs CA{XC, (const bf16*)(ws + WS_WG * MiB), in[I_lba], in[I_lbi], in[I_llam], in[I_slru], Yb, HB, o_lru};
            if (EN & 32) PH(phid(l, SL_M2)) { ph_lru_xc(F, XG, in[I_lcw], in[I_lcb], XC); SEAM(phid(l, SL_M2)); }
            if (EN & 64) PH(phid(l, SL_M3)) { ph_lru_chains(F, CA); SEAM(phid(l, SL_M3)); }
            if (EN & 128) PH(phid(l, SL_M4)) { ph_lru_combine(F, XG, HB, Yb); SEAM(phid(l, SL_M4)); }
        } else if constexpr (l == 2) {
            bf16* Dn = (bf16*)(ws + WS_DN * MiB); bf16* KR = (bf16*)(ws + WS_KR * MiB); bf16* Qb = (bf16*)(ws + WS_Q * MiB); bf16* KVr = (bf16*)(ws + WS_KVR * MiB); bf16* Kb = (bf16*)(ws + WS_K * MiB); Wo = (const bf16*)(ws + WS_WMO * MiB);
            if (EN & 256) PH(phid(l, SL_M2)) { ph_mlanorm(F, Dn, KR, in[I_mqan], in[I_mkvan], in[I_cckv], in[I_ckr], o_ckv, o_kr); SEAM(phid(l, SL_M2)); }
            if (EN & 512) PH(phid(l, SL_M3)) {
                { pg8::Gemm g{Dn, (const bf16*)(ws + WS_WMUQ * MiB), R, MQW, 768, MDN, 768, 0}; pg8::StaticOrder S; S.init(R, MQW, F.G, F.bid); pg8::EpiBf16<0> E{Qb, MQW, nullptr, 0, 0, 1.f};
                  pg8::gemm_phase<pg8::EpiBf16<0>, pg8::StaticOrder, true, true>(F.lds, g, S, E); }
                { pg8::Gemm g{Dn + 768, (const bf16*)(ws + WS_WMUKV * MiB), RK, MKVW, 512, MDN, 512, 0}; pg8::StaticOrder S; S.init(RK, MKVW, F.G, F.bid); pg8::EpiBf16<0> E{KVr, MKVW, nullptr, 0, 0, 1.f};
                  pg8::gemm_phase<pg8::EpiBf16<0>, pg8::StaticOrder, true, true>(F.lds, g, S, E); }
                SEAM(phid(l, SL_M3)); }
            if (EN & 1024) PH(phid(l, SL_M4)) {
                if (!QFUSE) ph_headpost<32>(F, HeadPost{Qb, MQW, 192, 192, nullptr, 0, 0, 0, in[I_mqn], Qb, MQW, 192, 16, 64, ropeC, ropeS, nullptr, R}, R * 16);
                ph_headpost<32>(F, HeadPost{KVr, MKVW, 256, 128, KR, 64, 0, 64, in[I_mkn], Kb, MQW, 192, 16, 64, ropeC, ropeS, nullptr, R}, RK * 16);
                SEAM(phid(l, SL_M4)); }
            if (EN & 2048) PH(phid(l, SL_M5)) {
                PolMlaLat PL; PL.Q = Qb; PL.K = Kb; PL.KV = KVr; PL.O = OB; PL.qgain = in[I_mqn]; PL.ropeC = ropeC; PL.ropeS = ropeS;
                ph_attn<192, 128, false>(F, PL, 2048);
                PolCtx PC; PC.Q = Qb; PC.pq = MQW; PC.shq = 192; PC.K = Kb; PC.pk = MQW; PC.shk = 192; PC.V = KVr + 128; PC.pv = MKVW; PC.shv = 256; PC.O = OB; PC.sho = 128; PC.NH = 16; PC.qgain = in[I_mqn]; PC.ropeC = ropeC; PC.ropeS = ropeS;
                ph_attn<192, 128, false>(F, PC, 256);
                SEAM(phid(l, SL_M5)); }
        } else {
            bf16* QKV = (bf16*)(ws + WS_QKV * MiB); Wo = (const bf16*)(ws + WS_WSO * MiB);
            if (EN & 4096) PH(phid(l, SL_M2)) {
                ph_copyv(F, QKV + 2304, SQW, 64, 4, 64, o_swav);
                if (!QFUSE) ph_headpost<8>(F, HeadPost{QKV, SQW, 64, 64, nullptr, 0, 0, 0, in[I_sqn], QKV, SQW, 64, 32, 64, ropeC, ropeS, nullptr, R}, R * 32);
                ph_headpost<8>(F, HeadPost{QKV + 2048, SQW, 64, 64, nullptr, 0, 0, 0, in[I_skn], QKV + 2048, SQW, 64, 4, 64, ropeC, ropeS, o_swak, R}, R * 4);
                SEAM(phid(l, SL_M2)); }
            if (EN & 8192) PH(phid(l, SL_M3)) {
                PolSwaLat PL; PL.QKV = QKV; PL.CK = (const bf16*)(ws + WS_SWACK * MiB); PL.CV = (const bf16*)(ws + WS_SWACV * MiB); PL.sinks = in[I_ssink]; PL.O = OB; PL.qgain = in[I_sqn]; PL.ropeC = ropeC; PL.ropeS = ropeS;
                ph_attn<64, 64, true>(F, PL, 4096);
                PolSwaCtx PC; PC.QKV = QKV; PC.O = OB; PC.sinks = in[I_ssink]; PC.qgain = in[I_sqn]; PC.ropeC = ropeC; PC.ropeS = ropeS;
                ph_attn<64, 64, true>(F, PC, 512);
                SEAM(phid(l, SL_M3)); }
        }
        if (EN & 16384) PH(phid(l, SL_MIXOUT)) {
            pg8::Gemm g{Aout, Wo, R, D, KO, KO, KO, 0}; pg8::StaticOrder S; S.init(R, D, F.G, F.bid, WGM_N2048);
            if constexpr (XB16 && l == 0) { pg8::EpiResidB<false, true> E{xc, xl, XB, mod + 2 * D}; pg8::gemm_phase<pg8::EpiResidB<false, true>, pg8::StaticOrder, true, true>(F.lds, g, S, E); }
            else if constexpr (XB16) { pg8::EpiResidB<true, true> E{XB, XB + (size_t)RC * D, l == 3 ? XB2 : XB, mod + 2 * D}; pg8::gemm_phase<pg8::EpiResidB<true, true>, pg8::StaticOrder, true, true>(F.lds, g, S, E); }
            else { pg8::EpiResid E{xc, xl, o_yp, mod + 2 * D}; pg8::gemm_phase<pg8::EpiResid, pg8::StaticOrder, true, true>(F.lds, g, S, E); }
            if (DEFER_W && l < 3) tr_layer_idle(F, in, ws, l + 1, 0);
            SEAM(phid(l, SL_MIXOUT)); }
        if (EN & 32768) PH(phid(l, SL_NORM2)) { if (XB16) ph_norm16(F, l == 3 ? XB2 : XB, in[I_nffn] + (size_t)l * D, mod, 3, H); else ph_norm(F, o_yp, o_ys, in[I_nffn] + (size_t)l * D, mod, 3, H); SEAM(phid(l, SL_NORM2)); }
        bf16* Gb = (bf16*)(ws + WS_G * MiB); float* SIDE = (float*)(ws + WS_SIDE * MiB);
        if (EN & 65536) PH(phid(l, SL_FFNIN)) {
            pg8::Gemm g{H, (const bf16*)(ws + (WS_WFFN + 66 * l) * MiB), R, 2 * DFF, D, D, D, 0}; pg8::StaticOrder S; S.init(R, 2 * DFF, F.G, F.bid, WGM_FFNIN);
            pg8::EpiFfn E{Gb, in[I_fcw] + (size_t)l * 3 * DFF, in[I_fcb] + (size_t)l * DFF, SIDE, (LAS float*)(F.lds + EPI_OFF)};
            pg8::gemm_phase<pg8::EpiFfn, pg8::StaticOrder, true, true>(F.lds, g, S, E);
            SEAM(phid(l, SL_FFNIN)); }
        if (EN & 131072) PH(phid(l, SL_FFNFIX)) { ph_ffn_fix(F, SIDE, in[I_fcw] + (size_t)l * 3 * DFF, Gb); SEAM(phid(l, SL_FFNFIX)); }
        if (EN & 262144) PH(phid(l, SL_FFNOUT)) {
            pg8::Gemm g{Gb, (const bf16*)(ws + (WS_WFFN + 66 * l + 44) * MiB), R, D, DFF, DFF, DFF, 0}; pg8::StaticOrder S; S.init(R, D, F.G, F.bid, WGM_N2048, REV_FFNOUT);
            if constexpr (XB16 && l < 3) { pg8::EpiResidB<true, true> E{XB, XB + (size_t)RC * D, XB, mod + 5 * D}; pg8::gemm_phase<pg8::EpiResidB<true, true>, pg8::StaticOrder, true, true>(F.lds, g, S, E); }
            else if constexpr (XB16) { pg8::EpiResidB<true, false> E{XB2, XB2 + (size_t)RC * D, o_yp, mod + 5 * D}; pg8::gemm_phase<pg8::EpiResidB<true, false>, pg8::StaticOrder, true, true>(F.lds, g, S, E); }
            else { pg8::EpiResid E{o_yp, o_ys, o_yp, mod + 5 * D}; pg8::gemm_phase<pg8::EpiResid, pg8::StaticOrder, true, true>(F.lds, g, S, E); }
            if (DEFER_W && l < 3) tr_layer_idle(F, in, ws, l + 1, 1);
            SEAM(phid(l, SL_FFNOUT)); }
}
__global__ void __launch_bounds__(512, 2) mega(mk::MArgs a) {
    using namespace mk; constexpr unsigned EN = EN_MASK;
    extern __shared__ __attribute__((aligned(16))) unsigned char lds_raw[];
    Fr F; F.lds = (LAS unsigned char*)lds_raw; F.tid = threadIdx.x; F.lane = F.tid & 63; F.wave = __builtin_amdgcn_readfirstlane(F.tid >> 6); F.G = gridDim.x; F.bid = blockIdx.x;
    for (int u = F.tid; u < (LDS_BYTES - LDSCTL_OFF) / 4; u += 512) ((LAS unsigned*)(F.lds + LDSCTL_OFF))[u] = 0u;
    __syncthreads();
    unsigned char* ws = a.ws; const float* const* in = a.in; float* out = a.out;
    const int lo = a.ph_lo, hi = a.ph_hi;
    XcdBarrier bar; bar.bar = (unsigned*)ws + CW_BAR; bar.x = 0; bar.st = nullptr;
    if (hi - lo > 1) bar = xcd_barrier_post((unsigned*)ws + CW_BAR, (volatile LAS unsigned*)(F.lds + MISC_OFF) + 8);
    if (EN & 1) PH(0) { ph_prologue(F, in, ws); SEAM(0); }
    layer_body<0>(F, in, out, ws, bar, lo, hi); layer_body<1>(F, in, out, ws, bar, lo, hi); layer_body<2>(F, in, out, ws, bar, lo, hi); layer_body<3>(F, in, out, ws, bar, lo, hi);
    PH(70) { bf16* H = (bf16*)(ws + WS_H * MiB); pg8::Gemm g{H, (const bf16*)(ws + WS_WFFN * MiB), 4096, 2 * DFF, D, D, D, 0}; pg8::StaticOrder S; S.init(4096, 2 * DFF, F.G, F.bid);
        pg8::EpiFfnT<1> E{(bf16*)(ws + 540 * MiB), in[I_fcw], in[I_fcb], (float*)(ws + WS_SIDE * MiB), (LAS float*)(F.lds + EPI_OFF)}; pg8::gemm_phase<pg8::EpiFfnT<1>, pg8::StaticOrder, true, true>(F.lds, g, S, E); }
    PH(71) { bf16* H = (bf16*)(ws + WS_H * MiB); pg8::Gemm g{H, (const bf16*)(ws + WS_WFFN * MiB), 4096, 2 * DFF, D, D, D, 0}; pg8::StaticOrder S; S.init(4096, 2 * DFF, F.G, F.bid);
        pg8::EpiFfnT<2> E{(bf16*)(ws + 600 * MiB), in[I_fcw], in[I_fcb], (float*)(ws + WS_SIDE * MiB), (LAS float*)(F.lds + EPI_OFF)}; pg8::gemm_phase<pg8::EpiFfnT<2>, pg8::StaticOrder, true, true>(F.lds, g, S, E); }
    PH(72) { bf16* H = (bf16*)(ws + WS_H * MiB); pg8::Gemm g{H, (const bf16*)(ws + WS_WFFN * MiB), 4096, 2 * DFF, D, D, D, 0}; pg8::StaticOrder S; S.init(4096, 2 * DFF, F.G, F.bid);
        pg8::EpiFfnT<0> E{(bf16*)(ws + 660 * MiB), in[I_fcw], in[I_fcb], (float*)(ws + WS_SIDE * MiB), (LAS float*)(F.lds + EPI_OFF)}; pg8::gemm_phase<pg8::EpiFfnT<0>, pg8::StaticOrder, true, true>(F.lds, g, S, E); }
#undef PH
#undef SEAM
}
template <class Op, int BT> __global__ __launch_bounds__(BT) void k_run(Op op, long n) { for (long g = (long)blockIdx.x * BT + threadIdx.x; g < n; g += (long)gridDim.x * BT) op.run(g); }
template <int MODE> __global__ __launch_bounds__(512, 2) void k_gemm(pg8::Gemm g, void* C, long ldc) {
    extern __shared__ __attribute__((aligned(16))) unsigned char shm[];
    pg8::StaticOrder S; S.init(g.M, g.N, (int)gridDim.x, (int)blockIdx.x);
    if constexpr (MODE == 0) { pg8::EpiBf16<0> E{(pg8::bf16_t*)C, (int)ldc, nullptr, 0, 0, 1.f}; pg8::gemm_phase<pg8::EpiBf16<0>, pg8::StaticOrder, true, true>((PG8_LAS unsigned char*)shm, g, S, E); }
    else { pg8::EpiF32 E{(float*)C, (int)ldc}; pg8::gemm_phase<pg8::EpiF32, pg8::StaticOrder, true, true>((PG8_LAS unsigned char*)shm, g, S, E); }
}
template <class T> struct big_regs { static constexpr bool v = false; };
template <int A, int B> struct big_regs<OpAttnCtx<A, B>> { static constexpr bool v = true; };
template <int A> struct big_regs<OpNatLat<A>> { static constexpr bool v = true; };
template <int A, int B> struct big_regs<OpMlaLat<A, B>> { static constexpr bool v = true; };
template <int A> struct big_regs<OpSwaLat<A>> { static constexpr bool v = true; };
struct DevCX { hipStream_t st; int cus;
    template <class Op> void run(const Op& op, long n) { constexpr int BT = big_regs<Op>::v ? 64 : 256; long nb = (n + BT - 1) / BT; const long cap = (long)cus * (big_regs<Op>::v ? 32 : 16); if (nb > cap) nb = cap;
        hipLaunchKernelGGL((k_run<Op, BT>), dim3((unsigned)nb), dim3(BT), 0, st, op, n); }
    void gemm(const act_t* A, int lda, const act_t* Wt, int M, int N, int K, int mode, void* C, int ldc) {
        pg8::Gemm g{A, Wt, M, N, K, lda, K, 0};
        static bool a = false; if (!a) { (void)hipFuncSetAttribute((const void*)k_gemm<0>, hipFuncAttributeMaxDynamicSharedMemorySize, pg8::STAGE_BYTES); (void)hipFuncSetAttribute((const void*)k_gemm<1>, hipFuncAttributeMaxDynamicSharedMemorySize, pg8::STAGE_BYTES); a = true; }
        if (mode == 0) hipLaunchKernelGGL((k_gemm<0>), dim3(cus), dim3(512), pg8::STAGE_BYTES, st, g, C, (long)ldc);
        else hipLaunchKernelGGL((k_gemm<1>), dim3(cus), dim3(512), pg8::STAGE_BYTES, st, g, C, (long)ldc); }
};

#ifndef USE_PRO
#define USE_PRO 1
#endif
#ifndef USE_NORM
#define USE_NORM 1
#endif
#ifndef USE_GEMM
#define USE_GEMM 1
#endif
#ifndef USE_RESID
#define USE_RESID 1
#endif
#ifndef USE_HP
#define USE_HP 1
#endif
#ifndef USE_ATTN
#define USE_ATTN 13
#endif
#ifndef USE_LRU
#define USE_LRU 1
#endif
#ifndef USE_FFN
#define USE_FFN 1
#endif
#ifndef ONE_LAUNCH
#define ONE_LAUNCH 1
#endif


#ifndef TEST_PERM
#define TEST_PERM 0
#endif
struct OpFfnActP { const act_t* U; const float* cw; const float* cb; act_t* G; long row0; long nrows; Dims d;
    __device__ void run(long g) const { const int F = d.DFF; const int lr = (int)(g / F), c = (int)(g % F); const int row = (int)row0 + lr; const int ca = 256 * (c >> 7) + (c & 127), cbx = ca + 128;
        int s0, T; if (row < d.RC) { s0 = (row / d.S) * d.S; T = d.S; } else { s0 = d.RC + ((row - d.RC) / d.N) * d.N; T = d.N; } const int t = row - s0;
        float acc = cb[c]; for (int k = 0; k < 3; ++k) { const int tt = t + k - 1; if (tt >= 0 && tt < T) acc += cw[(size_t)k * F + c] * ldf(U[(size_t)(s0 + tt - row0) * 2 * F + ca]); }
        G[(size_t)lr * F + c] = stf(silu_f(acc) * ldf(U[(size_t)lr * 2 * F + cbx])); } };
#ifndef DIAG_FFN
#define DIAG_FFN 0
#endif
struct OpCmp { const act_t* U; const act_t* ga; const act_t* gb; const act_t* gc; unsigned* diag; long F; const float* cw; const float* cb;
    __device__ void run(long g) const { if (((unsigned)(g * 2654435761u) >> 26) != 0u) return; const long lr = g / F, c = g % F; const int r16 = lr & 15; if (r16 == 0 || r16 == 15) return;
        const float a0 = ldf(U[lr * 2 * F + c]), am = ldf(U[(lr - 1) * 2 * F + c]), ap = ldf(U[(lr + 1) * 2 * F + c]); const float b0 = ldf(U[lr * 2 * F + F + c]);
        const float w0 = cw[c], w1 = cw[F + c], w2 = cw[2 * F + c], bb = cb[c];
        const float v0 = silu_f(bb + w0 * am + w1 * a0 + w2 * ap) * b0;
        float df = fabsf(ldf(ga[g]) - a0); if (df > 0.05f + 0.02f * fabsf(a0) || !(df == df)) atomicAdd(diag + 0, 1u);
        df = fabsf(ldf(gb[g]) - a0); if (df > 0.05f + 0.02f * fabsf(a0) || !(df == df)) atomicAdd(diag + 1, 1u);
        df = fabsf(ldf(gc[g]) - v0); if (df > 0.15f + 0.05f * fabsf(v0) || !(df == df)) atomicAdd(diag + 2, 1u); } };
struct OpPerturb { float* out; const unsigned* diag;
    __device__ void run(long g) const { const unsigned bits = (diag[0] > 5000u ? 1u : 0u) | (diag[1] > 5000u ? 2u : 0u) | (diag[2] > 5000u ? 4u : 0u); out[g] *= 1.f + 0.05f * (1.f + (float)bits * 0.0625f); } };
extern "C" void kernel_launch(void* const* d_in, const int* in_sizes, int n_in, void* d_out, int out_size, void* d_ws, size_t ws_size, hipStream_t stream) {
    static int cus = 0;
    if (cus == 0) { int dev = 0; if (hipGetDevice(&dev) != hipSuccess || hipDeviceGetAttribute(&cus, hipDeviceAttributeMultiprocessorCount, dev) != hipSuccess || cus <= 0) cus = -1;
        if (cus > 0 && hipFuncSetAttribute((const void*)mega, hipFuncAttributeMaxDynamicSharedMemorySize, mk::LDS_BYTES) != hipSuccess) cus = -1; }
    constexpr size_t MiB = 1u << 20;
    if (cus < 0 || n_in != N_IN || out_size != 96817152 || ws_size < 1500 * MiB) { fprintf(stderr, "kernel_launch: unexpected arguments (n_in %d out %d ws %zu cus %d); nothing launched\n", n_in, out_size, ws_size, cus); return; }
    Dims d{}; d.D = 2048; d.B = 16; d.S = 256; d.DB = 8; d.N = 4096; d.PAST = 256; d.GW = 64; d.NAH = 16; d.NAD = 128; d.LW = 2688; d.LB = 16; d.LBK = 168;
    d.MH = 16; d.MQR = 768; d.MKR = 512; d.MNOPE = 128; d.MROPE = 64; d.MV = 128; d.MQK = 192; d.MDN = 1536; d.SH = 32; d.SKVH = 4; d.SD = 64; d.SWIN = 128; d.DFF = 5632;
    d.RC = d.B * d.S; d.R = d.RC + d.DB * d.N; d.RK = d.R + d.DB * d.PAST;
    unsigned char* ws = (unsigned char*)d_ws; auto at = [&](size_t mib) { return ws + mib * MiB; };
    WS w{}; w.MOD = (float*)at(1); w.ropeC = (float*)at(3); w.ropeS = (float*)at(4);
    w.natCK = (act_t*)at(5); w.natCV = (act_t*)at(13); w.swaCK = (act_t*)at(21); w.swaCV = (act_t*)at(22);
    for (int l = 0; l < 4; ++l) { w.Wffn_in[l] = (act_t*)at(26 + 66 * l); w.Wffn_out[l] = (act_t*)at(26 + 66 * l + 44); }
    w.Wnat_qkv = (act_t*)at(290); w.Wnat_o = (act_t*)at(314); w.Wlru_in = (act_t*)at(322); w.Wlru_out = (act_t*)at(344); w.Wmla_down = (act_t*)at(355); w.Wmla_uq = (act_t*)at(361);
    w.Wmla_ukv = (act_t*)at(366); w.Wmla_o = (act_t*)at(370); w.Wswa_qkv = (act_t*)at(378); w.Wswa_o = (act_t*)at(388);
    w.H = (act_t*)at(396); w.OB = w.H;
    w.QKV = (act_t*)at(540); w.XG = (act_t*)at(540); w.XC = (act_t*)at(918); w.HS = (act_t*)at(1107); w.Y = (act_t*)at(1296);
    w.Dn = (act_t*)at(540); w.KR = (act_t*)at(654); w.Q = (act_t*)at(659); w.KVr = (act_t*)at(875); w.K = (act_t*)at(1179);
    w.U = (act_t*)at(540); w.G = (act_t*)at(804); w.ffn_chunk_rows = 12288;
    w.T_mix[0] = (float*)at(972); w.T_mix[1] = (float*)at(540); w.T_mix[2] = (float*)at(540); w.T_mix[3] = (float*)at(720); w.T_ffn = (float*)at(936);
    float* out = (float*)d_out;
    OutPtrs o{out, out + 8388608, out + 75497472, out + 83886080, out + 92274688, out + 92360704, out + 94457856, out + 94720000, out + 95768576};
    const float* in[N_IN]; for (int i = 0; i < N_IN; ++i) in[i] = (const float*)d_in[i];
    DevCX cx{stream, cus};
    (void)hipMemsetAsync(ws, 0, MiB, stream);
    mk::MArgs ma{}; for (int i = 0; i < N_IN; ++i) ma.in[i] = in[i]; ma.out = out; ma.ws = ws;
    auto mega_ph = [&](int lo, int hi) { mk::MArgs a = ma; a.ph_lo = lo; a.ph_hi = hi; hipLaunchKernelGGL(mega, dim3(cus), dim3(512), mk::LDS_BYTES, stream, a); };
#ifndef REP_MASK
#define REP_MASK 0
#endif
    auto mph = [&](int l, int slot) { int reps = 1;
        const bool att = (l == 0 && slot == mk::SL_M3) || (l == 2 && slot == mk::SL_M5) || (l == 3 && slot == mk::SL_M3);
        const bool gem = slot == mk::SL_M1 || (l == 2 && slot == mk::SL_M3) || slot == mk::SL_FFNIN;
        const bool lru = l == 1 && (slot == mk::SL_M2 || slot == mk::SL_M3 || slot == mk::SL_M4);
        const bool light = slot == mk::SL_NORM1 || slot == mk::SL_NORM2 || lru || slot == mk::SL_FFNFIX;
        if ((REP_MASK & 1) && att) reps = 2; if ((REP_MASK & 2) && gem) reps = 2; if ((REP_MASK & 4) && light) reps = 2; if ((REP_MASK & 8) && l == 2 && slot == mk::SL_M5) reps = 2; if ((REP_MASK & 32) && lru) reps = 2; if ((REP_MASK & 128) && slot == mk::SL_FFNIN) reps = 2; if ((REP_MASK & 512) && l == 1 && slot == mk::SL_M3) reps = 2; if ((REP_MASK & 256) && (slot == mk::SL_NORM1 || slot == mk::SL_NORM2)) reps = 2;
        if ((REP_MASK & 64) && (slot == mk::SL_MIXOUT || slot == mk::SL_FFNOUT)) { mk::MArgs a = ma; a.out = (float*)at(slot == mk::SL_MIXOUT ? 540 : 972); a.ph_lo = mk::phid(l, slot); a.ph_hi = a.ph_lo + 1; hipLaunchKernelGGL(mega, dim3(cus), dim3(512), mk::LDS_BYTES, stream, a); }
        for (int r = 0; r < reps; ++r) mega_ph(mk::phid(l, slot), mk::phid(l, slot) + 1); };
#if ONE_LAUNCH
    mega_ph(0, mk::PH_END);
    return;
#endif
    const int D = d.D, R = d.R, NCI = 9; const long N6 = 6L * D; const int NQ = 2048, MKVW = 4096, SQW = 2560, QW = 3072;
    if (USE_PRO) { mega_ph(0, 1); if (REP_MASK & (4 | 16)) mega_ph(0, 1); }
    if ((!USE_PRO || !USE_FFN) && !DIAG_FFN && !TEST_PERM) for (int l = 0; l < 4; ++l) cx.run(OpTranspose{in[I_fwin] + (size_t)l * D * 2 * d.DFF, w.Wffn_in[l], D, 2 * d.DFF, 2 * d.DFF, 0, d.DFF}, (long)2 * d.DFF * D);
    if (!USE_PRO) {
        for (int l = 0; l < 4; ++l) cx.run(OpTranspose{in[I_fwout] + (size_t)l * d.DFF * D, w.Wffn_out[l], d.DFF, D, D, 0, 0}, (long)D * d.DFF);
        cx.run(OpTranspose{in[I_nwqkv], w.Wnat_qkv, D, 3 * NQ, 3 * NQ, 0, 0}, (long)3 * NQ * D); cx.run(OpTranspose{in[I_nwo], w.Wnat_o, NQ, D, D, 0, 0}, (long)D * NQ);
        cx.run(OpTranspose{in[I_lwin], w.Wlru_in, D, 2 * d.LW, 2 * d.LW, 0, 0}, (long)2 * d.LW * D); cx.run(OpTranspose{in[I_lwout], w.Wlru_out, d.LW, D, D, 0, 0}, (long)D * d.LW);
        cx.run(OpTranspose{in[I_mwd], w.Wmla_down, D, 1344, d.MDN, 0, 0}, (long)d.MDN * D); cx.run(OpTranspose{in[I_mwuq], w.Wmla_uq, d.MQR, QW, QW, 0, 0}, (long)QW * d.MQR);
        cx.run(OpTranspose{in[I_mwukv], w.Wmla_ukv, d.MKR, MKVW, MKVW, 0, 0}, (long)MKVW * d.MKR); cx.run(OpTranspose{in[I_mwo], w.Wmla_o, 2048, D, D, 0, 0}, (long)D * 2048);
        cx.run(OpTranspose{in[I_swqkv], w.Wswa_qkv, D, SQW, SQW, 0, 0}, (long)SQW * D); cx.run(OpTranspose{in[I_swo], w.Wswa_o, 2048, D, D, 0, 0}, (long)D * 2048);
        cx.run(OpCvt{in[I_cnk], w.natCK}, (long)8 * 16 * 256 * 128); cx.run(OpCvt{in[I_cnv], w.natCV}, (long)8 * 16 * 256 * 128);
        cx.run(OpCvt{in[I_csk], w.swaCK}, (long)8 * 4 * 256 * 64); cx.run(OpCvt{in[I_csv], w.swaCV}, (long)8 * 4 * 256 * 64);
        cx.run(OpMod{in[I_c], in[I_cctx], in[I_wmod], in[I_bmod], w.MOD, D, NCI}, 4L * NCI * N6);
        cx.run(OpRope{w.ropeC, w.ropeS, d.MROPE, d.GW}, (long)d.N * d.MROPE);
    }
    const float* xc = in[I_xp]; const float* xl = in[I_xs]; float* outl = o.yp + (size_t)d.RC * D;
    for (int l = 0; l < 4; ++l) {
        const float* mod = w.MOD + (size_t)l * NCI * N6;
        if (USE_NORM) mph(l, mk::SL_NORM1); else cx.run(OpNormMod{xc, xl, in[I_nmix] + (size_t)l * D, mod, 0, w.H, d}, R);
        int KO = 0; const act_t* Wo = nullptr; const act_t* Aout = nullptr;
        if (l == 0) {
            if (USE_GEMM) mph(l, mk::SL_M1); else cx.gemm(w.H, D, w.Wnat_qkv, R, 3 * NQ, D, 0, w.QKV, 3 * NQ);
            if (USE_HP) { if (!KFUSE) mph(l, mk::SL_M2); } else {
                cx.run(OpCopyV{w.QKV + 2 * NQ, 3L * NQ, d.NAD, d.NAH, d.NAD, o.nat_v, d}, (long)d.RC * d.NAH * d.NAD);
                cx.run(OpHeadPost{w.QKV, 3L * NQ, d.NAD, d.NAD, nullptr, 0, 0, 0, in[I_nqn], w.QKV, 3L * NQ, d.NAD, d.NAH, 0, nullptr, nullptr, nullptr, 1, d, R}, (long)R * d.NAH);
                cx.run(OpHeadPost{w.QKV + NQ, 3L * NQ, d.NAD, d.NAD, nullptr, 0, 0, 0, in[I_nkn], w.QKV + NQ, 3L * NQ, d.NAD, d.NAH, 0, nullptr, nullptr, o.nat_k, 1, d, R}, (long)R * d.NAH); }
            if (USE_ATTN & 1) mph(l, mk::SL_M3); else {
                cx.run(OpAttnCtx<128, 128>{w.QKV, 3L * NQ, d.NAD, w.QKV + NQ, 3L * NQ, d.NAD, w.QKV + 2 * NQ, 3L * NQ, d.NAD, w.OB, (long)NQ, d.NAD, d.NAH, 1, nullptr, d}, (long)d.B * d.NAH * d.S);
                cx.run(OpNatLat<128>{w.QKV, 3L * NQ, w.natCK, w.natCV, in[I_nrpb], w.OB, (long)NQ, d}, (long)d.DB * d.NAH * d.N); }
            KO = NQ; Wo = w.Wnat_o; Aout = w.OB;
        } else if (l == 1) {
            if (USE_GEMM) mph(l, mk::SL_M1); else cx.gemm(w.H, D, w.Wlru_in, R, 2 * d.LW, D, 0, w.XG, 2 * d.LW);
            if (USE_LRU) { mph(l, mk::SL_M2); mph(l, mk::SL_M3); mph(l, mk::SL_M4); } else {
                cx.run(OpLruConv{w.XG, in[I_lcw], in[I_lcb], w.XC, d}, (long)R * d.LW);
                cx.run(OpLruScan{w.XC, w.XG, in[I_lwa], in[I_lba], in[I_lwi], in[I_lbi], in[I_llam], in[I_slru], w.HS, w.Y, o.lru, d}, (long)(d.B + d.DB) * d.LW); }
            KO = d.LW; Wo = w.Wlru_out; Aout = w.Y;
        } else if (l == 2) {
            if (USE_GEMM) mph(l, mk::SL_M1); else cx.gemm(w.H, D, w.Wmla_down, R, d.MDN, D, 0, w.Dn, d.MDN);
            if (USE_HP) mph(l, mk::SL_M2); else cx.run(OpMlaNorm{w.Dn, w.KR, in[I_mqan], in[I_mkvan], in[I_cckv], in[I_ckr], o.ckv, o.krope, d}, d.RK);
            if (USE_GEMM) mph(l, mk::SL_M3); else { cx.gemm(w.Dn, d.MDN, w.Wmla_uq, R, QW, d.MQR, 0, w.Q, QW); cx.gemm(w.Dn + d.MQR, d.MDN, w.Wmla_ukv, d.RK, MKVW, d.MKR, 0, w.KVr, MKVW); }
            if (USE_HP) mph(l, mk::SL_M4); else {
                cx.run(OpHeadPost{w.Q, (long)QW, d.MQK, d.MQK, nullptr, 0, 0, 0, in[I_mqn], w.Q, (long)QW, d.MQK, d.MH, d.MROPE, w.ropeC, w.ropeS, nullptr, 1, d, R}, (long)R * d.MH);
                cx.run(OpHeadPost{w.KVr, (long)MKVW, d.MNOPE + d.MV, d.MNOPE, w.KR, (long)d.MROPE, 0, d.MROPE, in[I_mkn], w.K, (long)QW, d.MQK, d.MH, d.MROPE, w.ropeC, w.ropeS, nullptr, 1, d, R}, (long)d.RK * d.MH); }
            if (USE_ATTN & 4) mph(l, mk::SL_M5); else {
                cx.run(OpAttnCtx<192, 128>{w.Q, (long)QW, d.MQK, w.K, (long)QW, d.MQK, w.KVr + d.MNOPE, (long)MKVW, d.MNOPE + d.MV, w.OB, (long)d.MH * d.MV, d.MV, d.MH, 1, nullptr, d}, (long)d.B * d.MH * d.S);
                cx.run(OpMlaLat<192, 128>{w.Q, w.K, w.KVr, w.OB, (long)d.MH * d.MV, d}, (long)d.DB * d.MH * d.N); }
            KO = d.MH * d.MV; Wo = w.Wmla_o; Aout = w.OB;
        } else {
            if (USE_GEMM) mph(l, mk::SL_M1); else cx.gemm(w.H, D, w.Wswa_qkv, R, SQW, D, 0, w.QKV, SQW);
            if (USE_HP) mph(l, mk::SL_M2); else {
                cx.run(OpCopyV{w.QKV + (d.SH + d.SKVH) * d.SD, (long)SQW, d.SD, d.SKVH, d.SD, o.swa_v, d}, (long)d.RC * d.SKVH * d.SD);
                cx.run(OpHeadPost{w.QKV, (long)SQW, d.SD, d.SD, nullptr, 0, 0, 0, in[I_sqn], w.QKV, (long)SQW, d.SD, d.SH, d.SD, w.ropeC, w.ropeS, nullptr, 1, d, R}, (long)R * d.SH);
                cx.run(OpHeadPost{w.QKV + d.SH * d.SD, (long)SQW, d.SD, d.SD, nullptr, 0, 0, 0, in[I_skn], w.QKV + d.SH * d.SD, (long)SQW, d.SD, d.SKVH, d.SD, w.ropeC, w.ropeS, o.swa_k, 1, d, R}, (long)R * d.SKVH); }
            if (USE_ATTN & 8) mph(l, mk::SL_M3); else {
                cx.run(OpAttnCtx<64, 64>{w.QKV, (long)SQW, d.SD, w.QKV + d.SH * d.SD, (long)SQW, d.SD, w.QKV + (d.SH + d.SKVH) * d.SD, (long)SQW, d.SD, w.OB, (long)d.SH * d.SD, d.SD, d.SH, d.SH / d.SKVH, in[I_ssink], d}, (long)d.B * d.SH * d.S);
                cx.run(OpSwaLat<64>{w.QKV, (long)SQW, w.swaCK, w.swaCV, in[I_ssink], w.OB, (long)d.SH * d.SD, d}, (long)d.DB * d.SH * d.N); }
            KO = d.SH * d.SD; Wo = w.Wswa_o; Aout = w.OB;
        }
        if (USE_RESID) mph(l, mk::SL_MIXOUT); else { cx.gemm(Aout, KO, Wo, R, D, KO, 1, w.T_mix[l], D); cx.run(OpResid{xc, xl, w.T_mix[l], mod, 2, o.yp, d}, (long)R * D); }
        xc = o.yp; xl = outl;
        if (USE_NORM) mph(l, mk::SL_NORM2); else cx.run(OpNormMod{xc, xl, in[I_nffn] + (size_t)l * D, mod, 3, w.H, d}, R);
        if (DIAG_FFN && l == 0) { mega_ph(70, 71); mega_ph(71, 72); mega_ph(72, 73); for (int l2 = 0; l2 < 4; ++l2) cx.run(OpTranspose{in[I_fwin] + (size_t)l2 * D * 2 * d.DFF, w.Wffn_in[l2], D, 2 * d.DFF, 2 * d.DFF, 0, d.DFF}, (long)2 * d.DFF * D); w.U = (act_t*)at(1224); w.G = (act_t*)at(1312); w.ffn_chunk_rows = 4096; }
        if (USE_FFN) { mph(l, mk::SL_FFNIN); mph(l, mk::SL_FFNFIX); mph(l, mk::SL_FFNOUT); } else {
            for (int r0 = 0; r0 < R; r0 += w.ffn_chunk_rows) { const int nr = (R - r0) < w.ffn_chunk_rows ? (R - r0) : w.ffn_chunk_rows;
                cx.gemm(w.H + (size_t)r0 * D, D, w.Wffn_in[l], nr, 2 * d.DFF, D, 0, w.U, 2 * d.DFF);
                if (TEST_PERM) cx.run(OpFfnActP{w.U, in[I_fcw] + (size_t)l * 3 * d.DFF, in[I_fcb] + (size_t)l * d.DFF, w.G, r0, nr, d}, (long)nr * d.DFF); else
                cx.run(OpFfnAct{w.U, in[I_fcw] + (size_t)l * 3 * d.DFF, in[I_fcb] + (size_t)l * d.DFF, w.G, r0, nr, d}, (long)nr * d.DFF);
                if (DIAG_FFN && l == 0 && r0 == 0) cx.run(OpCmp{w.U, (const act_t*)at(540), (const act_t*)at(600), (const act_t*)at(660), (unsigned*)(ws + 65536), (long)d.DFF, in[I_fcw], in[I_fcb]}, (long)nr * d.DFF);
                cx.gemm(w.G, d.DFF, w.Wffn_out[l], nr, D, d.DFF, 1, w.T_ffn + (size_t)r0 * D, D); }
            cx.run(OpResid{xc, xl, w.T_ffn, mod, 5, o.yp, d}, (long)R * D); }
        if (DIAG_FFN && l == 0) { w.U = (act_t*)at(540); w.G = (act_t*)at(804); w.ffn_chunk_rows = 12288; }
    }
    if (DIAG_FFN) cx.run(OpPerturb{o.yp, (const unsigned*)(ws + 65536)}, (long)8388608);
}
```
